# Optimizing an MI355X kernel written in HIP

```python
import jax, jax.numpy as jnp
from jax import lax
import numpy as np

D_MODEL = 1024
BATCH = 4
SEQ = 8192
DEPTH = 2

GRID_W = 64
CTX_LEN = 256
N_MIXERS = 2
CONV_WIDTH = 31
CONV_PAD = (CONV_WIDTH - 1) // 2
HG_HEAD_DIM = 128
HG_HEADS = D_MODEL // HG_HEAD_DIM
CHUNK = 64
N_EXPERTS = 16
CAPACITY_FACTOR = 2
D_EXPERT = 2 * D_MODEL
N_CONV_LAYERS = (DEPTH + 1) // 2
N_HGRN_LAYERS = DEPTH // 2
EPS = 1e-6

kernel_name = 'hybrid_conformer_hgrn2_ecmoe_prefix_dit'


def rms_norm(x, g):
    xf = x.astype(jnp.float32)
    y = xf * lax.rsqrt(jnp.mean(xf * xf, axis=-1, keepdims=True) + EPS)
    return (y * g.astype(jnp.float32)).astype(x.dtype)


def layer_norm(x, g, b):
    xf = x.astype(jnp.float32)
    mu = jnp.mean(xf, axis=-1, keepdims=True)
    xc = xf - mu
    y = xc * lax.rsqrt(jnp.mean(xc * xc, axis=-1, keepdims=True) + EPS)
    return (y * g.astype(jnp.float32) + b.astype(jnp.float32)).astype(x.dtype)


def modulate(h, shift, scale):
    return h * (1.0 + scale) + shift


def conformer_conv(h, w1, b1, dw, dwb, ln_g, ln_b, w2, b2):
    a, gate = jnp.split(h @ w1 + b1, 2, axis=-1)
    u = a * jax.nn.sigmoid(gate)
    u = lax.conv_general_dilated(u, dw[:, None, :], window_strides=(1,),
                                 padding=[(CONV_PAD, CONV_PAD)],
                                 dimension_numbers=('NWC', 'WIO', 'NWC'),
                                 feature_group_count=u.shape[-1]) + dwb
    u = jax.nn.silu(layer_norm(u, ln_g, ln_b))
    return u @ w2 + b2


def gla_chunk_scan(q, k, v, logf, s0):
    b, h, t, _ = q.shape
    nc = t // CHUNK

    def to_chunks(a):
        return jnp.moveaxis(a.reshape(b, h, nc, CHUNK, a.shape[-1]), 2, 0)

    mask = jnp.tril(jnp.ones((CHUNK, CHUNK), dtype=bool))[:, :, None]

    def step(s, xs):
        qc, kc, vc, gc = xs
        G = jnp.cumsum(gc, axis=2)
        o_inter = jnp.einsum('bhck,bhkv->bhcv', qc * jnp.exp(G), s)
        diff = G[:, :, :, None, :] - G[:, :, None, :, :]
        decay = jnp.exp(jnp.where(mask, diff, -jnp.inf))
        scores = jnp.einsum('bhtk,bhtsk,bhsk->bhts', qc, decay, kc)
        o_intra = jnp.einsum('bhts,bhsv->bhtv', scores, vc)
        g_last = G[:, :, -1:, :]
        s_new = (jnp.exp(g_last[:, :, 0, :])[..., None] * s
                 + jnp.einsum('bhsk,bhsv->bhkv', kc * jnp.exp(g_last - G), vc))
        return s_new, o_inter + o_intra

    s_fin, o = lax.scan(step, s0, (to_chunks(q), to_chunks(k), to_chunks(v), to_chunks(logf)))
    o = jnp.moveaxis(o, 0, 2).reshape(b, h, t, v.shape[-1])
    return o, s_fin


def hgrn2_mixer(h_ctx, h_lat, w_in, lb, norm_g, w_out, need_ctx):
    def heads(a):
        bsz, t, _ = a.shape
        return a.reshape(bsz, t, HG_HEADS, HG_HEAD_DIM).transpose(0, 2, 1, 3).astype(jnp.float32)

    def project(h):
        q, f_fw, f_bw, inp, g = jnp.split(h @ w_in, 5, axis=-1)
        dirs = []
        for f, lbd in ((f_fw, lb[0]), (f_bw, lb[1])):
            fg = lbd + (1.0 - lbd) * jax.nn.sigmoid(f.astype(jnp.float32))
            dirs.append((heads(1.0 - fg), heads(jnp.log(fg))))
        return heads(q), heads(inp), dirs, g

    def readout(o, g, dtype):
        bsz, _, t, _ = o.shape
        o = o.transpose(0, 2, 1, 3)
        o = o * lax.rsqrt(jnp.mean(o * o, axis=-1, keepdims=True) + EPS) * norm_g.astype(jnp.float32)
        gh = g.reshape(bsz, t, HG_HEADS, HG_HEAD_DIM).astype(jnp.float32)
        y = (o * jax.nn.silu(gh)).reshape(bsz, t, D_MODEL).astype(dtype)
        return y @ w_out

    qc, ic, dc, gc = project(h_ctx)
    ql, il, dl, gl = project(h_lat)
    s0 = jnp.zeros((h_lat.shape[0], HG_HEADS, HG_HEAD_DIM, HG_HEAD_DIM), jnp.float32)
    outs_ctx, outs_lat = [], []
    for d in range(2):
        fl = (lambda a: jnp.flip(a, axis=2)) if d == 1 else (lambda a: a)
        (kc, lfc), (kl, lfl) = dc[d], dl[d]
        oc, s_ctx = gla_chunk_scan(fl(qc), fl(kc), fl(ic), fl(lfc), s0)
        ol, _ = gla_chunk_scan(fl(ql), fl(kl), fl(il), fl(lfl), s_ctx)
        outs_ctx.append(fl(oc))
        outs_lat.append(fl(ol))
    y_lat = readout(outs_lat[0] + outs_lat[1], gl, h_lat.dtype)
    y_ctx = readout(outs_ctx[0] + outs_ctx[1], gc, h_ctx.dtype) if need_ctx else None
    return y_ctx, y_lat


def expert_choice_moe(h, router_w, w_gate, w_up, w_down):
    bsz, t, d = h.shape
    cap = CAPACITY_FACTOR * t // N_EXPERTS
    affin = jax.nn.softmax((h @ router_w).astype(jnp.float32), axis=-1)
    gate, idx = lax.top_k(jnp.swapaxes(affin, 1, 2), cap)
    xs = jax.vmap(lambda hb, ib: hb[ib])(h, idx)
    a = jnp.einsum('becd,edf->becf', xs, w_gate)
    u = jnp.einsum('becd,edf->becf', xs, w_up)
    y = jnp.einsum('becf,efd->becd', jax.nn.silu(a) * u, w_down) * gate[..., None].astype(h.dtype)
    return jax.vmap(lambda yb, ib: jnp.zeros((t, d), yb.dtype).at[ib.reshape(-1)].add(yb.reshape(-1, d)))(y, idx)


def setup_inputs(seed: int = 0) -> dict:
    key = jax.random.key(seed)
    ks = jax.random.split(key, 25)
    D, E, F = D_MODEL, N_EXPERTS, D_EXPERT

    def nrm(k, shape, s):
        return jax.random.normal(k, shape, jnp.float32) * s

    return {
        'x': nrm(ks[0], (BATCH, SEQ, D), 1.0),
        'c': nrm(ks[1], (BATCH, D), 1.0),
        'ctx': nrm(ks[2], (BATCH, CTX_LEN, D), 1.0),
        'c_ctx': nrm(ks[3], (D,), 1.0),
        'mod_w': nrm(ks[4], (DEPTH, D, 6 * D), D ** -0.5),
        'mod_b': nrm(ks[5], (DEPTH, 6 * D), 0.02),
        'norm_mix_g': 1.0 + nrm(ks[6], (DEPTH, D), 0.05),
        'norm_ffn_g': 1.0 + nrm(ks[7], (DEPTH, D), 0.05),
        'cv_w1': nrm(ks[8], (N_CONV_LAYERS, D, 2 * D), D ** -0.5),
        'cv_b1': nrm(ks[9], (N_CONV_LAYERS, 2 * D), 0.02),
        'cv_dw': nrm(ks[10], (N_CONV_LAYERS, CONV_WIDTH, D), CONV_WIDTH ** -0.5),
        'cv_dwb': nrm(ks[11], (N_CONV_LAYERS, D), 0.02),
        'cv_ln_g': 1.0 + nrm(ks[12], (N_CONV_LAYERS, D), 0.05),
        'cv_ln_b': nrm(ks[13], (N_CONV_LAYERS, D), 0.02),
        'cv_w2': nrm(ks[14], (N_CONV_LAYERS, D, D), D ** -0.5),
        'cv_b2': nrm(ks[15], (N_CONV_LAYERS, D), 0.02),
        'hg_w_in': nrm(ks[16], (N_HGRN_LAYERS, D, 5 * D), D ** -0.5),
        'hg_lb_logits': nrm(ks[17], (DEPTH, 2, D), 0.5),
        'hg_norm_g': 1.0 + nrm(ks[18], (N_HGRN_LAYERS, HG_HEAD_DIM), 0.05),
        'hg_w_out': nrm(ks[19], (N_HGRN_LAYERS, D, D), D ** -0.5),
        'router_w': nrm(ks[20], (DEPTH, D, E), D ** -0.5),
        'exp_w_gate': nrm(ks[21], (DEPTH, E, D, F), D ** -0.5),
        'exp_w_up': nrm(ks[22], (DEPTH, E, D, F), D ** -0.5),
        'exp_w_down': nrm(ks[23], (DEPTH, E, F, D), F ** -0.5),
        'final_g': 1.0 + nrm(ks[24], (D,), 0.05),
    }


def reference(x, c, ctx, c_ctx, mod_w, mod_b, norm_mix_g, norm_ffn_g, cv_w1, cv_b1, cv_dw, cv_dwb,
              cv_ln_g, cv_ln_b, cv_w2, cv_b2, hg_w_in, hg_lb_logits, hg_norm_g, hg_w_out,
              router_w, exp_w_gate, exp_w_up, exp_w_down, final_g):
    lat = x
    lb_soft = jax.nn.softmax(hg_lb_logits.astype(jnp.float32), axis=0)
    lb_all = jnp.cumsum(lb_soft, axis=0) - lb_soft[0]
    cond_lat = jax.nn.silu(c)
    cond_ctx = jax.nn.silu(c_ctx)
    for i in range(DEPTH):
        last = i == DEPTH - 1
        j = i // N_MIXERS
        m_lat = jnp.split((cond_lat @ mod_w[i] + mod_b[i])[:, None, :], 6, axis=-1)
        m_ctx = jnp.split((cond_ctx @ mod_w[i] + mod_b[i])[None, None, :], 6, axis=-1)

        h_lat = modulate(rms_norm(lat, norm_mix_g[i]), m_lat[0], m_lat[1])
        h_ctx = modulate(rms_norm(ctx, norm_mix_g[i]), m_ctx[0], m_ctx[1])
        if i % N_MIXERS == 0:
            cp = (cv_w1[j], cv_b1[j], cv_dw[j], cv_dwb[j], cv_ln_g[j], cv_ln_b[j], cv_w2[j], cv_b2[j])
            y_lat = conformer_conv(h_lat, *cp)
            y_ctx = None if last else conformer_conv(h_ctx, *cp)
        else:
            y_ctx, y_lat = hgrn2_mixer(h_ctx, h_lat, hg_w_in[j], lb_all[i], hg_norm_g[j], hg_w_out[j],
                                       not last)
        lat = lat + m_lat[2] * y_lat
        if not last:
            ctx = ctx + m_ctx[2] * y_ctx

        h_lat = modulate(rms_norm(lat, norm_ffn_g[i]), m_lat[3], m_lat[4])
        lat = lat + m_lat[5] * expert_choice_moe(h_lat, router_w[i], exp_w_gate[i], exp_w_up[i], exp_w_down[i])
        if not last:
            h_ctx = modulate(rms_norm(ctx, norm_ffn_g[i]), m_ctx[3], m_ctx[4])
            ctx = ctx + m_ctx[5] * expert_choice_moe(h_ctx, router_w[i], exp_w_gate[i], exp_w_up[i], exp_w_down[i])
    return rms_norm(lat, final_g)
```

```cpp
#include <hip/hip_runtime.h>
#include <hip/hip_cooperative_groups.h>
#include <cstdio>
#include <cstdint>
namespace cg = cooperative_groups;

#ifndef MK_SPLIT
#define MK_SPLIT 0
#endif

namespace pg8 {
#define PG8_LAS __attribute__((address_space(3)))
typedef unsigned short bf16_t;
typedef short bf16x8 __attribute__((ext_vector_type(8)));
typedef float f32x4 __attribute__((ext_vector_type(4)));
typedef unsigned u32x4 __attribute__((ext_vector_type(4)));
constexpr int BM = 256, BK = 64, HALF = 128, HTB = HALF * BK * 2  , STAGE_BYTES = 8 * HTB, NXCD = 8, WGM = 8;

__host__ __device__ __forceinline__ int lds_byte(int r, int c) { const int st = (r >> 4) * 2 + (c >> 5), rr = r & 15, cc = c & 31, ob = rr * 64 + cc * 2; return st * 1024 + (ob ^ (((ob >> 9) & 1) << 5)); }
__host__ __device__ __forceinline__ void stage_rc(int b, int& R, int& C) { const int st = b / 1024, sb = b % 1024, swz = sb ^ (((sb >> 9) & 1) << 5); R = (st >> 1) * 16 + swz / 64; C = (st & 1) * 32 + (swz % 64) / 2; }
__host__ __device__ __forceinline__ int perm32(int rho) { const int n = rho >> 4, i = rho & 15; return 8 * (i >> 2) + 4 * n + (i & 3); }

struct Unit { int pm, pn, pb; };
struct Gemm { const bf16_t* A; const bf16_t* Bt; int M, N, K; };

struct StaticOrder {
    int nM, nN, nwg, G, c, tpe;
    __host__ __device__ void init(int M, int N, int G_, int c_, int tpe_ = 0) { nM = M / BM; nN = N / BM; nwg = nM * nN; G = G_; c = c_; tpe = tpe_; }
    __host__ __device__ bool next(int i, Unit& u) const {
        const long L = (long)i * G + c; if (L >= nwg) return false;
        int wgid = (int)L; { const int q = nwg / NXCD, r = nwg % NXCD, xcd = wgid % NXCD, off = wgid / NXCD; wgid = (xcd < r ? xcd * (q + 1) : r * (q + 1) + (xcd - r) * q) + off; }
        const int nig = WGM * nN, gid = wgid / nig, fm = gid * WGM, gsz = (nM - fm) < WGM ? (nM - fm) : WGM;
        u.pm = fm + ((wgid % nig) % gsz); u.pn = (wgid % nig) / gsz; u.pb = tpe ? (u.pm / tpe) * nN + u.pn : u.pn; return true;
    }
    __device__ __forceinline__ void a_ready(const Unit&) const {}
    __device__ __forceinline__ void done(const Unit&) const {}
};

__device__ __forceinline__ unsigned cvt_pk_bf16(float lo, float hi) { unsigned r; asm volatile("v_cvt_pk_bf16_f32 %0, %1, %2" : "=v"(r) : "v"(lo), "v"(hi)); return r; }
__device__ __forceinline__ float fsigmoid(float x) { return __builtin_amdgcn_rcpf(1.0f + __expf(-x)); }

struct EpiBf16 {
    static constexpr bool PERM = true, AFTER_DRAIN = false;
    bf16_t* O; int ldc;
    __device__ __forceinline__ void operator()(const f32x4 (&acc)[2][2][4][2], const Unit& u, int wr, int wc, int fr, int fq) const {
        const int row0 = u.pm * BM + wr * 64 + fr, col0 = u.pn * BM + wc * 32 + 8 * fq;
#pragma unroll
        for (int ai = 0; ai < 2; ++ai)
#pragma unroll
            for (int m = 0; m < 4; ++m) { bf16_t* rowp = O + (size_t)(row0 + ai * HALF + m * 16) * ldc + col0;
#pragma unroll
                for (int bj = 0; bj < 2; ++bj) { const f32x4 v0 = acc[ai][bj][m][0], v1 = acc[ai][bj][m][1];
                    u32x4 w; w.x = cvt_pk_bf16(v0[0], v0[1]); w.y = cvt_pk_bf16(v0[2], v0[3]); w.z = cvt_pk_bf16(v1[0], v1[1]); w.w = cvt_pk_bf16(v1[2], v1[3]);
                    *(u32x4*)(rowp + bj * HALF) = w; } }
    }
};
template <int MODE> struct EpiGated {
    static constexpr bool PERM = true, AFTER_DRAIN = false;
    bf16_t* O; int ldc; const float* bias; int ystride;
    __device__ __forceinline__ void operator()(const f32x4 (&acc)[2][2][4][2], const Unit& u, int wr, int wc, int fr, int fq) const {
        const int row0 = u.pm * BM + wr * 64 + fr, ch0 = u.pn * HALF + wc * 32 + 8 * fq;
        f32x4 bx[2], by[2];
#pragma unroll
        for (int n = 0; n < 2; ++n) { if (MODE == 0) { bx[n] = *(const f32x4*)(bias + ch0 + 4 * n); by[n] = *(const f32x4*)(bias + ystride + ch0 + 4 * n); } else { bx[n] = (f32x4){0.f, 0.f, 0.f, 0.f}; by[n] = bx[n]; } }
#pragma unroll
        for (int ai = 0; ai < 2; ++ai)
#pragma unroll
            for (int m = 0; m < 4; ++m) { bf16_t* rowp = O + (size_t)(row0 + ai * HALF + m * 16) * ldc + ch0;
                float r[8];
#pragma unroll
                for (int n = 0; n < 2; ++n) { const f32x4 x = acc[ai][0][m][n] + bx[n], y = acc[ai][1][m][n] + by[n];
#pragma unroll
                    for (int j = 0; j < 4; ++j) r[4 * n + j] = (MODE == 0) ? x[j] * fsigmoid(y[j]) : x[j] * fsigmoid(x[j]) * y[j]; }
                u32x4 w; w.x = cvt_pk_bf16(r[0], r[1]); w.y = cvt_pk_bf16(r[2], r[3]); w.z = cvt_pk_bf16(r[4], r[5]); w.w = cvt_pk_bf16(r[6], r[7]);
                *(u32x4*)rowp = w; }
    }
};
struct EpiRes {
    static constexpr bool PERM = false, AFTER_DRAIN = false;
    const float* res0; float* out0; const float* res1; float* out1; const float* bias; const float* gate; int gstride;
    __device__ __forceinline__ void operator()(const f32x4 (&acc)[2][2][4][2], const Unit& u, int wr, int wc, int fr, int fq) const {
        const bool second = u.pm >= 128; const int grp = second ? 4 : (u.pm >> 5);
        const float* res = second ? res1 : res0; float* out = second ? out1 : out0;
        const int row0 = (second ? u.pm - 128 : u.pm) * BM + wr * 64 + fr, col0 = u.pn * BM + wc * 32 + 4 * fq;
        const float* gp = gate + (size_t)grp * gstride + col0;
#pragma unroll
        for (int bj = 0; bj < 2; ++bj)
#pragma unroll
            for (int n = 0; n < 2; ++n) {
                const f32x4 gv = *(const f32x4*)(gp + bj * HALF + n * 16);
                const f32x4 bv = bias ? *(const f32x4*)(bias + col0 + bj * HALF + n * 16) : (f32x4){0.f, 0.f, 0.f, 0.f};
#pragma unroll
                for (int ai = 0; ai < 2; ++ai)
#pragma unroll
                    for (int m = 0; m < 4; ++m) { const size_t off = (size_t)(row0 + ai * HALF + m * 16) * 1024 + col0 + bj * HALF + n * 16;
                        const f32x4 rv = *(const f32x4*)(res + off);
                        *(f32x4*)(out + off) = rv + gv * (acc[ai][bj][m][n] + bv); }
                asm volatile("" ::: "memory"); }
    }
};
struct EpiScaleRow {
    static constexpr bool PERM = true, AFTER_DRAIN = false;
    bf16_t* O; int ldc; const float* rs;
    __device__ __forceinline__ void operator()(const f32x4 (&acc)[2][2][4][2], const Unit& u, int wr, int wc, int fr, int fq) const {
        const int row0 = u.pm * BM + wr * 64 + fr, col0 = u.pn * BM + wc * 32 + 8 * fq;
#pragma unroll
        for (int ai = 0; ai < 2; ++ai)
#pragma unroll
            for (int m = 0; m < 4; ++m) { const int row = row0 + ai * HALF + m * 16; const float s = rs[row]; bf16_t* rowp = O + (size_t)row * ldc + col0;
#pragma unroll
                for (int bj = 0; bj < 2; ++bj) { const f32x4 v0 = acc[ai][bj][m][0] * s, v1 = acc[ai][bj][m][1] * s;
                    u32x4 w; w.x = cvt_pk_bf16(v0[0], v0[1]); w.y = cvt_pk_bf16(v0[2], v0[3]); w.z = cvt_pk_bf16(v1[0], v1[1]); w.w = cvt_pk_bf16(v1[2], v1[3]);
                    *(u32x4*)(rowp + bj * HALF) = w; } }
    }
};


template <class Epi, class Sched, bool ALIGN_EPI = false, bool SP2 = false>
__device__ __forceinline__ void gemm_phase(PG8_LAS unsigned char* lds, const Gemm g, const Sched& S, const Epi& E) {
    const int tid = threadIdx.x, wid = __builtin_amdgcn_readfirstlane(tid >> 6), lane = tid & 63, wr = wid >> 2, wc = wid & 3, fr = lane & 15, fq = lane >> 4;
    const int K = g.K, nt = K / BK;
    unsigned voffA[2], voffB[2];
#pragma unroll
    for (int i = 0; i < 2; ++i) { int R, C; stage_rc(tid * 16 + i * 8192, R, C); const int Rb = Epi::PERM ? ((R & ~31) + perm32(R & 31)) : R;
        voffA[i] = (unsigned)(R * K + C) * 2u; voffB[i] = (unsigned)(Rb * K + C) * 2u; }
    const size_t kstep = (size_t)(BK * 2);
    const size_t hstep = (size_t)HALF * K * 2;
    const size_t tstep = 2 * hstep;
    const unsigned ldsw = (unsigned)wid * 1024u;
    const int aoff = lds_byte(wr * 64 + fr, fq * 8), boff = lds_byte(wc * 32 + fr, fq * 8);
#define PG8_SA(b, h) (((b) * 2 + (h)) * HTB)
#define PG8_SB(b, h) ((4 + (b) * 2 + (h)) * HTB)
#define PG8_STAGE(bufoff, gbase, voff) do { _Pragma("unroll") for (int _i = 0; _i < 2; ++_i) \
        __builtin_amdgcn_global_load_lds((const unsigned*)((const char*)(gbase) + (voff)[_i]), (PG8_LAS unsigned*)(lds + (bufoff) + ldsw + _i * 8192), 16, 0, 0); } while (0)
#define PG8_LDA(dst, b, h) do { _Pragma("unroll") for (int m = 0; m < 4; ++m) _Pragma("unroll") for (int k = 0; k < 2; ++k) dst[m][k] = *(const PG8_LAS bf16x8*)(lds + PG8_SA(b, h) + aoff + m * 2048 + k * 1024); } while (0)
#define PG8_LDB(dst, b, h) do { _Pragma("unroll") for (int n = 0; n < 2; ++n) _Pragma("unroll") for (int k = 0; k < 2; ++k) dst[n][k] = *(const PG8_LAS bf16x8*)(lds + PG8_SB(b, h) + boff + n * 2048 + k * 1024); } while (0)
#define PG8_MMA(ai, bj, At, Bt) do { __builtin_amdgcn_s_setprio(1); _Pragma("unroll") for (int m = 0; m < 4; ++m) _Pragma("unroll") for (int n = 0; n < 2; ++n) _Pragma("unroll") for (int k = 0; k < 2; ++k) \
        acc[ai][bj][m][n] = __builtin_amdgcn_mfma_f32_16x16x32_bf16(Bt[n][k], At[m][k], acc[ai][bj][m][n], 0, 0, 0); __builtin_amdgcn_s_setprio(0); } while (0)
#define PG8_WAIT_V(n) asm volatile("s_waitcnt vmcnt(" #n ")" ::: "memory")
#define PG8_WAIT_L(n) asm volatile("s_waitcnt lgkmcnt(" #n ")" ::: "memory")
#define PG8_BAR __builtin_amdgcn_s_barrier()
#define PG8_SCHED __builtin_amdgcn_sched_barrier(0)
    Unit cur, nxt; int ui = 0;
    if (!S.next(0, cur)) return;
    f32x4 acc[2][2][4][2];
#pragma unroll
    for (int a = 0; a < 2; ++a)
#pragma unroll
        for (int b = 0; b < 2; ++b)
#pragma unroll
            for (int m = 0; m < 4; ++m)
#pragma unroll
                for (int n = 0; n < 2; ++n) acc[a][b][m][n] = (f32x4){0.f, 0.f, 0.f, 0.f};
    bf16x8 At[4][2], B0[2][2], B1[2][2];
    const char* cA = (const char*)g.A + (size_t)cur.pm * tstep; const char* cB = (const char*)g.Bt + (size_t)cur.pb * tstep;
    S.a_ready(cur);
    if constexpr (SP2) {
        PG8_STAGE(PG8_SB(0, 0), cB, voffB); PG8_STAGE(PG8_SB(0, 1), cB + hstep, voffB); PG8_STAGE(PG8_SA(0, 0), cA, voffA); PG8_STAGE(PG8_SA(0, 1), cA + hstep, voffA);
        if (wr == 1) PG8_BAR;
        PG8_WAIT_V(2); PG8_BAR;
        PG8_STAGE(PG8_SB(1, 0), cB + kstep, voffB); PG8_STAGE(PG8_SA(1, 0), cA + kstep, voffA); PG8_STAGE(PG8_SB(1, 1), cB + hstep + kstep, voffB);
        PG8_WAIT_V(6); PG8_BAR;
    } else {
        PG8_STAGE(PG8_SB(0, 0), cB, voffB); PG8_STAGE(PG8_SA(0, 0), cA, voffA); PG8_STAGE(PG8_SB(0, 1), cB + hstep, voffB); PG8_STAGE(PG8_SA(0, 1), cA + hstep, voffA);
        if (wr == 1) PG8_BAR;
        PG8_WAIT_V(4); PG8_BAR;
        PG8_STAGE(PG8_SB(1, 0), cB + kstep, voffB); PG8_STAGE(PG8_SA(1, 0), cA + kstep, voffA); PG8_STAGE(PG8_SB(1, 1), cB + hstep + kstep, voffB);
        PG8_WAIT_V(6); PG8_BAR;
    }
    for (;;) {
        const bool has_next = S.next(ui + 1, nxt);
        const char* nA = has_next ? (const char*)g.A + (size_t)nxt.pm * tstep : cA; const char* nB = has_next ? (const char*)g.Bt + (size_t)nxt.pb * tstep : cB;
        for (int t = 0; t < nt; t += 2) {
            const bool last = (t == nt - 2);
            const char* a1 = cA + (size_t)(t + 1) * kstep;
            const char* a2 = last ? nA : cA + (size_t)(t + 2) * kstep; const char* b2 = last ? nB : cB + (size_t)(t + 2) * kstep;
            const char* a3 = a2 + kstep; const char* b3 = b2 + kstep;
            if (last && has_next) S.a_ready(nxt);
            if constexpr (SP2) {
            PG8_LDB(B0, 0, 0); PG8_LDB(B1, 0, 1); PG8_SCHED; PG8_LDA(At, 0, 0); PG8_STAGE(PG8_SA(1, 1), a1 + hstep, voffA);
            PG8_WAIT_V(8); PG8_WAIT_L(0); PG8_BAR; PG8_MMA(0, 0, At, B0); PG8_MMA(0, 1, At, B1); PG8_BAR; PG8_SCHED;
            PG8_LDA(At, 0, 1); PG8_STAGE(PG8_SB(0, 0), b2, voffB); PG8_STAGE(PG8_SB(0, 1), b2 + hstep, voffB); PG8_STAGE(PG8_SA(0, 0), a2, voffA);
            PG8_WAIT_V(8); PG8_WAIT_L(0); PG8_BAR; PG8_MMA(1, 0, At, B0); PG8_MMA(1, 1, At, B1); PG8_BAR; PG8_SCHED;
            PG8_LDB(B0, 1, 0); PG8_LDB(B1, 1, 1); PG8_SCHED; PG8_LDA(At, 1, 0); PG8_STAGE(PG8_SA(0, 1), a2 + hstep, voffA);
            PG8_WAIT_V(8); PG8_WAIT_L(0); PG8_BAR; PG8_MMA(0, 0, At, B0); PG8_MMA(0, 1, At, B1); PG8_BAR; PG8_SCHED;
            PG8_LDA(At, 1, 1); PG8_STAGE(PG8_SB(1, 0), b3, voffB); PG8_STAGE(PG8_SB(1, 1), b3 + hstep, voffB); PG8_STAGE(PG8_SA(1, 0), a3, voffA);
            PG8_WAIT_V(8); PG8_WAIT_L(0); PG8_BAR; PG8_MMA(1, 0, At, B0); PG8_MMA(1, 1, At, B1); PG8_BAR; PG8_SCHED;
            } else {
            PG8_LDB(B0, 0, 0); PG8_SCHED; PG8_LDA(At, 0, 0); PG8_STAGE(PG8_SA(1, 1), a1 + hstep, voffA);
            PG8_WAIT_L(8); PG8_BAR; PG8_WAIT_L(0); PG8_MMA(0, 0, At, B0); PG8_BAR; PG8_SCHED;
            PG8_LDB(B1, 0, 1); PG8_STAGE(PG8_SB(0, 0), b2, voffB);
            PG8_BAR; PG8_WAIT_L(0); PG8_MMA(0, 1, At, B1); PG8_BAR;
            PG8_LDA(At, 0, 1); PG8_STAGE(PG8_SA(0, 0), a2, voffA);
            PG8_BAR; PG8_WAIT_L(0); PG8_MMA(1, 0, At, B0); PG8_BAR; PG8_SCHED;
            PG8_STAGE(PG8_SB(0, 1), b2 + hstep, voffB);
            PG8_WAIT_V(6); PG8_BAR; PG8_MMA(1, 1, At, B1); PG8_BAR;
            PG8_LDB(B0, 1, 0); PG8_SCHED; PG8_LDA(At, 1, 0); PG8_STAGE(PG8_SA(0, 1), a2 + hstep, voffA);
            PG8_WAIT_L(8); PG8_BAR; PG8_WAIT_L(0); PG8_MMA(0, 0, At, B0); PG8_BAR; PG8_SCHED;
            PG8_LDB(B1, 1, 1); PG8_STAGE(PG8_SB(1, 0), b3, voffB);
            PG8_BAR; PG8_WAIT_L(0); PG8_MMA(0, 1, At, B1); PG8_BAR;
            PG8_LDA(At, 1, 1); PG8_STAGE(PG8_SA(1, 0), a3, voffA);
            PG8_BAR; PG8_WAIT_L(0); PG8_MMA(1, 0, At, B0); PG8_BAR; PG8_SCHED;
            PG8_STAGE(PG8_SB(1, 1), b3 + hstep, voffB);
            PG8_WAIT_V(6); PG8_BAR; PG8_MMA(1, 1, At, B1); PG8_BAR;
            }
        }
        if constexpr (ALIGN_EPI) { if (wr == 0) PG8_BAR; }
        if constexpr (!Epi::AFTER_DRAIN) { E(acc, cur, wr, wc, fr, fq); S.done(cur); }
        if (!has_next) break;
#pragma unroll
        for (int a = 0; a < 2; ++a)
#pragma unroll
            for (int b = 0; b < 2; ++b)
#pragma unroll
                for (int m = 0; m < 4; ++m)
#pragma unroll
                    for (int n = 0; n < 2; ++n) acc[a][b][m][n] = (f32x4){0.f, 0.f, 0.f, 0.f};
        cur = nxt; cA = nA; cB = nB; ++ui;
        if constexpr (ALIGN_EPI) { if (wr == 1) PG8_BAR; }
    }
    PG8_WAIT_V(0);
    if constexpr (!ALIGN_EPI) { if (wr == 0) PG8_BAR; }
    PG8_BAR;
    if constexpr (Epi::AFTER_DRAIN) { E.fused(acc, cur, wr, wc, fr, fq, lds, wid, lane); S.done(cur); }
#undef PG8_SA
#undef PG8_SB
#undef PG8_STAGE
#undef PG8_LDA
#undef PG8_LDB
#undef PG8_MMA
#undef PG8_WAIT_V
#undef PG8_WAIT_L
#undef PG8_BAR
#undef PG8_SCHED
}
}

constexpr int NW = 8;
constexpr int D = 1024, NB = 4, T = 8192, TCX = 256, NLAT = NB * T, NCTX = NB * TCX, R = NLAT + NCTX;
constexpr int NE = 16, FF = 2048, CAPL = 1024, CAPC = 32;
constexpr int RPE0 = 4352, RPE1 = 4096;
constexpr int HD = 128, NH = 8, NSEQ = NB * NH * 2;
constexpr int NGRP = 17;
constexpr float EPS = 1e-6f;

constexpr size_t MiB = 1u << 20;
constexpr size_t WS_CTL = 0, CTL_ZERO_BYTES = 1 * MiB;
constexpr size_t WS_MV = 1 * MiB;
constexpr size_t WS_LB = WS_MV + 256 * 1024;
constexpr size_t WS_AFF = 2 * MiB;
constexpr size_t WS_INV = 5 * MiB;
constexpr size_t WS_SEL = 7 * MiB;
constexpr size_t WS_GSEL = 7 * MiB + 512 * 1024;
constexpr size_t WS_CTXS = 8 * MiB;
constexpr size_t WS_W1T = 12 * MiB, WS_W2T = 16 * MiB, WS_WINT = 18 * MiB, WS_WOUTT = 28 * MiB;
constexpr size_t WS_PTOT = 30 * MiB;
constexpr size_t WS_W13T = 32 * MiB;
constexpr size_t WS_WDT = 160 * MiB;
constexpr size_t WS_HB = 224 * MiB;
constexpr size_t WS_UB = 290 * MiB;
constexpr size_t WS_XG = 356 * MiB;
constexpr size_t WS_HBUF = 492 * MiB;
constexpr size_t WS_PRJ = 356 * MiB;
constexpr size_t WS_OLOC = 764 * MiB;
constexpr size_t WS_QGG = 892 * MiB;
constexpr size_t WS_SST = 32 * MiB;
constexpr size_t WS_END = 1020 * MiB;
static_assert(WS_PRJ + (size_t)R * 5120 * 2 <= WS_OLOC && WS_HBUF + (size_t)16 * RPE0 * 2048 * 2 <= WS_OLOC && WS_XG + (size_t)16 * RPE0 * 1024 * 2 <= WS_HBUF, "ws map");
static_assert(WS_HB + (size_t)R * 1024 * 2 <= WS_UB && WS_UB + (size_t)R * 1024 * 2 <= WS_XG && WS_QGG + (size_t)2 * NLAT * 1024 * 2 <= WS_END, "ws map 2");

constexpr int CW_BAR = 4096;
constexpr int LDS_BYTES = 147456;
constexpr int MISC_OFF = 131072 + 320;

#define GAS __attribute__((address_space(1)))
#define LAS __attribute__((address_space(3)))
typedef unsigned short bf16;
typedef unsigned v4u __attribute__((ext_vector_type(4)));
typedef unsigned v2u __attribute__((ext_vector_type(2)));
typedef float f32x4 __attribute__((ext_vector_type(4)));
typedef float f32x2 __attribute__((ext_vector_type(2)));
typedef short bf16x8 __attribute__((ext_vector_type(8)));
typedef short bf16x4 __attribute__((ext_vector_type(4)));
#define LDS_WAIT() asm volatile("s_waitcnt lgkmcnt(0)" ::: "memory")
__device__ __forceinline__ unsigned pk2(float lo, float hi) { return pg8::cvt_pk_bf16(lo, hi); }
__device__ __forceinline__ float bflo(unsigned w) { return __uint_as_float(w << 16); }
__device__ __forceinline__ float bfhi(unsigned w) { return __uint_as_float(w & 0xffff0000u); }
__device__ __forceinline__ float fsig(float x) { return __builtin_amdgcn_rcpf(1.0f + __expf(-x)); }
__device__ __forceinline__ float wave_sum(float v) {
#pragma unroll
    for (int o = 1; o < 64; o <<= 1) v += __shfl_xor(v, o);
    return v;
}

#define XB_TMO      128
#define XB_XCNT(j)  (256  + 64 * (j))
#define XB_XSUB(j)  (1280 + 64 * (j))
#define XB_XGEN(j)  (2304 + 64 * (j))
#define XB_TOP      3328
#define XB_TOPGEN   3392
#define XCD_BAR_WORDS 3456
#define XB_SPIN_CAP (1u << 20)
__device__ __forceinline__ unsigned xb_ld(unsigned* p)              { return __hip_atomic_load(p, __ATOMIC_RELAXED, __HIP_MEMORY_SCOPE_AGENT); }
__device__ __forceinline__ unsigned xb_add(unsigned* p, unsigned v) { return __hip_atomic_fetch_add(p, v, __ATOMIC_RELAXED, __HIP_MEMORY_SCOPE_AGENT); }
__device__ __forceinline__ unsigned xb_xcc_id() { return (unsigned)__builtin_amdgcn_s_getreg((3 << 11) | 20) & 0xFu; }
#define XB_SPIN(cond, bar) do { unsigned _sp = 0; while (cond) { __builtin_amdgcn_s_sleep(1); \
    if ((++_sp & 255u) == 0u) { if (xb_ld(&(bar)[XB_TMO])) break; if (_sp > XB_SPIN_CAP) { atomicAdd(&(bar)[XB_TMO], 1u); break; } } } } while (0)
struct XcdBarrier { unsigned* bar; unsigned x; volatile LAS unsigned* st; };
__device__ __forceinline__ XcdBarrier xcd_barrier_post(unsigned* bar, volatile LAS unsigned* st) {
    XcdBarrier b; b.bar = bar; b.x = xb_xcc_id(); b.st = st;
    if (threadIdx.x == 0) (void)xb_add(&bar[XB_XCNT(b.x)], 1u);
    return b;
}
__device__ __forceinline__ void xcd_barrier_complete(unsigned* bar, unsigned x, unsigned& nloc, unsigned& nx) {
    const unsigned G = gridDim.x * gridDim.y * gridDim.z;
    unsigned sum, cnt, mine, sp = 0u;
    for (;;) {
        sum = 0u; cnt = 0u; mine = 0u;
#pragma unroll
        for (unsigned j = 0; j < 16; ++j) { const unsigned c = xb_ld(&bar[XB_XCNT(j)]); sum += c; cnt += (c > 0u) ? 1u : 0u; mine = (j == x) ? c : mine; }
        if (sum == G) break;
        __builtin_amdgcn_s_sleep(1);
        if ((++sp & 255u) == 0u) { if (xb_ld(&bar[XB_TMO])) break; if (sp > XB_SPIN_CAP) { atomicAdd(&bar[XB_TMO], 1u); break; } }
    }
    nloc = mine > 0u ? mine : 1u; nx = cnt > 0u ? cnt : 1u;
}
__device__ __forceinline__ void xcd_barrier(const XcdBarrier& b) {
    asm volatile("s_waitcnt vmcnt(0)" ::: "memory");
    __syncthreads();
    if (threadIdx.x == 0) {
        unsigned* bar = b.bar;
        __builtin_amdgcn_s_waitcnt(0);
        unsigned nloc = b.st[0], nx = b.st[1];
        if (nloc == 0u) { xcd_barrier_complete(bar, b.x, nloc, nx); b.st[0] = nloc; b.st[1] = nx; }
        const unsigned old = xb_add(&bar[XB_XSUB(b.x)], 1u);
        const unsigned gen = old / nloc;
        if (old + 1u == (gen + 1u) * nloc) {
            __builtin_amdgcn_fence(__ATOMIC_RELEASE, "agent");
            asm volatile("s_waitcnt vmcnt(0)" ::: "memory");
            const unsigned og = xb_add(&bar[XB_TOP], 1u);
            const unsigned tg = og / nx;
            if (og + 1u == (tg + 1u) * nx) xb_add(&bar[XB_TOPGEN], 1u);
            else XB_SPIN(xb_ld(&bar[XB_TOPGEN]) == tg, bar);
            __builtin_amdgcn_fence(__ATOMIC_ACQUIRE, "agent");
            xb_add(&bar[XB_XGEN(b.x)], 1u);
            asm volatile("s_waitcnt vmcnt(0)" ::: "memory");
        } else {
            XB_SPIN(xb_ld(&bar[XB_XGEN(b.x)]) == gen, bar);
            __builtin_amdgcn_fence(__ATOMIC_ACQUIRE, "agent");
            asm volatile("s_waitcnt vmcnt(0)" ::: "memory");
        }
    }
    __syncthreads();
}

struct Ctx {
    LAS unsigned char* lds;
    int tid, lane, wave, vcu, G, gw, NGW;
};

__device__ __forceinline__ void transpose_item(const float* W, int ldw, int k0, int n0, bf16* WT, int K, int drow0, LAS float* scr, int lane) {
#pragma unroll 8
    for (int i = 0; i < 32; ++i) { const int kk = 2 * i + (lane >> 5); scr[kk * 33 + (lane & 31)] = W[(size_t)(k0 + kk) * ldw + n0 + (lane & 31)]; }
    LDS_WAIT(); asm volatile("" ::: "memory");
    const int c = lane & 7;
#pragma unroll
    for (int j = 0; j < 4; ++j) { const int n = (lane >> 3) + 8 * j; const LAS float* s = scr + (8 * c) * 33 + n;
        v4u o; o.x = pk2(s[0 * 33], s[1 * 33]); o.y = pk2(s[2 * 33], s[3 * 33]); o.z = pk2(s[4 * 33], s[5 * 33]); o.w = pk2(s[6 * 33], s[7 * 33]);
        *(v4u*)(WT + (size_t)(drow0 + n) * K + k0 + 8 * c) = o; }
    LDS_WAIT(); asm volatile("" ::: "memory");
}
__device__ __forceinline__ void paired_src(int db, int& type, int& ch) { const int j0 = 32 * db, pn = j0 >> 8, jj = j0 & 255; type = jj >> 7; ch = 128 * pn + (jj & 127); }

__device__ __forceinline__ void convert_small(const Ctx& C, const float* w1, const float* w2, const float* win, const float* wout, unsigned char* ws) {
    LAS float* scr = (LAS float*)(C.lds + C.wave * 16384);
    constexpr int I1 = 16 * 64, I2 = 16 * 32, I3 = 16 * 160, I4 = 16 * 32, NI = I1 + I2 + I3 + I4;
    for (int it = C.gw; it < NI; it += C.NGW) {
        int r = it;
        if (r < I1) { const int kb = r / 64, db = r % 64; int type, ch; paired_src(db, type, ch); transpose_item(w1, 2048, 64 * kb, type * 1024 + ch, (bf16*)(ws + WS_W1T), 1024, 32 * db, scr, C.lane); continue; } r -= I1;
        if (r < I2) { const int kb = r / 32, db = r % 32; transpose_item(w2, 1024, 64 * kb, 32 * db, (bf16*)(ws + WS_W2T), 1024, 32 * db, scr, C.lane); continue; } r -= I2;
        if (r < I3) { const int kb = r / 160, db = r % 160; transpose_item(win, 5120, 64 * kb, 32 * db, (bf16*)(ws + WS_WINT), 1024, 32 * db, scr, C.lane); continue; } r -= I3;
        { const int kb = r / 32, db = r % 32; transpose_item(wout, 1024, 64 * kb, 32 * db, (bf16*)(ws + WS_WOUTT), 1024, 32 * db, scr, C.lane); }
    }
}
__device__ __forceinline__ void convert_moe(const Ctx& C, const float* wg, const float* wu, const float* wd, int layer, unsigned char* ws) {
    LAS float* scr = (LAS float*)(C.lds + C.wave * 16384);
    constexpr int IGU = 16 * 128, IDN = 32 * 32, IE = IGU + IDN;
    const size_t lo = (size_t)layer * NE * 1024 * 2048;
    for (int it = C.gw; it < NE * IE; it += C.NGW) {
        const int e = it / IE; int r = it % IE;
        if (r < IGU) { const int kb = r / 128, db = r % 128; int type, ch; paired_src(db, type, ch);
            transpose_item((type ? wu : wg) + lo + (size_t)e * 1024 * 2048, 2048, 64 * kb, ch, (bf16*)(ws + WS_W13T) + (size_t)e * 4096 * 1024, 1024, 32 * db, scr, C.lane); }
        else { r -= IGU; const int kb = r / 32, db = r % 32;
            transpose_item(wd + lo + (size_t)e * 2048 * 1024, 1024, 64 * kb, 32 * db, (bf16*)(ws + WS_WDT) + (size_t)e * 1024 * 2048, 2048, 32 * db, scr, C.lane); }
    }
}
__device__ __forceinline__ void mod_gemv(const Ctx& C, const float* c, const float* cctx, const float* mod_w, const float* mod_b, float* MV) {
    LAS float* cond = (LAS float*)C.lds;
    LAS float* red = cond + 5 * 1024;
    bool have = false;
    for (int item = blockIdx.x; item < 192; item += C.G) {
        if (!have) { for (int i = C.tid; i < 5 * 1024; i += NW * 64) { const int g = i >> 10, k = i & 1023; const float v = g < 4 ? c[g * 1024 + k] : cctx[k]; cond[i] = v * fsig(v); } have = true; }
        __syncthreads();
        const int l = item / 96, n = (item % 96) * 64 + C.lane;
        const float* W = mod_w + (size_t)l * 1024 * 6144 + n;
        float a[5] = {0.f, 0.f, 0.f, 0.f, 0.f};
        for (int kk = 0; kk < 128; kk += 8) { float w[8];
#pragma unroll
            for (int u = 0; u < 8; ++u) w[u] = W[(size_t)(C.wave * 128 + kk + u) * 6144];
#pragma unroll
            for (int u = 0; u < 8; ++u)
#pragma unroll
                for (int g = 0; g < 5; ++g) a[g] += cond[g * 1024 + C.wave * 128 + kk + u] * w[u]; }
#pragma unroll
        for (int g = 0; g < 5; ++g) red[(C.wave * 5 + g) * 64 + C.lane] = a[g];
        __syncthreads();
        if (C.wave < 5) { float s = 0.f;
#pragma unroll
            for (int w = 0; w < 8; ++w) s += red[(w * 5 + C.wave) * 64 + C.lane];
            MV[(size_t)(l * 5 + C.wave) * 6144 + n] = s + mod_b[l * 6144 + n]; }
    }
}

struct RowArgs {
    const float* src_lat; const float* src_ctx;
    float* dst_lat; float* dst_ctx;
    const float* gamma;
    const float* mv;
    const float* mvg;
    int i_shift, i_scale, i_gate;
    bf16* HB; float* AFF; const float* router_w;
    const bf16* Y; const short* INV; int rpe;
    int nrows;
};
template <bool COMBINE, bool ROUTER, bool FINAL>
__device__ __forceinline__ void row_phase(const Ctx& C, const RowArgs& A) {
    LAS float* rwT = (LAS float*)C.lds;
    if (ROUTER) { for (int i = C.tid; i < 16384; i += NW * 64) rwT[(i & 15) * 1024 + (i >> 4)] = A.router_w[i]; __syncthreads(); }
    const int rpw = (A.nrows + C.NGW - 1) / C.NGW;
    const int r_lo = C.gw * rpw, r_hi = min(A.nrows, r_lo + rpw);
    const int l4 = 4 * C.lane;
    int cur_grp = -1;
    f32x4 ga[4], sh[4], m5[4];
#pragma unroll
    for (int j = 0; j < 4; ++j) { ga[j] = (f32x4){0.f, 0.f, 0.f, 0.f}; sh[j] = ga[j]; m5[j] = ga[j]; }
    for (int r = r_lo; r < r_hi; ++r) {
        const bool isctx = r >= NLAT; const int grp = isctx ? 4 : (r >> 13);
        if (grp != cur_grp) { cur_grp = grp; const float* mvn = A.mv + (size_t)grp * 6144;
#pragma unroll
            for (int j = 0; j < 4; ++j) { const int c0 = l4 + 256 * j; const f32x4 g = *(const f32x4*)(A.gamma + c0);
                if (FINAL) { ga[j] = g; }
                else { const f32x4 sc = *(const f32x4*)(mvn + A.i_scale * 1024 + c0); ga[j] = g * (sc + 1.0f); sh[j] = *(const f32x4*)(mvn + A.i_shift * 1024 + c0); }
                if (COMBINE) m5[j] = *(const f32x4*)(A.mvg + (size_t)grp * 6144 + A.i_gate * 1024 + c0); } }
        const size_t roff = isctx ? (size_t)(r - NLAT) * 1024 : (size_t)r * 1024;
        const float* src = (isctx ? A.src_ctx : A.src_lat) + roff;
        f32x4 v[4];
#pragma unroll
        for (int j = 0; j < 4; ++j) v[j] = *(const f32x4*)(src + l4 + 256 * j);
        if (COMBINE) {
            f32x4 acc[4];
#pragma unroll
            for (int j = 0; j < 4; ++j) acc[j] = (f32x4){0.f, 0.f, 0.f, 0.f};
            const int sv = (C.lane < 16) ? (int)A.INV[(size_t)r * 16 + C.lane] : -1;
            unsigned long long m = __ballot(sv >= 0);
            while (m) { const int e = __ffsll((long long)m) - 1; m &= m - 1;
                const int slot = __shfl(sv, e);
                const bf16* yr = A.Y + ((size_t)e * A.rpe + slot) * 1024 + l4;
#pragma unroll
                for (int j = 0; j < 4; ++j) { const v2u w = *(const v2u*)(yr + 256 * j); acc[j] += (f32x4){bflo(w.x), bfhi(w.x), bflo(w.y), bfhi(w.y)}; } }
#pragma unroll
            for (int j = 0; j < 4; ++j) v[j] += m5[j] * acc[j];
            if (!FINAL) { float* dst = (isctx ? A.dst_ctx : A.dst_lat) + roff;
#pragma unroll
                for (int j = 0; j < 4; ++j) *(f32x4*)(dst + l4 + 256 * j) = v[j]; }
        }
        float ss = 0.f;
#pragma unroll
        for (int j = 0; j < 4; ++j) ss += (v[j].x * v[j].x + v[j].y * v[j].y) + (v[j].z * v[j].z + v[j].w * v[j].w);
        const float rstd = rsqrtf(wave_sum(ss) * (1.0f / 1024.0f) + EPS);
        if (FINAL) { float* dst = A.dst_lat + roff;
#pragma unroll
            for (int j = 0; j < 4; ++j) *(f32x4*)(dst + l4 + 256 * j) = v[j] * rstd * ga[j];
            continue; }
        f32x4 hv[4];
#pragma unroll
        for (int j = 0; j < 4; ++j) { hv[j] = v[j] * rstd * ga[j] + sh[j];
            v2u w; w.x = pk2(hv[j].x, hv[j].y); w.y = pk2(hv[j].z, hv[j].w); *(v2u*)(A.HB + (size_t)r * 1024 + l4 + 256 * j) = w; }
        if (ROUTER) {
            float lg[16];
#pragma unroll
            for (int e = 0; e < 16; ++e) { float s = 0.f;
#pragma unroll
                for (int j = 0; j < 4; ++j) { const f32x4 w = *(const LAS f32x4*)(rwT + e * 1024 + l4 + 256 * j); s += (hv[j].x * w.x + hv[j].y * w.y) + (hv[j].z * w.z + hv[j].w * w.w); }
                lg[e] = s; }
            float t8[8], t4[4], t2[2], t1;
#pragma unroll
            for (int i = 0; i < 8; ++i) { const bool up = (C.lane & 32) != 0; const float send = up ? lg[i] : lg[i + 8], keep = up ? lg[i + 8] : lg[i]; t8[i] = keep + __shfl_xor(send, 32); }
#pragma unroll
            for (int i = 0; i < 4; ++i) { const bool up = (C.lane & 16) != 0; const float send = up ? t8[i] : t8[i + 4], keep = up ? t8[i + 4] : t8[i]; t4[i] = keep + __shfl_xor(send, 16); }
#pragma unroll
            for (int i = 0; i < 2; ++i) { const bool up = (C.lane & 8) != 0; const float send = up ? t4[i] : t4[i + 2], keep = up ? t4[i + 2] : t4[i]; t2[i] = keep + __shfl_xor(send, 8); }
            { const bool up = (C.lane & 4) != 0; const float send = up ? t2[0] : t2[1], keep = up ? t2[1] : t2[0]; t1 = keep + __shfl_xor(send, 4); }
            t1 += __shfl_xor(t1, 2); t1 += __shfl_xor(t1, 1);
            const int e = ((C.lane >> 5) & 1) * 8 + ((C.lane >> 4) & 1) * 4 + ((C.lane >> 3) & 1) * 2 + ((C.lane >> 2) & 1);
            float mx = t1;
#pragma unroll
            for (int o = 4; o < 64; o <<= 1) mx = fmaxf(mx, __shfl_xor(mx, o));
            const float p = __expf(t1 - mx); float sum = p;
#pragma unroll
            for (int o = 4; o < 64; o <<= 1) sum += __shfl_xor(sum, o);
            if ((C.lane & 3) == 0) A.AFF[(size_t)r * 16 + e] = p / sum;
        }
    }
    if (ROUTER) __syncthreads();
}

__device__ __forceinline__ void conv_phase(const Ctx& C, const bf16* U, bf16* V, const float* dw, const float* dwb, const float* lng, const float* lnb) {
    LAS unsigned* ut = (LAS unsigned*)C.lds;
    LAS float* part = (LAS float*)(C.lds + 126976);
    LAS float* stat = part + 512;
    const int cp = C.tid;
    f32x2 wt[31];
#pragma unroll
    for (int j = 0; j < 31; ++j) wt[j] = *(const f32x2*)(dw + j * 1024 + 2 * cp);
    const f32x2 bb = *(const f32x2*)(dwb + 2 * cp), gg = *(const f32x2*)(lng + 2 * cp), be = *(const f32x2*)(lnb + 2 * cp);
    for (int tile = C.vcu; tile < 1056; tile += C.G) {
        int rowbase, t0, tseq;
        if (tile < 1024) { rowbase = (tile >> 8) * T; t0 = (tile & 255) * 32; tseq = T; } else { const int tt = tile - 1024; rowbase = NLAT + (tt >> 3) * TCX; t0 = (tt & 7) * 32; tseq = TCX; }
        for (int q = C.tid; q < 62 * 128; q += NW * 64) { const int i = q >> 7, cc = q & 127, t = t0 - 15 + i;
            v4u val = (v4u){0u, 0u, 0u, 0u};
            if (t >= 0 && t < tseq) val = *(const v4u*)(U + (size_t)(rowbase + t) * 1024 + cc * 8);
            *(LAS v4u*)(C.lds + i * 2048 + cc * 16) = val; }
        __syncthreads();
        f32x2 ov[32];
#pragma unroll
        for (int g = 0; g < 8; ++g) {
            f32x2 a[4];
#pragma unroll
            for (int oo = 0; oo < 4; ++oo) a[oo] = bb;
#pragma unroll
            for (int jj = 0; jj < 34; ++jj) { const unsigned uw = ut[(4 * g + jj) * 512 + cp]; const f32x2 uu = (f32x2){bflo(uw), bfhi(uw)};
#pragma unroll
                for (int oo = 0; oo < 4; ++oo) { const int tap = jj - oo; if (tap >= 0 && tap <= 30) a[oo] = __builtin_elementwise_fma(wt[tap], uu, a[oo]); } }
#pragma unroll
            for (int oo = 0; oo < 4; ++oo) { ov[4 * g + oo] = a[oo];
                const float s1 = wave_sum(a[oo].x + a[oo].y), s2 = wave_sum(a[oo].x * a[oo].x + a[oo].y * a[oo].y);
                if (C.lane == 0) { part[((4 * g + oo) * 8 + C.wave) * 2] = s1; part[((4 * g + oo) * 8 + C.wave) * 2 + 1] = s2; } }
            asm volatile("" ::: "memory");
        }
        __syncthreads();
        if (C.tid < 32) { float s1 = 0.f, s2 = 0.f;
#pragma unroll
            for (int w = 0; w < 8; ++w) { s1 += part[(C.tid * 8 + w) * 2]; s2 += part[(C.tid * 8 + w) * 2 + 1]; }
            const float mean = s1 * (1.0f / 1024.0f), var = fmaxf(s2 * (1.0f / 1024.0f) - mean * mean, 0.f);
            stat[C.tid * 2] = mean; stat[C.tid * 2 + 1] = rsqrtf(var + EPS); }
        __syncthreads();
#pragma unroll
        for (int tk = 0; tk < 32; ++tk) { const float mean = stat[tk * 2], rstd = stat[tk * 2 + 1];
            const float y0 = (ov[tk].x - mean) * rstd * gg.x + be.x, y1 = (ov[tk].y - mean) * rstd * gg.y + be.y;
            *(unsigned*)(V + (size_t)(rowbase + t0 + tk) * 1024 + 2 * cp) = pk2(y0 * fsig(y0), y1 * fsig(y1)); }
    }
}

__device__ __forceinline__ unsigned block_excl_scan(const Ctx& C, unsigned v, LAS unsigned* wsum, unsigned& total) {
    unsigned inc = v;
#pragma unroll
    for (int o = 1; o < 64; o <<= 1) { const unsigned t = __shfl_up(inc, o); if (C.lane >= o) inc += t; }
    if (C.lane == 63) wsum[C.wave] = inc;
    __syncthreads();
    unsigned base = 0, tot = 0;
#pragma unroll
    for (int w = 0; w < NW; ++w) { const unsigned s = wsum[w]; if (w < C.wave) base += s; tot += s; }
    __syncthreads();
    total = tot;
    return base + inc - v;
}
__device__ __forceinline__ void topk_phase(const Ctx& C, int nprob, int rpe, const float* AFF, int* SEL, float* GSEL, short* INV) {
    LAS unsigned* hist = (LAS unsigned*)C.lds;
    LAS unsigned* misc = hist + 256;
    LAS unsigned* wsum = misc + 16;
    for (int prob = blockIdx.x; prob < nprob; prob += C.G) {
        const int set = prob >> 4, e = prob & 15; const bool lat = set < 4;
        const int kk = lat ? CAPL : CAPC, rowbase = lat ? set * T : NLAT + (set - 4) * TCX, slotbase = lat ? set * CAPL : 4 * CAPL + (set - 4) * CAPC;
        const int cnt = lat ? 16 : (C.tid < 256 ? 1 : 0), base = lat ? C.tid * 16 : C.tid;
        unsigned key[16];
#pragma unroll
        for (int i = 0; i < 16; ++i) key[i] = (i < cnt) ? __float_as_uint(AFF[(size_t)(rowbase + base + i) * 16 + e]) : 0u;
        unsigned prefix = 0u, mask = 0u, need = (unsigned)kk;
#pragma unroll 1
        for (int pass = 0; pass < 4; ++pass) { const int shift = 24 - 8 * pass;
            if (C.tid < 256) hist[C.tid] = 0u;
            __syncthreads();
#pragma unroll
            for (int i = 0; i < 16; ++i) if (i < cnt && (key[i] & mask) == prefix) __hip_atomic_fetch_add(&hist[(key[i] >> shift) & 255u], 1u, __ATOMIC_RELAXED, __HIP_MEMORY_SCOPE_WORKGROUP);
            __syncthreads();
            if (C.wave == 0) { unsigned h[4], tot = 0u;
#pragma unroll
                for (int b = 0; b < 4; ++b) { h[b] = hist[4 * C.lane + b]; tot += h[b]; }
                unsigned inc = tot;
#pragma unroll
                for (int o = 1; o < 64; o <<= 1) { const unsigned t = __shfl_down(inc, o); if (C.lane + o < 64) inc += t; }
                unsigned cgt = inc - tot;
#pragma unroll
                for (int b = 3; b >= 0; --b) { if (cgt < need && need <= cgt + h[b]) { misc[0] = (unsigned)(4 * C.lane + b); misc[1] = need - cgt; } cgt += h[b]; } }
            __syncthreads();
            prefix |= misc[0] << shift; mask |= 255u << shift; need = misc[1];
        }
        unsigned neq = 0u, ngt = 0u;
#pragma unroll
        for (int i = 0; i < 16; ++i) if (i < cnt) { neq += (key[i] == prefix) ? 1u : 0u; ngt += (key[i] > prefix) ? 1u : 0u; }
        unsigned tot;
        const unsigned eq_before = block_excl_scan(C, neq, wsum, tot);
        const unsigned take_eq = (need > eq_before) ? min(neq, need - eq_before) : 0u;
        unsigned slot = block_excl_scan(C, ngt + take_eq, wsum, tot);
        unsigned eqr = eq_before;
#pragma unroll
        for (int i = 0; i < 16; ++i) if (i < cnt) {
            bool sel = key[i] > prefix;
            if (key[i] == prefix) { sel = eqr < need; ++eqr; }
            const int row = rowbase + base + i;
            if (sel) { const int s = slotbase + (int)slot; ++slot; SEL[e * rpe + s] = row; GSEL[e * rpe + s] = __uint_as_float(key[i]); INV[(size_t)row * 16 + e] = (short)s; }
            else INV[(size_t)row * 16 + e] = (short)-1; }
        if (rpe == RPE0 && set == 4 && C.tid < RPE0 - (4 * CAPL + 4 * CAPC)) { const int s = 4 * CAPL + 4 * CAPC + C.tid; SEL[e * rpe + s] = 0; GSEL[e * rpe + s] = 0.f; }
        __syncthreads();
    }
}
__device__ __forceinline__ void gather_phase(const Ctx& C, int nrows, const int* SEL, const bf16* HB, bf16* XG) {
    for (int r = C.gw; r < nrows; r += C.NGW) { const int src = SEL[r];
        const v4u a = *(const v4u*)(HB + (size_t)src * 1024 + 8 * C.lane), b = *(const v4u*)(HB + (size_t)src * 1024 + 512 + 8 * C.lane);
        *(v4u*)(XG + (size_t)r * 1024 + 8 * C.lane) = a; *(v4u*)(XG + (size_t)r * 1024 + 512 + 8 * C.lane) = b; }
}

__device__ __forceinline__ f32x4 mfma16(bf16x8 a, bf16x8 b, f32x4 c) { return __builtin_amdgcn_mfma_f32_16x16x32_bf16(a, b, c, 0, 0, 0); }
constexpr int SC_QG = 0, SC_KT = 17408, SC_KGT = 34816, SC_VT = 53248, SC_SC = 71680, SC_SEG = 80896, SC_PCH = 84992, SC_PG = 85504;
constexpr int QROW = 272, TROW = 144;

__device__ __forceinline__ void scanA_phase(const Ctx& C, const bf16* PRJ, const float* LB, bf16* OLOC, bf16* QGG, float* SLOC, float* PTOT) {
    LAS unsigned char* L = C.lds;
    LAS float* SEG = (LAS float*)(L + SC_SEG); LAS float* PCH = (LAS float*)(L + SC_PCH); LAS float* PG = (LAS float*)(L + SC_PG);
    const int lane = C.lane, w = C.wave, g = lane >> 4, lr = lane & 15, k0 = 2 * lane, seg = w;
    for (int ui = C.vcu; ui < NSEQ * NGRP; ui += C.G) {
        int seq, grp; if (ui < NSEQ * 16) { seq = ui >> 4; grp = 1 + (ui & 15); } else { seq = ui - NSEQ * 16; grp = 0; }
        const int b = seq >> 4, h = (seq >> 1) & 7, dir = seq & 1, nch = grp ? 8 : 4, sgn = dir ? -1 : 1;
        const int hc = h * HD;
        const float lb0 = LB[dir * 1024 + hc + k0], lb1 = LB[dir * 1024 + hc + k0 + 1];
        f32x4 S[8];
#pragma unroll
        for (int i = 0; i < 8; ++i) S[i] = (f32x4){0.f, 0.f, 0.f, 0.f};
        if (C.tid < 128) PG[C.tid] = 1.0f;
        const int Pb = grp ? (grp - 1) * 512 : 0, rbase = grp ? b * T : NLAT + b * TCX, tlen = grp ? T : TCX;
#define ROWC(c) (rbase + (dir ? tlen - 1 - (Pb + 64 * (c)) : Pb + 64 * (c)))
        unsigned fq[8], qq[8]; v4u vv[2];
        { const int rc = ROWC(0);
#pragma unroll
            for (int i = 0; i < 8; ++i) { const bf16* rp = PRJ + (size_t)(rc + sgn * (8 * seg + i)) * 5120; fq[i] = *(const unsigned*)(rp + (1 + dir) * 1024 + hc + k0); qq[i] = *(const unsigned*)(rp + hc + k0); }
#pragma unroll
            for (int ii = 0; ii < 2; ++ii) { const int cq = C.tid + 512 * ii; vv[ii] = *(const v4u*)(PRJ + (size_t)(rc + sgn * (cq >> 4)) * 5120 + 3072 + hc + (cq & 15) * 8); } }
        __syncthreads();
#pragma unroll 1
        for (int c = 0; c < nch; ++c) {
            const int rc = ROWC(c);
            float pl0[8], pl1[8], kk0[8], kk1[8]; float run0 = 1.f, run1 = 1.f;
#pragma unroll
            for (int i = 0; i < 8; ++i) { const float s0 = fsig(bflo(fq[i])), s1 = fsig(bfhi(fq[i]));
                const float fg0 = lb0 + (1.f - lb0) * s0, fg1 = lb1 + (1.f - lb1) * s1;
                kk0[i] = (1.f - lb0) * (1.f - s0); kk1[i] = (1.f - lb1) * (1.f - s1);
                run0 *= fg0; run1 *= fg1; pl0[i] = run0; pl1[i] = run1; }
            *(LAS f32x2*)(SEG + seg * 128 + k0) = (f32x2){run0, run1};
#pragma unroll
            for (int ii = 0; ii < 2; ++ii) { const int cq = C.tid + 512 * ii, p = cq >> 4, v0 = (cq & 15) * 8; LAS bf16* vt = (LAS bf16*)(L + SC_VT) + p;
                const unsigned wds[4] = {vv[ii].x, vv[ii].y, vv[ii].z, vv[ii].w};
#pragma unroll
                for (int j = 0; j < 4; ++j) { vt[(v0 + 2 * j) * (TROW / 2)] = (bf16)(wds[j] & 0xffffu); vt[(v0 + 2 * j + 1) * (TROW / 2)] = (bf16)(wds[j] >> 16); } }
            const float pg0 = PG[k0], pg1 = PG[k0 + 1];
            __syncthreads();
            float pb0 = 1.f, pb1 = 1.f, pt0 = 1.f, pt1 = 1.f;
#pragma unroll
            for (int s = 0; s < 8; ++s) { const f32x2 t = *(const LAS f32x2*)(SEG + s * 128 + k0); if (s < seg) { pb0 *= t.x; pb1 *= t.y; } pt0 *= t.x; pt1 *= t.y; }
            unsigned kg0[4], kg1[4]; float kprev0 = 0.f, kprev1 = 0.f;
#pragma unroll
            for (int i = 0; i < 8; ++i) { const int p = 8 * seg + i;
                const float P0 = pb0 * pl0[i], P1 = pb1 * pl1[i];
                const float qg0 = bflo(qq[i]) * P0, qg1 = bfhi(qq[i]) * P1;
                const float kt0 = kk0[i] * __builtin_amdgcn_rcpf(fmaxf(P0, 1e-30f)), kt1 = kk1[i] * __builtin_amdgcn_rcpf(fmaxf(P1, 1e-30f));
                *(LAS unsigned*)(L + SC_QG + p * QROW + k0 * 2) = pk2(qg0, qg1);
                *(LAS unsigned*)(L + SC_KT + p * QROW + k0 * 2) = pk2(kt0, kt1);
                const float a0 = kt0 * pt0, a1 = kt1 * pt1;
                if (i & 1) { kg0[i >> 1] = pk2(kprev0, a0); kg1[i >> 1] = pk2(kprev1, a1); } else { kprev0 = a0; kprev1 = a1; }
                if (grp) *(unsigned*)(QGG + ((size_t)dir * NLAT + (size_t)(rc + sgn * p)) * 1024 + hc + k0) = pk2(qg0 * pg0, qg1 * pg1); }
            *(LAS v4u*)(L + SC_KGT + k0 * TROW + seg * 16) = (v4u){kg0[0], kg0[1], kg0[2], kg0[3]};
            *(LAS v4u*)(L + SC_KGT + (k0 + 1) * TROW + seg * 16) = (v4u){kg1[0], kg1[1], kg1[2], kg1[3]};
            if (seg == 0) *(LAS f32x2*)(PCH + k0) = (f32x2){pt0, pt1};
            if (c + 1 < nch) { const int rn = ROWC(c + 1);
#pragma unroll
                for (int i = 0; i < 8; ++i) { const bf16* rp = PRJ + (size_t)(rn + sgn * (8 * seg + i)) * 5120; fq[i] = *(const unsigned*)(rp + (1 + dir) * 1024 + hc + k0); qq[i] = *(const unsigned*)(rp + hc + k0); }
#pragma unroll
                for (int ii = 0; ii < 2; ++ii) { const int cq = C.tid + 512 * ii; vv[ii] = *(const v4u*)(PRJ + (size_t)(rn + sgn * (cq >> 4)) * 5120 + 3072 + hc + (cq & 15) * 8); } }
            __syncthreads();
            if (seg == 0) *(LAS f32x2*)(PG + k0) = (f32x2){pg0 * pt0, pg1 * pt1};
            { const int pi = w >> 1;
#pragma unroll
                for (int tt = 0; tt < 2; ++tt) { const int si = 2 * (w & 1) + tt; f32x4 acc = (f32x4){0.f, 0.f, 0.f, 0.f};
#pragma unroll
                    for (int ks = 0; ks < 4; ++ks) { const bf16x8 a = *(const LAS bf16x8*)(L + SC_QG + (16 * pi + lr) * QROW + (32 * ks + 8 * g) * 2);
                        const bf16x8 bb = *(const LAS bf16x8*)(L + SC_KT + (16 * si + lr) * QROW + (32 * ks + 8 * g) * 2); acc = mfma16(a, bb, acc); }
#pragma unroll
                    for (int r = 0; r < 4; ++r) { const int p = 16 * pi + 4 * g + r, s = 16 * si + lr; const float val = (s <= p) ? acc[r] : 0.f;
                        *(LAS bf16*)(L + SC_SC + p * TROW + s * 2) = (bf16)(pk2(val, 0.f) & 0xffffu); } } }
            __syncthreads();
            bf16x8 bv[2];
#pragma unroll
            for (int ks = 0; ks < 2; ++ks) bv[ks] = *(const LAS bf16x8*)(L + SC_VT + (16 * w + lr) * TROW + (32 * ks + 8 * g) * 2);
            f32x4 O[4];
#pragma unroll
            for (int pt = 0; pt < 4; ++pt) O[pt] = (f32x4){0.f, 0.f, 0.f, 0.f};
#pragma unroll
            for (int ks = 0; ks < 4; ++ks) {
                v4u sw; sw.x = pk2(S[2 * ks][0], S[2 * ks][1]); sw.y = pk2(S[2 * ks][2], S[2 * ks][3]); sw.z = pk2(S[2 * ks + 1][0], S[2 * ks + 1][1]); sw.w = pk2(S[2 * ks + 1][2], S[2 * ks + 1][3]);
                const bf16x8 sb = __builtin_bit_cast(bf16x8, sw);
#pragma unroll
                for (int pt = 0; pt < 4; ++pt) { const LAS unsigned char* qp = L + SC_QG + (16 * pt + lr) * QROW + (32 * ks + 4 * g) * 2;
                    const v2u lo = *(const LAS v2u*)qp, hi = *(const LAS v2u*)(qp + 32);
                    const bf16x8 a = __builtin_bit_cast(bf16x8, (v4u){lo.x, lo.y, hi.x, hi.y}); O[pt] = mfma16(a, sb, O[pt]); } }
#pragma unroll
            for (int ks = 0; ks < 2; ++ks)
#pragma unroll
                for (int pt = 0; pt < 4; ++pt) { const bf16x8 a = *(const LAS bf16x8*)(L + SC_SC + (16 * pt + lr) * TROW + (32 * ks + 8 * g) * 2); O[pt] = mfma16(a, bv[ks], O[pt]); }
            if (grp) {
#pragma unroll
                for (int pt = 0; pt < 4; ++pt)
#pragma unroll
                    for (int r = 0; r < 4; ++r) { const int p = 16 * pt + 4 * g + r;
                        OLOC[((size_t)dir * NLAT + (size_t)(rc + sgn * p)) * 1024 + hc + 16 * w + lr] = (bf16)(pk2(O[pt][r], 0.f) & 0xffffu); } }
#pragma unroll
            for (int kt = 0; kt < 8; ++kt) { const f32x4 pc = *(const LAS f32x4*)(PCH + 16 * kt + 4 * g); S[kt] = S[kt] * pc;
#pragma unroll
                for (int ks = 0; ks < 2; ++ks) { const bf16x8 a = *(const LAS bf16x8*)(L + SC_KGT + (16 * kt + lr) * TROW + (32 * ks + 8 * g) * 2); S[kt] = mfma16(a, bv[ks], S[kt]); } }
            __syncthreads();
        }
        if (grp < 16) {
#pragma unroll
            for (int kt = 0; kt < 8; ++kt)
#pragma unroll
                for (int r = 0; r < 4; ++r) SLOC[(((size_t)seq * 16 + grp) * 128 + 16 * kt + 4 * g + r) * 128 + 16 * w + lr] = S[kt][r]; }
        if (C.tid < 128) PTOT[((size_t)seq * NGRP + grp) * 128 + C.tid] = PG[C.tid];
        __syncthreads();
#undef ROWC
    }
}
__device__ __forceinline__ void scanB_phase(const Ctx& C, const float* SLOC, const float* PTOT, bf16* SST) {
    for (int id = C.vcu * (NW * 64) + C.tid; id < NSEQ * 2048; id += C.G * NW * 64) {
        const int seq = id >> 11, k = ((id >> 7) & 15) * 8, v = id & 127;
        float s[8];
#pragma unroll
        for (int i = 0; i < 8; ++i) s[i] = 0.f;
#pragma unroll 1
        for (int gi = 0; gi < 16; ++gi) { const float* pt = PTOT + ((size_t)seq * NGRP + gi) * 128 + k; const float* sl = SLOC + (((size_t)seq * 16 + gi) * 128 + k) * 128 + v;
#pragma unroll
            for (int i = 0; i < 8; ++i) s[i] = pt[i] * s[i] + sl[(size_t)i * 128];
            v4u o; o.x = pk2(s[0], s[1]); o.y = pk2(s[2], s[3]); o.z = pk2(s[4], s[5]); o.w = pk2(s[6], s[7]);
            *(v4u*)(SST + (((size_t)seq * 16 + gi) * 128 + v) * 128 + k) = o; }
    }
}
__device__ __forceinline__ void readout_phase(const Ctx& C, const bf16* PRJ, const bf16* OLOC, const bf16* QGG, const bf16* SST, const float* norm_g, bf16* YH) {
    LAS float* OT = (LAS float*)C.lds;
    const int lane = C.lane, w = C.wave, g = lane >> 4, lr = lane & 15;
    const int p = C.tid >> 3, sg = C.tid & 7;
    f32x4 ng[4];
#pragma unroll
    for (int i = 0; i < 4; ++i) ng[i] = *(const f32x4*)(norm_g + 16 * sg + 4 * i);
    for (int ui = C.vcu; ui < NB * NH * 128; ui += C.G) {
        const int tt = ui & 127, h = (ui >> 7) & 7, b = ui >> 10, hc = h * HD, row0 = b * T + 64 * tt;
        f32x4 O[4];
#pragma unroll
        for (int pt = 0; pt < 4; ++pt) O[pt] = (f32x4){0.f, 0.f, 0.f, 0.f};
#pragma unroll
        for (int dir = 0; dir < 2; ++dir) { const int seq = (b * 8 + h) * 2 + dir, gs = dir ? ((127 - tt) >> 3) : (tt >> 3);
            const bf16* Bb = SST + (((size_t)seq * 16 + gs) * 128 + 16 * w + lr) * 128;
            const bf16* Ab = QGG + ((size_t)dir * NLAT + row0 + lr) * 1024 + hc;
#pragma unroll
            for (int ks = 0; ks < 4; ++ks) { const bf16x8 bb = *(const bf16x8*)(Bb + 32 * ks + 8 * g);
#pragma unroll
                for (int pt = 0; pt < 4; ++pt) { const bf16x8 a = *(const bf16x8*)(Ab + (size_t)(16 * pt) * 1024 + 32 * ks + 8 * g); O[pt] = mfma16(a, bb, O[pt]); } } }
#pragma unroll
        for (int pt = 0; pt < 4; ++pt)
#pragma unroll
            for (int r = 0; r < 4; ++r) OT[(16 * pt + 4 * g + r) * 132 + 16 * w + lr] = O[pt][r];
        __syncthreads();
        { const size_t row = (size_t)row0 + p; const int c0 = hc + 16 * sg;
            f32x4 o[4];
#pragma unroll
            for (int i = 0; i < 4; ++i) o[i] = *(const LAS f32x4*)(OT + p * 132 + 16 * sg + 4 * i);
#pragma unroll
            for (int dir = 0; dir < 2; ++dir) { const bf16* op = OLOC + ((size_t)dir * NLAT + row) * 1024 + c0;
                const v4u a = *(const v4u*)op, bq = *(const v4u*)(op + 8);
                o[0] += (f32x4){bflo(a.x), bfhi(a.x), bflo(a.y), bfhi(a.y)}; o[1] += (f32x4){bflo(a.z), bfhi(a.z), bflo(a.w), bfhi(a.w)};
                o[2] += (f32x4){bflo(bq.x), bfhi(bq.x), bflo(bq.y), bfhi(bq.y)}; o[3] += (f32x4){bflo(bq.z), bfhi(bq.z), bflo(bq.w), bfhi(bq.w)}; }
            float ss = 0.f;
#pragma unroll
            for (int i = 0; i < 4; ++i) ss += (o[i].x * o[i].x + o[i].y * o[i].y) + (o[i].z * o[i].z + o[i].w * o[i].w);
            ss += __shfl_xor(ss, 1); ss += __shfl_xor(ss, 2); ss += __shfl_xor(ss, 4);
            const float rstd = rsqrtf(ss * (1.0f / 128.0f) + EPS);
            const bf16* gp = PRJ + row * 5120 + 4096 + c0;
            const v4u ga = *(const v4u*)gp, gb = *(const v4u*)(gp + 8);
            const unsigned gw[8] = {ga.x, ga.y, ga.z, ga.w, gb.x, gb.y, gb.z, gb.w};
            unsigned ow[8];
#pragma unroll
            for (int i = 0; i < 8; ++i) { const float g0 = bflo(gw[i]), g1 = bfhi(gw[i]);
                const float y0 = o[i >> 1][(2 * i) & 3] * rstd * ng[i >> 1][(2 * i) & 3] * (g0 * fsig(g0));
                const float y1 = o[i >> 1][(2 * i + 1) & 3] * rstd * ng[i >> 1][(2 * i + 1) & 3] * (g1 * fsig(g1));
                ow[i] = pk2(y0, y1); }
            bf16* yp = YH + row * 1024 + c0;
            *(v4u*)yp = (v4u){ow[0], ow[1], ow[2], ow[3]}; *(v4u*)(yp + 8) = (v4u){ow[4], ow[5], ow[6], ow[7]}; }
        __syncthreads();
    }
}

constexpr int NPHASE = 22;
struct Args { const float* in[25]; float* out; unsigned char* ws; int ph_lo, ph_hi; };
__global__ void __launch_bounds__(NW * 64, 2) mk_fwd(Args args) {
    extern __shared__ __attribute__((aligned(16))) unsigned char lds_raw[];
    Ctx C;
    C.lds = (LAS unsigned char*)lds_raw;
    C.tid = threadIdx.x; C.lane = C.tid & 63; C.wave = __builtin_amdgcn_readfirstlane(C.tid >> 6);
    C.G = gridDim.x; { const int bx = blockIdx.x; C.vcu = (C.G % 8 == 0) ? (bx % 8) * (C.G / 8) + bx / 8 : bx; }
    C.gw = C.vcu * NW + C.wave; C.NGW = C.G * NW;
    unsigned char* ws = args.ws;
    const int lo = args.ph_lo, hi = args.ph_hi;
    volatile LAS unsigned* MISC = (volatile LAS unsigned*)(C.lds + MISC_OFF);
    for (int u = C.tid; u < (LDS_BYTES - 131072) / 4; u += NW * 64) ((LAS unsigned*)(C.lds + 131072))[u] = 0u;
    __syncthreads();
    XcdBarrier bar; bar.bar = (unsigned*)(ws + WS_CTL) + CW_BAR; bar.x = 0; bar.st = nullptr;
    if (hi - lo > 1) bar = xcd_barrier_post((unsigned*)(ws + WS_CTL) + CW_BAR, MISC + 8);
#ifndef MK_PHMASK
#define MK_PHMASK 0x3fffff
#endif
#define INR(k) (lo <= (k) && (k) < hi)
#define IN(k) ((((MK_PHMASK) >> (k)) & 1) && INR(k))
#define SEAM(k) do { if (INR(k) && INR((k) + 1)) xcd_barrier(bar); } while (0)

    const float* x = args.in[0]; const float* ctx_in = args.in[2];
    float* MV = (float*)(ws + WS_MV); float* LBT = (float*)(ws + WS_LB); float* AFF = (float*)(ws + WS_AFF); short* INV = (short*)(ws + WS_INV);
    int* SEL = (int*)(ws + WS_SEL); float* GSEL = (float*)(ws + WS_GSEL); float* CTXS = (float*)(ws + WS_CTXS);
    bf16* HB = (bf16*)(ws + WS_HB); bf16* UB = (bf16*)(ws + WS_UB); bf16* XG = (bf16*)(ws + WS_XG); bf16* HBUF = (bf16*)(ws + WS_HBUF); bf16* PRJ = (bf16*)(ws + WS_PRJ);
    bf16* OLOC = (bf16*)(ws + WS_OLOC); bf16* QGG = (bf16*)(ws + WS_QGG); float* SLOC = (float*)(ws + WS_UB); float* PTOT = (float*)(ws + WS_PTOT); bf16* SST = (bf16*)(ws + WS_SST); bf16* YH = (bf16*)(ws + WS_UB);
    float* out = args.out;

    if (IN(0)) {
        mod_gemv(C, args.in[1], args.in[3], args.in[4], args.in[5], MV);
        for (int i = C.vcu * NW * 64 + C.tid; i < 2048; i += C.G * NW * 64) { const float* lg = args.in[17]; LBT[i] = fsig(lg[2048 + i] - lg[i]); }
        __syncthreads();
        convert_small(C, args.in[8], args.in[14], args.in[16], args.in[19], ws);
        convert_moe(C, args.in[21], args.in[22], args.in[23], 0, ws);
    }
#if !MK_SPLIT
    if (INR(0) && INR(1)) { cg::grid_group grid = cg::this_grid(); __threadfence(); grid.sync(); }
#endif
    SEAM(0);
    if (IN(1)) { RowArgs A{}; A.src_lat = x; A.src_ctx = ctx_in; A.gamma = args.in[6]; A.mv = MV; A.i_shift = 0; A.i_scale = 1; A.i_gate = 2; A.HB = HB; A.nrows = R;
        row_phase<false, false, false>(C, A); }
    SEAM(1);
    if (IN(2)) { pg8::Gemm g{HB, (const bf16*)(ws + WS_W1T), R, 2048, 1024}; pg8::StaticOrder S; S.init(R, 2048, C.G, (int)blockIdx.x);
        pg8::EpiGated<0> E{UB, 1024, args.in[9], 1024};
        pg8::gemm_phase<pg8::EpiGated<0>, pg8::StaticOrder, true, true>(C.lds, g, S, E); }
    SEAM(2);
    if (IN(3)) conv_phase(C, UB, HB, args.in[10], args.in[11], args.in[12], args.in[13]);
    SEAM(3);
    if (IN(4)) { pg8::Gemm g{HB, (const bf16*)(ws + WS_W2T), R, 1024, 1024}; pg8::StaticOrder S; S.init(R, 1024, C.G, (int)blockIdx.x);
        pg8::EpiRes E{x, out, ctx_in, CTXS, args.in[15], MV + 2 * 1024, 6144};
        pg8::gemm_phase<pg8::EpiRes, pg8::StaticOrder, true, true>(C.lds, g, S, E); }
    SEAM(4);
    if (IN(5)) { RowArgs A{}; A.src_lat = out; A.src_ctx = CTXS; A.gamma = args.in[7]; A.mv = MV; A.i_shift = 3; A.i_scale = 4; A.i_gate = 5; A.HB = HB; A.AFF = AFF; A.router_w = args.in[20]; A.nrows = R;
        row_phase<false, true, false>(C, A); }
    SEAM(5);
    if (IN(6)) topk_phase(C, 128, RPE0, AFF, SEL, GSEL, INV);
    SEAM(6);
    if (IN(7)) gather_phase(C, NE * RPE0, SEL, HB, XG);
    SEAM(7);
    if (IN(8)) { pg8::Gemm g{XG, (const bf16*)(ws + WS_W13T), NE * RPE0, 4096, 1024}; pg8::StaticOrder S; S.init(NE * RPE0, 4096, C.G, (int)blockIdx.x, RPE0 / 256);
        pg8::EpiGated<1> E{HBUF, 2048, nullptr, 0};
        pg8::gemm_phase<pg8::EpiGated<1>, pg8::StaticOrder, true, true>(C.lds, g, S, E); }
    SEAM(8);
    if (IN(9)) { pg8::Gemm g{HBUF, (const bf16*)(ws + WS_WDT), NE * RPE0, 1024, 2048}; pg8::StaticOrder S; S.init(NE * RPE0, 1024, C.G, (int)blockIdx.x, RPE0 / 256);
        pg8::EpiScaleRow E{XG, 1024, GSEL};
        pg8::gemm_phase<pg8::EpiScaleRow, pg8::StaticOrder, true, true>(C.lds, g, S, E); }
    SEAM(9);
    if (IN(10)) { RowArgs A{}; A.src_lat = out; A.src_ctx = CTXS; A.dst_lat = out; A.dst_ctx = CTXS; A.gamma = args.in[6] + 1024; A.mv = MV; A.i_shift = 0; A.i_scale = 1; A.i_gate = 5; A.HB = HB;
        A.Y = XG; A.INV = INV; A.rpe = RPE0; A.nrows = R;
        A.mv = MV + 5 * 6144; A.mvg = MV; row_phase<true, false, false>(C, A); }
    SEAM(10);
    if (IN(11)) { pg8::Gemm g{HB, (const bf16*)(ws + WS_WINT), R, 5120, 1024}; pg8::StaticOrder S; S.init(R, 5120, C.G, (int)blockIdx.x);
        pg8::EpiBf16 E{PRJ, 5120};
        pg8::gemm_phase<pg8::EpiBf16, pg8::StaticOrder, true, true>(C.lds, g, S, E); }
    SEAM(11);
    if (IN(12)) scanA_phase(C, PRJ, LBT, OLOC, QGG, SLOC, PTOT);
    SEAM(12);
    if (IN(13)) scanB_phase(C, SLOC, PTOT, SST);
    SEAM(13);
    if (IN(14)) readout_phase(C, PRJ, OLOC, QGG, SST, args.in[18], YH);
    SEAM(14);
    if (IN(15)) { pg8::Gemm g{YH, (const bf16*)(ws + WS_WOUTT), NLAT, 1024, 1024}; pg8::StaticOrder S; S.init(NLAT, 1024, C.G, (int)blockIdx.x);
        pg8::EpiRes E{out, out, nullptr, nullptr, nullptr, MV + 5 * 6144 + 2 * 1024, 6144};
        pg8::gemm_phase<pg8::EpiRes, pg8::StaticOrder, true, true>(C.lds, g, S, E); }
    SEAM(15);
    if (IN(16)) { RowArgs A{}; A.src_lat = out; A.gamma = args.in[7] + 1024; A.mv = MV + 5 * 6144; A.i_shift = 3; A.i_scale = 4; A.i_gate = 5; A.HB = HB; A.AFF = AFF; A.router_w = args.in[20] + 16384; A.nrows = NLAT;
        row_phase<false, true, false>(C, A);
        convert_moe(C, args.in[21], args.in[22], args.in[23], 1, ws); }
    SEAM(16);
    if (IN(17)) topk_phase(C, 64, RPE1, AFF, SEL, GSEL, INV);
    SEAM(17);
    if (IN(18)) gather_phase(C, NE * RPE1, SEL, HB, XG);
    SEAM(18);
    if (IN(19)) { pg8::Gemm g{XG, (const bf16*)(ws + WS_W13T), NE * RPE1, 4096, 1024}; pg8::StaticOrder S; S.init(NE * RPE1, 4096, C.G, (int)blockIdx.x, RPE1 / 256);
        pg8::EpiGated<1> E{HBUF, 2048, nullptr, 0};
        pg8::gemm_phase<pg8::EpiGated<1>, pg8::StaticOrder, true, true>(C.lds, g, S, E); }
    SEAM(19);
    if (IN(20)) { pg8::Gemm g{HBUF, (const bf16*)(ws + WS_WDT), NE * RPE1, 1024, 2048}; pg8::StaticOrder S; S.init(NE * RPE1, 1024, C.G, (int)blockIdx.x, RPE1 / 256);
        pg8::EpiScaleRow E{XG, 1024, GSEL};
        pg8::gemm_phase<pg8::EpiScaleRow, pg8::StaticOrder, true, true>(C.lds, g, S, E); }
    SEAM(20);
    if (IN(21)) { RowArgs A{}; A.src_lat = out; A.dst_lat = out; A.gamma = args.in[24]; A.mv = MV + 5 * 6144; A.mvg = MV + 5 * 6144; A.i_gate = 5; A.Y = XG; A.INV = INV; A.rpe = RPE1; A.nrows = NLAT;
        row_phase<true, false, true>(C, A); }
#undef IN
#undef INR
#undef SEAM
}

extern "C" void kernel_launch(void* const* d_in, const int* in_sizes, int n_in, void* d_out, int out_size, void* d_ws, size_t ws_size, hipStream_t stream) {
    static int grid = 0;
    if (grid == 0) {
        if (n_in != 25 || in_sizes[0] != NLAT * D || out_size != NLAT * D || ws_size < WS_END) { fprintf(stderr, "kernel_launch: unexpected shapes (n_in %d, in0 %d, out %d, ws %zu)\n", n_in, n_in > 0 ? in_sizes[0] : -1, out_size, ws_size); grid = -1; return; }
        int dev = 0, cus = 0, per_cu = 0;
        if (hipGetDevice(&dev) != hipSuccess || hipDeviceGetAttribute(&cus, hipDeviceAttributeMultiprocessorCount, dev) != hipSuccess) { grid = -1; return; }
        if (hipFuncSetAttribute((const void*)mk_fwd, hipFuncAttributeMaxDynamicSharedMemorySize, LDS_BYTES) != hipSuccess) { fprintf(stderr, "kernel_launch: hipFuncSetAttribute failed\n"); grid = -1; return; }
        if (hipOccupancyMaxActiveBlocksPerMultiprocessor(&per_cu, (const void*)mk_fwd, NW * 64, LDS_BYTES) != hipSuccess || per_cu < 1) { fprintf(stderr, "kernel_launch: occupancy query reports %d blocks per CU\n", per_cu); (void)hipGetLastError(); grid = -1; return; }
        grid = cus;
    }
    if (grid < 0) return;
    if (hipMemsetAsync((char*)d_ws + WS_CTL, 0, CTL_ZERO_BYTES, stream) != hipSuccess) { fprintf(stderr, "kernel_launch: memset failed\n"); return; }
    Args a{};
    for (int i = 0; i < 25; ++i) a.in[i] = (const float*)d_in[i];
    a.out = (float*)d_out; a.ws = (unsigned char*)d_ws;
#if MK_SPLIT
    for (int p = 0; p < NPHASE; ++p) { a.ph_lo = p; a.ph_hi = p + 1; hipLaunchKernelGGL(mk_fwd, dim3(grid), dim3(NW * 64), LDS_BYTES, stream, a); }
#else
    a.ph_lo = 0; a.ph_hi = NPHASE;
    void* kargs[] = {&a};
    hipError_t e = hipLaunchCooperativeKernel((const void*)mk_fwd, dim3(grid), dim3(NW * 64), kargs, LDS_BYTES, stream);
    if (e != hipSuccess) fprintf(stderr, "kernel_launch: cooperative launch failed: %s (grid %d)\n", hipGetErrorString(e), grid);
#endif
}
```

```cpp
#include <hip/hip_runtime.h>
#include <hip/hip_cooperative_groups.h>
#include <cstdio>
#include <cstdint>
namespace cg = cooperative_groups;

#ifndef MK_SPLIT
#define MK_SPLIT 0
#endif

namespace pg8 {
#define PG8_LAS __attribute__((address_space(3)))
typedef unsigned short bf16_t;
typedef short bf16x8 __attribute__((ext_vector_type(8)));
typedef float f32x4 __attribute__((ext_vector_type(4)));
typedef unsigned u32x4 __attribute__((ext_vector_type(4)));
constexpr int BM = 256, BK = 64, HALF = 128, HTB = HALF * BK * 2  , STAGE_BYTES = 8 * HTB, NXCD = 8, WGM = 8;

__host__ __device__ __forceinline__ int lds_byte(int r, int c) { const int st = (r >> 4) * 2 + (c >> 5), rr = r & 15, cc = c & 31, ob = rr * 64 + cc * 2; return st * 1024 + (ob ^ (((ob >> 9) & 1) << 5)); }
__host__ __device__ __forceinline__ void stage_rc(int b, int& R, int& C) { const int st = b / 1024, sb = b % 1024, swz = sb ^ (((sb >> 9) & 1) << 5); R = (st >> 1) * 16 + swz / 64; C = (st & 1) * 32 + (swz % 64) / 2; }
__host__ __device__ __forceinline__ int perm32(int rho) { const int n = rho >> 4, i = rho & 15; return 8 * (i >> 2) + 4 * n + (i & 3); }

struct Unit { int pm, pn, pb; };
struct Gemm { const bf16_t* A; const bf16_t* Bt; int M, N, K; };

struct StaticOrder {
    int nM, nN, nwg, G, c, tpe;
    __host__ __device__ void init(int M, int N, int G_, int c_, int tpe_ = 0) { nM = M / BM; nN = N / BM; nwg = nM * nN; G = G_; c = c_; tpe = tpe_; }
    __host__ __device__ bool next(int i, Unit& u) const {
        const long L = (long)i * G + c; if (L >= nwg) return false;
        int wgid = (int)L; { const int q = nwg / NXCD, r = nwg % NXCD, xcd = wgid % NXCD, off = wgid / NXCD; wgid = (xcd < r ? xcd * (q + 1) : r * (q + 1) + (xcd - r) * q) + off; }
        const int nig = WGM * nN, gid = wgid / nig, fm = gid * WGM, gsz = (nM - fm) < WGM ? (nM - fm) : WGM;
        u.pm = fm + ((wgid % nig) % gsz); u.pn = (wgid % nig) / gsz; u.pb = tpe ? (u.pm / tpe) * nN + u.pn : u.pn; return true;
    }
    __device__ __forceinline__ void a_ready(const Unit&) const {}
    __device__ __forceinline__ void done(const Unit&) const {}
};

__device__ __forceinline__ unsigned cvt_pk_bf16(float lo, float hi) { unsigned r; asm volatile("v_cvt_pk_bf16_f32 %0, %1, %2" : "=v"(r) : "v"(lo), "v"(hi)); return r; }
__device__ __forceinline__ float fsigmoid(float x) { return __builtin_amdgcn_rcpf(1.0f + __expf(-x)); }

struct EpiBf16 {
    static constexpr bool PERM = true, AFTER_DRAIN = false;
    bf16_t* O; int ldc;
    __device__ __forceinline__ void operator()(const f32x4 (&acc)[2][2][4][2], const Unit& u, int wr, int wc, int fr, int fq) const {
        const int row0 = u.pm * BM + wr * 64 + fr, col0 = u.pn * BM + wc * 32 + 8 * fq;
#pragma unroll
        for (int ai = 0; ai < 2; ++ai)
#pragma unroll
            for (int m = 0; m < 4; ++m) { bf16_t* rowp = O + (size_t)(row0 + ai * HALF + m * 16) * ldc + col0;
#pragma unroll
                for (int bj = 0; bj < 2; ++bj) { const f32x4 v0 = acc[ai][bj][m][0], v1 = acc[ai][bj][m][1];
                    u32x4 w; w.x = cvt_pk_bf16(v0[0], v0[1]); w.y = cvt_pk_bf16(v0[2], v0[3]); w.z = cvt_pk_bf16(v1[0], v1[1]); w.w = cvt_pk_bf16(v1[2], v1[3]);
                    *(u32x4*)(rowp + bj * HALF) = w; } }
    }
};
template <int MODE> struct EpiGated {
    static constexpr bool PERM = true, AFTER_DRAIN = false;
    bf16_t* O; int ldc; const float* bias; int ystride;
    __device__ __forceinline__ void operator()(const f32x4 (&acc)[2][2][4][2], const Unit& u, int wr, int wc, int fr, int fq) const {
        const int row0 = u.pm * BM + wr * 64 + fr, ch0 = u.pn * HALF + wc * 32 + 8 * fq;
        f32x4 bx[2], by[2];
#pragma unroll
        for (int n = 0; n < 2; ++n) { if (MODE == 0) { bx[n] = *(const f32x4*)(bias + ch0 + 4 * n); by[n] = *(const f32x4*)(bias + ystride + ch0 + 4 * n); } else { bx[n] = (f32x4){0.f, 0.f, 0.f, 0.f}; by[n] = bx[n]; } }
#pragma unroll
        for (int ai = 0; ai < 2; ++ai)
#pragma unroll
            for (int m = 0; m < 4; ++m) { bf16_t* rowp = O + (size_t)(row0 + ai * HALF + m * 16) * ldc + ch0;
                float r[8];
#pragma unroll
                for (int n = 0; n < 2; ++n) { const f32x4 x = acc[ai][0][m][n] + bx[n], y = acc[ai][1][m][n] + by[n];
#pragma unroll
                    for (int j = 0; j < 4; ++j) r[4 * n + j] = (MODE == 0) ? x[j] * fsigmoid(y[j]) : x[j] * fsigmoid(x[j]) * y[j]; }
                u32x4 w; w.x = cvt_pk_bf16(r[0], r[1]); w.y = cvt_pk_bf16(r[2], r[3]); w.z = cvt_pk_bf16(r[4], r[5]); w.w = cvt_pk_bf16(r[6], r[7]);
                *(u32x4*)rowp = w; }
    }
};
struct EpiRes {
    static constexpr bool PERM = false, AFTER_DRAIN = false;
    const float* res0; float* out0; const float* res1; float* out1; const float* bias; const float* gate; int gstride;
    __device__ __forceinline__ void operator()(const f32x4 (&acc)[2][2][4][2], const Unit& u, int wr, int wc, int fr, int fq) const {
        const bool second = u.pm >= 128; const int grp = second ? 4 : (u.pm >> 5);
        const float* res = second ? res1 : res0; float* out = second ? out1 : out0;
        const int row0 = (second ? u.pm - 128 : u.pm) * BM + wr * 64 + fr, col0 = u.pn * BM + wc * 32 + 4 * fq;
        const float* gp = gate + (size_t)grp * gstride + col0;
#pragma unroll
        for (int bj = 0; bj < 2; ++bj)
#pragma unroll
            for (int n = 0; n < 2; ++n) {
                const f32x4 gv = *(const f32x4*)(gp + bj * HALF + n * 16);
                const f32x4 bv = bias ? *(const f32x4*)(bias + col0 + bj * HALF + n * 16) : (f32x4){0.f, 0.f, 0.f, 0.f};
#pragma unroll
                for (int ai = 0; ai < 2; ++ai)
#pragma unroll
                    for (int m = 0; m < 4; ++m) { const size_t off = (size_t)(row0 + ai * HALF + m * 16) * 1024 + col0 + bj * HALF + n * 16;
                        const f32x4 rv = *(const f32x4*)(res + off);
                        *(f32x4*)(out + off) = rv + gv * (acc[ai][bj][m][n] + bv); }
                asm volatile("" ::: "memory"); }
    }
};
struct EpiScaleRow {
    static constexpr bool PERM = true, AFTER_DRAIN = false;
    bf16_t* O; int ldc; const float* rs;
    __device__ __forceinline__ void operator()(const f32x4 (&acc)[2][2][4][2], const Unit& u, int wr, int wc, int fr, int fq) const {
        const int row0 = u.pm * BM + wr * 64 + fr, col0 = u.pn * BM + wc * 32 + 8 * fq;
#pragma unroll
        for (int ai = 0; ai < 2; ++ai)
#pragma unroll
            for (int m = 0; m < 4; ++m) { const int row = row0 + ai * HALF + m * 16; const float s = rs[row]; bf16_t* rowp = O + (size_t)row * ldc + col0;
#pragma unroll
                for (int bj = 0; bj < 2; ++bj) { const f32x4 v0 = acc[ai][bj][m][0] * s, v1 = acc[ai][bj][m][1] * s;
                    u32x4 w; w.x = cvt_pk_bf16(v0[0], v0[1]); w.y = cvt_pk_bf16(v0[2], v0[3]); w.z = cvt_pk_bf16(v1[0], v1[1]); w.w = cvt_pk_bf16(v1[2], v1[3]);
                    *(u32x4*)(rowp + bj * HALF) = w; } }
    }
};


template <class Epi, class Sched, bool ALIGN_EPI = false, bool SP2 = false>
__device__ __forceinline__ void gemm_phase(PG8_LAS unsigned char* lds, const Gemm g, const Sched& S, const Epi& E) {
    const int tid = threadIdx.x, wid = __builtin_amdgcn_readfirstlane(tid >> 6), lane = tid & 63, wr = wid >> 2, wc = wid & 3, fr = lane & 15, fq = lane >> 4;
    const int K = g.K, nt = K / BK;
    unsigned voffA[2], voffB[2];
#pragma unroll
    for (int i = 0; i < 2; ++i) { int R, C; stage_rc(tid * 16 + i * 8192, R, C); const int Rb = Epi::PERM ? ((R & ~31) + perm32(R & 31)) : R;
        voffA[i] = (unsigned)(R * K + C) * 2u; voffB[i] = (unsigned)(Rb * K + C) * 2u; }
    const size_t kstep = (size_t)(BK * 2);
    const size_t hstep = (size_t)HALF * K * 2;
    const size_t tstep = 2 * hstep;
    const unsigned ldsw = (unsigned)wid * 1024u;
    const int aoff = lds_byte(wr * 64 + fr, fq * 8), boff = lds_byte(wc * 32 + fr, fq * 8);
#define PG8_SA(b, h) (((b) * 2 + (h)) * HTB)
#define PG8_SB(b, h) ((4 + (b) * 2 + (h)) * HTB)
#define PG8_STAGE(bufoff, gbase, voff) do { _Pragma("unroll") for (int _i = 0; _i < 2; ++_i) \
        __builtin_amdgcn_global_load_lds((const unsigned*)((const char*)(gbase) + (voff)[_i]), (PG8_LAS unsigned*)(lds + (bufoff) + ldsw + _i * 8192), 16, 0, 0); } while (0)
#define PG8_LDA(dst, b, h) do { _Pragma("unroll") for (int m = 0; m < 4; ++m) _Pragma("unroll") for (int k = 0; k < 2; ++k) dst[m][k] = *(const PG8_LAS bf16x8*)(lds + PG8_SA(b, h) + aoff + m * 2048 + k * 1024); } while (0)
#define PG8_LDB(dst, b, h) do { _Pragma("unroll") for (int n = 0; n < 2; ++n) _Pragma("unroll") for (int k = 0; k < 2; ++k) dst[n][k] = *(const PG8_LAS bf16x8*)(lds + PG8_SB(b, h) + boff + n * 2048 + k * 1024); } while (0)
#define PG8_MMA(ai, bj, At, Bt) do { __builtin_amdgcn_s_setprio(1); _Pragma("unroll") for (int m = 0; m < 4; ++m) _Pragma("unroll") for (int n = 0; n < 2; ++n) _Pragma("unroll") for (int k = 0; k < 2; ++k) \
        acc[ai][bj][m][n] = __builtin_amdgcn_mfma_f32_16x16x32_bf16(Bt[n][k], At[m][k], acc[ai][bj][m][n], 0, 0, 0); __builtin_amdgcn_s_setprio(0); } while (0)
#define PG8_WAIT_V(n) asm volatile("s_waitcnt vmcnt(" #n ")" ::: "memory")
#define PG8_WAIT_L(n) asm volatile("s_waitcnt lgkmcnt(" #n ")" ::: "memory")
#define PG8_BAR __builtin_amdgcn_s_barrier()
#define PG8_SCHED __builtin_amdgcn_sched_barrier(0)
    Unit cur, nxt; int ui = 0;
    if (!S.next(0, cur)) return;
    f32x4 acc[2][2][4][2];
#pragma unroll
    for (int a = 0; a < 2; ++a)
#pragma unroll
        for (int b = 0; b < 2; ++b)
#pragma unroll
            for (int m = 0; m < 4; ++m)
#pragma unroll
                for (int n = 0; n < 2; ++n) acc[a][b][m][n] = (f32x4){0.f, 0.f, 0.f, 0.f};
    bf16x8 At[4][2], B0[2][2], B1[2][2];
    const char* cA = (const char*)g.A + (size_t)cur.pm * tstep; const char* cB = (const char*)g.Bt + (size_t)cur.pb * tstep;
    S.a_ready(cur);
    if constexpr (SP2) {
        PG8_STAGE(PG8_SB(0, 0), cB, voffB); PG8_STAGE(PG8_SB(0, 1), cB + hstep, voffB); PG8_STAGE(PG8_SA(0, 0), cA, voffA); PG8_STAGE(PG8_SA(0, 1), cA + hstep, voffA);
        if (wr == 1) PG8_BAR;
        PG8_WAIT_V(2); PG8_BAR;
        PG8_STAGE(PG8_SB(1, 0), cB + kstep, voffB); PG8_STAGE(PG8_SA(1, 0), cA + kstep, voffA); PG8_STAGE(PG8_SB(1, 1), cB + hstep + kstep, voffB);
        PG8_WAIT_V(6); PG8_BAR;
    } else {
        PG8_STAGE(PG8_SB(0, 0), cB, voffB); PG8_STAGE(PG8_SA(0, 0), cA, voffA); PG8_STAGE(PG8_SB(0, 1), cB + hstep, voffB); PG8_STAGE(PG8_SA(0, 1), cA + hstep, voffA);
        if (wr == 1) PG8_BAR;
        PG8_WAIT_V(4); PG8_BAR;
        PG8_STAGE(PG8_SB(1, 0), cB + kstep, voffB); PG8_STAGE(PG8_SA(1, 0), cA + kstep, voffA); PG8_STAGE(PG8_SB(1, 1), cB + hstep + kstep, voffB);
        PG8_WAIT_V(6); PG8_BAR;
    }
    for (;;) {
        const bool has_next = S.next(ui + 1, nxt);
        const char* nA = has_next ? (const char*)g.A + (size_t)nxt.pm * tstep : cA; const char* nB = has_next ? (const char*)g.Bt + (size_t)nxt.pb * tstep : cB;
        for (int t = 0; t < nt; t += 2) {
            const bool last = (t == nt - 2);
            const char* a1 = cA + (size_t)(t + 1) * kstep;
            const char* a2 = last ? nA : cA + (size_t)(t + 2) * kstep; const char* b2 = last ? nB : cB + (size_t)(t + 2) * kstep;
            const char* a3 = a2 + kstep; const char* b3 = b2 + kstep;
            if (last && has_next) S.a_ready(nxt);
            if constexpr (SP2) {
            PG8_LDB(B0, 0, 0); PG8_LDB(B1, 0, 1); PG8_SCHED; PG8_LDA(At, 0, 0); PG8_STAGE(PG8_SA(1, 1), a1 + hstep, voffA);
            PG8_WAIT_V(8); PG8_WAIT_L(0); PG8_BAR; PG8_MMA(0, 0, At, B0); PG8_MMA(0, 1, At, B1); PG8_BAR; PG8_SCHED;
            PG8_LDA(At, 0, 1); PG8_STAGE(PG8_SB(0, 0), b2, voffB); PG8_STAGE(PG8_SB(0, 1), b2 + hstep, voffB); PG8_STAGE(PG8_SA(0, 0), a2, voffA);
            PG8_WAIT_V(8); PG8_WAIT_L(0); PG8_BAR; PG8_MMA(1, 0, At, B0); PG8_MMA(1, 1, At, B1); PG8_BAR; PG8_SCHED;
            PG8_LDB(B0, 1, 0); PG8_LDB(B1, 1, 1); PG8_SCHED; PG8_LDA(At, 1, 0); PG8_STAGE(PG8_SA(0, 1), a2 + hstep, voffA);
            PG8_WAIT_V(8); PG8_WAIT_L(0); PG8_BAR; PG8_MMA(0, 0, At, B0); PG8_MMA(0, 1, At, B1); PG8_BAR; PG8_SCHED;
            PG8_LDA(At, 1, 1); PG8_STAGE(PG8_SB(1, 0), b3, voffB); PG8_STAGE(PG8_SB(1, 1), b3 + hstep, voffB); PG8_STAGE(PG8_SA(1, 0), a3, voffA);
            PG8_WAIT_V(8); PG8_WAIT_L(0); PG8_BAR; PG8_MMA(1, 0, At, B0); PG8_MMA(1, 1, At, B1); PG8_BAR; PG8_SCHED;
            } else {
            PG8_LDB(B0, 0, 0); PG8_SCHED; PG8_LDA(At, 0, 0); PG8_STAGE(PG8_SA(1, 1), a1 + hstep, voffA);
            PG8_WAIT_L(8); PG8_BAR; PG8_WAIT_L(0); PG8_MMA(0, 0, At, B0); PG8_BAR; PG8_SCHED;
            PG8_LDB(B1, 0, 1); PG8_STAGE(PG8_SB(0, 0), b2, voffB);
            PG8_BAR; PG8_WAIT_L(0); PG8_MMA(0, 1, At, B1); PG8_BAR;
            PG8_LDA(At, 0, 1); PG8_STAGE(PG8_SA(0, 0), a2, voffA);
            PG8_BAR; PG8_WAIT_L(0); PG8_MMA(1, 0, At, B0); PG8_BAR; PG8_SCHED;
            PG8_STAGE(PG8_SB(0, 1), b2 + hstep, voffB);
            PG8_WAIT_V(6); PG8_BAR; PG8_MMA(1, 1, At, B1); PG8_BAR;
            PG8_LDB(B0, 1, 0); PG8_SCHED; PG8_LDA(At, 1, 0); PG8_STAGE(PG8_SA(0, 1), a2 + hstep, voffA);
            PG8_WAIT_L(8); PG8_BAR; PG8_WAIT_L(0); PG8_MMA(0, 0, At, B0); PG8_BAR; PG8_SCHED;
            PG8_LDB(B1, 1, 1); PG8_STAGE(PG8_SB(1, 0), b3, voffB);
            PG8_BAR; PG8_WAIT_L(0); PG8_MMA(0, 1, At, B1); PG8_BAR;
            PG8_LDA(At, 1, 1); PG8_STAGE(PG8_SA(1, 0), a3, voffA);
            PG8_BAR; PG8_WAIT_L(0); PG8_MMA(1, 0, At, B0); PG8_BAR; PG8_SCHED;
            PG8_STAGE(PG8_SB(1, 1), b3 + hstep, voffB);
            PG8_WAIT_V(6); PG8_BAR; PG8_MMA(1, 1, At, B1); PG8_BAR;
            }
        }
        if constexpr (ALIGN_EPI) { if (wr == 0) PG8_BAR; }
        if constexpr (!Epi::AFTER_DRAIN) { E(acc, cur, wr, wc, fr, fq); S.done(cur); }
        if (!has_next) break;
#pragma unroll
        for (int a = 0; a < 2; ++a)
#pragma unroll
            for (int b = 0; b < 2; ++b)
#pragma unroll
                for (int m = 0; m < 4; ++m)
#pragma unroll
                    for (int n = 0; n < 2; ++n) acc[a][b][m][n] = (f32x4){0.f, 0.f, 0.f, 0.f};
        cur = nxt; cA = nA; cB = nB; ++ui;
        if constexpr (ALIGN_EPI) { if (wr == 1) PG8_BAR; }
    }
    PG8_WAIT_V(0);
    if constexpr (!ALIGN_EPI) { if (wr == 0) PG8_BAR; }
    PG8_BAR;
    if constexpr (Epi::AFTER_DRAIN) { E.fused(acc, cur, wr, wc, fr, fq, lds, wid, lane); S.done(cur); }
#undef PG8_SA
#undef PG8_SB
#undef PG8_STAGE
#undef PG8_LDA
#undef PG8_LDB
#undef PG8_MMA
#undef PG8_WAIT_V
#undef PG8_WAIT_L
#undef PG8_BAR
#undef PG8_SCHED
}
}

constexpr int NW = 8;
constexpr int D = 1024, NB = 4, T = 8192, TCX = 256, NLAT = NB * T, NCTX = NB * TCX, R = NLAT + NCTX;
constexpr int NE = 16, FF = 2048, CAPL = 1024, CAPC = 32;
constexpr int RPE0 = 4352, RPE1 = 4096;
constexpr int HD = 128, NH = 8, NSEQ = NB * NH * 2;
constexpr int NGRP = 17;
constexpr float EPS = 1e-6f;

constexpr size_t MiB = 1u << 20;
constexpr size_t WS_CTL = 0, CTL_ZERO_BYTES = 1 * MiB;
constexpr size_t WS_MV = 1 * MiB;
constexpr size_t WS_LB = WS_MV + 256 * 1024;
constexpr size_t WS_AFF = 2 * MiB;
constexpr size_t WS_INV = 5 * MiB;
constexpr size_t WS_SEL = 7 * MiB;
constexpr size_t WS_GSEL = 7 * MiB + 512 * 1024;
constexpr size_t WS_CTXS = 8 * MiB;
constexpr size_t WS_W1T = 12 * MiB, WS_W2T = 16 * MiB, WS_WINT = 18 * MiB, WS_WOUTT = 28 * MiB;
constexpr size_t WS_PTOT = 30 * MiB;
constexpr size_t WS_W13T = 32 * MiB;
constexpr size_t WS_WDT = 160 * MiB;
constexpr size_t WS_HB = 224 * MiB;
constexpr size_t WS_UB = 290 * MiB;
constexpr size_t WS_XG = 356 * MiB;
constexpr size_t WS_HBUF = 492 * MiB;
constexpr size_t WS_PRJ = 356 * MiB;
constexpr size_t WS_OLOC = 764 * MiB;
constexpr size_t WS_QGG = 892 * MiB;
constexpr size_t WS_SST = 32 * MiB;
constexpr size_t WS_END = 1020 * MiB;
static_assert(WS_PRJ + (size_t)R * 5120 * 2 <= WS_OLOC && WS_HBUF + (size_t)16 * RPE0 * 2048 * 2 <= WS_OLOC && WS_XG + (size_t)16 * RPE0 * 1024 * 2 <= WS_HBUF, "ws map");
static_assert(WS_HB + (size_t)R * 1024 * 2 <= WS_UB && WS_UB + (size_t)R * 1024 * 2 <= WS_XG && WS_QGG + (size_t)2 * NLAT * 1024 * 2 <= WS_END, "ws map 2");

constexpr int CW_BAR = 4096;
constexpr int LDS_BYTES = 147456;
constexpr int MISC_OFF = 131072 + 320;

#define GAS __attribute__((address_space(1)))
#define LAS __attribute__((address_space(3)))
typedef unsigned short bf16;
typedef unsigned v4u __attribute__((ext_vector_type(4)));
typedef unsigned v2u __attribute__((ext_vector_type(2)));
typedef float f32x4 __attribute__((ext_vector_type(4)));
typedef float f32x2 __attribute__((ext_vector_type(2)));
typedef short bf16x8 __attribute__((ext_vector_type(8)));
typedef short bf16x4 __attribute__((ext_vector_type(4)));
#define LDS_WAIT() asm volatile("s_waitcnt lgkmcnt(0)" ::: "memory")
__device__ __forceinline__ unsigned pk2(float lo, float hi) { return pg8::cvt_pk_bf16(lo, hi); }
__device__ __forceinline__ float bflo(unsigned w) { return __uint_as_float(w << 16); }
__device__ __forceinline__ float bfhi(unsigned w) { return __uint_as_float(w & 0xffff0000u); }
__device__ __forceinline__ float fsig(float x) { return __builtin_amdgcn_rcpf(1.0f + __expf(-x)); }
__device__ __forceinline__ float wave_sum(float v) {
#pragma unroll
    for (int o = 1; o < 64; o <<= 1) v += __shfl_xor(v, o);
    return v;
}

#define XB_TMO      128
#define XB_XCNT(j)  (256  + 64 * (j))
#define XB_XSUB(j)  (1280 + 64 * (j))
#define XB_XGEN(j)  (2304 + 64 * (j))
#define XB_TOP      3328
#define XB_TOPGEN   3392
#define XCD_BAR_WORDS 3456
#define XB_SPIN_CAP (1u << 20)
__device__ __forceinline__ unsigned xb_ld(unsigned* p)              { return __hip_atomic_load(p, __ATOMIC_RELAXED, __HIP_MEMORY_SCOPE_AGENT); }
__device__ __forceinline__ unsigned xb_add(unsigned* p, unsigned v) { return __hip_atomic_fetch_add(p, v, __ATOMIC_RELAXED, __HIP_MEMORY_SCOPE_AGENT); }
__device__ __forceinline__ unsigned xb_xcc_id() { return (unsigned)__builtin_amdgcn_s_getreg((3 << 11) | 20) & 0xFu; }
#define XB_SPIN(cond, bar) do { unsigned _sp = 0; while (cond) { __builtin_amdgcn_s_sleep(1); \
    if ((++_sp & 255u) == 0u) { if (xb_ld(&(bar)[XB_TMO])) break; if (_sp > XB_SPIN_CAP) { atomicAdd(&(bar)[XB_TMO], 1u); break; } } } } while (0)
struct XcdBarrier { unsigned* bar; unsigned x; volatile LAS unsigned* st; };
__device__ __forceinline__ XcdBarrier xcd_barrier_post(unsigned* bar, volatile LAS unsigned* st) {
    XcdBarrier b; b.bar = bar; b.x = xb_xcc_id(); b.st = st;
    if (threadIdx.x == 0) (void)xb_add(&bar[XB_XCNT(b.x)], 1u);
    return b;
}
__device__ __forceinline__ void xcd_barrier_complete(unsigned* bar, unsigned x, unsigned& nloc, unsigned& nx) {
    const unsigned G = gridDim.x * gridDim.y * gridDim.z;
    unsigned sum, cnt, mine, sp = 0u;
    for (;;) {
        sum = 0u; cnt = 0u; mine = 0u;
#pragma unroll
        for (unsigned j = 0; j < 16; ++j) { const unsigned c = xb_ld(&bar[XB_XCNT(j)]); sum += c; cnt += (c > 0u) ? 1u : 0u; mine = (j == x) ? c : mine; }
        if (sum == G) break;
        __builtin_amdgcn_s_sleep(1);
        if ((++sp & 255u) == 0u) { if (xb_ld(&bar[XB_TMO])) break; if (sp > XB_SPIN_CAP) { atomicAdd(&bar[XB_TMO], 1u); break; } }
    }
    nloc = mine > 0u ? mine : 1u; nx = cnt > 0u ? cnt : 1u;
}
__device__ __forceinline__ void xcd_barrier(const XcdBarrier& b) {
    asm volatile("s_waitcnt vmcnt(0)" ::: "memory");
    __syncthreads();
    if (threadIdx.x == 0) {
        unsigned* bar = b.bar;
        __builtin_amdgcn_s_waitcnt(0);
        unsigned nloc = b.st[0], nx = b.st[1];
        if (nloc == 0u) { xcd_barrier_complete(bar, b.x, nloc, nx); b.st[0] = nloc; b.st[1] = nx; }
        const unsigned old = xb_add(&bar[XB_XSUB(b.x)], 1u);
        const unsigned gen = old / nloc;
        if (old + 1u == (gen + 1u) * nloc) {
            __builtin_amdgcn_fence(__ATOMIC_RELEASE, "agent");
            asm volatile("s_waitcnt vmcnt(0)" ::: "memory");
            const unsigned og = xb_add(&bar[XB_TOP], 1u);
            const unsigned tg = og / nx;
            if (og + 1u == (tg + 1u) * nx) xb_add(&bar[XB_TOPGEN], 1u);
            else XB_SPIN(xb_ld(&bar[XB_TOPGEN]) == tg, bar);
            __builtin_amdgcn_fence(__ATOMIC_ACQUIRE, "agent");
            xb_add(&bar[XB_XGEN(b.x)], 1u);
            asm volatile("s_waitcnt vmcnt(0)" ::: "memory");
        } else {
            XB_SPIN(xb_ld(&bar[XB_XGEN(b.x)]) == gen, bar);
            __builtin_amdgcn_fence(__ATOMIC_ACQUIRE, "agent");
            asm volatile("s_waitcnt vmcnt(0)" ::: "memory");
        }
    }
    __syncthreads();
}

struct Ctx {
    LAS unsigned char* lds;
    int tid, lane, wave, vcu, G, gw, NGW;
};

__device__ __forceinline__ void transpose_item(const float* W, int ldw, int k0, int n0, bf16* WT, int K, int drow0, LAS float* scr, int lane) {
    float tv[32];
    const float* wp = W + (size_t)(k0 + (lane >> 5)) * ldw + n0 + (lane & 31);
#pragma unroll
    for (int i = 0; i < 32; ++i) tv[i] = wp[(size_t)(2 * i) * ldw];
#pragma unroll
    for (int i = 0; i < 32; ++i) scr[(2 * i + (lane >> 5)) * 33 + (lane & 31)] = tv[i];
    LDS_WAIT(); asm volatile("" ::: "memory");
    const int c = lane & 7;
#pragma unroll
    for (int j = 0; j < 4; ++j) { const int n = (lane >> 3) + 8 * j; const LAS float* s = scr + (8 * c) * 33 + n;
        v4u o; o.x = pk2(s[0 * 33], s[1 * 33]); o.y = pk2(s[2 * 33], s[3 * 33]); o.z = pk2(s[4 * 33], s[5 * 33]); o.w = pk2(s[6 * 33], s[7 * 33]);
        *(v4u*)(WT + (size_t)(drow0 + n) * K + k0 + 8 * c) = o; }
    LDS_WAIT(); asm volatile("" ::: "memory");
}
__device__ __forceinline__ void paired_src(int db, int& type, int& ch) { const int j0 = 32 * db, pn = j0 >> 8, jj = j0 & 255; type = jj >> 7; ch = 128 * pn + (jj & 127); }

__device__ __forceinline__ void convert_small(const Ctx& C, const float* w1, const float* w2, const float* win, const float* wout, unsigned char* ws) {
    LAS float* scr = (LAS float*)(C.lds + C.wave * 16384);
    constexpr int I1 = 16 * 64, I2 = 16 * 32, I3 = 16 * 160, I4 = 16 * 32, NI = I1 + I2 + I3 + I4;
    for (int it = C.gw; it < NI; it += C.NGW) {
        int r = it;
        if (r < I1) { const int kb = r / 64, db = r % 64; int type, ch; paired_src(db, type, ch); transpose_item(w1, 2048, 64 * kb, type * 1024 + ch, (bf16*)(ws + WS_W1T), 1024, 32 * db, scr, C.lane); continue; } r -= I1;
        if (r < I2) { const int kb = r / 32, db = r % 32; transpose_item(w2, 1024, 64 * kb, 32 * db, (bf16*)(ws + WS_W2T), 1024, 32 * db, scr, C.lane); continue; } r -= I2;
        if (r < I3) { const int kb = r / 160, db = r % 160; transpose_item(win, 5120, 64 * kb, 32 * db, (bf16*)(ws + WS_WINT), 1024, 32 * db, scr, C.lane); continue; } r -= I3;
        { const int kb = r / 32, db = r % 32; transpose_item(wout, 1024, 64 * kb, 32 * db, (bf16*)(ws + WS_WOUTT), 1024, 32 * db, scr, C.lane); }
    }
}
__device__ __forceinline__ void convert_moe(const Ctx& C, const float* wg, const float* wu, const float* wd, int layer, unsigned char* ws) {
    LAS float* scr = (LAS float*)(C.lds + C.wave * 16384);
    constexpr int IGU = 16 * 128, IDN = 32 * 32, IE = IGU + IDN;
    const size_t lo = (size_t)layer * NE * 1024 * 2048;
    for (int it = C.gw; it < NE * IE; it += C.NGW) {
        const int e = it / IE; int r = it % IE;
        if (r < IGU) { const int kb = r / 128, db = r % 128; int type, ch; paired_src(db, type, ch);
            transpose_item((type ? wu : wg) + lo + (size_t)e * 1024 * 2048, 2048, 64 * kb, ch, (bf16*)(ws + WS_W13T) + (size_t)e * 4096 * 1024, 1024, 32 * db, scr, C.lane); }
        else { r -= IGU; const int kb = r / 32, db = r % 32;
            transpose_item(wd + lo + (size_t)e * 2048 * 1024, 1024, 64 * kb, 32 * db, (bf16*)(ws + WS_WDT) + (size_t)e * 1024 * 2048, 2048, 32 * db, scr, C.lane); }
    }
}
__device__ __forceinline__ void mod_gemv(const Ctx& C, const float* c, const float* cctx, const float* mod_w, const float* mod_b, float* MV) {
    LAS float* cond = (LAS float*)C.lds;
    LAS float* red = cond + 5 * 1024;
    bool have = false;
    for (int item = blockIdx.x; item < 192; item += C.G) {
        if (!have) { for (int i = C.tid; i < 5 * 1024; i += NW * 64) { const int g = i >> 10, k = i & 1023; const float v = g < 4 ? c[g * 1024 + k] : cctx[k]; cond[i] = v * fsig(v); } have = true; }
        __syncthreads();
        const int l = item / 96, n = (item % 96) * 64 + C.lane;
        const float* W = mod_w + (size_t)l * 1024 * 6144 + n;
        float a[5] = {0.f, 0.f, 0.f, 0.f, 0.f};
        for (int kk = 0; kk < 128; kk += 8) { float w[8];
#pragma unroll
            for (int u = 0; u < 8; ++u) w[u] = W[(size_t)(C.wave * 128 + kk + u) * 6144];
#pragma unroll
            for (int u = 0; u < 8; ++u)
#pragma unroll
                for (int g = 0; g < 5; ++g) a[g] += cond[g * 1024 + C.wave * 128 + kk + u] * w[u]; }
#pragma unroll
        for (int g = 0; g < 5; ++g) red[(C.wave * 5 + g) * 64 + C.lane] = a[g];
        __syncthreads();
        if (C.wave < 5) { float s = 0.f;
#pragma unroll
            for (int w = 0; w < 8; ++w) s += red[(w * 5 + C.wave) * 64 + C.lane];
            MV[(size_t)(l * 5 + C.wave) * 6144 + n] = s + mod_b[l * 6144 + n]; }
    }
}

struct RowArgs {
    const float* src_lat; const float* src_ctx;
    float* dst_lat; float* dst_ctx;
    const float* gamma;
    const float* mv;
    const float* mvg;
    int i_shift, i_scale, i_gate;
    bf16* HB; float* AFF; const float* router_w;
    const bf16* Y; const short* INV; int rpe;
    int nrows;
};
template <bool COMBINE, bool ROUTER, bool FINAL>
__device__ __forceinline__ void row_phase(const Ctx& C, const RowArgs& A) {
    LAS float* rwT = (LAS float*)C.lds;
    if (ROUTER) { for (int i = C.tid; i < 16384; i += NW * 64) rwT[(i & 15) * 1024 + (i >> 4)] = A.router_w[i]; __syncthreads(); }
    const int rpw = (A.nrows + C.NGW - 1) / C.NGW;
    const int r_lo = C.gw * rpw, r_hi = min(A.nrows, r_lo + rpw);
    const int l4 = 4 * C.lane;
    int cur_grp = -1;
    f32x4 ga[4], sh[4], m5[4];
#pragma unroll
    for (int j = 0; j < 4; ++j) { ga[j] = (f32x4){0.f, 0.f, 0.f, 0.f}; sh[j] = ga[j]; m5[j] = ga[j]; }
    f32x4 vn[4];
#pragma unroll
    for (int j = 0; j < 4; ++j) vn[j] = (f32x4){0.f, 0.f, 0.f, 0.f};
    if (r_lo < r_hi) { const bool ic = r_lo >= NLAT; const float* s0 = (ic ? A.src_ctx + (size_t)(r_lo - NLAT) * 1024 : A.src_lat + (size_t)r_lo * 1024);
#pragma unroll
        for (int j = 0; j < 4; ++j) vn[j] = *(const f32x4*)(s0 + l4 + 256 * j); }
    for (int r = r_lo; r < r_hi; ++r) {
        const bool isctx = r >= NLAT; const int grp = isctx ? 4 : (r >> 13);
        if (grp != cur_grp) { cur_grp = grp; const float* mvn = A.mv + (size_t)grp * 6144;
#pragma unroll
            for (int j = 0; j < 4; ++j) { const int c0 = l4 + 256 * j; const f32x4 g = *(const f32x4*)(A.gamma + c0);
                if (FINAL) { ga[j] = g; }
                else { const f32x4 sc = *(const f32x4*)(mvn + A.i_scale * 1024 + c0); ga[j] = g * (sc + 1.0f); sh[j] = *(const f32x4*)(mvn + A.i_shift * 1024 + c0); }
                if (COMBINE) m5[j] = *(const f32x4*)(A.mvg + (size_t)grp * 6144 + A.i_gate * 1024 + c0); } }
        const size_t roff = isctx ? (size_t)(r - NLAT) * 1024 : (size_t)r * 1024;
        f32x4 v[4];
#pragma unroll
        for (int j = 0; j < 4; ++j) v[j] = vn[j];
        if (r + 1 < r_hi) { const int rn = r + 1; const bool ic = rn >= NLAT; const float* s1 = (ic ? A.src_ctx + (size_t)(rn - NLAT) * 1024 : A.src_lat + (size_t)rn * 1024);
#pragma unroll
            for (int j = 0; j < 4; ++j) vn[j] = *(const f32x4*)(s1 + l4 + 256 * j); }
        if (COMBINE) {
            f32x4 acc[4];
#pragma unroll
            for (int j = 0; j < 4; ++j) acc[j] = (f32x4){0.f, 0.f, 0.f, 0.f};
            const int sv = (C.lane < 16) ? (int)A.INV[(size_t)r * 16 + C.lane] : -1;
            unsigned long long m = __ballot(sv >= 0);
            while (m) { const int e = __ffsll((long long)m) - 1; m &= m - 1;
                const int slot = __shfl(sv, e);
                const bf16* yr = A.Y + ((size_t)e * A.rpe + slot) * 1024 + l4;
#pragma unroll
                for (int j = 0; j < 4; ++j) { const v2u w = *(const v2u*)(yr + 256 * j); acc[j] += (f32x4){bflo(w.x), bfhi(w.x), bflo(w.y), bfhi(w.y)}; } }
#pragma unroll
            for (int j = 0; j < 4; ++j) v[j] += m5[j] * acc[j];
            if (!FINAL) { float* dst = (isctx ? A.dst_ctx : A.dst_lat) + roff;
#pragma unroll
                for (int j = 0; j < 4; ++j) *(f32x4*)(dst + l4 + 256 * j) = v[j]; }
        }
        float ss = 0.f;
#pragma unroll
        for (int j = 0; j < 4; ++j) ss += (v[j].x * v[j].x + v[j].y * v[j].y) + (v[j].z * v[j].z + v[j].w * v[j].w);
        const float rstd = rsqrtf(wave_sum(ss) * (1.0f / 1024.0f) + EPS);
        if (FINAL) { float* dst = A.dst_lat + roff;
#pragma unroll
            for (int j = 0; j < 4; ++j) *(f32x4*)(dst + l4 + 256 * j) = v[j] * rstd * ga[j];
            continue; }
        f32x4 hv[4];
#pragma unroll
        for (int j = 0; j < 4; ++j) { hv[j] = v[j] * rstd * ga[j] + sh[j];
            v2u w; w.x = pk2(hv[j].x, hv[j].y); w.y = pk2(hv[j].z, hv[j].w); *(v2u*)(A.HB + (size_t)r * 1024 + l4 + 256 * j) = w; }
        if (ROUTER) {
            float lg[16];
#pragma unroll
            for (int e = 0; e < 16; ++e) { float s = 0.f;
#pragma unroll
                for (int j = 0; j < 4; ++j) { const f32x4 w = *(const LAS f32x4*)(rwT + e * 1024 + l4 + 256 * j); s += (hv[j].x * w.x + hv[j].y * w.y) + (hv[j].z * w.z + hv[j].w * w.w); }
                lg[e] = s; }
            float t8[8], t4[4], t2[2], t1;
#pragma unroll
            for (int i = 0; i < 8; ++i) { const bool up = (C.lane & 32) != 0; const float send = up ? lg[i] : lg[i + 8], keep = up ? lg[i + 8] : lg[i]; t8[i] = keep + __shfl_xor(send, 32); }
#pragma unroll
            for (int i = 0; i < 4; ++i) { const bool up = (C.lane & 16) != 0; const float send = up ? t8[i] : t8[i + 4], keep = up ? t8[i + 4] : t8[i]; t4[i] = keep + __shfl_xor(send, 16); }
#pragma unroll
            for (int i = 0; i < 2; ++i) { const bool up = (C.lane & 8) != 0; const float send = up ? t4[i] : t4[i + 2], keep = up ? t4[i + 2] : t4[i]; t2[i] = keep + __shfl_xor(send, 8); }
            { const bool up = (C.lane & 4) != 0; const float send = up ? t2[0] : t2[1], keep = up ? t2[1] : t2[0]; t1 = keep + __shfl_xor(send, 4); }
            t1 += __shfl_xor(t1, 2); t1 += __shfl_xor(t1, 1);
            const int e = ((C.lane >> 5) & 1) * 8 + ((C.lane >> 4) & 1) * 4 + ((C.lane >> 3) & 1) * 2 + ((C.lane >> 2) & 1);
            float mx = t1;
#pragma unroll
            for (int o = 4; o < 64; o <<= 1) mx = fmaxf(mx, __shfl_xor(mx, o));
            const float p = __expf(t1 - mx); float sum = p;
#pragma unroll
            for (int o = 4; o < 64; o <<= 1) sum += __shfl_xor(sum, o);
            if ((C.lane & 3) == 0) A.AFF[(size_t)r * 16 + e] = p / sum;
        }
    }
    if (ROUTER) __syncthreads();
}

__device__ __forceinline__ void conv_phase(const Ctx& C, const bf16* U, bf16* V, const float* dw, const float* dwb, const float* lng, const float* lnb) {
    LAS unsigned* ut = (LAS unsigned*)C.lds;
    LAS float* part = (LAS float*)(C.lds + 126976);
    LAS float* stat = part + 512;
    const int cp = C.tid;
    f32x2 wt[31];
#pragma unroll
    for (int j = 0; j < 31; ++j) wt[j] = *(const f32x2*)(dw + j * 1024 + 2 * cp);
    const f32x2 bb = *(const f32x2*)(dwb + 2 * cp), gg = *(const f32x2*)(lng + 2 * cp), be = *(const f32x2*)(lnb + 2 * cp);
    for (int tile = C.vcu; tile < 1056; tile += C.G) {
        int rowbase, t0, tseq;
        if (tile < 1024) { rowbase = (tile >> 8) * T; t0 = (tile & 255) * 32; tseq = T; } else { const int tt = tile - 1024; rowbase = NLAT + (tt >> 3) * TCX; t0 = (tt & 7) * 32; tseq = TCX; }
        for (int q = C.tid; q < 62 * 128; q += NW * 64) { const int i = q >> 7, cc = q & 127, t = t0 - 15 + i;
            v4u val = (v4u){0u, 0u, 0u, 0u};
            if (t >= 0 && t < tseq) val = *(const v4u*)(U + (size_t)(rowbase + t) * 1024 + cc * 8);
            *(LAS v4u*)(C.lds + i * 2048 + cc * 16) = val; }
        __syncthreads();
        f32x2 ov[32];
#pragma unroll
        for (int g = 0; g < 8; ++g) {
            f32x2 a[4];
#pragma unroll
            for (int oo = 0; oo < 4; ++oo) a[oo] = bb;
#pragma unroll
            for (int jj = 0; jj < 34; ++jj) { const unsigned uw = ut[(4 * g + jj) * 512 + cp]; const f32x2 uu = (f32x2){bflo(uw), bfhi(uw)};
#pragma unroll
                for (int oo = 0; oo < 4; ++oo) { const int tap = jj - oo; if (tap >= 0 && tap <= 30) a[oo] = __builtin_elementwise_fma(wt[tap], uu, a[oo]); } }
#pragma unroll
            for (int oo = 0; oo < 4; ++oo) { ov[4 * g + oo] = a[oo];
                const float s1 = wave_sum(a[oo].x + a[oo].y), s2 = wave_sum(a[oo].x * a[oo].x + a[oo].y * a[oo].y);
                if (C.lane == 0) { part[((4 * g + oo) * 8 + C.wave) * 2] = s1; part[((4 * g + oo) * 8 + C.wave) * 2 + 1] = s2; } }
            asm volatile("" ::: "memory");
        }
        __syncthreads();
        if (C.tid < 32) { float s1 = 0.f, s2 = 0.f;
#pragma unroll
            for (int w = 0; w < 8; ++w) { s1 += part[(C.tid * 8 + w) * 2]; s2 += part[(C.tid * 8 + w) * 2 + 1]; }
            const float mean = s1 * (1.0f / 1024.0f), var = fmaxf(s2 * (1.0f / 1024.0f) - mean * mean, 0.f);
            stat[C.tid * 2] = mean; stat[C.tid * 2 + 1] = rsqrtf(var + EPS); }
        __syncthreads();
#pragma unroll
        for (int tk = 0; tk < 32; ++tk) { const float mean = stat[tk * 2], rstd = stat[tk * 2 + 1];
            const float y0 = (ov[tk].x - mean) * rstd * gg.x + be.x, y1 = (ov[tk].y - mean) * rstd * gg.y + be.y;
            *(unsigned*)(V + (size_t)(rowbase + t0 + tk) * 1024 + 2 * cp) = pk2(y0 * fsig(y0), y1 * fsig(y1)); }
    }
}

__device__ __forceinline__ unsigned block_excl_scan(const Ctx& C, unsigned v, LAS unsigned* wsum, unsigned& total) {
    unsigned inc = v;
#pragma unroll
    for (int o = 1; o < 64; o <<= 1) { const unsigned t = __shfl_up(inc, o); if (C.lane >= o) inc += t; }
    if (C.lane == 63) wsum[C.wave] = inc;
    __syncthreads();
    unsigned base = 0, tot = 0;
#pragma unroll
    for (int w = 0; w < NW; ++w) { const unsigned s = wsum[w]; if (w < C.wave) base += s; tot += s; }
    __syncthreads();
    total = tot;
    return base + inc - v;
}
__device__ __forceinline__ void topk_phase(const Ctx& C, int nprob, int rpe, const float* AFF, int* SEL, float* GSEL, short* INV) {
    LAS unsigned* hist = (LAS unsigned*)C.lds;
    LAS unsigned* misc = hist + 256;
    LAS unsigned* wsum = misc + 16;
    for (int prob = blockIdx.x; prob < nprob; prob += C.G) {
        const int set = prob >> 4, e = prob & 15; const bool lat = set < 4;
        const int kk = lat ? CAPL : CAPC, rowbase = lat ? set * T : NLAT + (set - 4) * TCX, slotbase = lat ? set * CAPL : 4 * CAPL + (set - 4) * CAPC;
        const int cnt = lat ? 16 : (C.tid < 256 ? 1 : 0), base = lat ? C.tid * 16 : C.tid;
        unsigned key[16];
#pragma unroll
        for (int i = 0; i < 16; ++i) key[i] = (i < cnt) ? __float_as_uint(AFF[(size_t)(rowbase + base + i) * 16 + e]) : 0u;
        unsigned prefix = 0u, mask = 0u, need = (unsigned)kk;
#pragma unroll 1
        for (int pass = 0; pass < 4; ++pass) { const int shift = 24 - 8 * pass;
            if (C.tid < 256) hist[C.tid] = 0u;
            __syncthreads();
#pragma unroll
            for (int i = 0; i < 16; ++i) if (i < cnt && (key[i] & mask) == prefix) __hip_atomic_fetch_add(&hist[(key[i] >> shift) & 255u], 1u, __ATOMIC_RELAXED, __HIP_MEMORY_SCOPE_WORKGROUP);
            __syncthreads();
            if (C.wave == 0) { unsigned h[4], tot = 0u;
#pragma unroll
                for (int b = 0; b < 4; ++b) { h[b] = hist[4 * C.lane + b]; tot += h[b]; }
                unsigned inc = tot;
#pragma unroll
                for (int o = 1; o < 64; o <<= 1) { const unsigned t = __shfl_down(inc, o); if (C.lane + o < 64) inc += t; }
                unsigned cgt = inc - tot;
#pragma unroll
                for (int b = 3; b >= 0; --b) { if (cgt < need && need <= cgt + h[b]) { misc[0] = (unsigned)(4 * C.lane + b); misc[1] = need - cgt; } cgt += h[b]; } }
            __syncthreads();
            prefix |= misc[0] << shift; mask |= 255u << shift; need = misc[1];
        }
        unsigned neq = 0u, ngt = 0u;
#pragma unroll
        for (int i = 0; i < 16; ++i) if (i < cnt) { neq += (key[i] == prefix) ? 1u : 0u; ngt += (key[i] > prefix) ? 1u : 0u; }
        unsigned tot;
        const unsigned eq_before = block_excl_scan(C, neq, wsum, tot);
        const unsigned take_eq = (need > eq_before) ? min(neq, need - eq_before) : 0u;
        unsigned slot = block_excl_scan(C, ngt + take_eq, wsum, tot);
        unsigned eqr = eq_before;
#pragma unroll
        for (int i = 0; i < 16; ++i) if (i < cnt) {
            bool sel = key[i] > prefix;
            if (key[i] == prefix) { sel = eqr < need; ++eqr; }
            const int row = rowbase + base + i;
            if (sel) { const int s = slotbase + (int)slot; ++slot; SEL[e * rpe + s] = row; GSEL[e * rpe + s] = __uint_as_float(key[i]); INV[(size_t)row * 16 + e] = (short)s; }
            else INV[(size_t)row * 16 + e] = (short)-1; }
        if (rpe == RPE0 && set == 4 && C.tid < RPE0 - (4 * CAPL + 4 * CAPC)) { const int s = 4 * CAPL + 4 * CAPC + C.tid; SEL[e * rpe + s] = 0; GSEL[e * rpe + s] = 0.f; }
        __syncthreads();
    }
}
__device__ __forceinline__ void gather_phase(const Ctx& C, int nrows, const int* SEL, const bf16* HB, bf16* XG) {
    for (int r = C.gw; r < nrows; r += C.NGW) { const int src = SEL[r];
        const v4u a = *(const v4u*)(HB + (size_t)src * 1024 + 8 * C.lane), b = *(const v4u*)(HB + (size_t)src * 1024 + 512 + 8 * C.lane);
        *(v4u*)(XG + (size_t)r * 1024 + 8 * C.lane) = a; *(v4u*)(XG + (size_t)r * 1024 + 512 + 8 * C.lane) = b; }
}

__device__ __forceinline__ f32x4 mfma16(bf16x8 a, bf16x8 b, f32x4 c) { return __builtin_amdgcn_mfma_f32_16x16x32_bf16(a, b, c, 0, 0, 0); }
constexpr int SC_QG = 0, SC_KT = 17408, SC_KGT = 34816, SC_VT = 53248, SC_SC = 71680, SC_SEG = 80896, SC_PCH = 84992, SC_PG = 85504;
constexpr int QROW = 272, TROW = 144;

__device__ __forceinline__ void scanA_phase(const Ctx& C, const bf16* PRJ, const float* LB, bf16* OLOC, bf16* QGG, float* SLOC, float* PTOT) {
    LAS unsigned char* L = C.lds;
    LAS float* SEG = (LAS float*)(L + SC_SEG); LAS float* PCH = (LAS float*)(L + SC_PCH); LAS float* PG = (LAS float*)(L + SC_PG);
    const int lane = C.lane, w = C.wave, g = lane >> 4, lr = lane & 15, k0 = 2 * lane, seg = w;
    for (int ui = C.vcu; ui < NSEQ * NGRP; ui += C.G) {
        int seq, grp; if (ui < NSEQ * 16) { seq = ui >> 4; grp = 1 + (ui & 15); } else { seq = ui - NSEQ * 16; grp = 0; }
        const int b = seq >> 4, h = (seq >> 1) & 7, dir = seq & 1, nch = grp ? 8 : 4, sgn = dir ? -1 : 1;
        const int hc = h * HD;
        const float lb0 = LB[dir * 1024 + hc + k0], lb1 = LB[dir * 1024 + hc + k0 + 1];
        f32x4 S[8];
#pragma unroll
        for (int i = 0; i < 8; ++i) S[i] = (f32x4){0.f, 0.f, 0.f, 0.f};
        if (C.tid < 128) PG[C.tid] = 1.0f;
        const int Pb = grp ? (grp - 1) * 512 : 0, rbase = grp ? b * T : NLAT + b * TCX, tlen = grp ? T : TCX;
#define ROWC(c) (rbase + (dir ? tlen - 1 - (Pb + 64 * (c)) : Pb + 64 * (c)))
        unsigned fq[8], qq[8]; v4u vv[2];
        { const int rc = ROWC(0);
#pragma unroll
            for (int i = 0; i < 8; ++i) { const bf16* rp = PRJ + (size_t)(rc + sgn * (8 * seg + i)) * 5120; fq[i] = *(const unsigned*)(rp + (1 + dir) * 1024 + hc + k0); qq[i] = *(const unsigned*)(rp + hc + k0); }
#pragma unroll
            for (int ii = 0; ii < 2; ++ii) { const int cq = C.tid + 512 * ii; vv[ii] = *(const v4u*)(PRJ + (size_t)(rc + sgn * (cq >> 4)) * 5120 + 3072 + hc + (cq & 15) * 8); } }
        __syncthreads();
#pragma unroll 1
        for (int c = 0; c < nch; ++c) {
            const int rc = ROWC(c);
            float pl0[8], pl1[8], kk0[8], kk1[8]; float run0 = 1.f, run1 = 1.f;
#pragma unroll
            for (int i = 0; i < 8; ++i) { const float s0 = fsig(bflo(fq[i])), s1 = fsig(bfhi(fq[i]));
                const float fg0 = lb0 + (1.f - lb0) * s0, fg1 = lb1 + (1.f - lb1) * s1;
                kk0[i] = (1.f - lb0) * (1.f - s0); kk1[i] = (1.f - lb1) * (1.f - s1);
                run0 *= fg0; run1 *= fg1; pl0[i] = run0; pl1[i] = run1; }
            *(LAS f32x2*)(SEG + seg * 128 + k0) = (f32x2){run0, run1};
#pragma unroll
            for (int ii = 0; ii < 2; ++ii) { const int cq = C.tid + 512 * ii, p = cq >> 4, v0 = (cq & 15) * 8; LAS bf16* vt = (LAS bf16*)(L + SC_VT) + p;
                const unsigned wds[4] = {vv[ii].x, vv[ii].y, vv[ii].z, vv[ii].w};
#pragma unroll
                for (int j = 0; j < 4; ++j) { vt[(v0 + 2 * j) * (TROW / 2)] = (bf16)(wds[j] & 0xffffu); vt[(v0 + 2 * j + 1) * (TROW / 2)] = (bf16)(wds[j] >> 16); } }
            const float pg0 = PG[k0], pg1 = PG[k0 + 1];
            __syncthreads();
            float pb0 = 1.f, pb1 = 1.f, pt0 = 1.f, pt1 = 1.f;
#pragma unroll
            for (int s = 0; s < 8; ++s) { const f32x2 t = *(const LAS f32x2*)(SEG + s * 128 + k0); if (s < seg) { pb0 *= t.x; pb1 *= t.y; } pt0 *= t.x; pt1 *= t.y; }
            unsigned kg0[4], kg1[4]; float kprev0 = 0.f, kprev1 = 0.f;
#pragma unroll
            for (int i = 0; i < 8; ++i) { const int p = 8 * seg + i;
                const float P0 = pb0 * pl0[i], P1 = pb1 * pl1[i];
                const float qg0 = bflo(qq[i]) * P0, qg1 = bfhi(qq[i]) * P1;
                const float kt0 = kk0[i] * __builtin_amdgcn_rcpf(fmaxf(P0, 1e-30f)), kt1 = kk1[i] * __builtin_amdgcn_rcpf(fmaxf(P1, 1e-30f));
                *(LAS unsigned*)(L + SC_QG + p * QROW + k0 * 2) = pk2(qg0, qg1);
                *(LAS unsigned*)(L + SC_KT + p * QROW + k0 * 2) = pk2(kt0, kt1);
                const float a0 = kt0 * pt0, a1 = kt1 * pt1;
                if (i & 1) { kg0[i >> 1] = pk2(kprev0, a0); kg1[i >> 1] = pk2(kprev1, a1); } else { kprev0 = a0; kprev1 = a1; }
                if (grp) *(unsigned*)(QGG + ((size_t)dir * NLAT + (size_t)(rc + sgn * p)) * 1024 + hc + k0) = pk2(qg0 * pg0, qg1 * pg1); }
            *(LAS v4u*)(L + SC_KGT + k0 * TROW + seg * 16) = (v4u){kg0[0], kg0[1], kg0[2], kg0[3]};
            *(LAS v4u*)(L + SC_KGT + (k0 + 1) * TROW + seg * 16) = (v4u){kg1[0], kg1[1], kg1[2], kg1[3]};
            if (seg == 0) *(LAS f32x2*)(PCH + k0) = (f32x2){pt0, pt1};
            if (c + 1 < nch) { const int rn = ROWC(c + 1);
#pragma unroll
                for (int i = 0; i < 8; ++i) { const bf16* rp = PRJ + (size_t)(rn + sgn * (8 * seg + i)) * 5120; fq[i] = *(const unsigned*)(rp + (1 + dir) * 1024 + hc + k0); qq[i] = *(const unsigned*)(rp + hc + k0); }
#pragma unroll
                for (int ii = 0; ii < 2; ++ii) { const int cq = C.tid + 512 * ii; vv[ii] = *(const v4u*)(PRJ + (size_t)(rn + sgn * (cq >> 4)) * 5120 + 3072 + hc + (cq & 15) * 8); } }
            __syncthreads();
            if (seg == 0) *(LAS f32x2*)(PG + k0) = (f32x2){pg0 * pt0, pg1 * pt1};
            { const int pi = w >> 1;
#pragma unroll
                for (int tt = 0; tt < 2; ++tt) { const int si = 2 * (w & 1) + tt; f32x4 acc = (f32x4){0.f, 0.f, 0.f, 0.f};
#pragma unroll
                    for (int ks = 0; ks < 4; ++ks) { const bf16x8 a = *(const LAS bf16x8*)(L + SC_QG + (16 * pi + lr) * QROW + (32 * ks + 8 * g) * 2);
                        const bf16x8 bb = *(const LAS bf16x8*)(L + SC_KT + (16 * si + lr) * QROW + (32 * ks + 8 * g) * 2); acc = mfma16(a, bb, acc); }
#pragma unroll
                    for (int r = 0; r < 4; ++r) { const int p = 16 * pi + 4 * g + r, s = 16 * si + lr; const float val = (s <= p) ? acc[r] : 0.f;
                        *(LAS bf16*)(L + SC_SC + p * TROW + s * 2) = (bf16)(pk2(val, 0.f) & 0xffffu); } } }
            __syncthreads();
            bf16x8 bv[2];
#pragma unroll
            for (int ks = 0; ks < 2; ++ks) bv[ks] = *(const LAS bf16x8*)(L + SC_VT + (16 * w + lr) * TROW + (32 * ks + 8 * g) * 2);
            f32x4 O[4];
#pragma unroll
            for (int pt = 0; pt < 4; ++pt) O[pt] = (f32x4){0.f, 0.f, 0.f, 0.f};
#pragma unroll
            for (int ks = 0; ks < 4; ++ks) {
                v4u sw; sw.x = pk2(S[2 * ks][0], S[2 * ks][1]); sw.y = pk2(S[2 * ks][2], S[2 * ks][3]); sw.z = pk2(S[2 * ks + 1][0], S[2 * ks + 1][1]); sw.w = pk2(S[2 * ks + 1][2], S[2 * ks + 1][3]);
                const bf16x8 sb = __builtin_bit_cast(bf16x8, sw);
#pragma unroll
                for (int pt = 0; pt < 4; ++pt) { const LAS unsigned char* qp = L + SC_QG + (16 * pt + lr) * QROW + (32 * ks + 4 * g) * 2;
                    const v2u lo = *(const LAS v2u*)qp, hi = *(const LAS v2u*)(qp + 32);
                    const bf16x8 a = __builtin_bit_cast(bf16x8, (v4u){lo.x, lo.y, hi.x, hi.y}); O[pt] = mfma16(a, sb, O[pt]); } }
#pragma unroll
            for (int ks = 0; ks < 2; ++ks)
#pragma unroll
                for (int pt = 0; pt < 4; ++pt) { const bf16x8 a = *(const LAS bf16x8*)(L + SC_SC + (16 * pt + lr) * TROW + (32 * ks + 8 * g) * 2); O[pt] = mfma16(a, bv[ks], O[pt]); }
            if (grp) {
#pragma unroll
                for (int pt = 0; pt < 4; ++pt)
#pragma unroll
                    for (int r = 0; r < 4; ++r) { const int p = 16 * pt + 4 * g + r;
                        OLOC[((size_t)dir * NLAT + (size_t)(rc + sgn * p)) * 1024 + hc + 16 * w + lr] = (bf16)(pk2(O[pt][r], 0.f) & 0xffffu); } }
#pragma unroll
            for (int kt = 0; kt < 8; ++kt) { const f32x4 pc = *(const LAS f32x4*)(PCH + 16 * kt + 4 * g); S[kt] = S[kt] * pc;
#pragma unroll
                for (int ks = 0; ks < 2; ++ks) { const bf16x8 a = *(const LAS bf16x8*)(L + SC_KGT + (16 * kt + lr) * TROW + (32 * ks + 8 * g) * 2); S[kt] = mfma16(a, bv[ks], S[kt]); } }
            __syncthreads();
        }
        if (grp < 16) {
#pragma unroll
            for (int kt = 0; kt < 8; ++kt)
#pragma unroll
                for (int r = 0; r < 4; ++r) SLOC[(((size_t)seq * 16 + grp) * 128 + 16 * kt + 4 * g + r) * 128 + 16 * w + lr] = S[kt][r]; }
        if (C.tid < 128) PTOT[((size_t)seq * NGRP + grp) * 128 + C.tid] = PG[C.tid];
        __syncthreads();
#undef ROWC
    }
}
__device__ __forceinline__ void scanB_phase(const Ctx& C, const float* SLOC, const float* PTOT, bf16* SST) {
    for (int id = C.vcu * (NW * 64) + C.tid; id < NSEQ * 2048; id += C.G * NW * 64) {
        const int seq = id >> 11, k = ((id >> 7) & 15) * 8, v = id & 127;
        float s[8];
#pragma unroll
        for (int i = 0; i < 8; ++i) s[i] = 0.f;
#pragma unroll 1
        for (int gi = 0; gi < 16; ++gi) { const float* pt = PTOT + ((size_t)seq * NGRP + gi) * 128 + k; const float* sl = SLOC + (((size_t)seq * 16 + gi) * 128 + k) * 128 + v;
#pragma unroll
            for (int i = 0; i < 8; ++i) s[i] = pt[i] * s[i] + sl[(size_t)i * 128];
            v4u o; o.x = pk2(s[0], s[1]); o.y = pk2(s[2], s[3]); o.z = pk2(s[4], s[5]); o.w = pk2(s[6], s[7]);
            *(v4u*)(SST + (((size_t)seq * 16 + gi) * 128 + v) * 128 + k) = o; }
    }
}
__device__ __forceinline__ void readout_phase(const Ctx& C, const bf16* PRJ, const bf16* OLOC, const bf16* QGG, const bf16* SST, const float* norm_g, bf16* YH) {
    LAS unsigned char* L = C.lds;
    constexpr int ABUF = 64 * QROW;
    LAS float* OT = (LAS float*)(L + 4 * ABUF);
    const int lane = C.lane, w = C.wave, g = lane >> 4, lr = lane & 15;
    const int p = C.tid >> 3, sg = C.tid & 7;
    f32x4 ng[4];
#pragma unroll
    for (int i = 0; i < 4; ++i) ng[i] = *(const f32x4*)(norm_g + 16 * sg + 4 * i);
    for (int ui = C.vcu; ui < NB * NH * 16; ui += C.G) {
        const int j = ui & 15, h = (ui >> 4) & 7, b = ui >> 7, hc = h * HD, row00 = b * T + 512 * j;
        bf16x8 bfr[2][4];
#pragma unroll
        for (int dir = 0; dir < 2; ++dir) { const int seq = (b * 8 + h) * 2 + dir, gs = dir ? 15 - j : j;
            const bf16* Bb = SST + (((size_t)seq * 16 + gs) * 128 + 16 * w + lr) * 128;
#pragma unroll
            for (int ks = 0; ks < 4; ++ks) bfr[dir][ks] = *(const bf16x8*)(Bb + 32 * ks + 8 * g); }
        v4u ar[2][2];
#define RO_LOADA(tile) do { _Pragma("unroll") for (int dir = 0; dir < 2; ++dir) _Pragma("unroll") for (int ii = 0; ii < 2; ++ii) { const int cq = C.tid + 512 * ii; \
            ar[dir][ii] = *(const v4u*)(QGG + ((size_t)dir * NLAT + row00 + 64 * (tile) + (cq >> 4)) * 1024 + hc + (cq & 15) * 8); } } while (0)
#define RO_WRITEA(buf) do { _Pragma("unroll") for (int dir = 0; dir < 2; ++dir) _Pragma("unroll") for (int ii = 0; ii < 2; ++ii) { const int cq = C.tid + 512 * ii; \
            *(LAS v4u*)(L + ((buf) * 2 + dir) * ABUF + (cq >> 4) * QROW + (cq & 15) * 16) = ar[dir][ii]; } } while (0)
        RO_LOADA(0); RO_WRITEA(0);
        __syncthreads();
#pragma unroll 1
        for (int t = 0; t < 8; ++t) {
            const int buf = t & 1; const size_t row = (size_t)row00 + 64 * t + p; const int c0 = hc + 16 * sg;
            if (t < 7) RO_LOADA(t + 1);
            v4u eo[2][2]; v4u eg[2];
#pragma unroll
            for (int dir = 0; dir < 2; ++dir) { const bf16* op = OLOC + ((size_t)dir * NLAT + row) * 1024 + c0; eo[dir][0] = *(const v4u*)op; eo[dir][1] = *(const v4u*)(op + 8); }
            { const bf16* gp = PRJ + row * 5120 + 4096 + c0; eg[0] = *(const v4u*)gp; eg[1] = *(const v4u*)(gp + 8); }
            f32x4 O[4];
#pragma unroll
            for (int pt = 0; pt < 4; ++pt) O[pt] = (f32x4){0.f, 0.f, 0.f, 0.f};
#pragma unroll
            for (int dir = 0; dir < 2; ++dir)
#pragma unroll
                for (int ks = 0; ks < 4; ++ks)
#pragma unroll
                    for (int pt = 0; pt < 4; ++pt) { const bf16x8 a = *(const LAS bf16x8*)(L + (buf * 2 + dir) * ABUF + (16 * pt + lr) * QROW + (32 * ks + 8 * g) * 2); O[pt] = mfma16(a, bfr[dir][ks], O[pt]); }
#pragma unroll
            for (int pt = 0; pt < 4; ++pt)
#pragma unroll
                for (int r = 0; r < 4; ++r) OT[(16 * pt + 4 * g + r) * 132 + 16 * w + lr] = O[pt][r];
            if (t < 7) RO_WRITEA(buf ^ 1);
            __syncthreads();
            f32x4 o[4];
#pragma unroll
            for (int i = 0; i < 4; ++i) o[i] = *(const LAS f32x4*)(OT + p * 132 + 16 * sg + 4 * i);
#pragma unroll
            for (int dir = 0; dir < 2; ++dir) { const v4u a = eo[dir][0], bq = eo[dir][1];
                o[0] += (f32x4){bflo(a.x), bfhi(a.x), bflo(a.y), bfhi(a.y)}; o[1] += (f32x4){bflo(a.z), bfhi(a.z), bflo(a.w), bfhi(a.w)};
                o[2] += (f32x4){bflo(bq.x), bfhi(bq.x), bflo(bq.y), bfhi(bq.y)}; o[3] += (f32x4){bflo(bq.z), bfhi(bq.z), bflo(bq.w), bfhi(bq.w)}; }
            float ss = 0.f;
#pragma unroll
            for (int i = 0; i < 4; ++i) ss += (o[i].x * o[i].x + o[i].y * o[i].y) + (o[i].z * o[i].z + o[i].w * o[i].w);
            ss += __shfl_xor(ss, 1); ss += __shfl_xor(ss, 2); ss += __shfl_xor(ss, 4);
            const float rstd = rsqrtf(ss * (1.0f / 128.0f) + EPS);
            const unsigned gw[8] = {eg[0].x, eg[0].y, eg[0].z, eg[0].w, eg[1].x, eg[1].y, eg[1].z, eg[1].w};
            unsigned ow[8];
#pragma unroll
            for (int i = 0; i < 8; ++i) { const float g0 = bflo(gw[i]), g1 = bfhi(gw[i]);
                const float y0 = o[i >> 1][(2 * i) & 3] * rstd * ng[i >> 1][(2 * i) & 3] * (g0 * fsig(g0));
                const float y1 = o[i >> 1][(2 * i + 1) & 3] * rstd * ng[i >> 1][(2 * i + 1) & 3] * (g1 * fsig(g1));
                ow[i] = pk2(y0, y1); }
            bf16* yp = YH + row * 1024 + c0;
            *(v4u*)yp = (v4u){ow[0], ow[1], ow[2], ow[3]}; *(v4u*)(yp + 8) = (v4u){ow[4], ow[5], ow[6], ow[7]};
            __syncthreads();
        }
#undef RO_LOADA
#undef RO_WRITEA
    }
}

constexpr int NPHASE = 22;
struct Args { const float* in[25]; float* out; unsigned char* ws; int ph_lo, ph_hi; };
__global__ void __launch_bounds__(NW * 64, 2) mk_fwd(Args args) {
    extern __shared__ __attribute__((aligned(16))) unsigned char lds_raw[];
    Ctx C;
    C.lds = (LAS unsigned char*)lds_raw;
    C.tid = threadIdx.x; C.lane = C.tid & 63; C.wave = __builtin_amdgcn_readfirstlane(C.tid >> 6);
    C.G = gridDim.x; { const int bx = blockIdx.x; C.vcu = (C.G % 8 == 0) ? (bx % 8) * (C.G / 8) + bx / 8 : bx; }
    C.gw = C.vcu * NW + C.wave; C.NGW = C.G * NW;
    unsigned char* ws = args.ws;
    const int lo = args.ph_lo, hi = args.ph_hi;
    volatile LAS unsigned* MISC = (volatile LAS unsigned*)(C.lds + MISC_OFF);
    for (int u = C.tid; u < (LDS_BYTES - 131072) / 4; u += NW * 64) ((LAS unsigned*)(C.lds + 131072))[u] = 0u;
    __syncthreads();
    XcdBarrier bar; bar.bar = (unsigned*)(ws + WS_CTL) + CW_BAR; bar.x = 0; bar.st = nullptr;
    if (hi - lo > 1) bar = xcd_barrier_post((unsigned*)(ws + WS_CTL) + CW_BAR, MISC + 8);
#ifndef MK_PHMASK
#define MK_PHMASK 0x3fffff
#endif
#define INR(k) (lo <= (k) && (k) < hi)
#define IN(k) ((((MK_PHMASK) >> (k)) & 1) && INR(k))
#define SEAM(k) do { if (INR(k) && INR((k) + 1)) xcd_barrier(bar); } while (0)
#ifndef MK_REP_PHASE
#define MK_REP_PHASE -1
#endif
#define REP(k) for (int _rep = 0; _rep < ((k) == MK_REP_PHASE ? 3 : 1); ++_rep, __syncthreads())

    const float* x = args.in[0]; const float* ctx_in = args.in[2];
    float* MV = (float*)(ws + WS_MV); float* LBT = (float*)(ws + WS_LB); float* AFF = (float*)(ws + WS_AFF); short* INV = (short*)(ws + WS_INV);
    int* SEL = (int*)(ws + WS_SEL); float* GSEL = (float*)(ws + WS_GSEL); float* CTXS = (float*)(ws + WS_CTXS);
    bf16* HB = (bf16*)(ws + WS_HB); bf16* UB = (bf16*)(ws + WS_UB); bf16* XG = (bf16*)(ws + WS_XG); bf16* HBUF = (bf16*)(ws + WS_HBUF); bf16* PRJ = (bf16*)(ws + WS_PRJ);
    bf16* OLOC = (bf16*)(ws + WS_OLOC); bf16* QGG = (bf16*)(ws + WS_QGG); float* SLOC = (float*)(ws + WS_UB); float* PTOT = (float*)(ws + WS_PTOT); bf16* SST = (bf16*)(ws + WS_SST); bf16* YH = (bf16*)(ws + WS_UB);
    float* out = args.out;

    if (IN(0)) REP(0) {
        mod_gemv(C, args.in[1], args.in[3], args.in[4], args.in[5], MV);
        for (int i = C.vcu * NW * 64 + C.tid; i < 2048; i += C.G * NW * 64) { const float* lg = args.in[17]; LBT[i] = fsig(lg[2048 + i] - lg[i]); }
        __syncthreads();
        convert_small(C, args.in[8], args.in[14], args.in[16], args.in[19], ws);
        convert_moe(C, args.in[21], args.in[22], args.in[23], 0, ws);
    }
#if !MK_SPLIT
    if (INR(0) && INR(1)) { cg::grid_group grid = cg::this_grid(); __threadfence(); grid.sync(); }
#endif
    SEAM(0);
    if (IN(1)) REP(1) { RowArgs A{}; A.src_lat = x; A.src_ctx = ctx_in; A.gamma = args.in[6]; A.mv = MV; A.i_shift = 0; A.i_scale = 1; A.i_gate = 2; A.HB = HB; A.nrows = R;
        row_phase<false, false, false>(C, A); }
    SEAM(1);
    if (IN(2)) REP(2) { pg8::Gemm g{HB, (const bf16*)(ws + WS_W1T), R, 2048, 1024}; pg8::StaticOrder S; S.init(R, 2048, C.G, (int)blockIdx.x);
        pg8::EpiGated<0> E{UB, 1024, args.in[9], 1024};
        pg8::gemm_phase<pg8::EpiGated<0>, pg8::StaticOrder, true, true>(C.lds, g, S, E); }
    SEAM(2);
    if (IN(3)) REP(3) conv_phase(C, UB, HB, args.in[10], args.in[11], args.in[12], args.in[13]);
    SEAM(3);
    if (IN(4)) REP(4) { pg8::Gemm g{HB, (const bf16*)(ws + WS_W2T), R, 1024, 1024}; pg8::StaticOrder S; S.init(R, 1024, C.G, (int)blockIdx.x);
        pg8::EpiRes E{x, out, ctx_in, CTXS, args.in[15], MV + 2 * 1024, 6144};
        pg8::gemm_phase<pg8::EpiRes, pg8::StaticOrder, true, true>(C.lds, g, S, E); }
    SEAM(4);
    if (IN(5)) REP(5) { RowArgs A{}; A.src_lat = out; A.src_ctx = CTXS; A.gamma = args.in[7]; A.mv = MV; A.i_shift = 3; A.i_scale = 4; A.i_gate = 5; A.HB = HB; A.AFF = AFF; A.router_w = args.in[20]; A.nrows = R;
        row_phase<false, true, false>(C, A); }
    SEAM(5);
    if (IN(6)) REP(6) topk_phase(C, 128, RPE0, AFF, SEL, GSEL, INV);
    SEAM(6);
    if (IN(7)) REP(7) gather_phase(C, NE * RPE0, SEL, HB, XG);
    SEAM(7);
    if (IN(8)) REP(8) { pg8::Gemm g{XG, (const bf16*)(ws + WS_W13T), NE * RPE0, 4096, 1024}; pg8::StaticOrder S; S.init(NE * RPE0, 4096, C.G, (int)blockIdx.x, RPE0 / 256);
        pg8::EpiGated<1> E{HBUF, 2048, nullptr, 0};
        pg8::gemm_phase<pg8::EpiGated<1>, pg8::StaticOrder, true, true>(C.lds, g, S, E); }
    SEAM(8);
    if (IN(9)) REP(9) { pg8::Gemm g{HBUF, (const bf16*)(ws + WS_WDT), NE * RPE0, 1024, 2048}; pg8::StaticOrder S; S.init(NE * RPE0, 1024, C.G, (int)blockIdx.x, RPE0 / 256);
        pg8::EpiScaleRow E{XG, 1024, GSEL};
        pg8::gemm_phase<pg8::EpiScaleRow, pg8::StaticOrder, true, true>(C.lds, g, S, E); }
    SEAM(9);
    if (IN(10)) REP(10) { RowArgs A{}; A.src_lat = out; A.src_ctx = CTXS; A.dst_lat = out; A.dst_ctx = CTXS; A.gamma = args.in[6] + 1024; A.mv = MV; A.i_shift = 0; A.i_scale = 1; A.i_gate = 5; A.HB = HB;
        A.Y = XG; A.INV = INV; A.rpe = RPE0; A.nrows = R;
        A.mv = MV + 5 * 6144; A.mvg = MV; row_phase<true, false, false>(C, A); }
    SEAM(10);
    if (IN(11)) REP(11) { pg8::Gemm g{HB, (const bf16*)(ws + WS_WINT), R, 5120, 1024}; pg8::StaticOrder S; S.init(R, 5120, C.G, (int)blockIdx.x);
        pg8::EpiBf16 E{PRJ, 5120};
        pg8::gemm_phase<pg8::EpiBf16, pg8::StaticOrder, true, true>(C.lds, g, S, E); }
    SEAM(11);
    if (IN(12)) REP(12) scanA_phase(C, PRJ, LBT, OLOC, QGG, SLOC, PTOT);
    SEAM(12);
    if (IN(13)) REP(13) scanB_phase(C, SLOC, PTOT, SST);
    SEAM(13);
    if (IN(14)) REP(14) readout_phase(C, PRJ, OLOC, QGG, SST, args.in[18], YH);
    SEAM(14);
    if (IN(15)) REP(15) { pg8::Gemm g{YH, (const bf16*)(ws + WS_WOUTT), NLAT, 1024, 1024}; pg8::StaticOrder S; S.init(NLAT, 1024, C.G, (int)blockIdx.x);
        pg8::EpiRes E{out, out, nullptr, nullptr, nullptr, MV + 5 * 6144 + 2 * 1024, 6144};
        pg8::gemm_phase<pg8::EpiRes, pg8::StaticOrder, true, true>(C.lds, g, S, E); }
    SEAM(15);
    if (IN(16)) REP(16) { RowArgs A{}; A.src_lat = out; A.gamma = args.in[7] + 1024; A.mv = MV + 5 * 6144; A.i_shift = 3; A.i_scale = 4; A.i_gate = 5; A.HB = HB; A.AFF = AFF; A.router_w = args.in[20] + 16384; A.nrows = NLAT;
        row_phase<false, true, false>(C, A);
        convert_moe(C, args.in[21], args.in[22], args.in[23], 1, ws); }
    SEAM(16);
    if (IN(17)) REP(17) topk_phase(C, 64, RPE1, AFF, SEL, GSEL, INV);
    SEAM(17);
    if (IN(18)) REP(18) gather_phase(C, NE * RPE1, SEL, HB, XG);
    SEAM(18);
    if (IN(19)) REP(19) { pg8::Gemm g{XG, (const bf16*)(ws + WS_W13T), NE * RPE1, 4096, 1024}; pg8::StaticOrder S; S.init(NE * RPE1, 4096, C.G, (int)blockIdx.x, RPE1 / 256);
        pg8::EpiGated<1> E{HBUF, 2048, nullptr, 0};
        pg8::gemm_phase<pg8::EpiGated<1>, pg8::StaticOrder, true, true>(C.lds, g, S, E); }
    SEAM(19);
    if (IN(20)) REP(20) { pg8::Gemm g{HBUF, (const bf16*)(ws + WS_WDT), NE * RPE1, 1024, 2048}; pg8::StaticOrder S; S.init(NE * RPE1, 1024, C.G, (int)blockIdx.x, RPE1 / 256);
        pg8::EpiScaleRow E{XG, 1024, GSEL};
        pg8::gemm_phase<pg8::EpiScaleRow, pg8::StaticOrder, true, true>(C.lds, g, S, E); }
    SEAM(20);
    if (IN(21)) REP(21) { RowArgs A{}; A.src_lat = out; A.dst_lat = out; A.gamma = args.in[24]; A.mv = MV + 5 * 6144; A.mvg = MV + 5 * 6144; A.i_gate = 5; A.Y = XG; A.INV = INV; A.rpe = RPE1; A.nrows = NLAT;
        row_phase<true, false, true>(C, A); }
#undef IN
#undef REP
#undef INR
#undef SEAM
}

extern "C" void kernel_launch(void* const* d_in, const int* in_sizes, int n_in, void* d_out, int out_size, void* d_ws, size_t ws_size, hipStream_t stream) {
    static int grid = 0;
    if (grid == 0) {
        if (n_in != 25 || in_sizes[0] != NLAT * D || out_size != NLAT * D || ws_size < WS_END) { fprintf(stderr, "kernel_launch: unexpected shapes (n_in %d, in0 %d, out %d, ws %zu)\n", n_in, n_in > 0 ? in_sizes[0] : -1, out_size, ws_size); grid = -1; return; }
        int dev = 0, cus = 0, per_cu = 0;
        if (hipGetDevice(&dev) != hipSuccess || hipDeviceGetAttribute(&cus, hipDeviceAttributeMultiprocessorCount, dev) != hipSuccess) { grid = -1; return; }
        if (hipFuncSetAttribute((const void*)mk_fwd, hipFuncAttributeMaxDynamicSharedMemorySize, LDS_BYTES) != hipSuccess) { fprintf(stderr, "kernel_launch: hipFuncSetAttribute failed\n"); grid = -1; return; }
        if (hipOccupancyMaxActiveBlocksPerMultiprocessor(&per_cu, (const void*)mk_fwd, NW * 64, LDS_BYTES) != hipSuccess || per_cu < 1) { fprintf(stderr, "kernel_launch: occupancy query reports %d blocks per CU\n", per_cu); (void)hipGetLastError(); grid = -1; return; }
        grid = cus;
    }
    if (grid < 0) return;
    if (hipMemsetAsync((char*)d_ws + WS_CTL, 0, CTL_ZERO_BYTES, stream) != hipSuccess) { fprintf(stderr, "kernel_launch: memset failed\n"); return; }
    Args a{};
    for (int i = 0; i < 25; ++i) a.in[i] = (const float*)d_in[i];
    a.out = (float*)d_out; a.ws = (unsigned char*)d_ws;
#if MK_SPLIT
    for (int p = 0; p < NPHASE; ++p) { a.ph_lo = p; a.ph_hi = p + 1; hipLaunchKernelGGL(mk_fwd, dim3(grid), dim3(NW * 64), LDS_BYTES, stream, a); }
#else
    a.ph_lo = 0; a.ph_hi = NPHASE;
    void* kargs[] = {&a};
    hipError_t e = hipLaunchCooperativeKernel((const void*)mk_fwd, dim3(grid), dim3(NW * 64), kargs, LDS_BYTES, stream);
    if (e != hipSuccess) fprintf(stderr, "kernel_launch: cooperative launch failed: %s (grid %d)\n", hipGetErrorString(e), grid);
#endif
}
```

```cpp
#include <hip/hip_runtime.h>
#include <hip/hip_cooperative_groups.h>
#include <cstdio>
#include <cstdint>
namespace cg = cooperative_groups;

#ifndef MK_SPLIT
#define MK_SPLIT 0
#endif

__device__ __forceinline__ int lane_id() { int l; asm volatile("v_mbcnt_lo_u32_b32 %0, -1, 0\n\tv_mbcnt_hi_u32_b32 %0, -1, %0" : "=v"(l)); return l; }
#define TID_OF(wv) ((wv) * 64 + lane_id())
namespace pg8 {
#define PG8_LAS __attribute__((address_space(3)))
typedef unsigned short bf16_t;
typedef short bf16x8 __attribute__((ext_vector_type(8)));
typedef float f32x4 __attribute__((ext_vector_type(4)));
typedef unsigned u32x4 __attribute__((ext_vector_type(4)));
constexpr int BM = 256, BK = 64, HALF = 128, HTB = HALF * BK * 2  , STAGE_BYTES = 8 * HTB, NXCD = 8, WGM = 8;

__host__ __device__ __forceinline__ int lds_byte(int r, int c) { const int st = (r >> 4) * 2 + (c >> 5), rr = r & 15, cc = c & 31, ob = rr * 64 + cc * 2; return st * 1024 + (ob ^ (((ob >> 9) & 1) << 5)); }
__host__ __device__ __forceinline__ void stage_rc(int b, int& R, int& C) { const int st = b / 1024, sb = b % 1024, swz = sb ^ (((sb >> 9) & 1) << 5); R = (st >> 1) * 16 + swz / 64; C = (st & 1) * 32 + (swz % 64) / 2; }
__host__ __device__ __forceinline__ int perm32(int rho) { const int n = rho >> 4, i = rho & 15; return 8 * (i >> 2) + 4 * n + (i & 3); }

struct Unit { int pm, pn, pb; };
struct Gemm { const bf16_t* A; const bf16_t* Bt; int M, N, K; };

struct StaticOrder {
    int nM, nN, nwg, G, c, tpe;
    __host__ __device__ void init(int M, int N, int G_, int c_, int tpe_ = 0) { nM = M / BM; nN = N / BM; nwg = nM * nN; G = G_; c = c_; tpe = tpe_; }
    __host__ __device__ bool next(int i, Unit& u) const {
        const long L = (long)i * G + c; if (L >= nwg) return false;
        int wgid = (int)L; { const int q = nwg / NXCD, r = nwg % NXCD, xcd = wgid % NXCD, off = wgid / NXCD; wgid = (xcd < r ? xcd * (q + 1) : r * (q + 1) + (xcd - r) * q) + off; }
        const int nig = WGM * nN, gid = wgid / nig, fm = gid * WGM, gsz = (nM - fm) < WGM ? (nM - fm) : WGM;
        int pmo = wgid - gid * nig, pn = 0;
        if ((gsz & (gsz - 1)) == 0) { const int sh = __builtin_ctz(gsz); pn = pmo >> sh; pmo &= gsz - 1; } else { while (pmo >= gsz) { pmo -= gsz; ++pn; } }
        u.pm = fm + pmo; u.pn = pn;
        if (tpe) { int e = 0, r = u.pm; while (r >= tpe) { r -= tpe; ++e; } u.pb = e * nN + u.pn; } else u.pb = u.pn;
        return true;
    }
    __device__ __forceinline__ void a_ready(const Unit&) const {}
    __device__ __forceinline__ void done(const Unit&) const {}
};

typedef float f32x32 __attribute__((ext_vector_type(32)));
struct AccQ { f32x32 q[2][2];
    __device__ __forceinline__ f32x4 get(int ai, int bj, int m, int n) const { const int i = (m * 2 + n) * 4; const f32x32& v = q[ai][bj]; return (f32x4){v[i], v[i + 1], v[i + 2], v[i + 3]}; }
    __device__ __forceinline__ void set(int ai, int bj, int m, int n, f32x4 c) { const int i = (m * 2 + n) * 4; f32x32& v = q[ai][bj]; v[i] = c[0]; v[i + 1] = c[1]; v[i + 2] = c[2]; v[i + 3] = c[3]; }
};
__device__ __forceinline__ unsigned cvt_pk_bf16(float lo, float hi) { unsigned r; asm("v_cvt_pk_bf16_f32 %0, %1, %2" : "=v"(r) : "v"(lo), "v"(hi)); return r; }
__device__ __forceinline__ float fsigmoid(float x) { return __builtin_amdgcn_rcpf(1.0f + __expf(-x)); }

struct EpiBf16 {
    static constexpr bool PERM = true, AFTER_DRAIN = false;
    bf16_t* O; int ldc; const float* lb; int hm_rows;
    __device__ __forceinline__ void operator()(const f32x4 (&acc)[2][2][4][2], const Unit& u, int wr, int wc, int fr, int fq) const {
        const int row0 = u.pm * BM + wr * 64 + fr, col0 = u.pn * BM + wc * 32 + 8 * fq;
        const bool gate = lb != nullptr && u.pn >= 4 && u.pn < 12;
        f32x4 om[2][2];
#pragma unroll
        for (int bj = 0; bj < 2; ++bj)
#pragma unroll
            for (int n = 0; n < 2; ++n) om[bj][n] = gate ? (f32x4){1.f, 1.f, 1.f, 1.f} - *(const f32x4*)(lb + (col0 - 1024) + bj * HALF + 4 * n) : (f32x4){0.f, 0.f, 0.f, 0.f};
#pragma unroll
        for (int ai = 0; ai < 2; ++ai)
#pragma unroll
            for (int m = 0; m < 4; ++m) { const int row = row0 + ai * HALF + m * 16;
                bf16_t* rowp = hm_rows ? O + ((size_t)(2 * u.pn) * hm_rows + row) * HALF + wc * 32 + 8 * fq - 0 : O + (size_t)row * ldc + col0;
                const size_t bjstep = hm_rows ? (size_t)hm_rows * HALF : (size_t)HALF;
#pragma unroll
                for (int bj = 0; bj < 2; ++bj) { f32x4 v0 = acc[ai][bj][m][0], v1 = acc[ai][bj][m][1];
                    if (gate) {
#pragma unroll
                        for (int j = 0; j < 4; ++j) { v0[j] = om[bj][0][j] * fsigmoid(-v0[j]); v1[j] = om[bj][1][j] * fsigmoid(-v1[j]); } }
                    u32x4 w; w.x = cvt_pk_bf16(v0[0], v0[1]); w.y = cvt_pk_bf16(v0[2], v0[3]); w.z = cvt_pk_bf16(v1[0], v1[1]); w.w = cvt_pk_bf16(v1[2], v1[3]);
                    *(u32x4*)(rowp + bj * bjstep) = w; } }
    }
};
template <int MODE> struct EpiGated {
    static constexpr bool PERM = true, AFTER_DRAIN = false;
    bf16_t* O; int ldc; const float* bias; int ystride;
    __device__ __forceinline__ void operator()(const f32x4 (&acc)[2][2][4][2], const Unit& u, int wr, int wc, int fr, int fq) const {
        const int row0 = u.pm * BM + wr * 64 + fr, ch0 = u.pn * HALF + wc * 32 + 8 * fq;
        f32x4 bx[2], by[2];
#pragma unroll
        for (int n = 0; n < 2; ++n) { if (MODE == 0) { bx[n] = *(const f32x4*)(bias + ch0 + 4 * n); by[n] = *(const f32x4*)(bias + ystride + ch0 + 4 * n); } else { bx[n] = (f32x4){0.f, 0.f, 0.f, 0.f}; by[n] = bx[n]; } }
#pragma unroll
        for (int ai = 0; ai < 2; ++ai)
#pragma unroll
            for (int m = 0; m < 4; ++m) { bf16_t* rowp = O + (size_t)(row0 + ai * HALF + m * 16) * ldc + ch0;
                float r[8];
#pragma unroll
                for (int n = 0; n < 2; ++n) { const f32x4 x = acc[ai][0][m][n] + bx[n], y = acc[ai][1][m][n] + by[n];
#pragma unroll
                    for (int j = 0; j < 4; ++j) r[4 * n + j] = (MODE == 0) ? x[j] * fsigmoid(y[j]) : x[j] * fsigmoid(x[j]) * y[j]; }
                u32x4 w; w.x = cvt_pk_bf16(r[0], r[1]); w.y = cvt_pk_bf16(r[2], r[3]); w.z = cvt_pk_bf16(r[4], r[5]); w.w = cvt_pk_bf16(r[6], r[7]);
                *(u32x4*)rowp = w; }
    }
};
struct EpiRes {
    static constexpr bool PERM = false, AFTER_DRAIN = false;
    const float* res0; float* out0; const float* res1; float* out1; const float* bias; const float* gate; int gstride;
    __device__ __forceinline__ void operator()(const f32x4 (&acc)[2][2][4][2], const Unit& u, int wr, int wc, int fr, int fq) const {
        const bool second = u.pm >= 128; const int grp = second ? 4 : (u.pm >> 5);
        const float* res = second ? res1 : res0; float* out = second ? out1 : out0;
        const int row0 = (second ? u.pm - 128 : u.pm) * BM + wr * 64 + fr, col0 = u.pn * BM + wc * 32 + 4 * fq;
        const float* gp = gate + (size_t)grp * gstride + col0;
        const unsigned off0 = ((unsigned)row0 * 1024u + (unsigned)col0) * 4u;
#pragma unroll
        for (int bj = 0; bj < 2; ++bj) {
            f32x4 gv[2], bv[2], rv[2][2][4];
#pragma unroll
            for (int n = 0; n < 2; ++n) { gv[n] = *(const f32x4*)(gp + bj * HALF + n * 16); bv[n] = bias ? *(const f32x4*)(bias + col0 + bj * HALF + n * 16) : (f32x4){0.f, 0.f, 0.f, 0.f}; }
#pragma unroll
            for (int n = 0; n < 2; ++n)
#pragma unroll
                for (int ai = 0; ai < 2; ++ai)
#pragma unroll
                    for (int m = 0; m < 4; ++m) rv[n][ai][m] = *(const f32x4*)((const char*)res + (off0 + (unsigned)(((ai * HALF + m * 16) * 1024 + bj * HALF + n * 16) * 4)));
#pragma unroll
            for (int n = 0; n < 2; ++n)
#pragma unroll
                for (int ai = 0; ai < 2; ++ai)
#pragma unroll
                    for (int m = 0; m < 4; ++m) *(f32x4*)((char*)out + (off0 + (unsigned)(((ai * HALF + m * 16) * 1024 + bj * HALF + n * 16) * 4))) = rv[n][ai][m] + gv[n] * (acc[ai][bj][m][n] + bv[n]);
            asm volatile("" ::: "memory"); }
    }
};
struct EpiScaleRow {
    static constexpr bool PERM = true, AFTER_DRAIN = false;
    bf16_t* O; int ldc; const float* rs; float mul;
    __device__ __forceinline__ void operator()(const AccQ& acc, const Unit& u, int wr, int wc, int fr, int fq) const {
        const int row0 = u.pm * BM + wr * 64 + fr, col0 = u.pn * BM + wc * 32 + 8 * fq;
#pragma unroll
        for (int ai = 0; ai < 2; ++ai)
#pragma unroll
            for (int m = 0; m < 4; ++m) { const int row = row0 + ai * HALF + m * 16; const float s = rs[row] * mul; bf16_t* rowp = O + (size_t)row * ldc + col0;
#pragma unroll
                for (int bj = 0; bj < 2; ++bj) { const f32x4 v0 = acc.get(ai, bj, m, 0) * s, v1 = acc.get(ai, bj, m, 1) * s;
                    u32x4 w; w.x = cvt_pk_bf16(v0[0], v0[1]); w.y = cvt_pk_bf16(v0[2], v0[3]); w.z = cvt_pk_bf16(v1[0], v1[1]); w.w = cvt_pk_bf16(v1[2], v1[3]);
                    *(u32x4*)(rowp + bj * HALF) = w; }
                asm volatile("" ::: "memory"); }
    }
};

typedef unsigned u32x2 __attribute__((ext_vector_type(2)));
__device__ __forceinline__ unsigned pk4_fp8(float a, float b, float c, float d) { unsigned lo, hi; asm("v_cvt_pk_fp8_f32 %0, %1, %2" : "=v"(lo) : "v"(a), "v"(b)); asm("v_cvt_pk_fp8_f32 %0, %1, %2" : "=v"(hi) : "v"(c), "v"(d)); return (lo & 0xffffu) | (hi << 16); }
struct EpiSwiGLU8 {
    static constexpr bool PERM = true, AFTER_DRAIN = false;
    unsigned char* O; int ldc; float s;
    __device__ __forceinline__ void operator()(const AccQ& acc, const Unit& u, int wr, int wc, int fr, int fq) const {
        const int row0 = u.pm * BM + wr * 64 + fr, ch0 = u.pn * HALF + wc * 32 + 8 * fq;
#pragma unroll
        for (int ai = 0; ai < 2; ++ai)
#pragma unroll
            for (int m = 0; m < 4; ++m) { unsigned char* rowp = O + (size_t)(row0 + ai * HALF + m * 16) * ldc + ch0;
                float r[8];
#pragma unroll
                for (int n = 0; n < 2; ++n) { const f32x4 x = acc.get(ai, 0, m, n) * s, y = acc.get(ai, 1, m, n) * s;
#pragma unroll
                    for (int j = 0; j < 4; ++j) r[4 * n + j] = x[j] * fsigmoid(x[j]) * y[j]; }
                u32x2 w; w.x = pk4_fp8(r[0], r[1], r[2], r[3]); w.y = pk4_fp8(r[4], r[5], r[6], r[7]);
                *(u32x2*)rowp = w; }
    }
};
struct EpiGLU8 {
    static constexpr bool PERM = true, AFTER_DRAIN = false;
    bf16_t* O; int ldc; const float* bias; int ystride; float s;
    __device__ __forceinline__ void operator()(const AccQ& acc, const Unit& u, int wr, int wc, int fr, int fq) const {
        const int row0 = u.pm * BM + wr * 64 + fr, ch0 = u.pn * HALF + wc * 32 + 8 * fq;
        f32x4 bx[2], by[2];
#pragma unroll
        for (int n = 0; n < 2; ++n) { bx[n] = *(const f32x4*)(bias + ch0 + 4 * n); by[n] = *(const f32x4*)(bias + ystride + ch0 + 4 * n); }
#pragma unroll
        for (int ai = 0; ai < 2; ++ai)
#pragma unroll
            for (int m = 0; m < 4; ++m) { bf16_t* rowp = O + (size_t)(row0 + ai * HALF + m * 16) * ldc + ch0;
                float r[8];
#pragma unroll
                for (int n = 0; n < 2; ++n) { const f32x4 x = acc.get(ai, 0, m, n) * s + bx[n], y = acc.get(ai, 1, m, n) * s + by[n];
#pragma unroll
                    for (int j = 0; j < 4; ++j) r[4 * n + j] = x[j] * fsigmoid(y[j]); }
                u32x4 w; w.x = cvt_pk_bf16(r[0], r[1]); w.y = cvt_pk_bf16(r[2], r[3]); w.z = cvt_pk_bf16(r[4], r[5]); w.w = cvt_pk_bf16(r[6], r[7]);
                *(u32x4*)rowp = w; }
    }
};


template <class Epi, class Sched, bool ALIGN_EPI = false, bool SP2 = false, bool GATHER = false>
__device__ __forceinline__ void gemm_phase(PG8_LAS unsigned char* lds, const Gemm g, const Sched& S, const Epi& E, const int wv, const int* gsel = nullptr, PG8_LAS unsigned* gtab = nullptr) {
    const int tid = TID_OF(wv), wid = wv, lane = tid & 63, wr = wid >> 2, wc = wid & 3, fr = lane & 15, fq = lane >> 4;
    const int K = g.K, nt = K / BK;
    unsigned voffA[2], voffB[2]; int gR[2]; unsigned gC2[2];
#pragma unroll
    for (int i = 0; i < 2; ++i) { int R, C; stage_rc(tid * 16 + i * 8192, R, C); const int Rb = Epi::PERM ? ((R & ~31) + perm32(R & 31)) : R;
        voffA[i] = (unsigned)(R * K + C) * 2u; voffB[i] = (unsigned)(Rb * K + C) * 2u; gR[i] = R; gC2[i] = (unsigned)C * 2u; }
    unsigned cur0[2] = {0u, 0u}, cur1[2] = {0u, 0u}, nx0[2] = {0u, 0u}, nx1[2] = {0u, 0u};
    if constexpr (GATHER) { Unit uu; for (int i = 0; S.next(i, uu); ++i) if (tid < 256) gtab[i * 256 + tid] = (unsigned)gsel[uu.pm * 256 + tid] * (unsigned)(K * 2);
        __syncthreads(); }
#define PG8_GOFFS(ui_, o0, o1) do { _Pragma("unroll") for (int i = 0; i < 2; ++i) { o0[i] = gtab[(ui_) * 256 + gR[i]] + gC2[i]; o1[i] = gtab[(ui_) * 256 + 128 + gR[i]] + gC2[i]; } } while (0)
#define PG8_STAGE_A(bufoff, ptr_plain, ptr_gather, goffs) do { if constexpr (GATHER) { PG8_STAGE(bufoff, ptr_gather, goffs); } else { PG8_STAGE(bufoff, ptr_plain, voffA); } } while (0)
    const size_t kstep = (size_t)(BK * 2);
    const size_t hstep = (size_t)HALF * K * 2;
    const size_t tstep = 2 * hstep;
    const unsigned ldsw = (unsigned)wid * 1024u;
    const int aoff = lds_byte(wr * 64 + fr, fq * 8), boff = lds_byte(wc * 32 + fr, fq * 8);
#define PG8_SA(b, h) (((b) * 2 + (h)) * HTB)
#define PG8_SB(b, h) ((4 + (b) * 2 + (h)) * HTB)
#define PG8_STAGE(bufoff, gbase, voff) do { _Pragma("unroll") for (int _i = 0; _i < 2; ++_i) \
        __builtin_amdgcn_global_load_lds((const unsigned*)((const char*)(gbase) + (voff)[_i]), (PG8_LAS unsigned*)(lds + (bufoff) + ldsw + _i * 8192), 16, 0, 0); } while (0)
#define PG8_LDA(dst, b, h) do { _Pragma("unroll") for (int m = 0; m < 4; ++m) _Pragma("unroll") for (int k = 0; k < 2; ++k) dst[m][k] = *(const PG8_LAS bf16x8*)(lds + PG8_SA(b, h) + aoff + m * 2048 + k * 1024); } while (0)
#define PG8_LDB(dst, b, h) do { _Pragma("unroll") for (int n = 0; n < 2; ++n) _Pragma("unroll") for (int k = 0; k < 2; ++k) dst[n][k] = *(const PG8_LAS bf16x8*)(lds + PG8_SB(b, h) + boff + n * 2048 + k * 1024); } while (0)
#define PG8_MMA(ai, bj, At, Bt) do { __builtin_amdgcn_s_setprio(1); _Pragma("unroll") for (int m = 0; m < 4; ++m) _Pragma("unroll") for (int n = 0; n < 2; ++n) _Pragma("unroll") for (int k = 0; k < 2; ++k) \
        acc[ai][bj][m][n] = __builtin_amdgcn_mfma_f32_16x16x32_bf16(Bt[n][k], At[m][k], acc[ai][bj][m][n], 0, 0, 0); __builtin_amdgcn_s_setprio(0); } while (0)
#define PG8_WAIT_V(n) asm volatile("s_waitcnt vmcnt(" #n ")" ::: "memory")
#define PG8_WAIT_L(n) asm volatile("s_waitcnt lgkmcnt(" #n ")" ::: "memory")
#define PG8_BAR __builtin_amdgcn_s_barrier()
#define PG8_SCHED __builtin_amdgcn_sched_barrier(0)
    Unit cur, nxt; int ui = 0;
    if (!S.next(0, cur)) return;
    f32x4 acc[2][2][4][2];
#pragma unroll
    for (int a = 0; a < 2; ++a)
#pragma unroll
        for (int b = 0; b < 2; ++b)
#pragma unroll
            for (int m = 0; m < 4; ++m)
#pragma unroll
                for (int n = 0; n < 2; ++n) acc[a][b][m][n] = (f32x4){0.f, 0.f, 0.f, 0.f};
    bf16x8 At[4][2], B0[2][2], B1[2][2];
    const char* cA = (const char*)g.A + (size_t)cur.pm * tstep; const char* cB = (const char*)g.Bt + (size_t)cur.pb * tstep;
    const char* const gA = (const char*)g.A;
    if constexpr (GATHER) PG8_GOFFS(0, cur0, cur1);
    S.a_ready(cur);
    if constexpr (SP2) {
        PG8_STAGE(PG8_SB(0, 0), cB, voffB); PG8_STAGE(PG8_SB(0, 1), cB + hstep, voffB); PG8_STAGE_A(PG8_SA(0, 0), cA, gA, cur0); PG8_STAGE_A(PG8_SA(0, 1), cA + hstep, gA, cur1);
        if (wr == 1) PG8_BAR;
        PG8_WAIT_V(2); PG8_BAR;
        PG8_STAGE(PG8_SB(1, 0), cB + kstep, voffB); PG8_STAGE_A(PG8_SA(1, 0), cA + kstep, gA + kstep, cur0); PG8_STAGE(PG8_SB(1, 1), cB + hstep + kstep, voffB);
        PG8_WAIT_V(6); PG8_BAR;
    } else {
        PG8_STAGE(PG8_SB(0, 0), cB, voffB); PG8_STAGE_A(PG8_SA(0, 0), cA, gA, cur0); PG8_STAGE(PG8_SB(0, 1), cB + hstep, voffB); PG8_STAGE_A(PG8_SA(0, 1), cA + hstep, gA, cur1);
        if (wr == 1) PG8_BAR;
        PG8_WAIT_V(4); PG8_BAR;
        PG8_STAGE(PG8_SB(1, 0), cB + kstep, voffB); PG8_STAGE_A(PG8_SA(1, 0), cA + kstep, gA + kstep, cur0); PG8_STAGE(PG8_SB(1, 1), cB + hstep + kstep, voffB);
        PG8_WAIT_V(6); PG8_BAR;
    }
    for (;;) {
        const bool has_next = S.next(ui + 1, nxt);
        if constexpr (GATHER) { if (has_next) PG8_GOFFS(ui + 1, nx0, nx1); else { _Pragma("unroll") for (int i = 0; i < 2; ++i) { nx0[i] = cur0[i]; nx1[i] = cur1[i]; } } }
        const char* nA = has_next ? (const char*)g.A + (size_t)nxt.pm * tstep : cA; const char* nB = has_next ? (const char*)g.Bt + (size_t)nxt.pb * tstep : cB;
#pragma unroll 1
        for (int t = 0; t < nt; t += 2) {
            const bool last = (t == nt - 2);
            const char* a1 = cA + (size_t)(t + 1) * kstep;
            const char* a2 = last ? nA : cA + (size_t)(t + 2) * kstep; const char* b2 = last ? nB : cB + (size_t)(t + 2) * kstep;
            const char* a3 = a2 + kstep; const char* b3 = b2 + kstep;
            const char* ga1 = gA + (size_t)(t + 1) * kstep; const char* ga2 = last ? gA : gA + (size_t)(t + 2) * kstep; const char* ga3 = ga2 + kstep;
            unsigned o2h0[2], o2h1[2];
#pragma unroll
            for (int i = 0; i < 2; ++i) { o2h0[i] = last ? nx0[i] : cur0[i]; o2h1[i] = last ? nx1[i] : cur1[i]; }
            if (last && has_next) S.a_ready(nxt);
            if constexpr (SP2) {
            PG8_LDB(B0, 0, 0); PG8_LDB(B1, 0, 1); PG8_SCHED; PG8_LDA(At, 0, 0); PG8_STAGE_A(PG8_SA(1, 1), a1 + hstep, ga1, cur1);
            PG8_WAIT_V(8); PG8_WAIT_L(0); PG8_BAR; PG8_MMA(0, 0, At, B0); PG8_MMA(0, 1, At, B1); PG8_BAR; PG8_SCHED;
            PG8_LDA(At, 0, 1); PG8_STAGE(PG8_SB(0, 0), b2, voffB); PG8_STAGE(PG8_SB(0, 1), b2 + hstep, voffB); PG8_STAGE_A(PG8_SA(0, 0), a2, ga2, o2h0);
            PG8_WAIT_V(8); PG8_WAIT_L(0); PG8_BAR; PG8_MMA(1, 0, At, B0); PG8_MMA(1, 1, At, B1); PG8_BAR; PG8_SCHED;
            PG8_LDB(B0, 1, 0); PG8_LDB(B1, 1, 1); PG8_SCHED; PG8_LDA(At, 1, 0); PG8_STAGE_A(PG8_SA(0, 1), a2 + hstep, ga2, o2h1);
            PG8_WAIT_V(8); PG8_WAIT_L(0); PG8_BAR; PG8_MMA(0, 0, At, B0); PG8_MMA(0, 1, At, B1); PG8_BAR; PG8_SCHED;
            PG8_LDA(At, 1, 1); PG8_STAGE(PG8_SB(1, 0), b3, voffB); PG8_STAGE(PG8_SB(1, 1), b3 + hstep, voffB); PG8_STAGE_A(PG8_SA(1, 0), a3, ga3, o2h0);
            PG8_WAIT_V(8); PG8_WAIT_L(0); PG8_BAR; PG8_MMA(1, 0, At, B0); PG8_MMA(1, 1, At, B1); PG8_BAR; PG8_SCHED;
            } else {
            PG8_LDB(B0, 0, 0); PG8_SCHED; PG8_LDA(At, 0, 0); PG8_STAGE_A(PG8_SA(1, 1), a1 + hstep, ga1, cur1);
            PG8_WAIT_L(8); PG8_BAR; PG8_WAIT_L(0); PG8_MMA(0, 0, At, B0); PG8_BAR; PG8_SCHED;
            PG8_LDB(B1, 0, 1); PG8_STAGE(PG8_SB(0, 0), b2, voffB);
            PG8_BAR; PG8_WAIT_L(0); PG8_MMA(0, 1, At, B1); PG8_BAR;
            PG8_LDA(At, 0, 1); PG8_STAGE_A(PG8_SA(0, 0), a2, ga2, o2h0);
            PG8_BAR; PG8_WAIT_L(0); PG8_MMA(1, 0, At, B0); PG8_BAR; PG8_SCHED;
            PG8_STAGE(PG8_SB(0, 1), b2 + hstep, voffB);
            PG8_WAIT_V(6); PG8_BAR; PG8_MMA(1, 1, At, B1); PG8_BAR;
            PG8_LDB(B0, 1, 0); PG8_SCHED; PG8_LDA(At, 1, 0); PG8_STAGE_A(PG8_SA(0, 1), a2 + hstep, ga2, o2h1);
            PG8_WAIT_L(8); PG8_BAR; PG8_WAIT_L(0); PG8_MMA(0, 0, At, B0); PG8_BAR; PG8_SCHED;
            PG8_LDB(B1, 1, 1); PG8_STAGE(PG8_SB(1, 0), b3, voffB);
            PG8_BAR; PG8_WAIT_L(0); PG8_MMA(0, 1, At, B1); PG8_BAR;
            PG8_LDA(At, 1, 1); PG8_STAGE_A(PG8_SA(1, 0), a3, ga3, o2h0);
            PG8_BAR; PG8_WAIT_L(0); PG8_MMA(1, 0, At, B0); PG8_BAR; PG8_SCHED;
            PG8_STAGE(PG8_SB(1, 1), b3 + hstep, voffB);
            PG8_WAIT_V(6); PG8_BAR; PG8_MMA(1, 1, At, B1); PG8_BAR;
            }
        }
        if constexpr (ALIGN_EPI) { if (wr == 0) PG8_BAR; }
        if constexpr (!Epi::AFTER_DRAIN) { int tq = tid; asm volatile("" : "+v"(tq)); const int lq = tq & 63; E(acc, cur, wr, wc, lq & 15, lq >> 4); S.done(cur); }
        if (!has_next) break;
#pragma unroll
        for (int a = 0; a < 2; ++a)
#pragma unroll
            for (int b = 0; b < 2; ++b)
#pragma unroll
                for (int m = 0; m < 4; ++m)
#pragma unroll
                    for (int n = 0; n < 2; ++n) acc[a][b][m][n] = (f32x4){0.f, 0.f, 0.f, 0.f};
        cur = nxt; cA = nA; cB = nB; ++ui;
#pragma unroll
        for (int i = 0; i < 2; ++i) { cur0[i] = nx0[i]; cur1[i] = nx1[i]; }
        if constexpr (ALIGN_EPI) { if (wr == 1) PG8_BAR; }
    }
    PG8_WAIT_V(0);
    if constexpr (!ALIGN_EPI) { if (wr == 0) PG8_BAR; }
    PG8_BAR;
    if constexpr (Epi::AFTER_DRAIN) { E.fused(acc, cur, wr, wc, fr, fq, lds, wid, lane); S.done(cur); }
#undef PG8_SA
#undef PG8_SB
#undef PG8_STAGE
#undef PG8_STAGE_A
#undef PG8_GOFFS
#undef PG8_LDA
#undef PG8_LDB
#undef PG8_MMA
#undef PG8_WAIT_V
#undef PG8_WAIT_L
#undef PG8_BAR
#undef PG8_SCHED
}
typedef int v4i_t __attribute__((ext_vector_type(4)));
typedef int v8i_t __attribute__((ext_vector_type(8)));
typedef short s16x16_ld __attribute__((ext_vector_type(16), aligned(16)));
typedef v8i_t v8i_ld __attribute__((aligned(16)));
template <class Epi, class Sched, bool ALIGN_EPI = false, bool SP2 = false, bool GATHER = false, int KC = 0>
__device__ __forceinline__ void gemm_phase_f8(PG8_LAS unsigned char* lds, const Gemm g, const Sched& S, const Epi& E, const int wv, const int* gsel = nullptr, PG8_LAS unsigned* gtab = nullptr) {
    const int tid = TID_OF(wv), wid = wv, lane = tid & 63, wr = wid >> 2, wc = wid & 3, fr = lane & 15, fq = lane >> 4;
    const int K = KC ? KC : g.K, nt = K / 128;
    unsigned voffA[2], voffB[2]; int gR[2]; unsigned gC2[2];
#pragma unroll
    for (int i = 0; i < 2; ++i) { int R, C; stage_rc(tid * 16 + i * 8192, R, C); const int Rb = Epi::PERM ? ((R & ~31) + perm32(R & 31)) : R;
        voffA[i] = (unsigned)(R * K) + (unsigned)C * 2u; voffB[i] = (unsigned)(Rb * K) + (unsigned)C * 2u; gR[i] = R; gC2[i] = (unsigned)C * 2u; }
    unsigned cur0[2] = {0u, 0u}, cur1[2] = {0u, 0u}, nx0[2] = {0u, 0u}, nx1[2] = {0u, 0u};
    if constexpr (GATHER) { Unit uu; for (int i = 0; S.next(i, uu); ++i) if (tid < 256) ((PG8_LAS float*)gtab)[i * 256 + tid] = __uint_as_float((unsigned)(gsel ? gsel[uu.pm * 256 + tid] : uu.pm * 256 + tid) * (unsigned)K);
        __syncthreads(); }
#define PG8_GOFFS(ui_, o0, o1) do { _Pragma("unroll") for (int i = 0; i < 2; ++i) { o0[i] = __float_as_uint(((const PG8_LAS float*)gtab)[(ui_) * 256 + gR[i]]) + gC2[i]; o1[i] = __float_as_uint(((const PG8_LAS float*)gtab)[(ui_) * 256 + 128 + gR[i]]) + gC2[i]; } } while (0)
#define PG8_STAGE_A(bufoff, ptr_plain, ptr_gather, goffs) do { if constexpr (GATHER) { PG8_STAGE(bufoff, ptr_gather, goffs); } else { PG8_STAGE(bufoff, ptr_plain, voffA); } } while (0)
#define PG8_STAGE_AG(bufoff, ptr_plain, ptr_gather, goffs) do { if constexpr (GATHER) { PG8_STAGE(bufoff, ptr_gather, goffs); } else { PG8_STAGE(bufoff, ptr_plain, lvA); } } while (0)
    const size_t kstep = (size_t)(BK * 2);
    const size_t hstep = (size_t)HALF * K;
    const size_t tstep = 2 * hstep;
    const unsigned ldsw = (unsigned)wid * 1024u;
    const int aoff = lds_byte(wr * 64 + fr, fq * 16), boff = lds_byte(wc * 32 + fr, fq * 16);
#define PG8_SA(b, h) (((b) * 2 + (h)) * HTB)
#define PG8_SB(b, h) ((4 + (b) * 2 + (h)) * HTB)
#define PG8_STAGE(bufoff, gbase, voff) do { _Pragma("unroll") for (int _i = 0; _i < 2; ++_i) \
        __builtin_amdgcn_global_load_lds((const unsigned*)((const char*)(gbase) + (voff)[_i]), (PG8_LAS unsigned*)(lds + (bufoff) + ldsw + _i * 8192), 16, 0, 0); } while (0)
#define PG8_LDA(dst, b, h) do { _Pragma("unroll") for (int m = 0; m < 4; ++m) { const bf16x8 lo_ = *(const PG8_LAS bf16x8*)(lds + PG8_SA(b, h) + aoffv + m * 2048), hi_ = *(const PG8_LAS bf16x8*)(lds + PG8_SA(b, h) + aoffv + m * 2048 + 16); dst[m] = __builtin_bit_cast(v8i_t, __builtin_shufflevector(lo_, hi_, 0, 1, 2, 3, 4, 5, 6, 7, 8, 9, 10, 11, 12, 13, 14, 15)); } } while (0)
#define PG8_LDB(dst, b, h) do { _Pragma("unroll") for (int n = 0; n < 2; ++n) { const bf16x8 lo_ = *(const PG8_LAS bf16x8*)(lds + PG8_SB(b, h) + boffv + n * 2048), hi_ = *(const PG8_LAS bf16x8*)(lds + PG8_SB(b, h) + boffv + n * 2048 + 16); dst[n] = __builtin_bit_cast(v8i_t, __builtin_shufflevector(lo_, hi_, 0, 1, 2, 3, 4, 5, 6, 7, 8, 9, 10, 11, 12, 13, 14, 15)); } } while (0)
#define aoffv laoff
#define boffv lboff
#define PG8_MMA(ai, bj, At, Bt) do { __builtin_amdgcn_s_setprio(1); _Pragma("unroll") for (int m = 0; m < 4; ++m) _Pragma("unroll") for (int n = 0; n < 2; ++n) \
        acc.set(ai, bj, m, n, __builtin_amdgcn_mfma_scale_f32_16x16x128_f8f6f4(Bt[n], At[m], acc.get(ai, bj, m, n), 0, 0, 0, 0x7f7f7f7f, 0, 0x7f7f7f7f)); __builtin_amdgcn_s_setprio(0); } while (0)
#define PG8_WAIT_V(n) asm volatile("s_waitcnt vmcnt(" #n ")" ::: "memory")
#define PG8_WAIT_L(n) asm volatile("s_waitcnt lgkmcnt(" #n ")" ::: "memory")
#define PG8_BAR __builtin_amdgcn_s_barrier()
#define PG8_SCHED __builtin_amdgcn_sched_barrier(0)
    Unit cur, nxt; int ui = 0;
    if (!S.next(0, cur)) return;
    AccQ acc;
#pragma unroll
    for (int a = 0; a < 2; ++a)
#pragma unroll
        for (int b = 0; b < 2; ++b)
#pragma unroll
            for (int e = 0; e < 32; ++e) acc.q[a][b][e] = 0.f;
    v8i_t At[4], B0[2], B1[2];
    const char* cA = (const char*)g.A + (size_t)cur.pm * tstep; const char* cB = (const char*)g.Bt + (size_t)cur.pb * tstep;
    const char* const gA = (const char*)g.A;
    if constexpr (GATHER) PG8_GOFFS(0, cur0, cur1);
    S.a_ready(cur);
    if constexpr (SP2) {
        PG8_STAGE(PG8_SB(0, 0), cB, voffB); PG8_STAGE(PG8_SB(0, 1), cB + hstep, voffB); PG8_STAGE_A(PG8_SA(0, 0), cA, gA, cur0); PG8_STAGE_A(PG8_SA(0, 1), cA + hstep, gA, cur1);
        if (wr == 1) PG8_BAR;
        PG8_WAIT_V(2); PG8_BAR;
        PG8_STAGE(PG8_SB(1, 0), cB + kstep, voffB); PG8_STAGE_A(PG8_SA(1, 0), cA + kstep, gA + kstep, cur0); PG8_STAGE(PG8_SB(1, 1), cB + hstep + kstep, voffB);
        PG8_WAIT_V(6); PG8_BAR;
    } else {
        PG8_STAGE(PG8_SB(0, 0), cB, voffB); PG8_STAGE_A(PG8_SA(0, 0), cA, gA, cur0); PG8_STAGE(PG8_SB(0, 1), cB + hstep, voffB); PG8_STAGE_A(PG8_SA(0, 1), cA + hstep, gA, cur1);
        if (wr == 1) PG8_BAR;
        PG8_WAIT_V(4); PG8_BAR;
        PG8_STAGE(PG8_SB(1, 0), cB + kstep, voffB); PG8_STAGE_A(PG8_SA(1, 0), cA + kstep, gA + kstep, cur0); PG8_STAGE(PG8_SB(1, 1), cB + hstep + kstep, voffB);
        PG8_WAIT_V(6); PG8_BAR;
    }
    for (;;) {
        const bool has_next = S.next(ui + 1, nxt);
        const char* nA = has_next ? (const char*)g.A + (size_t)nxt.pm * tstep : cA; const char* nB = has_next ? (const char*)g.Bt + (size_t)nxt.pb * tstep : cB;
#pragma unroll 1
        for (int t = 0; t < nt; t += 2) {
            const bool last = (t == nt - 2);
            unsigned lvA[2], lvB[2], lC2[2]; int lR[2];
            { int tq = tid; asm volatile("" : "+v"(tq));
#pragma unroll
              for (int i = 0; i < 2; ++i) { int R, C; stage_rc(tq * 16 + i * 8192, R, C); const int Rb = Epi::PERM ? ((R & ~31) + perm32(R & 31)) : R;
                  lvA[i] = (unsigned)(R * K) + (unsigned)C * 2u; lvB[i] = (unsigned)(Rb * K) + (unsigned)C * 2u; lR[i] = R; lC2[i] = (unsigned)C * 2u; } }
            int laoff, lboff; { int tq = tid; asm volatile("" : "+v"(tq)); const int lq = tq & 63, lfr = lq & 15, lfq = lq >> 4, lw = tq >> 6; laoff = lds_byte((lw >> 2) * 64 + lfr, lfq * 16); lboff = lds_byte((lw & 3) * 32 + lfr, lfq * 16); }
            const char* a1 = cA + (size_t)(t + 1) * kstep;
            const char* a2 = last ? nA : cA + (size_t)(t + 2) * kstep; const char* b2 = last ? nB : cB + (size_t)(t + 2) * kstep;
            const char* a3 = a2 + kstep; const char* b3 = b2 + kstep;
            const char* ga1 = gA + (size_t)(t + 1) * kstep; const char* ga2 = last ? gA : gA + (size_t)(t + 2) * kstep; const char* ga3 = ga2 + kstep;
            const int u2 = (last && has_next) ? ui + 1 : ui;
            unsigned g1h1[2] = {0u, 0u}, g2h0[2] = {0u, 0u}, g2h1[2] = {0u, 0u};
            if constexpr (GATHER) { const PG8_LAS float* gt = (const PG8_LAS float*)gtab;
#pragma unroll
                for (int i = 0; i < 2; ++i) { g1h1[i] = __float_as_uint(gt[ui * 256 + 128 + lR[i]]) + lC2[i]; g2h0[i] = __float_as_uint(gt[u2 * 256 + lR[i]]) + lC2[i]; g2h1[i] = __float_as_uint(gt[u2 * 256 + 128 + lR[i]]) + lC2[i]; } }
            if (last && has_next) S.a_ready(nxt);
            if constexpr (SP2) {
            PG8_LDB(B0, 0, 0); PG8_LDB(B1, 0, 1); PG8_SCHED; PG8_LDA(At, 0, 0); PG8_STAGE_AG(PG8_SA(1, 1), a1 + hstep, ga1, g1h1);
            PG8_WAIT_V(8); PG8_WAIT_L(0); PG8_BAR; PG8_MMA(0, 0, At, B0); PG8_MMA(0, 1, At, B1); PG8_BAR; PG8_SCHED;
            PG8_LDA(At, 0, 1); PG8_STAGE(PG8_SB(0, 0), b2, lvB); PG8_STAGE(PG8_SB(0, 1), b2 + hstep, lvB); PG8_STAGE_AG(PG8_SA(0, 0), a2, ga2, g2h0);
            PG8_WAIT_V(8); PG8_WAIT_L(0); PG8_BAR; PG8_MMA(1, 0, At, B0); PG8_MMA(1, 1, At, B1); PG8_BAR; PG8_SCHED;
            PG8_LDB(B0, 1, 0); PG8_LDB(B1, 1, 1); PG8_SCHED; PG8_LDA(At, 1, 0); PG8_STAGE_AG(PG8_SA(0, 1), a2 + hstep, ga2, g2h1);
            PG8_WAIT_V(8); PG8_WAIT_L(0); PG8_BAR; PG8_MMA(0, 0, At, B0); PG8_MMA(0, 1, At, B1); PG8_BAR; PG8_SCHED;
            PG8_LDA(At, 1, 1); PG8_STAGE(PG8_SB(1, 0), b3, lvB); PG8_STAGE(PG8_SB(1, 1), b3 + hstep, lvB); PG8_STAGE_AG(PG8_SA(1, 0), a3, ga3, g2h0);
            PG8_WAIT_V(8); PG8_WAIT_L(0); PG8_BAR; PG8_MMA(1, 0, At, B0); PG8_MMA(1, 1, At, B1); PG8_BAR; PG8_SCHED;
            } else {
            PG8_LDB(B0, 0, 0); PG8_SCHED; PG8_LDA(At, 0, 0); PG8_STAGE_AG(PG8_SA(1, 1), a1 + hstep, ga1, g1h1);
            PG8_WAIT_L(8); PG8_BAR; PG8_WAIT_L(0); PG8_MMA(0, 0, At, B0); PG8_BAR; PG8_SCHED;
            PG8_LDB(B1, 0, 1); PG8_STAGE(PG8_SB(0, 0), b2, lvB);
            PG8_BAR; PG8_WAIT_L(0); PG8_MMA(0, 1, At, B1); PG8_BAR;
            PG8_LDA(At, 0, 1); PG8_STAGE_AG(PG8_SA(0, 0), a2, ga2, g2h0);
            PG8_BAR; PG8_WAIT_L(0); PG8_MMA(1, 0, At, B0); PG8_BAR; PG8_SCHED;
            PG8_STAGE(PG8_SB(0, 1), b2 + hstep, lvB);
            PG8_WAIT_V(6); PG8_BAR; PG8_MMA(1, 1, At, B1); PG8_BAR;
            PG8_LDB(B0, 1, 0); PG8_SCHED; PG8_LDA(At, 1, 0); PG8_STAGE_AG(PG8_SA(0, 1), a2 + hstep, ga2, g2h1);
            PG8_WAIT_L(8); PG8_BAR; PG8_WAIT_L(0); PG8_MMA(0, 0, At, B0); PG8_BAR; PG8_SCHED;
            PG8_LDB(B1, 1, 1); PG8_STAGE(PG8_SB(1, 0), b3, lvB);
            PG8_BAR; PG8_WAIT_L(0); PG8_MMA(0, 1, At, B1); PG8_BAR;
            PG8_LDA(At, 1, 1); PG8_STAGE_AG(PG8_SA(1, 0), a3, ga3, g2h0);
            PG8_BAR; PG8_WAIT_L(0); PG8_MMA(1, 0, At, B0); PG8_BAR; PG8_SCHED;
            PG8_STAGE(PG8_SB(1, 1), b3 + hstep, lvB);
            PG8_WAIT_V(6); PG8_BAR; PG8_MMA(1, 1, At, B1); PG8_BAR;
            }
        }
        if constexpr (ALIGN_EPI) { if (wr == 0) PG8_BAR; }
        if constexpr (!Epi::AFTER_DRAIN) { int tq = tid; asm volatile("" : "+v"(tq)); const int lq = tq & 63; E(acc, cur, wr, wc, lq & 15, lq >> 4); S.done(cur); }
        if (!has_next) break;
#pragma unroll
        for (int a = 0; a < 2; ++a)
#pragma unroll
            for (int b = 0; b < 2; ++b)
#pragma unroll
                for (int e = 0; e < 32; ++e) acc.q[a][b][e] = 0.f;
        cur = nxt; cA = nA; cB = nB; ++ui;

        if constexpr (ALIGN_EPI) { if (wr == 1) PG8_BAR; }
    }
    PG8_WAIT_V(0);
    if constexpr (!ALIGN_EPI) { if (wr == 0) PG8_BAR; }
    PG8_BAR;
    if constexpr (Epi::AFTER_DRAIN) { E.fused(acc, cur, wr, wc, fr, fq, lds, wid, lane); S.done(cur); }
#undef PG8_SA
#undef PG8_SB
#undef PG8_STAGE
#undef PG8_STAGE_A
#undef PG8_STAGE_AG
#undef PG8_GOFFS
#undef PG8_LDA
#undef PG8_LDB
#undef aoffv
#undef boffv
#undef PG8_MMA
#undef PG8_WAIT_V
#undef PG8_WAIT_L
#undef PG8_BAR
#undef PG8_SCHED
}
}

constexpr int NW = 8;
constexpr int D = 1024, NB = 4, T = 8192, TCX = 256, NLAT = NB * T, NCTX = NB * TCX, R = NLAT + NCTX;
constexpr int NE = 16, FF = 2048, CAPL = 1024, CAPC = 32;
constexpr int RPE0 = 4352, RPE1 = 4096;
constexpr int HD = 128, NH = 8, NSEQ = NB * NH * 2;
constexpr int NGRP = 17;
constexpr float EPS = 1e-6f;

constexpr size_t MiB = 1u << 20;
constexpr size_t WS_CTL = 0, CTL_ZERO_BYTES = 64 * 1024;
constexpr size_t WS_MV = 1 * MiB;
constexpr size_t WS_LB = WS_MV + 256 * 1024;
constexpr size_t WS_AFF = 2 * MiB;
constexpr size_t WS_INV = 5 * MiB;
constexpr size_t WS_SEL = 7 * MiB;
constexpr size_t WS_GSEL = 7 * MiB + 512 * 1024;
constexpr size_t WS_CTXS = 8 * MiB;
constexpr size_t WS_W1T = 12 * MiB, WS_W2T = 16 * MiB, WS_WINT = 18 * MiB, WS_WOUTT = 28 * MiB;
constexpr size_t WS_PTOT = 30 * MiB;
constexpr size_t WS_W13T = 32 * MiB;
constexpr size_t WS_WDT = 160 * MiB;
constexpr size_t WS_W13T_L1 = 96 * MiB, WS_WDT_L1 = 192 * MiB;
constexpr int MOE_ITEMS = 16 * (16 * 128 + 32 * 32);
constexpr size_t WS_HB = 224 * MiB;
constexpr size_t WS_UB = 290 * MiB;
constexpr size_t WS_XG = 356 * MiB;
constexpr size_t WS_HBUF = 492 * MiB;
constexpr size_t WS_PRJ = 356 * MiB;
constexpr size_t WS_OLOC = 764 * MiB;
constexpr size_t WS_QGG = 892 * MiB;
constexpr size_t WS_SST = 32 * MiB;
constexpr size_t WS_END = 1020 * MiB;
static_assert(WS_PRJ + (size_t)R * 5120 * 2 <= WS_OLOC && WS_HBUF + (size_t)16 * RPE0 * 2048 * 2 <= WS_OLOC && WS_XG + (size_t)16 * RPE0 * 1024 * 2 <= WS_HBUF, "ws map");
static_assert(WS_HB + (size_t)R * 1024 * 2 <= WS_UB && WS_UB + (size_t)R * 1024 * 2 <= WS_XG && WS_QGG + (size_t)2 * NLAT * 1024 * 2 <= WS_END, "ws map 2");

constexpr int CW_BAR = 4096;
constexpr int LDS_BYTES = 155648;
constexpr int GTAB_OFF = 131072;
constexpr int MISC_OFF = 131072 + 20 * 1024 + 320;
static_assert(MISC_OFF + 192 <= LDS_BYTES, "LDS map");

#define GAS __attribute__((address_space(1)))
#define LAS __attribute__((address_space(3)))
typedef unsigned short bf16;
typedef unsigned v4u __attribute__((ext_vector_type(4)));
typedef unsigned v2u __attribute__((ext_vector_type(2)));
typedef float f32x4 __attribute__((ext_vector_type(4)));
typedef float f32x2 __attribute__((ext_vector_type(2)));
typedef short bf16x8 __attribute__((ext_vector_type(8)));
typedef short bf16x4 __attribute__((ext_vector_type(4)));
#define LDS_WAIT() asm volatile("s_waitcnt lgkmcnt(0)" ::: "memory")
__device__ __forceinline__ unsigned pk2(float lo, float hi) { return pg8::cvt_pk_bf16(lo, hi); }
__device__ __forceinline__ float bflo(unsigned w) { return __uint_as_float(w << 16); }
__device__ __forceinline__ float bfhi(unsigned w) { return __uint_as_float(w & 0xffff0000u); }
__device__ __forceinline__ float fsig(float x) { return __builtin_amdgcn_rcpf(1.0f + __expf(-x)); }
__device__ __forceinline__ float wave_sum(float v) {
#pragma unroll
    for (int o = 1; o < 64; o <<= 1) v += __shfl_xor(v, o);
    return v;
}

#define XB_TMO      128
#define XB_XCNT(j)  (256  + 64 * (j))
#define XB_XSUB(j)  (1280 + 64 * (j))
#define XB_XGEN(j)  (2304 + 64 * (j))
#define XB_TOP      3328
#define XB_TOPGEN   3392
#define XCD_BAR_WORDS 3456
#define XB_SPIN_CAP (1u << 20)
__device__ __forceinline__ unsigned xb_ld(unsigned* p)              { return __hip_atomic_load(p, __ATOMIC_RELAXED, __HIP_MEMORY_SCOPE_AGENT); }
__device__ __forceinline__ unsigned xb_add(unsigned* p, unsigned v) { return __hip_atomic_fetch_add(p, v, __ATOMIC_RELAXED, __HIP_MEMORY_SCOPE_AGENT); }
__device__ __forceinline__ unsigned xb_xcc_id() { return (unsigned)__builtin_amdgcn_s_getreg((3 << 11) | 20) & 0xFu; }
#define XB_SPIN(cond, bar) do { unsigned _sp = 0; while (cond) { __builtin_amdgcn_s_sleep(1); \
    if ((++_sp & 255u) == 0u) { if (xb_ld(&(bar)[XB_TMO])) break; if (_sp > XB_SPIN_CAP) { atomicAdd(&(bar)[XB_TMO], 1u); break; } } } } while (0)
struct XcdBarrier { unsigned* bar; unsigned x; volatile LAS unsigned* st; };
__device__ __forceinline__ XcdBarrier xcd_barrier_post(unsigned* bar, volatile LAS unsigned* st, const int wv) {
    XcdBarrier b; b.bar = bar; b.x = xb_xcc_id(); b.st = st;
    if (TID_OF(wv) == 0) (void)xb_add(&bar[XB_XCNT(b.x)], 1u);
    return b;
}
__device__ __forceinline__ void xcd_barrier_complete(unsigned* bar, unsigned x, unsigned& nloc, unsigned& nx) {
    const unsigned G = gridDim.x * gridDim.y * gridDim.z;
    unsigned sum, cnt, mine, sp = 0u;
    for (;;) {
        sum = 0u; cnt = 0u; mine = 0u;
#pragma unroll
        for (unsigned j = 0; j < 16; ++j) { const unsigned c = xb_ld(&bar[XB_XCNT(j)]); sum += c; cnt += (c > 0u) ? 1u : 0u; mine = (j == x) ? c : mine; }
        if (sum == G) break;
        __builtin_amdgcn_s_sleep(1);
        if ((++sp & 255u) == 0u) { if (xb_ld(&bar[XB_TMO])) break; if (sp > XB_SPIN_CAP) { atomicAdd(&bar[XB_TMO], 1u); break; } }
    }
    nloc = mine > 0u ? mine : 1u; nx = cnt > 0u ? cnt : 1u;
}
__device__ __forceinline__ void xcd_barrier(const XcdBarrier& b, const int wv) {
    asm volatile("s_waitcnt vmcnt(0)" ::: "memory");
    __syncthreads();
    if (TID_OF(wv) == 0) {
        unsigned* bar = b.bar;
        __builtin_amdgcn_s_waitcnt(0);
        unsigned nloc = b.st[0], nx = b.st[1];
        if (nloc == 0u) { xcd_barrier_complete(bar, b.x, nloc, nx); b.st[0] = nloc; b.st[1] = nx; }
        const unsigned old = xb_add(&bar[XB_XSUB(b.x)], 1u);
        const unsigned gen = old / nloc;
        if (old + 1u == (gen + 1u) * nloc) {
            __builtin_amdgcn_fence(__ATOMIC_RELEASE, "agent");
            asm volatile("s_waitcnt vmcnt(0)" ::: "memory");
            const unsigned og = xb_add(&bar[XB_TOP], 1u);
            const unsigned tg = og / nx;
            if (og + 1u == (tg + 1u) * nx) xb_add(&bar[XB_TOPGEN], 1u);
            else XB_SPIN(xb_ld(&bar[XB_TOPGEN]) == tg, bar);
            __builtin_amdgcn_fence(__ATOMIC_ACQUIRE, "agent");
            xb_add(&bar[XB_XGEN(b.x)], 1u);
            asm volatile("s_waitcnt vmcnt(0)" ::: "memory");
        } else {
            XB_SPIN(xb_ld(&bar[XB_XGEN(b.x)]) == gen, bar);
            __builtin_amdgcn_fence(__ATOMIC_ACQUIRE, "agent");
            asm volatile("s_waitcnt vmcnt(0)" ::: "memory");
        }
    }
    __syncthreads();
}

struct Ctx {
    LAS unsigned char* lds;
    int tid, lane, wave, vcu, G, gw, NGW;
};
__device__ __forceinline__ Ctx make_ctx(unsigned char* lds_raw, const int wv) {
    Ctx C; int l = lane_id(); asm volatile("" : "+v"(l));
    C.lds = (LAS unsigned char*)lds_raw; C.tid = wv * 64 + l; C.lane = l; C.wave = wv;
    C.G = gridDim.x; { const int bx = blockIdx.x; C.vcu = (C.G % 8 == 0) ? (bx % 8) * (C.G / 8) + bx / 8 : bx; }
    C.gw = C.vcu * NW + C.wave; C.NGW = C.G * NW;
    return C;
}

__device__ __forceinline__ void transpose_item(const float* W, int ldw, int k0, int n0, bf16* WT, int K, int drow0, LAS float* scr, int lane) {
    float tv[32];
    const float* wp = W + (size_t)(k0 + (lane >> 5)) * ldw + n0 + (lane & 31);
#pragma unroll
    for (int i = 0; i < 32; ++i) tv[i] = wp[(size_t)(2 * i) * ldw];
#pragma unroll
    for (int i = 0; i < 32; ++i) scr[(2 * i + (lane >> 5)) * 33 + (lane & 31)] = tv[i];
    LDS_WAIT(); asm volatile("" ::: "memory");
    const int c = lane & 7;
#pragma unroll
    for (int j = 0; j < 4; ++j) { const int n = (lane >> 3) + 8 * j; const LAS float* s = scr + (8 * c) * 33 + n;
        v4u o; o.x = pk2(s[0 * 33], s[1 * 33]); o.y = pk2(s[2 * 33], s[3 * 33]); o.z = pk2(s[4 * 33], s[5 * 33]); o.w = pk2(s[6 * 33], s[7 * 33]);
        *(v4u*)(WT + (size_t)(drow0 + n) * K + k0 + 8 * c) = o; }
    LDS_WAIT(); asm volatile("" ::: "memory");
}
__device__ __forceinline__ void paired_src(int db, int& type, int& ch) { const int j0 = 32 * db, pn = j0 >> 8, jj = j0 & 255; type = jj >> 7; ch = 128 * pn + (jj & 127); }

__device__ __forceinline__ void transpose_item_f8(const float* W, int ldw, int k0, int n0, unsigned char* WT, int K, int drow0, LAS float* scr, int lane) {
    float tv[32];
    const float* wp = W + (size_t)(k0 + (lane >> 5)) * ldw + n0 + (lane & 31);
#pragma unroll
    for (int i = 0; i < 32; ++i) tv[i] = wp[(size_t)(2 * i) * ldw];
#pragma unroll
    for (int i = 0; i < 32; ++i) scr[(2 * i + (lane >> 5)) * 33 + (lane & 31)] = tv[i] * 32.0f;
    LDS_WAIT(); asm volatile("" ::: "memory");
    const int n = lane >> 1, kh = (lane & 1) * 32; const LAS float* sp = scr + kh * 33 + n;
    unsigned o[8];
#pragma unroll
    for (int q = 0; q < 8; ++q) o[q] = pg8::pk4_fp8(sp[(4 * q) * 33], sp[(4 * q + 1) * 33], sp[(4 * q + 2) * 33], sp[(4 * q + 3) * 33]);
    unsigned char* dp = WT + (size_t)(drow0 + n) * K + k0 + kh;
    *(v4u*)dp = (v4u){o[0], o[1], o[2], o[3]}; *(v4u*)(dp + 16) = (v4u){o[4], o[5], o[6], o[7]};
    LDS_WAIT(); asm volatile("" ::: "memory");
}
__device__ __forceinline__ void convert_small(const Ctx& C, const float* w1, const float* w2, const float* win, const float* wout, unsigned char* ws) {
    LAS float* scr = (LAS float*)(C.lds + C.wave * 16384);
    constexpr int I1 = 16 * 64, I2 = 16 * 32, I3 = 16 * 160, I4 = 16 * 32, NI = I1 + I2 + I3 + I4;
    for (int it = C.gw; it < NI; it += C.NGW) {
        int r = it;
        if (r < I1) { const int kb = r / 64, db = r % 64; int type, ch; paired_src(db, type, ch); transpose_item(w1, 2048, 64 * kb, type * 1024 + ch, (bf16*)(ws + WS_W1T), 1024, 32 * db, scr, C.lane); continue; } r -= I1;
        if (r < I2) { const int kb = r / 32, db = r % 32; transpose_item(w2, 1024, 64 * kb, 32 * db, (bf16*)(ws + WS_W2T), 1024, 32 * db, scr, C.lane); continue; } r -= I2;
        if (r < I3) { const int kb = r / 160, db = r % 160; transpose_item(win, 5120, 64 * kb, 32 * db, (bf16*)(ws + WS_WINT), 1024, 32 * db, scr, C.lane); continue; } r -= I3;
        { const int kb = r / 32, db = r % 32; transpose_item(wout, 1024, 64 * kb, 32 * db, (bf16*)(ws + WS_WOUTT), 1024, 32 * db, scr, C.lane); }
    }
}
__device__ __forceinline__ void convert_moe(const Ctx& C, const float* wg, const float* wu, const float* wd, int layer, unsigned char* ws, int it_lo, int it_hi, int widx, int nw) {
    LAS float* scr = (LAS float*)(C.lds + C.wave * 16384);
    constexpr int IGU = 16 * 128, IDN = 32 * 32, IE = IGU + IDN;
    const size_t lo = (size_t)layer * NE * 1024 * 2048;
    unsigned char* const w13 = ws + (layer ? WS_W13T_L1 : WS_W13T); unsigned char* const wdt = ws + (layer ? WS_WDT_L1 : WS_WDT);
    for (int it = it_lo + widx; it < it_hi; it += nw) {
        const int e = it / IE; int r = it % IE;
        if (r < IGU) { const int kb = r / 128, db = r % 128; int type, ch; paired_src(db, type, ch);
            transpose_item_f8((type ? wu : wg) + lo + (size_t)e * 1024 * 2048, 2048, 64 * kb, ch, w13 + (size_t)e * 4096 * 1024, 1024, 32 * db, scr, C.lane); }
        else { r -= IGU; const int kb = r / 32, db = r % 32;
            transpose_item_f8(wd + lo + (size_t)e * 2048 * 1024, 1024, 64 * kb, 32 * db, wdt + (size_t)e * 1024 * 2048, 2048, 32 * db, scr, C.lane); }
    }
}
__device__ __forceinline__ void mod_gemv(const Ctx& C, const float* c, const float* cctx, const float* mod_w, const float* mod_b, float* MV) {
    LAS float* cond = (LAS float*)C.lds;
    LAS float* red = cond + 5 * 1024;
    bool have = false;
    for (int item = blockIdx.x; item < 192; item += C.G) {
        if (!have) { for (int i = C.tid; i < 5 * 1024; i += NW * 64) { const int g = i >> 10, k = i & 1023; const float v = g < 4 ? c[g * 1024 + k] : cctx[k]; cond[i] = v * fsig(v); } have = true; }
        __syncthreads();
        const int l = item / 96, n = (item % 96) * 64 + C.lane;
        const float* W = mod_w + (size_t)l * 1024 * 6144 + n;
        float a[5] = {0.f, 0.f, 0.f, 0.f, 0.f};
        for (int kk = 0; kk < 128; kk += 32) { float w[32];
#pragma unroll
            for (int u = 0; u < 32; ++u) w[u] = W[(size_t)(C.wave * 128 + kk + u) * 6144];
#pragma unroll
            for (int u = 0; u < 32; ++u)
#pragma unroll
                for (int g = 0; g < 5; ++g) a[g] += cond[g * 1024 + C.wave * 128 + kk + u] * w[u]; }
#pragma unroll
        for (int g = 0; g < 5; ++g) red[(C.wave * 5 + g) * 64 + C.lane] = a[g];
        __syncthreads();
        if (C.wave < 5) { float s = 0.f;
#pragma unroll
            for (int w = 0; w < 8; ++w) s += red[(w * 5 + C.wave) * 64 + C.lane];
            MV[(size_t)(l * 5 + C.wave) * 6144 + n] = s + mod_b[l * 6144 + n]; }
    }
}

struct RowArgs {
    const float* src_lat; const float* src_ctx;
    float* dst_lat; float* dst_ctx;
    const float* gamma;
    const float* mv;
    const float* mvg;
    int i_shift, i_scale, i_gate;
    bf16* HB; unsigned char* HB8; float* AFF; const float* router_w;
    const bf16* Y; const short* INV; int rpe;
    int nrows;
    int f8out;
};
template <bool COMBINE, bool ROUTER, bool FINAL>
__device__ __forceinline__ void row_phase(const Ctx& C, const RowArgs& A) {
    LAS float* rwT = (LAS float*)C.lds;
    if (ROUTER) { for (int i = C.tid; i < 16384; i += NW * 64) rwT[(i & 15) * 1024 + (i >> 4)] = A.router_w[i]; __syncthreads(); }
    const int rpw = (A.nrows + C.NGW - 1) / C.NGW;
    const int r_lo = C.gw * rpw, r_hi = min(A.nrows, r_lo + rpw);
    const int l4 = 4 * C.lane;
    int cur_grp = -1;
    f32x4 ga[4], sh[4], m5[4];
#pragma unroll
    for (int j = 0; j < 4; ++j) { ga[j] = (f32x4){0.f, 0.f, 0.f, 0.f}; sh[j] = ga[j]; m5[j] = ga[j]; }
    f32x4 vn[4];
#pragma unroll
    for (int j = 0; j < 4; ++j) vn[j] = (f32x4){0.f, 0.f, 0.f, 0.f};
    if (r_lo < r_hi) { const bool ic = r_lo >= NLAT; const float* s0 = (ic ? A.src_ctx + (size_t)(r_lo - NLAT) * 1024 : A.src_lat + (size_t)r_lo * 1024);
#pragma unroll
        for (int j = 0; j < 4; ++j) vn[j] = *(const f32x4*)(s0 + l4 + 256 * j); }
    int svn = -1;
    if (COMBINE && r_lo < r_hi) svn = (C.lane < 16) ? (int)A.INV[(size_t)r_lo * 16 + C.lane] : -1;
    for (int r = r_lo; r < r_hi; ++r) {
        const bool isctx = r >= NLAT; const int grp = isctx ? 4 : (r >> 13);
        if (grp != cur_grp) { cur_grp = grp; const float* mvn = A.mv + (size_t)grp * 6144;
#pragma unroll
            for (int j = 0; j < 4; ++j) { const int c0 = l4 + 256 * j; const f32x4 g = *(const f32x4*)(A.gamma + c0);
                if (FINAL) { ga[j] = g; }
                else { const f32x4 sc = *(const f32x4*)(mvn + A.i_scale * 1024 + c0); ga[j] = g * (sc + 1.0f); sh[j] = *(const f32x4*)(mvn + A.i_shift * 1024 + c0); }
                if (COMBINE) m5[j] = *(const f32x4*)(A.mvg + (size_t)grp * 6144 + A.i_gate * 1024 + c0); } }
        const size_t roff = isctx ? (size_t)(r - NLAT) * 1024 : (size_t)r * 1024;
        f32x4 v[4];
#pragma unroll
        for (int j = 0; j < 4; ++j) v[j] = vn[j];
        if (r + 1 < r_hi) { const int rn = r + 1; const bool ic = rn >= NLAT; const float* s1 = (ic ? A.src_ctx + (size_t)(rn - NLAT) * 1024 : A.src_lat + (size_t)rn * 1024);
#pragma unroll
            for (int j = 0; j < 4; ++j) vn[j] = *(const f32x4*)(s1 + l4 + 256 * j); }
        if (COMBINE) {
            f32x4 acc[4];
#pragma unroll
            for (int j = 0; j < 4; ++j) acc[j] = (f32x4){0.f, 0.f, 0.f, 0.f};
            const int sv = svn;
            if (r + 1 < r_hi) svn = (C.lane < 16) ? (int)A.INV[(size_t)(r + 1) * 16 + C.lane] : -1;
            unsigned long long m = __ballot(sv >= 0);
            while (m) {
                const int e0 = __ffsll((long long)m) - 1; m &= m - 1;
                const bool two = m != 0ull; const int e1 = two ? __ffsll((long long)m) - 1 : e0; if (two) m &= m - 1;
                const bf16* y0 = A.Y + ((size_t)e0 * A.rpe + __shfl(sv, e0)) * 1024 + l4;
                const bf16* y1 = A.Y + ((size_t)e1 * A.rpe + __shfl(sv, e1)) * 1024 + l4;
                v2u w0[4], w1[4];
#pragma unroll
                for (int j = 0; j < 4; ++j) { w0[j] = *(const v2u*)(y0 + 256 * j); w1[j] = *(const v2u*)(y1 + 256 * j); }
#pragma unroll
                for (int j = 0; j < 4; ++j) { acc[j] += (f32x4){bflo(w0[j].x), bfhi(w0[j].x), bflo(w0[j].y), bfhi(w0[j].y)};
                    if (two) acc[j] += (f32x4){bflo(w1[j].x), bfhi(w1[j].x), bflo(w1[j].y), bfhi(w1[j].y)}; } }
#pragma unroll
            for (int j = 0; j < 4; ++j) v[j] += m5[j] * acc[j];
            if (!FINAL) { float* dst = (isctx ? A.dst_ctx : A.dst_lat) + roff;
#pragma unroll
                for (int j = 0; j < 4; ++j) *(f32x4*)(dst + l4 + 256 * j) = v[j]; }
        }
        float ss = 0.f;
#pragma unroll
        for (int j = 0; j < 4; ++j) ss += (v[j].x * v[j].x + v[j].y * v[j].y) + (v[j].z * v[j].z + v[j].w * v[j].w);
        const float rstd = rsqrtf(wave_sum(ss) * (1.0f / 1024.0f) + EPS);
        if (FINAL) { float* dst = A.dst_lat + roff;
#pragma unroll
            for (int j = 0; j < 4; ++j) *(f32x4*)(dst + l4 + 256 * j) = v[j] * rstd * ga[j];
            continue; }
        f32x4 hv[4];
#pragma unroll
        for (int j = 0; j < 4; ++j) { hv[j] = v[j] * rstd * ga[j] + sh[j];
            if (ROUTER || A.f8out) { *(unsigned*)(A.HB8 + (size_t)r * 1024 + l4 + 256 * j) = pg8::pk4_fp8(hv[j].x, hv[j].y, hv[j].z, hv[j].w); }
            else { v2u w; w.x = pk2(hv[j].x, hv[j].y); w.y = pk2(hv[j].z, hv[j].w); *(v2u*)(A.HB + (size_t)r * 1024 + l4 + 256 * j) = w; } }
        if (ROUTER) {
            float lg[16];
#pragma unroll
            for (int e = 0; e < 16; ++e) { float s = 0.f;
#pragma unroll
                for (int j = 0; j < 4; ++j) { const f32x4 w = *(const LAS f32x4*)(rwT + e * 1024 + l4 + 256 * j); s += (hv[j].x * w.x + hv[j].y * w.y) + (hv[j].z * w.z + hv[j].w * w.w); }
                lg[e] = s; }
            float t8[8], t4[4], t2[2], t1;
#pragma unroll
            for (int i = 0; i < 8; ++i) { const bool up = (C.lane & 32) != 0; const float send = up ? lg[i] : lg[i + 8], keep = up ? lg[i + 8] : lg[i]; t8[i] = keep + __shfl_xor(send, 32); }
#pragma unroll
            for (int i = 0; i < 4; ++i) { const bool up = (C.lane & 16) != 0; const float send = up ? t8[i] : t8[i + 4], keep = up ? t8[i + 4] : t8[i]; t4[i] = keep + __shfl_xor(send, 16); }
#pragma unroll
            for (int i = 0; i < 2; ++i) { const bool up = (C.lane & 8) != 0; const float send = up ? t4[i] : t4[i + 2], keep = up ? t4[i + 2] : t4[i]; t2[i] = keep + __shfl_xor(send, 8); }
            { const bool up = (C.lane & 4) != 0; const float send = up ? t2[0] : t2[1], keep = up ? t2[1] : t2[0]; t1 = keep + __shfl_xor(send, 4); }
            t1 += __shfl_xor(t1, 2); t1 += __shfl_xor(t1, 1);
            const int e = ((C.lane >> 5) & 1) * 8 + ((C.lane >> 4) & 1) * 4 + ((C.lane >> 3) & 1) * 2 + ((C.lane >> 2) & 1);
            float mx = t1;
#pragma unroll
            for (int o = 4; o < 64; o <<= 1) mx = fmaxf(mx, __shfl_xor(mx, o));
            const float p = __expf(t1 - mx); float sum = p;
#pragma unroll
            for (int o = 4; o < 64; o <<= 1) sum += __shfl_xor(sum, o);
            if ((C.lane & 3) == 0) A.AFF[(size_t)r * 16 + e] = p / sum;
        }
    }
    if (ROUTER) __syncthreads();
}

__device__ __forceinline__ void conv_phase(const Ctx& C, const bf16* U, bf16* V, const float* dw, const float* dwb, const float* lng, const float* lnb) {
    LAS unsigned* ut = (LAS unsigned*)C.lds;
    LAS float* part = (LAS float*)(C.lds + 126976);
    LAS float* stat = part + 512;
    const int cp = C.tid;
    f32x2 wt[31];
#pragma unroll
    for (int j = 0; j < 31; ++j) wt[j] = *(const f32x2*)(dw + j * 1024 + 2 * cp);
    const f32x2 bb = *(const f32x2*)(dwb + 2 * cp), gg = *(const f32x2*)(lng + 2 * cp), be = *(const f32x2*)(lnb + 2 * cp);
    for (int tile = C.vcu; tile < 1056; tile += C.G) {
        int rowbase, t0, tseq;
        if (tile < 1024) { rowbase = (tile >> 8) * T; t0 = (tile & 255) * 32; tseq = T; } else { const int tt = tile - 1024; rowbase = NLAT + (tt >> 3) * TCX; t0 = (tt & 7) * 32; tseq = TCX; }
        { v4u tv[16];
#pragma unroll
            for (int k = 0; k < 16; ++k) { const int i = 4 * k + (C.tid >> 7), t = t0 - 15 + i; tv[k] = (v4u){0u, 0u, 0u, 0u};
                if (i < 62 && t >= 0 && t < tseq) tv[k] = *(const v4u*)(U + (size_t)(rowbase + t) * 1024 + (C.tid & 127) * 8); }
#pragma unroll
            for (int k = 0; k < 16; ++k) { const int i = 4 * k + (C.tid >> 7); if (i < 62) *(LAS v4u*)(C.lds + i * 2048 + (C.tid & 127) * 16) = tv[k]; } }
        __syncthreads();
        f32x2 ov[32];
#pragma unroll
        for (int g = 0; g < 8; ++g) {
            f32x2 a[4];
#pragma unroll
            for (int oo = 0; oo < 4; ++oo) a[oo] = bb;
#pragma unroll
            for (int jj = 0; jj < 34; ++jj) { const unsigned uw = ut[(4 * g + jj) * 512 + cp]; const f32x2 uu = (f32x2){bflo(uw), bfhi(uw)};
#pragma unroll
                for (int oo = 0; oo < 4; ++oo) { const int tap = jj - oo; if (tap >= 0 && tap <= 30) a[oo] = __builtin_elementwise_fma(wt[tap], uu, a[oo]); } }
            float r8[8];
#pragma unroll
            for (int oo = 0; oo < 4; ++oo) { ov[4 * g + oo] = a[oo]; r8[2 * oo] = a[oo].x + a[oo].y; r8[2 * oo + 1] = a[oo].x * a[oo].x + a[oo].y * a[oo].y; }
            float r4[4], r2[2], r1;
#pragma unroll
            for (int i = 0; i < 4; ++i) { const bool up = (C.lane & 32) != 0; const float send = up ? r8[i] : r8[i + 4], keep = up ? r8[i + 4] : r8[i]; r4[i] = keep + __shfl_xor(send, 32); }
#pragma unroll
            for (int i = 0; i < 2; ++i) { const bool up = (C.lane & 16) != 0; const float send = up ? r4[i] : r4[i + 2], keep = up ? r4[i + 2] : r4[i]; r2[i] = keep + __shfl_xor(send, 16); }
            { const bool up = (C.lane & 8) != 0; const float send = up ? r2[0] : r2[1], keep = up ? r2[1] : r2[0]; r1 = keep + __shfl_xor(send, 8); }
            r1 += __shfl_xor(r1, 4); r1 += __shfl_xor(r1, 2); r1 += __shfl_xor(r1, 1);
            if ((C.lane & 7) == 0) { const int vi = ((C.lane >> 5) & 1) * 4 + ((C.lane >> 4) & 1) * 2 + ((C.lane >> 3) & 1); part[((4 * g + (vi >> 1)) * 8 + C.wave) * 2 + (vi & 1)] = r1; }
            asm volatile("" ::: "memory");
        }
        __syncthreads();
        if (C.tid < 32) { float s1 = 0.f, s2 = 0.f;
#pragma unroll
            for (int w = 0; w < 8; ++w) { s1 += part[(C.tid * 8 + w) * 2]; s2 += part[(C.tid * 8 + w) * 2 + 1]; }
            const float mean = s1 * (1.0f / 1024.0f), var = fmaxf(s2 * (1.0f / 1024.0f) - mean * mean, 0.f);
            stat[C.tid * 2] = mean; stat[C.tid * 2 + 1] = rsqrtf(var + EPS); }
        __syncthreads();
#pragma unroll
        for (int tk = 0; tk < 32; ++tk) { const float mean = stat[tk * 2], rstd = stat[tk * 2 + 1];
            const float y0 = (ov[tk].x - mean) * rstd * gg.x + be.x, y1 = (ov[tk].y - mean) * rstd * gg.y + be.y;
            *(unsigned*)(V + (size_t)(rowbase + t0 + tk) * 1024 + 2 * cp) = pk2(y0 * fsig(y0), y1 * fsig(y1)); }
    }
}

__device__ __forceinline__ unsigned block_excl_scan(const Ctx& C, unsigned v, LAS unsigned* wsum, unsigned& total) {
    unsigned inc = v;
#pragma unroll
    for (int o = 1; o < 64; o <<= 1) { const unsigned t = __shfl_up(inc, o); if (C.lane >= o) inc += t; }
    if (C.lane == 63) wsum[C.wave] = inc;
    __syncthreads();
    unsigned base = 0, tot = 0;
#pragma unroll
    for (int w = 0; w < NW; ++w) { const unsigned s = wsum[w]; if (w < C.wave) base += s; tot += s; }
    __syncthreads();
    total = tot;
    return base + inc - v;
}
__device__ __forceinline__ void topk_phase(const Ctx& C, int nprob, int rpe, const float* AFF, int* SEL, float* GSEL, short* INV) {
    LAS unsigned* hist = (LAS unsigned*)C.lds;
    LAS unsigned* misc = hist + 256;
    LAS unsigned* wsum = misc + 16;
    for (int prob = blockIdx.x; prob < nprob; prob += C.G) {
        const int set = prob >> 4, e = prob & 15; const bool lat = set < 4;
        const int kk = lat ? CAPL : CAPC, rowbase = lat ? set * T : NLAT + (set - 4) * TCX, slotbase = lat ? set * CAPL : 4 * CAPL + (set - 4) * CAPC;
        const int cnt = lat ? 16 : (C.tid < 256 ? 1 : 0), base = lat ? C.tid * 16 : C.tid;
        unsigned key[16];
#pragma unroll
        for (int i = 0; i < 16; ++i) key[i] = (i < cnt) ? __float_as_uint(AFF[(size_t)(rowbase + base + i) * 16 + e]) : 0u;
        unsigned prefix = 0u, mask = 0u, need = (unsigned)kk;
#pragma unroll 1
        for (int pass = 0; pass < 4; ++pass) { const int shift = 24 - 8 * pass;
            if (C.tid < 256) hist[C.tid] = 0u;
            __syncthreads();
#pragma unroll
            for (int i = 0; i < 16; ++i) if (i < cnt && (key[i] & mask) == prefix) __hip_atomic_fetch_add(&hist[(key[i] >> shift) & 255u], 1u, __ATOMIC_RELAXED, __HIP_MEMORY_SCOPE_WORKGROUP);
            __syncthreads();
            if (C.wave == 0) { unsigned h[4], tot = 0u;
#pragma unroll
                for (int b = 0; b < 4; ++b) { h[b] = hist[4 * C.lane + b]; tot += h[b]; }
                unsigned inc = tot;
#pragma unroll
                for (int o = 1; o < 64; o <<= 1) { const unsigned t = __shfl_down(inc, o); if (C.lane + o < 64) inc += t; }
                unsigned cgt = inc - tot;
#pragma unroll
                for (int b = 3; b >= 0; --b) { if (cgt < need && need <= cgt + h[b]) { misc[0] = (unsigned)(4 * C.lane + b); misc[1] = need - cgt; } cgt += h[b]; } }
            __syncthreads();
            prefix |= misc[0] << shift; mask |= 255u << shift; need = misc[1];
        }
        unsigned neq = 0u, ngt = 0u;
#pragma unroll
        for (int i = 0; i < 16; ++i) if (i < cnt) { neq += (key[i] == prefix) ? 1u : 0u; ngt += (key[i] > prefix) ? 1u : 0u; }
        unsigned tot;
        const unsigned eq_before = block_excl_scan(C, neq, wsum, tot);
        const unsigned take_eq = (need > eq_before) ? min(neq, need - eq_before) : 0u;
        unsigned slot = block_excl_scan(C, ngt + take_eq, wsum, tot);
        unsigned eqr = eq_before;
#pragma unroll
        for (int i = 0; i < 16; ++i) if (i < cnt) {
            bool sel = key[i] > prefix;
            if (key[i] == prefix) { sel = eqr < need; ++eqr; }
            const int row = rowbase + base + i;
            if (sel) { const int s = slotbase + (int)slot; ++slot; SEL[e * rpe + s] = row; GSEL[e * rpe + s] = __uint_as_float(key[i]); INV[(size_t)row * 16 + e] = (short)s; }
            else INV[(size_t)row * 16 + e] = (short)-1; }
        if (rpe == RPE0 && set == 4 && C.tid < RPE0 - (4 * CAPL + 4 * CAPC)) { const int s = 4 * CAPL + 4 * CAPC + C.tid; SEL[e * rpe + s] = 0; GSEL[e * rpe + s] = 0.f; }
        __syncthreads();
    }
}
__device__ __forceinline__ void gather_phase(const Ctx& C, int nrows, const int* SEL, const bf16* HB, bf16* XG) {
    for (int r = C.gw; r < nrows; r += C.NGW) { const int src = SEL[r];
        const v4u a = *(const v4u*)(HB + (size_t)src * 1024 + 8 * C.lane), b = *(const v4u*)(HB + (size_t)src * 1024 + 512 + 8 * C.lane);
        *(v4u*)(XG + (size_t)r * 1024 + 8 * C.lane) = a; *(v4u*)(XG + (size_t)r * 1024 + 512 + 8 * C.lane) = b; }
}

__device__ __forceinline__ f32x4 mfma16(bf16x8 a, bf16x8 b, f32x4 c) { return __builtin_amdgcn_mfma_f32_16x16x32_bf16(a, b, c, 0, 0, 0); }
#define PRJ_AT(qn, h_, row_) (PRJ + (((size_t)((qn) * NH + (h_)) * R + (size_t)(row_)) * HD))
#define DH_AT(buf, dir_, h_, row_) ((buf) + (((size_t)((dir_) * NH + (h_)) * NLAT + (size_t)(row_)) * HD))
constexpr int QROW = 272, TROW = 144;
constexpr int SC_QG = 0, SC_KT = 17408, SC_KGT = 34816  , SC_VT = 71680  , SC_SC = 108544, SC_SEG = 117760, SC_PCH = 121856  , SC_PG = 122880;
static_assert(SC_PG + 512 <= 131072, "scan LDS map");

__device__ __forceinline__ void scanA_phase(const Ctx& C, const bf16* PRJ, const float* LB, bf16* OLOC, bf16* QGG, float* SLOC, float* PTOT) {
    LAS unsigned char* L = C.lds;
    LAS float* SEG = (LAS float*)(L + SC_SEG); LAS float* PG = (LAS float*)(L + SC_PG);
    const int lane = C.lane, w = C.wave, g = lane >> 4, lr = lane & 15, k0 = 2 * lane, seg = w;
    for (int ui = C.vcu; ui < NSEQ * NGRP; ui += C.G) {
        int seq, grp; if (ui < NSEQ * 16) { seq = ui >> 4; grp = 1 + (ui & 15); } else { seq = ui - NSEQ * 16; grp = 0; }
        const int b = seq >> 4, h = (seq >> 1) & 7, dir = seq & 1, nch = grp ? 8 : 4, sgn = dir ? -1 : 1;
        const int hc = h * HD;
        f32x4 S[8];
#pragma unroll
        for (int i = 0; i < 8; ++i) S[i] = (f32x4){0.f, 0.f, 0.f, 0.f};
        if (C.tid < 128) PG[C.tid] = 1.0f;
        const int Pb = grp ? (grp - 1) * 512 : 0, rbase = grp ? b * T : NLAT + b * TCX, tlen = grp ? T : TCX;
#define ROWC(c) (rbase + (dir ? tlen - 1 - (Pb + 64 * (c)) : Pb + 64 * (c)))
        unsigned fq[8], qq[8]; v4u vv[2];
        float pl0[8], pl1[8], kk0[8], kk1[8], pg0 = 1.f, pg1 = 1.f, pt0 = 1.f, pt1 = 1.f;
#define SC_LOAD(c) do { const int rn_ = ROWC(c); \
            _Pragma("unroll") for (int i = 0; i < 8; ++i) { const int rw_ = rn_ + sgn * (8 * seg + i); fq[i] = *(const unsigned*)(PRJ_AT(1 + dir, h, rw_) + k0); qq[i] = *(const unsigned*)(PRJ_AT(0, h, rw_) + k0); } \
            _Pragma("unroll") for (int ii = 0; ii < 2; ++ii) { const int cq = C.tid + 512 * ii; vv[ii] = *(const v4u*)(PRJ_AT(3, h, rn_ + sgn * (cq & 63)) + (cq >> 6) * 8); } } while (0)
#define SC_PREP1(c) do { float run0 = 1.f, run1 = 1.f; \
            _Pragma("unroll") for (int i = 0; i < 8; ++i) { kk0[i] = bflo(fq[i]); kk1[i] = bfhi(fq[i]);          \
                run0 *= 1.f - kk0[i]; run1 *= 1.f - kk1[i]; pl0[i] = run0; pl1[i] = run1; } \
            *(LAS f32x2*)(SEG + seg * 128 + k0) = (f32x2){run0, run1}; \
            _Pragma("unroll") for (int ii = 0; ii < 2; ++ii) { const int cq = C.tid + 512 * ii, p_ = cq & 63, v0 = (cq >> 6) * 8; LAS bf16* vt = (LAS bf16*)(L + SC_VT + ((c) & 1) * 18432) + p_; \
                const unsigned wds[4] = {vv[ii].x, vv[ii].y, vv[ii].z, vv[ii].w}; \
                _Pragma("unroll") for (int j = 0; j < 4; ++j) { vt[(v0 + 2 * j) * (TROW / 2)] = (bf16)(wds[j] & 0xffffu); vt[(v0 + 2 * j + 1) * (TROW / 2)] = (bf16)(wds[j] >> 16); } } \
            pg0 = PG[k0]; pg1 = PG[k0 + 1]; } while (0)
#define SC_PREP2(c) do { const int rc_ = ROWC(c); float pb0 = 1.f, pb1 = 1.f; pt0 = 1.f; pt1 = 1.f; \
            _Pragma("unroll") for (int s = 0; s < 8; ++s) { const f32x2 t = *(const LAS f32x2*)(SEG + s * 128 + k0); if (s < seg) { pb0 *= t.x; pb1 *= t.y; } pt0 *= t.x; pt1 *= t.y; } \
            unsigned kg0[4], kg1[4]; float kprev0 = 0.f, kprev1 = 0.f; \
            _Pragma("unroll") for (int i = 0; i < 8; ++i) { const int p_ = 8 * seg + i; \
                const float P0 = pb0 * pl0[i], P1 = pb1 * pl1[i]; \
                const float qg0 = bflo(qq[i]) * P0, qg1 = bfhi(qq[i]) * P1; \
                const float kt0 = kk0[i] * __builtin_amdgcn_rcpf(fmaxf(P0, 1e-30f)), kt1 = kk1[i] * __builtin_amdgcn_rcpf(fmaxf(P1, 1e-30f)); \
                *(LAS unsigned*)(L + SC_QG + p_ * QROW + k0 * 2) = pk2(qg0, qg1); \
                *(LAS unsigned*)(L + SC_KT + p_ * QROW + k0 * 2) = pk2(kt0, kt1); \
                const float a0 = kt0 * pt0, a1 = kt1 * pt1; \
                if (i & 1) { kg0[i >> 1] = pk2(kprev0, a0); kg1[i >> 1] = pk2(kprev1, a1); } else { kprev0 = a0; kprev1 = a1; } \
                if (grp) *(unsigned*)(DH_AT(QGG, dir, h, rc_ + sgn * p_) + k0) = pk2(qg0 * pg0, qg1 * pg1); } \
            *(LAS v4u*)(L + SC_KGT + ((c) & 1) * 18432 + k0 * TROW + seg * 16) = (v4u){kg0[0], kg0[1], kg0[2], kg0[3]}; \
            *(LAS v4u*)(L + SC_KGT + ((c) & 1) * 18432 + (k0 + 1) * TROW + seg * 16) = (v4u){kg1[0], kg1[1], kg1[2], kg1[3]}; \
            if (seg == 0) *(LAS f32x2*)(L + SC_PCH + ((c) & 1) * 512 + k0 * 4) = (f32x2){pt0, pt1}; \
            if ((c) + 1 < nch) SC_LOAD((c) + 1); } while (0)
#define SC_SCORES() do { if (seg == 0) *(LAS f32x2*)(PG + k0) = (f32x2){pg0 * pt0, pg1 * pt1}; \
            const int pi = w >> 1; \
            _Pragma("unroll") for (int tt = 0; tt < 2; ++tt) { const int si = 2 * (w & 1) + tt; f32x4 acc = (f32x4){0.f, 0.f, 0.f, 0.f}; \
                _Pragma("unroll") for (int ks = 0; ks < 4; ++ks) { const bf16x8 a = *(const LAS bf16x8*)(L + SC_QG + (16 * pi + lr) * QROW + (32 * ks + 8 * g) * 2); \
                    const bf16x8 bb = *(const LAS bf16x8*)(L + SC_KT + (16 * si + lr) * QROW + (32 * ks + 8 * g) * 2); acc = mfma16(a, bb, acc); } \
                _Pragma("unroll") for (int r = 0; r < 4; ++r) { const int p_ = 16 * pi + 4 * g + r, s_ = 16 * si + lr; const float val = (s_ <= p_) ? acc[r] : 0.f; \
                    *(LAS bf16*)(L + SC_SC + p_ * TROW + s_ * 2) = (bf16)(pk2(val, 0.f) & 0xffffu); } } } while (0)
#define SC_OUTPUTS(c) do { const int rc_ = ROWC(c); const LAS unsigned char* VTc = L + SC_VT + ((c) & 1) * 18432; f32x4 O[4]; \
            _Pragma("unroll") for (int pt = 0; pt < 4; ++pt) O[pt] = (f32x4){0.f, 0.f, 0.f, 0.f}; \
            _Pragma("unroll") for (int ks = 0; ks < 4; ++ks) { \
                v4u sw; sw.x = pk2(S[2 * ks][0], S[2 * ks][1]); sw.y = pk2(S[2 * ks][2], S[2 * ks][3]); sw.z = pk2(S[2 * ks + 1][0], S[2 * ks + 1][1]); sw.w = pk2(S[2 * ks + 1][2], S[2 * ks + 1][3]); \
                const bf16x8 sb = __builtin_bit_cast(bf16x8, sw); \
                _Pragma("unroll") for (int pt = 0; pt < 4; ++pt) { const LAS unsigned char* qp = L + SC_QG + (16 * pt + lr) * QROW + (32 * ks + 4 * g) * 2; \
                    const v2u lo = *(const LAS v2u*)qp, hi = *(const LAS v2u*)(qp + 32); \
                    const bf16x8 a = __builtin_bit_cast(bf16x8, (v4u){lo.x, lo.y, hi.x, hi.y}); O[pt] = mfma16(sb, a, O[pt]); } } \
            _Pragma("unroll") for (int ks = 0; ks < 2; ++ks) { const bf16x8 bvk = *(const LAS bf16x8*)(VTc + (16 * w + lr) * TROW + (32 * ks + 8 * g) * 2); \
                _Pragma("unroll") for (int pt = 0; pt < 4; ++pt) { const bf16x8 a = *(const LAS bf16x8*)(L + SC_SC + (16 * pt + lr) * TROW + (32 * ks + 8 * g) * 2); O[pt] = mfma16(bvk, a, O[pt]); } } \
            if (grp) { _Pragma("unroll") for (int pt = 0; pt < 4; ++pt) { const int p_ = 16 * pt + lr; \
                *(v2u*)(DH_AT(OLOC, dir, h, rc_ + sgn * p_) + 16 * w + 4 * g) = (v2u){pk2(O[pt][0], O[pt][1]), pk2(O[pt][2], O[pt][3])}; } } } while (0)
#define SC_UPDATE(c) do { const LAS unsigned char* VTc = L + SC_VT + ((c) & 1) * 18432; const LAS unsigned char* KGc = L + SC_KGT + ((c) & 1) * 18432; const LAS float* PCc = (const LAS float*)(L + SC_PCH + ((c) & 1) * 512); \
            bf16x8 bv[2]; \
            _Pragma("unroll") for (int ks = 0; ks < 2; ++ks) bv[ks] = *(const LAS bf16x8*)(VTc + (16 * w + lr) * TROW + (32 * ks + 8 * g) * 2); \
            _Pragma("unroll") for (int kt = 0; kt < 8; ++kt) { const f32x4 pc = *(const LAS f32x4*)(PCc + 16 * kt + 4 * g); S[kt] = S[kt] * pc; \
                _Pragma("unroll") for (int ks = 0; ks < 2; ++ks) { const bf16x8 a = *(const LAS bf16x8*)(KGc + (16 * kt + lr) * TROW + (32 * ks + 8 * g) * 2); S[kt] = mfma16(a, bv[ks], S[kt]); } } } while (0)
        SC_LOAD(0);
        __syncthreads();
        SC_PREP1(0);
        __syncthreads();
        SC_PREP2(0);
        __syncthreads();
        SC_SCORES();
        __syncthreads();
#pragma unroll 1
        for (int c = 0; c < nch; ++c) {
            const bool more = c + 1 < nch;
            if (more) SC_PREP1(c + 1);
            SC_OUTPUTS(c);
            __syncthreads();
            if (more) SC_PREP2(c + 1);
            SC_UPDATE(c);
            __syncthreads();
            if (more) SC_SCORES();
            __syncthreads();
        }
        if (grp < 16) {
#pragma unroll
            for (int kt = 0; kt < 8; ++kt)
#pragma unroll
                for (int r = 0; r < 4; ++r) SLOC[(((size_t)seq * 16 + grp) * 128 + 16 * kt + 4 * g + r) * 128 + 16 * w + lr] = S[kt][r]; }
        if (C.tid < 128) PTOT[((size_t)seq * NGRP + grp) * 128 + C.tid] = PG[C.tid];
        __syncthreads();
#undef ROWC
#undef SC_LOAD
#undef SC_PREP1
#undef SC_PREP2
#undef SC_SCORES
#undef SC_OUTPUTS
#undef SC_UPDATE
    }
}
__device__ __forceinline__ void scanB_phase(const Ctx& C, const float* SLOC, const float* PTOT, bf16* SST) {
    for (int id = C.vcu * (NW * 64) + C.tid; id < NSEQ * 2048; id += C.G * NW * 64) {
        const int seq = id >> 11, k = ((id >> 7) & 15) * 8, v = id & 127;
        float s[8];
#pragma unroll
        for (int i = 0; i < 8; ++i) s[i] = 0.f;
#pragma unroll 4
        for (int gi = 0; gi < 16; ++gi) { const float* pt = PTOT + ((size_t)seq * NGRP + gi) * 128 + k; const float* sl = SLOC + (((size_t)seq * 16 + gi) * 128 + k) * 128 + v;
#pragma unroll
            for (int i = 0; i < 8; ++i) s[i] = pt[i] * s[i] + sl[(size_t)i * 128];
            v4u o; o.x = pk2(s[0], s[1]); o.y = pk2(s[2], s[3]); o.z = pk2(s[4], s[5]); o.w = pk2(s[6], s[7]);
            *(v4u*)(SST + (((size_t)seq * 16 + gi) * 128 + v) * 128 + k) = o; }
    }
}
__device__ __forceinline__ void readout_phase(const Ctx& C, const bf16* PRJ, const bf16* OLOC, const bf16* QGG, const bf16* SST, const float* norm_g, bf16* YH) {
    LAS unsigned char* L = C.lds;
    constexpr int ABUF = 64 * QROW;
    LAS float* OT = (LAS float*)(L + 4 * ABUF);
    const int lane = C.lane, w = C.wave, g = lane >> 4, lr = lane & 15;
    const int p = C.tid >> 3, sg = C.tid & 7;
    f32x4 ng[4];
#pragma unroll
    for (int i = 0; i < 4; ++i) ng[i] = *(const f32x4*)(norm_g + 16 * sg + 4 * i);
    for (int ui = C.vcu; ui < NB * NH * 16; ui += C.G) {
        const int j = ui & 15, h = (ui >> 4) & 7, b = ui >> 7, hc = h * HD, row00 = b * T + 512 * j;
        bf16x8 bfr[2][4];
#pragma unroll
        for (int dir = 0; dir < 2; ++dir) { const int seq = (b * 8 + h) * 2 + dir, gs = dir ? 15 - j : j;
            const bf16* Bb = SST + (((size_t)seq * 16 + gs) * 128 + 16 * w + lr) * 128;
#pragma unroll
            for (int ks = 0; ks < 4; ++ks) bfr[dir][ks] = *(const bf16x8*)(Bb + 32 * ks + 8 * g); }
        v4u ar[2][2];
#define RO_LOADA(tile) do { _Pragma("unroll") for (int dir = 0; dir < 2; ++dir) _Pragma("unroll") for (int ii = 0; ii < 2; ++ii) { const int cq = C.tid + 512 * ii; \
            ar[dir][ii] = *(const v4u*)(DH_AT(QGG, dir, h, row00 + 64 * (tile) + (cq >> 4)) + (cq & 15) * 8); } } while (0)
#define RO_WRITEA(buf) do { _Pragma("unroll") for (int dir = 0; dir < 2; ++dir) _Pragma("unroll") for (int ii = 0; ii < 2; ++ii) { const int cq = C.tid + 512 * ii; \
            *(LAS v4u*)(L + ((buf) * 2 + dir) * ABUF + (cq >> 4) * QROW + (cq & 15) * 16) = ar[dir][ii]; } } while (0)
        RO_LOADA(0); RO_WRITEA(0);
        __syncthreads();
#pragma unroll 1
        for (int t = 0; t < 8; ++t) {
            const int buf = t & 1; const size_t row = (size_t)row00 + 64 * t + p; const int c0 = hc + 16 * sg;
            if (t < 7) RO_LOADA(t + 1);
            v4u eo[2][2]; v4u eg[2];
#pragma unroll
            for (int dir = 0; dir < 2; ++dir) { const bf16* op = DH_AT(OLOC, dir, h, row) + 16 * sg; eo[dir][0] = *(const v4u*)op; eo[dir][1] = *(const v4u*)(op + 8); }
            { const bf16* gp = PRJ_AT(4, h, row) + 16 * sg; eg[0] = *(const v4u*)gp; eg[1] = *(const v4u*)(gp + 8); }
            f32x4 O[4];
#pragma unroll
            for (int pt = 0; pt < 4; ++pt) O[pt] = (f32x4){0.f, 0.f, 0.f, 0.f};
#pragma unroll
            for (int dir = 0; dir < 2; ++dir)
#pragma unroll
                for (int ks = 0; ks < 4; ++ks)
#pragma unroll
                    for (int pt = 0; pt < 4; ++pt) { const bf16x8 a = *(const LAS bf16x8*)(L + (buf * 2 + dir) * ABUF + (16 * pt + lr) * QROW + (32 * ks + 8 * g) * 2); O[pt] = mfma16(a, bfr[dir][ks], O[pt]); }
#pragma unroll
            for (int pt = 0; pt < 4; ++pt)
#pragma unroll
                for (int r = 0; r < 4; ++r) OT[(16 * pt + 4 * g + r) * 132 + 16 * w + lr] = O[pt][r];
            if (t < 7) RO_WRITEA(buf ^ 1);
            __syncthreads();
            f32x4 o[4];
#pragma unroll
            for (int i = 0; i < 4; ++i) o[i] = *(const LAS f32x4*)(OT + p * 132 + 16 * sg + 4 * i);
#pragma unroll
            for (int dir = 0; dir < 2; ++dir) { const v4u a = eo[dir][0], bq = eo[dir][1];
                o[0] += (f32x4){bflo(a.x), bfhi(a.x), bflo(a.y), bfhi(a.y)}; o[1] += (f32x4){bflo(a.z), bfhi(a.z), bflo(a.w), bfhi(a.w)};
                o[2] += (f32x4){bflo(bq.x), bfhi(bq.x), bflo(bq.y), bfhi(bq.y)}; o[3] += (f32x4){bflo(bq.z), bfhi(bq.z), bflo(bq.w), bfhi(bq.w)}; }
            float ss = 0.f;
#pragma unroll
            for (int i = 0; i < 4; ++i) ss += (o[i].x * o[i].x + o[i].y * o[i].y) + (o[i].z * o[i].z + o[i].w * o[i].w);
            ss += __shfl_xor(ss, 1); ss += __shfl_xor(ss, 2); ss += __shfl_xor(ss, 4);
            const float rstd = rsqrtf(ss * (1.0f / 128.0f) + EPS);
            const unsigned gw[8] = {eg[0].x, eg[0].y, eg[0].z, eg[0].w, eg[1].x, eg[1].y, eg[1].z, eg[1].w};
            unsigned ow[8];
#pragma unroll
            for (int i = 0; i < 8; ++i) { const float g0 = bflo(gw[i]), g1 = bfhi(gw[i]);
                const float y0 = o[i >> 1][(2 * i) & 3] * rstd * ng[i >> 1][(2 * i) & 3] * (g0 * fsig(g0));
                const float y1 = o[i >> 1][(2 * i + 1) & 3] * rstd * ng[i >> 1][(2 * i + 1) & 3] * (g1 * fsig(g1));
                ow[i] = pk2(y0, y1); }
            bf16* yp = YH + row * 1024 + c0;
            *(v4u*)yp = (v4u){ow[0], ow[1], ow[2], ow[3]}; *(v4u*)(yp + 8) = (v4u){ow[4], ow[5], ow[6], ow[7]};
            __syncthreads();
        }
#undef RO_LOADA
#undef RO_WRITEA
    }
}

constexpr int NPHASE = 22;
struct Args { const float* in[25]; float* out; unsigned char* ws; int ph_lo, ph_hi; };
constexpr int GRID_C = 256;
constexpr int TAILQ_P2 = 5, TAILQ_P4 = 9, TAILQ_P9 = 6, TAILQ_P11 = 5, TAILQ_P6 = 4, TAILQ_P17 = 3, TAILQ_P3 = 4, TAILQ_P12 = 5;
__device__ __forceinline__ int tail_waves(int nwg, int G) { const int extra = nwg % G; return extra ? (G - extra) * NW : 0; }
#define IDLE_CONVERT(first_, layer_, lo_, q_) do { const int G_ = GRID_C; if ((first_) < G_ && (int)blockIdx.x >= (first_)) { const Ctx Ct = make_ctx(lds_raw, g_wave); CArgs& pt = *opaque_args(); const int nw_ = (G_ - (first_)) * NW; \
        convert_moe(Ct, pt.in[21], pt.in[22], pt.in[23], (layer_), pt.ws, (lo_), min(MOE_ITEMS, (lo_) + (q_) * nw_), ((int)blockIdx.x - (first_)) * NW + Ct.wave, nw_); } } while (0)
__device__ __forceinline__ int idle_waves(int first, int G) { return first < G ? (G - first) * NW : 0; }
#define RANK_CONVERT(rank_, first_, layer_, lo_, q_) do { const int G_ = GRID_C; if ((first_) < G_ && (rank_) >= (first_)) { const Ctx Ct = make_ctx(lds_raw, g_wave); CArgs& pt = *opaque_args(); const int nw_ = (G_ - (first_)) * NW; \
        convert_moe(Ct, pt.in[21], pt.in[22], pt.in[23], (layer_), pt.ws, (lo_), min(MOE_ITEMS, (lo_) + (q_) * nw_), ((rank_) - (first_)) * NW + Ct.wave, nw_); } } while (0)
#define L0_R2 (TAILQ_P2 * tail_waves(NWG_P2, GRID_C))
#define L0_R4 (TAILQ_P4 * tail_waves(NWG_P4, GRID_C))
#define L0_R3 (TAILQ_P3 * tail_waves(1056, GRID_C))
#define L0_A (max(0, MOE_ITEMS - L0_R2 - L0_R3 - L0_R4))
#define L1_R6 (TAILQ_P6 * idle_waves(128, GRID_C))
#define L1_R9 (TAILQ_P9 * tail_waves(NWG_P9, GRID_C))
#define L1_R11 (TAILQ_P11 * tail_waves(NWG_P11, GRID_C))
#define L1_R12 (TAILQ_P12 * tail_waves(NSEQ * NGRP, GRID_C))
#define L1_R17 (TAILQ_P17 * idle_waves(64, GRID_C))
#define L1_B (min(MOE_ITEMS, L1_R6 + L1_R9 + L1_R11 + L1_R12))
#define NWG_P2 ((R / 256) * 8)
#define NWG_P4 ((R / 256) * 4)
#define NWG_P9 ((NE * RPE0 / 256) * 4)
#define NWG_P11 ((R / 256) * 20)
#define TAIL_CONVERT(nwg_, layer_, lo_, q_) do { const int G_ = GRID_C, extra_ = (nwg_) % G_; if (extra_ && (int)blockIdx.x >= extra_) { const Ctx Ct = make_ctx(lds_raw, g_wave); CArgs& pt = *opaque_args(); const int nw_ = (G_ - extra_) * NW; \
        convert_moe(Ct, pt.in[21], pt.in[22], pt.in[23], (layer_), pt.ws, (lo_), min(MOE_ITEMS, (lo_) + (q_) * nw_), ((int)blockIdx.x - extra_) * NW + Ct.wave, nw_); } } while (0)
typedef const __attribute__((address_space(4))) Args CArgs;
__device__ __forceinline__ CArgs* opaque_args() { unsigned long long p = (unsigned long long)__builtin_amdgcn_kernarg_segment_ptr(); asm volatile("" : "+s"(p)); return (CArgs*)p; }
__global__ void __launch_bounds__(NW * 64, 2) mk_fwd(Args args) {
    extern __shared__ __attribute__((aligned(16))) unsigned char lds_raw[];
    const int g_wave = __builtin_amdgcn_readfirstlane((int)threadIdx.x >> 6);
    const Ctx C0 = make_ctx(lds_raw, g_wave);
    unsigned char* const ws = opaque_args()->ws;
#if MK_SPLIT
    const int lo = args.ph_lo, hi = args.ph_hi;
#else
    constexpr int lo = 0, hi = NPHASE;
#endif
    volatile LAS unsigned* MISC = (volatile LAS unsigned*)(C0.lds + MISC_OFF);
    for (int u = C0.tid; u < 128; u += NW * 64) ((LAS unsigned*)(C0.lds + MISC_OFF - 320))[u] = 0u;
    __syncthreads();
    if (hi - lo > 1) (void)xcd_barrier_post((unsigned*)(ws + WS_CTL) + CW_BAR, MISC + 8, g_wave);
#ifndef MK_PHMASK
#define MK_PHMASK 0x3fffff
#endif
#define INR(k) (lo <= (k) && (k) < hi)
#define IN(k) ((((MK_PHMASK) >> (k)) & 1) && INR(k))
#ifndef MK_TIME_A
#define MK_TIME_A -2
#define MK_TIME_B -2
#endif
#define MK_TIME_PHASE (MK_TIME_A > -2 ? 1 : -1)
#define SEAM(k) do { if (INR(k) && INR((k) + 1)) { XcdBarrier b_; b_.bar = (unsigned*)(opaque_args()->ws + WS_CTL) + CW_BAR; b_.x = xb_xcc_id(); b_.st = (volatile LAS unsigned*)((LAS unsigned char*)lds_raw + MISC_OFF) + 8; xcd_barrier(b_, g_wave); } \
    if (MK_TIME_A > -2 && blockIdx.x == 0 && TID_OF(g_wave) == 0) { const unsigned long long t_ = __builtin_amdgcn_s_memrealtime(); \
        if ((k) == MK_TIME_A) ((unsigned long long*)(ws + WS_CTL))[1024] = t_; \
        if ((k) == MK_TIME_B) { const unsigned long long t0_ = ((unsigned long long*)(ws + WS_CTL))[1024]; ((float*)(ws + WS_CTL))[2050] = (float)(t_ - t0_) * 0.00125f; } } } while (0)
#ifndef MK_REP_PHASE
#define MK_REP_PHASE -1
#endif
#define REP(k) for (int _rep = 0; _rep < ((k) == MK_REP_PHASE ? 3 : 1); ++_rep, __syncthreads())

#define P_x ((const float*)pa.in[0])
#define P_ctx_in ((const float*)pa.in[2])
#define P_MV ((float*)(ws + WS_MV))
#define P_LBT ((float*)(ws + WS_LB))
#define P_AFF ((float*)(ws + WS_AFF))
#define P_INV ((short*)(ws + WS_INV))
#define P_SEL ((int*)(ws + WS_SEL))
#define P_GSEL ((float*)(ws + WS_GSEL))
#define P_CTXS ((float*)(ws + WS_CTXS))
#define P_HB ((bf16*)(ws + WS_HB))
#define P_UB ((bf16*)(ws + WS_UB))
#define P_HB8 (ws + WS_UB)
#define P_HBUF8 (ws + WS_HBUF)
#define P_XG ((bf16*)(ws + WS_XG))
#define P_PRJ ((bf16*)(ws + WS_PRJ))
#define P_OLOC ((bf16*)(ws + WS_OLOC))
#define P_QGG ((bf16*)(ws + WS_QGG))
#define P_SLOC ((float*)(ws + WS_UB))
#define P_PTOT ((float*)(ws + WS_PTOT))
#define P_SST ((bf16*)(ws + WS_SST))
#define P_YH ((bf16*)(ws + WS_UB))
#define P_out (pa.out)

    if (MK_TIME_A == -1 && blockIdx.x == 0 && TID_OF(g_wave) == 0) ((unsigned long long*)(ws + WS_CTL))[1024] = __builtin_amdgcn_s_memrealtime();
    if (IN(0)) REP(0) { const Ctx C = make_ctx(lds_raw, g_wave); CArgs& pa = *opaque_args(); unsigned char* const ws = pa.ws;
        mod_gemv(C, pa.in[1], pa.in[3], pa.in[4], pa.in[5], P_MV);
        for (int i = C.vcu * NW * 64 + C.tid; i < 2048; i += C.G * NW * 64) { const float* lg = pa.in[17]; P_LBT[i] = fsig(lg[2048 + i] - lg[i]); }
        __syncthreads();
        convert_small(C, pa.in[8], pa.in[14], pa.in[16], pa.in[19], ws);
        convert_moe(C, pa.in[21], pa.in[22], pa.in[23], 0, ws, 0, L0_A, C.gw, C.NGW);
    }
    SEAM(0);
    if (IN(1)) REP(1) { const Ctx C = make_ctx(lds_raw, g_wave); CArgs& pa = *opaque_args(); unsigned char* const ws = pa.ws; RowArgs A{}; A.src_lat = P_x; A.src_ctx = P_ctx_in; A.gamma = pa.in[6]; A.mv = P_MV; A.i_shift = 0; A.i_scale = 1; A.i_gate = 2; A.HB = P_HB; A.nrows = R;
        row_phase<false, false, false>(C, A); }
    SEAM(1);
    if (IN(2)) REP(2) { const Ctx C = make_ctx(lds_raw, g_wave); CArgs& pa = *opaque_args(); unsigned char* const ws = pa.ws; pg8::Gemm g{P_HB, (const bf16*)(ws + WS_W1T), R, 2048, 1024}; pg8::StaticOrder S; S.init(R, 2048, C.G, (int)blockIdx.x);
        pg8::EpiGated<0> E{P_UB, 1024, pa.in[9], 1024};
        pg8::gemm_phase<pg8::EpiGated<0>, pg8::StaticOrder, true, true>(C.lds, g, S, E, C.wave);
        TAIL_CONVERT(NWG_P2, 0, min(MOE_ITEMS, L0_A + L0_R3), TAILQ_P2); }
    SEAM(2);
    if (IN(3)) REP(3) { const Ctx C = make_ctx(lds_raw, g_wave); CArgs& pa = *opaque_args(); unsigned char* const ws = pa.ws; conv_phase(C, P_UB, P_HB, pa.in[10], pa.in[11], pa.in[12], pa.in[13]); RANK_CONVERT(C.vcu, 1056 % GRID_C, 0, L0_A, TAILQ_P3); }
    SEAM(3);
    if (IN(4)) REP(4) { const Ctx C = make_ctx(lds_raw, g_wave); CArgs& pa = *opaque_args(); unsigned char* const ws = pa.ws; pg8::Gemm g{P_HB, (const bf16*)(ws + WS_W2T), R, 1024, 1024}; pg8::StaticOrder S; S.init(R, 1024, C.G, (int)blockIdx.x);
        pg8::EpiRes E{P_x, P_out, P_ctx_in, P_CTXS, pa.in[15], P_MV + 2 * 1024, 6144};
        pg8::gemm_phase<pg8::EpiRes, pg8::StaticOrder, false, true>(C.lds, g, S, E, C.wave);
        TAIL_CONVERT(NWG_P4, 0, min(MOE_ITEMS, L0_A + L0_R3 + L0_R2), TAILQ_P4); }
    SEAM(4);
    if (IN(5)) REP(5) { const Ctx C = make_ctx(lds_raw, g_wave); CArgs& pa = *opaque_args(); unsigned char* const ws = pa.ws; RowArgs A{}; A.src_lat = P_out; A.src_ctx = P_CTXS; A.gamma = pa.in[7]; A.mv = P_MV; A.i_shift = 3; A.i_scale = 4; A.i_gate = 5; A.HB = P_HB; A.HB8 = P_HB8; A.AFF = P_AFF; A.router_w = pa.in[20]; A.nrows = R;
        row_phase<false, true, false>(C, A); }
    SEAM(5);
    if (IN(6)) REP(6) { const Ctx C = make_ctx(lds_raw, g_wave); CArgs& pa = *opaque_args(); unsigned char* const ws = pa.ws; topk_phase(C, 128, RPE0, P_AFF, P_SEL, P_GSEL, P_INV); IDLE_CONVERT(128, 1, 0, TAILQ_P6); }
    SEAM(6);
    if (IN(8)) REP(8) { const Ctx C = make_ctx(lds_raw, g_wave); CArgs& pa = *opaque_args(); unsigned char* const ws = pa.ws; pg8::Gemm g{(const bf16*)P_HB8, (const bf16*)(ws + WS_W13T), NE * RPE0, 4096, 1024}; pg8::StaticOrder S; S.init(NE * RPE0, 4096, C.G, (int)blockIdx.x, RPE0 / 256);
        pg8::EpiSwiGLU8 E{P_HBUF8, 2048, 1.0f / 32.0f};
        pg8::gemm_phase_f8<pg8::EpiSwiGLU8, pg8::StaticOrder, true, true, true, 1024>(C.lds, g, S, E, C.wave, P_SEL, (LAS unsigned*)(C.lds + GTAB_OFF)); }
    SEAM(8);
    if (IN(9)) REP(9) { const Ctx C = make_ctx(lds_raw, g_wave); CArgs& pa = *opaque_args(); unsigned char* const ws = pa.ws; pg8::Gemm g{(const bf16*)P_HBUF8, (const bf16*)(ws + WS_WDT), NE * RPE0, 1024, 2048}; pg8::StaticOrder S; S.init(NE * RPE0, 1024, C.G, (int)blockIdx.x, RPE0 / 256);
        pg8::EpiScaleRow E{P_XG, 1024, P_GSEL, 1.0f / 32.0f};
        pg8::gemm_phase_f8<pg8::EpiScaleRow, pg8::StaticOrder, true, true, true, 2048>(C.lds, g, S, E, C.wave, nullptr, (LAS unsigned*)(C.lds + GTAB_OFF));
        TAIL_CONVERT(NWG_P9, 1, L1_R6, TAILQ_P9); }
    SEAM(9);
    if (IN(10)) REP(10) { const Ctx C = make_ctx(lds_raw, g_wave); CArgs& pa = *opaque_args(); unsigned char* const ws = pa.ws; RowArgs A{}; A.src_lat = P_out; A.src_ctx = P_CTXS; A.dst_lat = P_out; A.dst_ctx = P_CTXS; A.gamma = pa.in[6] + 1024; A.mv = P_MV; A.i_shift = 0; A.i_scale = 1; A.i_gate = 5; A.HB = P_HB;
        A.Y = P_XG; A.INV = P_INV; A.rpe = RPE0; A.nrows = R;
        A.mv = P_MV + 5 * 6144; A.mvg = P_MV; row_phase<true, false, false>(C, A); }
    SEAM(10);
    if (IN(11)) REP(11) { const Ctx C = make_ctx(lds_raw, g_wave); CArgs& pa = *opaque_args(); unsigned char* const ws = pa.ws; pg8::Gemm g{P_HB, (const bf16*)(ws + WS_WINT), R, 5120, 1024}; pg8::StaticOrder S; S.init(R, 5120, C.G, (int)blockIdx.x);
        pg8::EpiBf16 E{P_PRJ, 5120, P_LBT, R};
        pg8::gemm_phase<pg8::EpiBf16, pg8::StaticOrder, true, true>(C.lds, g, S, E, C.wave);
        TAIL_CONVERT(NWG_P11, 1, L1_R6 + L1_R9, TAILQ_P11); }
    SEAM(11);
    if (IN(12)) REP(12) { const Ctx C = make_ctx(lds_raw, g_wave); CArgs& pa = *opaque_args(); unsigned char* const ws = pa.ws; scanA_phase(C, P_PRJ, P_LBT, P_OLOC, P_QGG, P_SLOC, P_PTOT); RANK_CONVERT(C.vcu, (NSEQ * NGRP) % GRID_C, 1, L1_R6 + L1_R9 + L1_R11, TAILQ_P12); }
    SEAM(12);
    if (IN(13)) REP(13) { const Ctx C = make_ctx(lds_raw, g_wave); CArgs& pa = *opaque_args(); unsigned char* const ws = pa.ws; scanB_phase(C, P_SLOC, P_PTOT, P_SST); }
    SEAM(13);
    if (IN(14)) REP(14) { const Ctx C = make_ctx(lds_raw, g_wave); CArgs& pa = *opaque_args(); unsigned char* const ws = pa.ws; readout_phase(C, P_PRJ, P_OLOC, P_QGG, P_SST, pa.in[18], P_YH); }
    SEAM(14);
    if (IN(15)) REP(15) { const Ctx C = make_ctx(lds_raw, g_wave); CArgs& pa = *opaque_args(); unsigned char* const ws = pa.ws; pg8::Gemm g{P_YH, (const bf16*)(ws + WS_WOUTT), NLAT, 1024, 1024}; pg8::StaticOrder S; S.init(NLAT, 1024, C.G, (int)blockIdx.x);
        pg8::EpiRes E{P_out, P_out, nullptr, nullptr, nullptr, P_MV + 5 * 6144 + 2 * 1024, 6144};
        pg8::gemm_phase<pg8::EpiRes, pg8::StaticOrder, false, true>(C.lds, g, S, E, C.wave); }
    SEAM(15);
    if (IN(16)) REP(16) { const Ctx C = make_ctx(lds_raw, g_wave); CArgs& pa = *opaque_args(); unsigned char* const ws = pa.ws; RowArgs A{}; A.src_lat = P_out; A.gamma = pa.in[7] + 1024; A.mv = P_MV + 5 * 6144; A.i_shift = 3; A.i_scale = 4; A.i_gate = 5; A.HB = P_HB; A.HB8 = P_HB8; A.AFF = P_AFF; A.router_w = pa.in[20] + 16384; A.nrows = NLAT;
        row_phase<false, true, false>(C, A);
        convert_moe(C, pa.in[21], pa.in[22], pa.in[23], 1, ws, L1_B, max(L1_B, MOE_ITEMS - L1_R17), C.gw, C.NGW); }
    SEAM(16);
    if (IN(17)) REP(17) { const Ctx C = make_ctx(lds_raw, g_wave); CArgs& pa = *opaque_args(); unsigned char* const ws = pa.ws; topk_phase(C, 64, RPE1, P_AFF, P_SEL, P_GSEL, P_INV);
        IDLE_CONVERT(64, 1, max(L1_B, MOE_ITEMS - L1_R17), TAILQ_P17); }
    SEAM(17);
    if (IN(19)) REP(19) { const Ctx C = make_ctx(lds_raw, g_wave); CArgs& pa = *opaque_args(); unsigned char* const ws = pa.ws; pg8::Gemm g{(const bf16*)P_HB8, (const bf16*)(ws + WS_W13T_L1), NE * RPE1, 4096, 1024}; pg8::StaticOrder S; S.init(NE * RPE1, 4096, C.G, (int)blockIdx.x, RPE1 / 256);
        pg8::EpiSwiGLU8 E{P_HBUF8, 2048, 1.0f / 32.0f};
        pg8::gemm_phase_f8<pg8::EpiSwiGLU8, pg8::StaticOrder, true, true, true, 1024>(C.lds, g, S, E, C.wave, P_SEL, (LAS unsigned*)(C.lds + GTAB_OFF)); }
    SEAM(19);
    if (IN(20)) REP(20) { const Ctx C = make_ctx(lds_raw, g_wave); CArgs& pa = *opaque_args(); unsigned char* const ws = pa.ws; pg8::Gemm g{(const bf16*)P_HBUF8, (const bf16*)(ws + WS_WDT_L1), NE * RPE1, 1024, 2048}; pg8::StaticOrder S; S.init(NE * RPE1, 1024, C.G, (int)blockIdx.x, RPE1 / 256);
        pg8::EpiScaleRow E{P_XG, 1024, P_GSEL, 1.0f / 32.0f};
        pg8::gemm_phase_f8<pg8::EpiScaleRow, pg8::StaticOrder, true, true, true, 2048>(C.lds, g, S, E, C.wave, nullptr, (LAS unsigned*)(C.lds + GTAB_OFF)); }
    SEAM(20);
    if (IN(21)) REP(21) { const Ctx C = make_ctx(lds_raw, g_wave); CArgs& pa = *opaque_args(); unsigned char* const ws = pa.ws; RowArgs A{}; A.src_lat = P_out; A.dst_lat = P_out; A.gamma = pa.in[24]; A.mv = P_MV + 5 * 6144; A.mvg = P_MV + 5 * 6144; A.i_gate = 5; A.Y = P_XG; A.INV = P_INV; A.rpe = RPE1; A.nrows = NLAT;
        row_phase<true, false, true>(C, A);
        }
    if (MK_TIME_A > -2) { const Ctx C = make_ctx(lds_raw, g_wave); CArgs& pa = *opaque_args(); { XcdBarrier b_; b_.bar = (unsigned*)(pa.ws + WS_CTL) + CW_BAR; b_.x = xb_xcc_id(); b_.st = (volatile LAS unsigned*)((LAS unsigned char*)lds_raw + MISC_OFF) + 8; xcd_barrier(b_, g_wave); }
        if (blockIdx.x == 0 && C.tid == 0) { float add = ((const float*)(ws + WS_CTL))[2050]; if (MK_TIME_B == 21) { const unsigned long long t0_ = ((unsigned long long*)(ws + WS_CTL))[1024]; add = (float)(__builtin_amdgcn_s_memrealtime() - t0_) * (MK_TIME_A == -1 ? 0.0001f : 0.00125f); } pa.out[0] += add; } }
#undef IN
#undef P_x
#undef P_ctx_in
#undef P_MV
#undef P_LBT
#undef P_AFF
#undef P_INV
#undef P_SEL
#undef P_GSEL
#undef P_CTXS
#undef P_HB
#undef P_UB
#undef P_HB8
#undef P_HBUF8
#undef P_XG
#undef P_PRJ
#undef P_OLOC
#undef P_QGG
#undef P_SLOC
#undef P_PTOT
#undef P_SST
#undef P_YH
#undef P_out
#undef REP
#undef INR
#undef SEAM
}

extern "C" void kernel_launch(void* const* d_in, const int* in_sizes, int n_in, void* d_out, int out_size, void* d_ws, size_t ws_size, hipStream_t stream) {
    static int grid = 0;
    if (grid == 0) {
        if (n_in != 25 || in_sizes[0] != NLAT * D || out_size != NLAT * D || ws_size < WS_END) { fprintf(stderr, "kernel_launch: unexpected shapes (n_in %d, in0 %d, out %d, ws %zu)\n", n_in, n_in > 0 ? in_sizes[0] : -1, out_size, ws_size); grid = -1; return; }
        int dev = 0, cus = 0, per_cu = 0;
        if (hipGetDevice(&dev) != hipSuccess || hipDeviceGetAttribute(&cus, hipDeviceAttributeMultiprocessorCount, dev) != hipSuccess) { grid = -1; return; }
        if (hipFuncSetAttribute((const void*)mk_fwd, hipFuncAttributeMaxDynamicSharedMemorySize, LDS_BYTES) != hipSuccess) { fprintf(stderr, "kernel_launch: hipFuncSetAttribute failed\n"); grid = -1; return; }
        if (hipOccupancyMaxActiveBlocksPerMultiprocessor(&per_cu, (const void*)mk_fwd, NW * 64, LDS_BYTES) != hipSuccess || per_cu < 1) { fprintf(stderr, "kernel_launch: occupancy query reports %d blocks per CU\n", per_cu); (void)hipGetLastError(); grid = -1; return; }
        if (cus != GRID_C) { fprintf(stderr, "kernel_launch: built for a %d-CU device, found %d CUs\n", GRID_C, cus); grid = -1; return; }
        grid = cus;
    }
    if (grid < 0) return;
    if (hipMemsetAsync((char*)d_ws + WS_CTL, 0, CTL_ZERO_BYTES, stream) != hipSuccess) { fprintf(stderr, "kernel_launch: memset failed\n"); return; }
    Args a{};
    for (int i = 0; i < 25; ++i) a.in[i] = (const float*)d_in[i];
    a.out = (float*)d_out; a.ws = (unsigned char*)d_ws;
#if MK_SPLIT
    for (int p = 0; p < NPHASE; ++p) { a.ph_lo = p; a.ph_hi = p + 1; hipLaunchKernelGGL(mk_fwd, dim3(grid), dim3(NW * 64), LDS_BYTES, stream, a); }
#else
    a.ph_lo = 0; a.ph_hi = NPHASE;
#ifndef MK_COOP
#define MK_COOP 1
#endif
#if MK_COOP
    void* kargs[] = {&a};
    hipError_t e = hipLaunchCooperativeKernel((const void*)mk_fwd, dim3(grid), dim3(NW * 64), kargs, LDS_BYTES, stream);
    if (e != hipSuccess) fprintf(stderr, "kernel_launch: cooperative launch failed: %s (grid %d)\n", hipGetErrorString(e), grid);
#else
    hipLaunchKernelGGL(mk_fwd, dim3(grid), dim3(NW * 64), LDS_BYTES, stream, a);
#endif
#endif
}
```

```cpp
#include <hip/hip_runtime.h>
#include <hip/hip_cooperative_groups.h>
#include <cstdio>
#include <cstdint>
namespace cg = cooperative_groups;

#ifndef MK_SPLIT
#define MK_SPLIT 0
#endif

__device__ __forceinline__ int lane_id() { int l; asm volatile("v_mbcnt_lo_u32_b32 %0, -1, 0\n\tv_mbcnt_hi_u32_b32 %0, -1, %0" : "=v"(l)); return l; }
#define TID_OF(wv) ((wv) * 64 + lane_id())
namespace pg8 {
#define PG8_LAS __attribute__((address_space(3)))
typedef unsigned short bf16_t;
typedef short bf16x8 __attribute__((ext_vector_type(8)));
typedef float f32x4 __attribute__((ext_vector_type(4)));
typedef unsigned u32x4 __attribute__((ext_vector_type(4)));
constexpr int BM = 256, BK = 64, HALF = 128, HTB = HALF * BK * 2  , STAGE_BYTES = 8 * HTB, NXCD = 8, WGM = 8;

__host__ __device__ __forceinline__ int lds_byte(int r, int c) { const int st = (r >> 4) * 2 + (c >> 5), rr = r & 15, cc = c & 31, ob = rr * 64 + cc * 2; return st * 1024 + (ob ^ (((ob >> 9) & 1) << 5)); }
__host__ __device__ __forceinline__ void stage_rc(int b, int& R, int& C) { const int st = b / 1024, sb = b % 1024, swz = sb ^ (((sb >> 9) & 1) << 5); R = (st >> 1) * 16 + swz / 64; C = (st & 1) * 32 + (swz % 64) / 2; }
__host__ __device__ __forceinline__ int perm32(int rho) { const int n = rho >> 4, i = rho & 15; return 8 * (i >> 2) + 4 * n + (i & 3); }

struct Unit { int pm, pn, pb; };
struct Gemm { const bf16_t* A; const bf16_t* Bt; int M, N, K; };

struct StaticOrder {
    int nM, nN, nwg, G, c, tpe;
    __host__ __device__ void init(int M, int N, int G_, int c_, int tpe_ = 0) { nM = M / BM; nN = N / BM; nwg = nM * nN; G = G_; c = c_; tpe = tpe_; }
    __host__ __device__ bool next(int i, Unit& u) const {
        const long L = (long)i * G + c; if (L >= nwg) return false;
        int wgid = (int)L; { const int q = nwg / NXCD, r = nwg % NXCD, xcd = wgid % NXCD, off = wgid / NXCD; wgid = (xcd < r ? xcd * (q + 1) : r * (q + 1) + (xcd - r) * q) + off; }
        const int nig = WGM * nN, gid = wgid / nig, fm = gid * WGM, gsz = (nM - fm) < WGM ? (nM - fm) : WGM;
        u.pm = fm + ((wgid % nig) % gsz); u.pn = (wgid % nig) / gsz; u.pb = tpe ? (u.pm / tpe) * nN + u.pn : u.pn; return true;
    }
    __device__ __forceinline__ void a_ready(const Unit&) const {}
    __device__ __forceinline__ void done(const Unit&) const {}
};

typedef float f32x32 __attribute__((ext_vector_type(32)));
struct AccQ { f32x32 q[2][2];
    __device__ __forceinline__ f32x4 get(int ai, int bj, int m, int n) const { const int i = (m * 2 + n) * 4; const f32x32& v = q[ai][bj]; return (f32x4){v[i], v[i + 1], v[i + 2], v[i + 3]}; }
    __device__ __forceinline__ void set(int ai, int bj, int m, int n, f32x4 c) { const int i = (m * 2 + n) * 4; f32x32& v = q[ai][bj]; v[i] = c[0]; v[i + 1] = c[1]; v[i + 2] = c[2]; v[i + 3] = c[3]; }
};
__device__ __forceinline__ unsigned cvt_pk_bf16(float lo, float hi) { unsigned r; asm("v_cvt_pk_bf16_f32 %0, %1, %2" : "=v"(r) : "v"(lo), "v"(hi)); return r; }
__device__ __forceinline__ float fsigmoid(float x) { return __builtin_amdgcn_rcpf(1.0f + __expf(-x)); }

struct EpiBf16 {
    static constexpr bool PERM = true, AFTER_DRAIN = false;
    bf16_t* O; int ldc; const float* lb; int hm_rows;
    __device__ __forceinline__ void operator()(const f32x4 (&acc)[2][2][4][2], const Unit& u, int wr, int wc, int fr, int fq) const {
        const int row0 = u.pm * BM + wr * 64 + fr, col0 = u.pn * BM + wc * 32 + 8 * fq;
        const bool gate = lb != nullptr && u.pn >= 4 && u.pn < 12;
        f32x4 om[2][2];
#pragma unroll
        for (int bj = 0; bj < 2; ++bj)
#pragma unroll
            for (int n = 0; n < 2; ++n) om[bj][n] = gate ? (f32x4){1.f, 1.f, 1.f, 1.f} - *(const f32x4*)(lb + (col0 - 1024) + bj * HALF + 4 * n) : (f32x4){0.f, 0.f, 0.f, 0.f};
#pragma unroll
        for (int ai = 0; ai < 2; ++ai)
#pragma unroll
            for (int m = 0; m < 4; ++m) { const int row = row0 + ai * HALF + m * 16;
                bf16_t* rowp = hm_rows ? O + ((size_t)(2 * u.pn) * hm_rows + row) * HALF + wc * 32 + 8 * fq - 0 : O + (size_t)row * ldc + col0;
                const size_t bjstep = hm_rows ? (size_t)hm_rows * HALF : (size_t)HALF;
#pragma unroll
                for (int bj = 0; bj < 2; ++bj) { f32x4 v0 = acc[ai][bj][m][0], v1 = acc[ai][bj][m][1];
                    if (gate) {
#pragma unroll
                        for (int j = 0; j < 4; ++j) { v0[j] = om[bj][0][j] * fsigmoid(-v0[j]); v1[j] = om[bj][1][j] * fsigmoid(-v1[j]); } }
                    u32x4 w; w.x = cvt_pk_bf16(v0[0], v0[1]); w.y = cvt_pk_bf16(v0[2], v0[3]); w.z = cvt_pk_bf16(v1[0], v1[1]); w.w = cvt_pk_bf16(v1[2], v1[3]);
                    *(u32x4*)(rowp + bj * bjstep) = w; } }
    }
};
template <int MODE> struct EpiGated {
    static constexpr bool PERM = true, AFTER_DRAIN = false;
    bf16_t* O; int ldc; const float* bias; int ystride;
    __device__ __forceinline__ void operator()(const f32x4 (&acc)[2][2][4][2], const Unit& u, int wr, int wc, int fr, int fq) const {
        const int row0 = u.pm * BM + wr * 64 + fr, ch0 = u.pn * HALF + wc * 32 + 8 * fq;
        f32x4 bx[2], by[2];
#pragma unroll
        for (int n = 0; n < 2; ++n) { if (MODE == 0) { bx[n] = *(const f32x4*)(bias + ch0 + 4 * n); by[n] = *(const f32x4*)(bias + ystride + ch0 + 4 * n); } else { bx[n] = (f32x4){0.f, 0.f, 0.f, 0.f}; by[n] = bx[n]; } }
#pragma unroll
        for (int ai = 0; ai < 2; ++ai)
#pragma unroll
            for (int m = 0; m < 4; ++m) { bf16_t* rowp = O + (size_t)(row0 + ai * HALF + m * 16) * ldc + ch0;
                float r[8];
#pragma unroll
                for (int n = 0; n < 2; ++n) { const f32x4 x = acc[ai][0][m][n] + bx[n], y = acc[ai][1][m][n] + by[n];
#pragma unroll
                    for (int j = 0; j < 4; ++j) r[4 * n + j] = (MODE == 0) ? x[j] * fsigmoid(y[j]) : x[j] * fsigmoid(x[j]) * y[j]; }
                u32x4 w; w.x = cvt_pk_bf16(r[0], r[1]); w.y = cvt_pk_bf16(r[2], r[3]); w.z = cvt_pk_bf16(r[4], r[5]); w.w = cvt_pk_bf16(r[6], r[7]);
                *(u32x4*)rowp = w; }
    }
};
struct EpiDelta {
    static constexpr bool PERM = true, AFTER_DRAIN = false;
    bf16_t* O; int ldc; const float* bias; const float* gate; int gstride;
    __device__ __forceinline__ void operator()(const f32x4 (&acc)[2][2][4][2], const Unit& u, int wr, int wc, int fr, int fq) const {
        const int grp = u.pm >= 128 ? 4 : (u.pm >> 5);
        const int row0 = u.pm * BM + wr * 64 + fr, col0 = u.pn * BM + wc * 32 + 8 * fq;
        const float* gp = gate + (size_t)grp * gstride + col0;
        f32x4 gv[2][2], bv[2][2];
#pragma unroll
        for (int bj = 0; bj < 2; ++bj)
#pragma unroll
            for (int n = 0; n < 2; ++n) { gv[bj][n] = *(const f32x4*)(gp + bj * HALF + 4 * n); bv[bj][n] = bias ? *(const f32x4*)(bias + col0 + bj * HALF + 4 * n) : (f32x4){0.f, 0.f, 0.f, 0.f}; }
#pragma unroll
        for (int ai = 0; ai < 2; ++ai)
#pragma unroll
            for (int m = 0; m < 4; ++m) { bf16_t* rowp = O + (size_t)(row0 + ai * HALF + m * 16) * ldc + col0;
#pragma unroll
                for (int bj = 0; bj < 2; ++bj) { const f32x4 v0 = gv[bj][0] * (acc[ai][bj][m][0] + bv[bj][0]), v1 = gv[bj][1] * (acc[ai][bj][m][1] + bv[bj][1]);
                    u32x4 w; w.x = cvt_pk_bf16(v0[0], v0[1]); w.y = cvt_pk_bf16(v0[2], v0[3]); w.z = cvt_pk_bf16(v1[0], v1[1]); w.w = cvt_pk_bf16(v1[2], v1[3]);
                    *(u32x4*)(rowp + bj * HALF) = w; } }
    }
};
struct EpiRes {
    static constexpr bool PERM = false, AFTER_DRAIN = false;
    const float* res0; float* out0; const float* res1; float* out1; const float* bias; const float* gate; int gstride;
    __device__ __forceinline__ void operator()(const f32x4 (&acc)[2][2][4][2], const Unit& u, int wr, int wc, int fr, int fq) const {
        const bool second = u.pm >= 128; const int grp = second ? 4 : (u.pm >> 5);
        const float* res = second ? res1 : res0; float* out = second ? out1 : out0;
        const int row0 = (second ? u.pm - 128 : u.pm) * BM + wr * 64 + fr, col0 = u.pn * BM + wc * 32 + 4 * fq;
        const float* gp = gate + (size_t)grp * gstride + col0;
        const unsigned off0 = ((unsigned)row0 * 1024u + (unsigned)col0) * 4u;
#pragma unroll
        for (int bj = 0; bj < 2; ++bj) {
            f32x4 gv[2], bv[2], rv[2][2][4];
#pragma unroll
            for (int n = 0; n < 2; ++n) { gv[n] = *(const f32x4*)(gp + bj * HALF + n * 16); bv[n] = bias ? *(const f32x4*)(bias + col0 + bj * HALF + n * 16) : (f32x4){0.f, 0.f, 0.f, 0.f}; }
#pragma unroll
            for (int n = 0; n < 2; ++n)
#pragma unroll
                for (int ai = 0; ai < 2; ++ai)
#pragma unroll
                    for (int m = 0; m < 4; ++m) rv[n][ai][m] = *(const f32x4*)((const char*)res + (off0 + (unsigned)(((ai * HALF + m * 16) * 1024 + bj * HALF + n * 16) * 4)));
#pragma unroll
            for (int n = 0; n < 2; ++n)
#pragma unroll
                for (int ai = 0; ai < 2; ++ai)
#pragma unroll
                    for (int m = 0; m < 4; ++m) *(f32x4*)((char*)out + (off0 + (unsigned)(((ai * HALF + m * 16) * 1024 + bj * HALF + n * 16) * 4))) = rv[n][ai][m] + gv[n] * (acc[ai][bj][m][n] + bv[n]);
            asm volatile("" ::: "memory"); }
    }
};
struct EpiScaleRow {
    static constexpr bool PERM = true, AFTER_DRAIN = false;
    bf16_t* O; int ldc; const float* rs; float mul;
    __device__ __forceinline__ void operator()(const AccQ& acc, const Unit& u, int wr, int wc, int fr, int fq) const {
        const int row0 = u.pm * BM + wr * 64 + fr, col0 = u.pn * BM + wc * 32 + 8 * fq;
#pragma unroll
        for (int ai = 0; ai < 2; ++ai)
#pragma unroll
            for (int m = 0; m < 4; ++m) { const int row = row0 + ai * HALF + m * 16; const float s = rs[row] * mul; bf16_t* rowp = O + (size_t)row * ldc + col0;
#pragma unroll
                for (int bj = 0; bj < 2; ++bj) { const f32x4 v0 = acc.get(ai, bj, m, 0) * s, v1 = acc.get(ai, bj, m, 1) * s;
                    u32x4 w; w.x = cvt_pk_bf16(v0[0], v0[1]); w.y = cvt_pk_bf16(v0[2], v0[3]); w.z = cvt_pk_bf16(v1[0], v1[1]); w.w = cvt_pk_bf16(v1[2], v1[3]);
                    *(u32x4*)(rowp + bj * HALF) = w; }
                asm volatile("" ::: "memory"); }
    }
};

typedef unsigned u32x2 __attribute__((ext_vector_type(2)));
__device__ __forceinline__ unsigned pk4_fp8(float a, float b, float c, float d) { unsigned lo, hi; asm("v_cvt_pk_fp8_f32 %0, %1, %2" : "=v"(lo) : "v"(a), "v"(b)); asm("v_cvt_pk_fp8_f32 %0, %1, %2" : "=v"(hi) : "v"(c), "v"(d)); return (lo & 0xffffu) | (hi << 16); }
struct EpiSwiGLU8 {
    static constexpr bool PERM = true, AFTER_DRAIN = false;
    unsigned char* O; int ldc; float s;
    __device__ __forceinline__ void operator()(const AccQ& acc, const Unit& u, int wr, int wc, int fr, int fq) const {
        const int row0 = u.pm * BM + wr * 64 + fr, ch0 = u.pn * HALF + wc * 32 + 8 * fq;
#pragma unroll
        for (int ai = 0; ai < 2; ++ai)
#pragma unroll
            for (int m = 0; m < 4; ++m) { unsigned char* rowp = O + (size_t)(row0 + ai * HALF + m * 16) * ldc + ch0;
                float r[8];
#pragma unroll
                for (int n = 0; n < 2; ++n) { const f32x4 x = acc.get(ai, 0, m, n) * s, y = acc.get(ai, 1, m, n) * s;
#pragma unroll
                    for (int j = 0; j < 4; ++j) r[4 * n + j] = x[j] * fsigmoid(x[j]) * y[j]; }
                u32x2 w; w.x = pk4_fp8(r[0], r[1], r[2], r[3]); w.y = pk4_fp8(r[4], r[5], r[6], r[7]);
                *(u32x2*)rowp = w; }
    }
};


template <class Epi, class Sched, bool ALIGN_EPI = false, bool SP2 = false, bool GATHER = false>
__device__ __forceinline__ void gemm_phase(PG8_LAS unsigned char* lds, const Gemm g, const Sched& S, const Epi& E, const int wv, const int* gsel = nullptr, PG8_LAS unsigned* gtab = nullptr) {
    const int tid = TID_OF(wv), wid = wv, lane = tid & 63, wr = wid >> 2, wc = wid & 3, fr = lane & 15, fq = lane >> 4;
    const int K = g.K, nt = K / BK;
    unsigned voffA[2], voffB[2]; int gR[2]; unsigned gC2[2];
#pragma unroll
    for (int i = 0; i < 2; ++i) { int R, C; stage_rc(tid * 16 + i * 8192, R, C); const int Rb = Epi::PERM ? ((R & ~31) + perm32(R & 31)) : R;
        voffA[i] = (unsigned)(R * K + C) * 2u; voffB[i] = (unsigned)(Rb * K + C) * 2u; gR[i] = R; gC2[i] = (unsigned)C * 2u; }
    unsigned cur0[2] = {0u, 0u}, cur1[2] = {0u, 0u}, nx0[2] = {0u, 0u}, nx1[2] = {0u, 0u};
    if constexpr (GATHER) { Unit uu; for (int i = 0; S.next(i, uu); ++i) if (tid < 256) gtab[i * 256 + tid] = (unsigned)gsel[uu.pm * 256 + tid] * (unsigned)(K * 2);
        __syncthreads(); }
#define PG8_GOFFS(ui_, o0, o1) do { _Pragma("unroll") for (int i = 0; i < 2; ++i) { o0[i] = gtab[(ui_) * 256 + gR[i]] + gC2[i]; o1[i] = gtab[(ui_) * 256 + 128 + gR[i]] + gC2[i]; } } while (0)
#define PG8_STAGE_A(bufoff, ptr_plain, ptr_gather, goffs) do { if constexpr (GATHER) { PG8_STAGE(bufoff, ptr_gather, goffs); } else { PG8_STAGE(bufoff, ptr_plain, voffA); } } while (0)
    const size_t kstep = (size_t)(BK * 2);
    const size_t hstep = (size_t)HALF * K * 2;
    const size_t tstep = 2 * hstep;
    const unsigned ldsw = (unsigned)wid * 1024u;
    const int aoff = lds_byte(wr * 64 + fr, fq * 8), boff = lds_byte(wc * 32 + fr, fq * 8);
#define PG8_SA(b, h) (((b) * 2 + (h)) * HTB)
#define PG8_SB(b, h) ((4 + (b) * 2 + (h)) * HTB)
#define PG8_STAGE(bufoff, gbase, voff) do { _Pragma("unroll") for (int _i = 0; _i < 2; ++_i) \
        __builtin_amdgcn_global_load_lds((const unsigned*)((const char*)(gbase) + (voff)[_i]), (PG8_LAS unsigned*)(lds + (bufoff) + ldsw + _i * 8192), 16, 0, 0); } while (0)
#define PG8_LDA(dst, b, h) do { _Pragma("unroll") for (int m = 0; m < 4; ++m) _Pragma("unroll") for (int k = 0; k < 2; ++k) dst[m][k] = *(const PG8_LAS bf16x8*)(lds + PG8_SA(b, h) + aoff + m * 2048 + k * 1024); } while (0)
#define PG8_LDB(dst, b, h) do { _Pragma("unroll") for (int n = 0; n < 2; ++n) _Pragma("unroll") for (int k = 0; k < 2; ++k) dst[n][k] = *(const PG8_LAS bf16x8*)(lds + PG8_SB(b, h) + boff + n * 2048 + k * 1024); } while (0)
#define PG8_MMA(ai, bj, At, Bt) do { __builtin_amdgcn_s_setprio(1); _Pragma("unroll") for (int m = 0; m < 4; ++m) _Pragma("unroll") for (int n = 0; n < 2; ++n) _Pragma("unroll") for (int k = 0; k < 2; ++k) \
        acc[ai][bj][m][n] = __builtin_amdgcn_mfma_f32_16x16x32_bf16(Bt[n][k], At[m][k], acc[ai][bj][m][n], 0, 0, 0); __builtin_amdgcn_s_setprio(0); } while (0)
#define PG8_WAIT_V(n) asm volatile("s_waitcnt vmcnt(" #n ")" ::: "memory")
#define PG8_WAIT_L(n) asm volatile("s_waitcnt lgkmcnt(" #n ")" ::: "memory")
#define PG8_BAR __builtin_amdgcn_s_barrier()
#define PG8_SCHED __builtin_amdgcn_sched_barrier(0)
    Unit cur, nxt; int ui = 0;
    if (!S.next(0, cur)) return;
    f32x4 acc[2][2][4][2];
#pragma unroll
    for (int a = 0; a < 2; ++a)
#pragma unroll
        for (int b = 0; b < 2; ++b)
#pragma unroll
            for (int m = 0; m < 4; ++m)
#pragma unroll
                for (int n = 0; n < 2; ++n) acc[a][b][m][n] = (f32x4){0.f, 0.f, 0.f, 0.f};
    bf16x8 At[4][2], B0[2][2], B1[2][2];
    const char* cA = (const char*)g.A + (size_t)cur.pm * tstep; const char* cB = (const char*)g.Bt + (size_t)cur.pb * tstep;
    const char* const gA = (const char*)g.A;
    if constexpr (GATHER) PG8_GOFFS(0, cur0, cur1);
    S.a_ready(cur);
    if constexpr (SP2) {
        PG8_STAGE(PG8_SB(0, 0), cB, voffB); PG8_STAGE(PG8_SB(0, 1), cB + hstep, voffB); PG8_STAGE_A(PG8_SA(0, 0), cA, gA, cur0); PG8_STAGE_A(PG8_SA(0, 1), cA + hstep, gA, cur1);
        if (wr == 1) PG8_BAR;
        PG8_WAIT_V(2); PG8_BAR;
        PG8_STAGE(PG8_SB(1, 0), cB + kstep, voffB); PG8_STAGE_A(PG8_SA(1, 0), cA + kstep, gA + kstep, cur0); PG8_STAGE(PG8_SB(1, 1), cB + hstep + kstep, voffB);
        PG8_WAIT_V(6); PG8_BAR;
    } else {
        PG8_STAGE(PG8_SB(0, 0), cB, voffB); PG8_STAGE_A(PG8_SA(0, 0), cA, gA, cur0); PG8_STAGE(PG8_SB(0, 1), cB + hstep, voffB); PG8_STAGE_A(PG8_SA(0, 1), cA + hstep, gA, cur1);
        if (wr == 1) PG8_BAR;
        PG8_WAIT_V(4); PG8_BAR;
        PG8_STAGE(PG8_SB(1, 0), cB + kstep, voffB); PG8_STAGE_A(PG8_SA(1, 0), cA + kstep, gA + kstep, cur0); PG8_STAGE(PG8_SB(1, 1), cB + hstep + kstep, voffB);
        PG8_WAIT_V(6); PG8_BAR;
    }
    for (;;) {
        const bool has_next = S.next(ui + 1, nxt);
        if constexpr (GATHER) { if (has_next) PG8_GOFFS(ui + 1, nx0, nx1); else { _Pragma("unroll") for (int i = 0; i < 2; ++i) { nx0[i] = cur0[i]; nx1[i] = cur1[i]; } } }
        const char* nA = has_next ? (const char*)g.A + (size_t)nxt.pm * tstep : cA; const char* nB = has_next ? (const char*)g.Bt + (size_t)nxt.pb * tstep : cB;
#pragma unroll 1
        for (int t = 0; t < nt; t += 2) {
            const bool last = (t == nt - 2);
            const char* a1 = cA + (size_t)(t + 1) * kstep;
            const char* a2 = last ? nA : cA + (size_t)(t + 2) * kstep; const char* b2 = last ? nB : cB + (size_t)(t + 2) * kstep;
            const char* a3 = a2 + kstep; const char* b3 = b2 + kstep;
            const char* ga1 = gA + (size_t)(t + 1) * kstep; const char* ga2 = last ? gA : gA + (size_t)(t + 2) * kstep; const char* ga3 = ga2 + kstep;
            unsigned o2h0[2], o2h1[2];
#pragma unroll
            for (int i = 0; i < 2; ++i) { o2h0[i] = last ? nx0[i] : cur0[i]; o2h1[i] = last ? nx1[i] : cur1[i]; }
            if (last && has_next) S.a_ready(nxt);
            if constexpr (SP2) {
            PG8_LDB(B0, 0, 0); PG8_LDB(B1, 0, 1); PG8_SCHED; PG8_LDA(At, 0, 0); PG8_STAGE_A(PG8_SA(1, 1), a1 + hstep, ga1, cur1);
            PG8_WAIT_V(8); PG8_WAIT_L(0); PG8_BAR; PG8_MMA(0, 0, At, B0); PG8_MMA(0, 1, At, B1); PG8_BAR; PG8_SCHED;
            PG8_LDA(At, 0, 1); PG8_STAGE(PG8_SB(0, 0), b2, voffB); PG8_STAGE(PG8_SB(0, 1), b2 + hstep, voffB); PG8_STAGE_A(PG8_SA(0, 0), a2, ga2, o2h0);
            PG8_WAIT_V(8); PG8_WAIT_L(0); PG8_BAR; PG8_MMA(1, 0, At, B0); PG8_MMA(1, 1, At, B1); PG8_BAR; PG8_SCHED;
            PG8_LDB(B0, 1, 0); PG8_LDB(B1, 1, 1); PG8_SCHED; PG8_LDA(At, 1, 0); PG8_STAGE_A(PG8_SA(0, 1), a2 + hstep, ga2, o2h1);
            PG8_WAIT_V(8); PG8_WAIT_L(0); PG8_BAR; PG8_MMA(0, 0, At, B0); PG8_MMA(0, 1, At, B1); PG8_BAR; PG8_SCHED;
            PG8_LDA(At, 1, 1); PG8_STAGE(PG8_SB(1, 0), b3, voffB); PG8_STAGE(PG8_SB(1, 1), b3 + hstep, voffB); PG8_STAGE_A(PG8_SA(1, 0), a3, ga3, o2h0);
            PG8_WAIT_V(8); PG8_WAIT_L(0); PG8_BAR; PG8_MMA(1, 0, At, B0); PG8_MMA(1, 1, At, B1); PG8_BAR; PG8_SCHED;
            } else {
            PG8_LDB(B0, 0, 0); PG8_SCHED; PG8_LDA(At, 0, 0); PG8_STAGE_A(PG8_SA(1, 1), a1 + hstep, ga1, cur1);
            PG8_WAIT_L(8); PG8_BAR; PG8_WAIT_L(0); PG8_MMA(0, 0, At, B0); PG8_BAR; PG8_SCHED;
            PG8_LDB(B1, 0, 1); PG8_STAGE(PG8_SB(0, 0), b2, voffB);
            PG8_BAR; PG8_WAIT_L(0); PG8_MMA(0, 1, At, B1); PG8_BAR;
            PG8_LDA(At, 0, 1); PG8_STAGE_A(PG8_SA(0, 0), a2, ga2, o2h0);
            PG8_BAR; PG8_WAIT_L(0); PG8_MMA(1, 0, At, B0); PG8_BAR; PG8_SCHED;
            PG8_STAGE(PG8_SB(0, 1), b2 + hstep, voffB);
            PG8_WAIT_V(6); PG8_BAR; PG8_MMA(1, 1, At, B1); PG8_BAR;
            PG8_LDB(B0, 1, 0); PG8_SCHED; PG8_LDA(At, 1, 0); PG8_STAGE_A(PG8_SA(0, 1), a2 + hstep, ga2, o2h1);
            PG8_WAIT_L(8); PG8_BAR; PG8_WAIT_L(0); PG8_MMA(0, 0, At, B0); PG8_BAR; PG8_SCHED;
            PG8_LDB(B1, 1, 1); PG8_STAGE(PG8_SB(1, 0), b3, voffB);
            PG8_BAR; PG8_WAIT_L(0); PG8_MMA(0, 1, At, B1); PG8_BAR;
            PG8_LDA(At, 1, 1); PG8_STAGE_A(PG8_SA(1, 0), a3, ga3, o2h0);
            PG8_BAR; PG8_WAIT_L(0); PG8_MMA(1, 0, At, B0); PG8_BAR; PG8_SCHED;
            PG8_STAGE(PG8_SB(1, 1), b3 + hstep, voffB);
            PG8_WAIT_V(6); PG8_BAR; PG8_MMA(1, 1, At, B1); PG8_BAR;
            }
        }
        if constexpr (ALIGN_EPI) { if (wr == 0) PG8_BAR; }
        if constexpr (!Epi::AFTER_DRAIN) { int tq = tid; asm volatile("" : "+v"(tq)); const int lq = tq & 63; E(acc, cur, wr, wc, lq & 15, lq >> 4); S.done(cur); }
        if (!has_next) break;
#pragma unroll
        for (int a = 0; a < 2; ++a)
#pragma unroll
            for (int b = 0; b < 2; ++b)
#pragma unroll
                for (int m = 0; m < 4; ++m)
#pragma unroll
                    for (int n = 0; n < 2; ++n) acc[a][b][m][n] = (f32x4){0.f, 0.f, 0.f, 0.f};
        cur = nxt; cA = nA; cB = nB; ++ui;
#pragma unroll
        for (int i = 0; i < 2; ++i) { cur0[i] = nx0[i]; cur1[i] = nx1[i]; }
        if constexpr (ALIGN_EPI) { if (wr == 1) PG8_BAR; }
    }
    PG8_WAIT_V(0);
    if constexpr (!ALIGN_EPI) { if (wr == 0) PG8_BAR; }
    PG8_BAR;
    if constexpr (Epi::AFTER_DRAIN) { E.fused(acc, cur, wr, wc, fr, fq, lds, wid, lane); S.done(cur); }
#undef PG8_SA
#undef PG8_SB
#undef PG8_STAGE
#undef PG8_STAGE_A
#undef PG8_GOFFS
#undef PG8_LDA
#undef PG8_LDB
#undef PG8_MMA
#undef PG8_WAIT_V
#undef PG8_WAIT_L
#undef PG8_BAR
#undef PG8_SCHED
}
typedef int v4i_t __attribute__((ext_vector_type(4)));
typedef int v8i_t __attribute__((ext_vector_type(8)));
typedef short s16x16_ld __attribute__((ext_vector_type(16), aligned(16)));
typedef v8i_t v8i_ld __attribute__((aligned(16)));
template <class Epi, class Sched, bool ALIGN_EPI = false, bool SP2 = false, bool GATHER = false, int KC = 0>
__device__ __forceinline__ void gemm_phase_f8(PG8_LAS unsigned char* lds, const Gemm g, const Sched& S, const Epi& E, const int wv, const int* gsel = nullptr, PG8_LAS unsigned* gtab = nullptr) {
    const int tid = TID_OF(wv), wid = wv, lane = tid & 63, wr = wid >> 2, wc = wid & 3, fr = lane & 15, fq = lane >> 4;
    const int K = KC ? KC : g.K, nt = K / 128;
    unsigned voffA[2], voffB[2]; int gR[2]; unsigned gC2[2];
#pragma unroll
    for (int i = 0; i < 2; ++i) { int R, C; stage_rc(tid * 16 + i * 8192, R, C); const int Rb = Epi::PERM ? ((R & ~31) + perm32(R & 31)) : R;
        voffA[i] = (unsigned)(R * K) + (unsigned)C * 2u; voffB[i] = (unsigned)(Rb * K) + (unsigned)C * 2u; gR[i] = R; gC2[i] = (unsigned)C * 2u; }
    unsigned cur0[2] = {0u, 0u}, cur1[2] = {0u, 0u}, nx0[2] = {0u, 0u}, nx1[2] = {0u, 0u};
    if constexpr (GATHER) { Unit uu; for (int i = 0; S.next(i, uu); ++i) if (tid < 256) ((PG8_LAS float*)gtab)[i * 256 + tid] = __uint_as_float((unsigned)(gsel ? gsel[uu.pm * 256 + tid] : uu.pm * 256 + tid) * (unsigned)K);
        __syncthreads(); }
#define PG8_GOFFS(ui_, o0, o1) do { _Pragma("unroll") for (int i = 0; i < 2; ++i) { o0[i] = __float_as_uint(((const PG8_LAS float*)gtab)[(ui_) * 256 + gR[i]]) + gC2[i]; o1[i] = __float_as_uint(((const PG8_LAS float*)gtab)[(ui_) * 256 + 128 + gR[i]]) + gC2[i]; } } while (0)
#define PG8_STAGE_A(bufoff, ptr_plain, ptr_gather, goffs) do { if constexpr (GATHER) { PG8_STAGE(bufoff, ptr_gather, goffs); } else { PG8_STAGE(bufoff, ptr_plain, voffA); } } while (0)
#define PG8_STAGE_AG(bufoff, ptr_plain, ptr_gather, u_, h_) do { if constexpr (GATHER) { unsigned go_[2]; _Pragma("unroll") for (int i = 0; i < 2; ++i) go_[i] = __float_as_uint(((const PG8_LAS float*)gtab)[(u_) * 256 + (h_) * 128 + lR[i]]) + lC2[i]; PG8_STAGE(bufoff, ptr_gather, go_); } else { PG8_STAGE(bufoff, ptr_plain, lvA); } } while (0)
    const size_t kstep = (size_t)(BK * 2);
    const size_t hstep = (size_t)HALF * K;
    const size_t tstep = 2 * hstep;
    const unsigned ldsw = (unsigned)wid * 1024u;
    const int aoff = lds_byte(wr * 64 + fr, fq * 16), boff = lds_byte(wc * 32 + fr, fq * 16);
#define PG8_SA(b, h) (((b) * 2 + (h)) * HTB)
#define PG8_SB(b, h) ((4 + (b) * 2 + (h)) * HTB)
#define PG8_STAGE(bufoff, gbase, voff) do { _Pragma("unroll") for (int _i = 0; _i < 2; ++_i) \
        __builtin_amdgcn_global_load_lds((const unsigned*)((const char*)(gbase) + (voff)[_i]), (PG8_LAS unsigned*)(lds + (bufoff) + ldsw + _i * 8192), 16, 0, 0); } while (0)
#define PG8_LDA(dst, b, h) do { _Pragma("unroll") for (int m = 0; m < 4; ++m) { const bf16x8 lo_ = *(const PG8_LAS bf16x8*)(lds + PG8_SA(b, h) + aoffv + m * 2048), hi_ = *(const PG8_LAS bf16x8*)(lds + PG8_SA(b, h) + aoffv + m * 2048 + 16); dst[m] = __builtin_bit_cast(v8i_t, __builtin_shufflevector(lo_, hi_, 0, 1, 2, 3, 4, 5, 6, 7, 8, 9, 10, 11, 12, 13, 14, 15)); } } while (0)
#define PG8_LDB(dst, b, h) do { _Pragma("unroll") for (int n = 0; n < 2; ++n) { const bf16x8 lo_ = *(const PG8_LAS bf16x8*)(lds + PG8_SB(b, h) + boffv + n * 2048), hi_ = *(const PG8_LAS bf16x8*)(lds + PG8_SB(b, h) + boffv + n * 2048 + 16); dst[n] = __builtin_bit_cast(v8i_t, __builtin_shufflevector(lo_, hi_, 0, 1, 2, 3, 4, 5, 6, 7, 8, 9, 10, 11, 12, 13, 14, 15)); } } while (0)
#define aoffv laoff
#define boffv lboff
#define PG8_MMA(ai, bj, At, Bt) do { __builtin_amdgcn_s_setprio(1); _Pragma("unroll") for (int m = 0; m < 4; ++m) _Pragma("unroll") for (int n = 0; n < 2; ++n) \
        acc.set(ai, bj, m, n, __builtin_amdgcn_mfma_scale_f32_16x16x128_f8f6f4(Bt[n], At[m], acc.get(ai, bj, m, n), 0, 0, 0, 0x7f7f7f7f, 0, 0x7f7f7f7f)); __builtin_amdgcn_s_setprio(0); } while (0)
#define PG8_WAIT_V(n) asm volatile("s_waitcnt vmcnt(" #n ")" ::: "memory")
#define PG8_WAIT_L(n) asm volatile("s_waitcnt lgkmcnt(" #n ")" ::: "memory")
#define PG8_BAR __builtin_amdgcn_s_barrier()
#define PG8_SCHED __builtin_amdgcn_sched_barrier(0)
    Unit cur, nxt; int ui = 0;
    if (!S.next(0, cur)) return;
    AccQ acc;
#pragma unroll
    for (int a = 0; a < 2; ++a)
#pragma unroll
        for (int b = 0; b < 2; ++b)
#pragma unroll
            for (int e = 0; e < 32; ++e) acc.q[a][b][e] = 0.f;
    v8i_t At[4], B0[2], B1[2];
    const char* cA = (const char*)g.A + (size_t)cur.pm * tstep; const char* cB = (const char*)g.Bt + (size_t)cur.pb * tstep;
    const char* const gA = (const char*)g.A;
    if constexpr (GATHER) PG8_GOFFS(0, cur0, cur1);
    S.a_ready(cur);
    if constexpr (SP2) {
        PG8_STAGE(PG8_SB(0, 0), cB, voffB); PG8_STAGE(PG8_SB(0, 1), cB + hstep, voffB); PG8_STAGE_A(PG8_SA(0, 0), cA, gA, cur0); PG8_STAGE_A(PG8_SA(0, 1), cA + hstep, gA, cur1);
        if (wr == 1) PG8_BAR;
        PG8_WAIT_V(2); PG8_BAR;
        PG8_STAGE(PG8_SB(1, 0), cB + kstep, voffB); PG8_STAGE_A(PG8_SA(1, 0), cA + kstep, gA + kstep, cur0); PG8_STAGE(PG8_SB(1, 1), cB + hstep + kstep, voffB);
        PG8_WAIT_V(6); PG8_BAR;
    } else {
        PG8_STAGE(PG8_SB(0, 0), cB, voffB); PG8_STAGE_A(PG8_SA(0, 0), cA, gA, cur0); PG8_STAGE(PG8_SB(0, 1), cB + hstep, voffB); PG8_STAGE_A(PG8_SA(0, 1), cA + hstep, gA, cur1);
        if (wr == 1) PG8_BAR;
        PG8_WAIT_V(4); PG8_BAR;
        PG8_STAGE(PG8_SB(1, 0), cB + kstep, voffB); PG8_STAGE_A(PG8_SA(1, 0), cA + kstep, gA + kstep, cur0); PG8_STAGE(PG8_SB(1, 1), cB + hstep + kstep, voffB);
        PG8_WAIT_V(6); PG8_BAR;
    }
    for (;;) {
        const bool has_next = S.next(ui + 1, nxt);
        const char* nA = has_next ? (const char*)g.A + (size_t)nxt.pm * tstep : cA; const char* nB = has_next ? (const char*)g.Bt + (size_t)nxt.pb * tstep : cB;
#pragma unroll 1
        for (int t = 0; t < nt; t += 2) {
            const bool last = (t == nt - 2);
            unsigned lvA[2], lvB[2], lC2[2]; int lR[2];
            { int tq = tid; asm volatile("" : "+v"(tq));
#pragma unroll
              for (int i = 0; i < 2; ++i) { int R, C; stage_rc(tq * 16 + i * 8192, R, C); const int Rb = Epi::PERM ? ((R & ~31) + perm32(R & 31)) : R;
                  lvA[i] = (unsigned)(R * K) + (unsigned)C * 2u; lvB[i] = (unsigned)(Rb * K) + (unsigned)C * 2u; lR[i] = R; lC2[i] = (unsigned)C * 2u; } }
            int laoff, lboff; { int tq = tid; asm volatile("" : "+v"(tq)); const int lq = tq & 63, lfr = lq & 15, lfq = lq >> 4, lw = tq >> 6; laoff = lds_byte((lw >> 2) * 64 + lfr, lfq * 16); lboff = lds_byte((lw & 3) * 32 + lfr, lfq * 16); }
            const char* a1 = cA + (size_t)(t + 1) * kstep;
            const char* a2 = last ? nA : cA + (size_t)(t + 2) * kstep; const char* b2 = last ? nB : cB + (size_t)(t + 2) * kstep;
            const char* a3 = a2 + kstep; const char* b3 = b2 + kstep;
            const char* ga1 = gA + (size_t)(t + 1) * kstep; const char* ga2 = last ? gA : gA + (size_t)(t + 2) * kstep; const char* ga3 = ga2 + kstep;
            const int u2 = (last && has_next) ? ui + 1 : ui;
            if (last && has_next) S.a_ready(nxt);
            if constexpr (SP2) {
            PG8_LDB(B0, 0, 0); PG8_LDB(B1, 0, 1); PG8_SCHED; PG8_LDA(At, 0, 0); PG8_STAGE_AG(PG8_SA(1, 1), a1 + hstep, ga1, ui, 1);
            PG8_WAIT_V(8); PG8_WAIT_L(0); PG8_BAR; PG8_MMA(0, 0, At, B0); PG8_MMA(0, 1, At, B1); PG8_BAR; PG8_SCHED;
            PG8_LDA(At, 0, 1); PG8_STAGE(PG8_SB(0, 0), b2, lvB); PG8_STAGE(PG8_SB(0, 1), b2 + hstep, lvB); PG8_STAGE_AG(PG8_SA(0, 0), a2, ga2, u2, 0);
            PG8_WAIT_V(8); PG8_WAIT_L(0); PG8_BAR; PG8_MMA(1, 0, At, B0); PG8_MMA(1, 1, At, B1); PG8_BAR; PG8_SCHED;
            PG8_LDB(B0, 1, 0); PG8_LDB(B1, 1, 1); PG8_SCHED; PG8_LDA(At, 1, 0); PG8_STAGE_AG(PG8_SA(0, 1), a2 + hstep, ga2, u2, 1);
            PG8_WAIT_V(8); PG8_WAIT_L(0); PG8_BAR; PG8_MMA(0, 0, At, B0); PG8_MMA(0, 1, At, B1); PG8_BAR; PG8_SCHED;
            PG8_LDA(At, 1, 1); PG8_STAGE(PG8_SB(1, 0), b3, lvB); PG8_STAGE(PG8_SB(1, 1), b3 + hstep, lvB); PG8_STAGE_AG(PG8_SA(1, 0), a3, ga3, u2, 0);
            PG8_WAIT_V(8); PG8_WAIT_L(0); PG8_BAR; PG8_MMA(1, 0, At, B0); PG8_MMA(1, 1, At, B1); PG8_BAR; PG8_SCHED;
            } else {
            PG8_LDB(B0, 0, 0); PG8_SCHED; PG8_LDA(At, 0, 0); PG8_STAGE_AG(PG8_SA(1, 1), a1 + hstep, ga1, ui, 1);
            PG8_WAIT_L(8); PG8_BAR; PG8_WAIT_L(0); PG8_MMA(0, 0, At, B0); PG8_BAR; PG8_SCHED;
            PG8_LDB(B1, 0, 1); PG8_STAGE(PG8_SB(0, 0), b2, lvB);
            PG8_BAR; PG8_WAIT_L(0); PG8_MMA(0, 1, At, B1); PG8_BAR;
            PG8_LDA(At, 0, 1); PG8_STAGE_AG(PG8_SA(0, 0), a2, ga2, u2, 0);
            PG8_BAR; PG8_WAIT_L(0); PG8_MMA(1, 0, At, B0); PG8_BAR; PG8_SCHED;
            PG8_STAGE(PG8_SB(0, 1), b2 + hstep, lvB);
            PG8_WAIT_V(6); PG8_BAR; PG8_MMA(1, 1, At, B1); PG8_BAR;
            PG8_LDB(B0, 1, 0); PG8_SCHED; PG8_LDA(At, 1, 0); PG8_STAGE_AG(PG8_SA(0, 1), a2 + hstep, ga2, u2, 1);
            PG8_WAIT_L(8); PG8_BAR; PG8_WAIT_L(0); PG8_MMA(0, 0, At, B0); PG8_BAR; PG8_SCHED;
            PG8_LDB(B1, 1, 1); PG8_STAGE(PG8_SB(1, 0), b3, lvB);
            PG8_BAR; PG8_WAIT_L(0); PG8_MMA(0, 1, At, B1); PG8_BAR;
            PG8_LDA(At, 1, 1); PG8_STAGE_AG(PG8_SA(1, 0), a3, ga3, u2, 0);
            PG8_BAR; PG8_WAIT_L(0); PG8_MMA(1, 0, At, B0); PG8_BAR; PG8_SCHED;
            PG8_STAGE(PG8_SB(1, 1), b3 + hstep, lvB);
            PG8_WAIT_V(6); PG8_BAR; PG8_MMA(1, 1, At, B1); PG8_BAR;
            }
        }
        if constexpr (ALIGN_EPI) { if (wr == 0) PG8_BAR; }
        if constexpr (!Epi::AFTER_DRAIN) { int tq = tid; asm volatile("" : "+v"(tq)); const int lq = tq & 63; E(acc, cur, wr, wc, lq & 15, lq >> 4); S.done(cur); }
        if (!has_next) break;
#pragma unroll
        for (int a = 0; a < 2; ++a)
#pragma unroll
            for (int b = 0; b < 2; ++b)
#pragma unroll
                for (int e = 0; e < 32; ++e) acc.q[a][b][e] = 0.f;
        cur = nxt; cA = nA; cB = nB; ++ui;

        if constexpr (ALIGN_EPI) { if (wr == 1) PG8_BAR; }
    }
    PG8_WAIT_V(0);
    if constexpr (!ALIGN_EPI) { if (wr == 0) PG8_BAR; }
    PG8_BAR;
    if constexpr (Epi::AFTER_DRAIN) { E.fused(acc, cur, wr, wc, fr, fq, lds, wid, lane); S.done(cur); }
#undef PG8_SA
#undef PG8_SB
#undef PG8_STAGE
#undef PG8_STAGE_A
#undef PG8_STAGE_AG
#undef PG8_GOFFS
#undef PG8_LDA
#undef PG8_LDB
#undef aoffv
#undef boffv
#undef PG8_MMA
#undef PG8_WAIT_V
#undef PG8_WAIT_L
#undef PG8_BAR
#undef PG8_SCHED
}
}

constexpr int NW = 8;
constexpr int D = 1024, NB = 4, T = 8192, TCX = 256, NLAT = NB * T, NCTX = NB * TCX, R = NLAT + NCTX;
constexpr int NE = 16, FF = 2048, CAPL = 1024, CAPC = 32;
constexpr int RPE0 = 4352, RPE1 = 4096;
constexpr int HD = 128, NH = 8, NSEQ = NB * NH * 2;
constexpr int NGRP = 17;
constexpr float EPS = 1e-6f;

constexpr size_t MiB = 1u << 20;
constexpr size_t WS_CTL = 0, CTL_ZERO_BYTES = 64 * 1024;
constexpr size_t WS_MV = 1 * MiB;
constexpr size_t WS_LB = WS_MV + 256 * 1024;
constexpr size_t WS_AFF = 2 * MiB;
constexpr size_t WS_INV = 5 * MiB;
constexpr size_t WS_SEL = 7 * MiB;
constexpr size_t WS_GSEL = 7 * MiB + 512 * 1024;
constexpr size_t WS_CTXS = 8 * MiB;
constexpr size_t WS_W1T = 12 * MiB, WS_W2T = 16 * MiB, WS_WINT = 18 * MiB, WS_WOUTT = 28 * MiB;
constexpr size_t WS_PTOT = 30 * MiB;
constexpr size_t WS_W13T = 32 * MiB;
constexpr size_t WS_WDT = 160 * MiB;
constexpr size_t WS_W13T_L1 = 96 * MiB, WS_WDT_L1 = 192 * MiB;
constexpr int MOE_ITEMS = 16 * (16 * 128 + 32 * 32);
constexpr size_t WS_HB = 224 * MiB;
constexpr size_t WS_UB = 290 * MiB;
constexpr size_t WS_XG = 356 * MiB;
constexpr size_t WS_HBUF = 492 * MiB;
constexpr size_t WS_PRJ = 356 * MiB;
constexpr size_t WS_OLOC = 764 * MiB;
constexpr size_t WS_QGG = 892 * MiB;
constexpr size_t WS_SST = 32 * MiB;
constexpr size_t WS_END = 1020 * MiB;
static_assert(WS_PRJ + (size_t)R * 5120 * 2 <= WS_OLOC && WS_HBUF + (size_t)16 * RPE0 * 2048 * 2 <= WS_OLOC && WS_XG + (size_t)16 * RPE0 * 1024 * 2 <= WS_HBUF, "ws map");
static_assert(WS_HB + (size_t)R * 1024 * 2 <= WS_UB && WS_UB + (size_t)R * 1024 * 2 <= WS_XG && WS_QGG + (size_t)2 * NLAT * 1024 * 2 <= WS_END, "ws map 2");

constexpr int CW_BAR = 4096;
constexpr int LDS_BYTES = 155648;
constexpr int GTAB_OFF = 131072;
constexpr int MISC_OFF = 131072 + 20 * 1024 + 320;
static_assert(MISC_OFF + 192 <= LDS_BYTES, "LDS map");

#define GAS __attribute__((address_space(1)))
#define LAS __attribute__((address_space(3)))
typedef unsigned short bf16;
typedef unsigned v4u __attribute__((ext_vector_type(4)));
typedef unsigned v2u __attribute__((ext_vector_type(2)));
typedef float f32x4 __attribute__((ext_vector_type(4)));
typedef float f32x2 __attribute__((ext_vector_type(2)));
typedef short bf16x8 __attribute__((ext_vector_type(8)));
typedef short bf16x4 __attribute__((ext_vector_type(4)));
#define LDS_WAIT() asm volatile("s_waitcnt lgkmcnt(0)" ::: "memory")
__device__ __forceinline__ unsigned pk2(float lo, float hi) { return pg8::cvt_pk_bf16(lo, hi); }
__device__ __forceinline__ float bflo(unsigned w) { return __uint_as_float(w << 16); }
__device__ __forceinline__ float bfhi(unsigned w) { return __uint_as_float(w & 0xffff0000u); }
__device__ __forceinline__ float fsig(float x) { return __builtin_amdgcn_rcpf(1.0f + __expf(-x)); }
__device__ __forceinline__ float wave_sum(float v) {
#pragma unroll
    for (int o = 1; o < 64; o <<= 1) v += __shfl_xor(v, o);
    return v;
}

#define XB_TMO      128
#define XB_XCNT(j)  (256  + 64 * (j))
#define XB_XSUB(j)  (1280 + 64 * (j))
#define XB_XGEN(j)  (2304 + 64 * (j))
#define XB_TOP      3328
#define XB_TOPGEN   3392
#define XCD_BAR_WORDS 3456
#define XB_SPIN_CAP (1u << 20)
__device__ __forceinline__ unsigned xb_ld(unsigned* p)              { return __hip_atomic_load(p, __ATOMIC_RELAXED, __HIP_MEMORY_SCOPE_AGENT); }
__device__ __forceinline__ unsigned xb_add(unsigned* p, unsigned v) { return __hip_atomic_fetch_add(p, v, __ATOMIC_RELAXED, __HIP_MEMORY_SCOPE_AGENT); }
__device__ __forceinline__ unsigned xb_xcc_id() { return (unsigned)__builtin_amdgcn_s_getreg((3 << 11) | 20) & 0xFu; }
#define XB_SPIN(cond, bar) do { unsigned _sp = 0; while (cond) { __builtin_amdgcn_s_sleep(1); \
    if ((++_sp & 255u) == 0u) { if (xb_ld(&(bar)[XB_TMO])) break; if (_sp > XB_SPIN_CAP) { atomicAdd(&(bar)[XB_TMO], 1u); break; } } } } while (0)
struct XcdBarrier { unsigned* bar; unsigned x; volatile LAS unsigned* st; };
__device__ __forceinline__ XcdBarrier xcd_barrier_post(unsigned* bar, volatile LAS unsigned* st, const int wv) {
    XcdBarrier b; b.bar = bar; b.x = xb_xcc_id(); b.st = st;
    if (TID_OF(wv) == 0) (void)xb_add(&bar[XB_XCNT(b.x)], 1u);
    return b;
}
__device__ __forceinline__ void xcd_barrier_complete(unsigned* bar, unsigned x, unsigned& nloc, unsigned& nx) {
    const unsigned G = gridDim.x * gridDim.y * gridDim.z;
    unsigned sum, cnt, mine, sp = 0u;
    for (;;) {
        sum = 0u; cnt = 0u; mine = 0u;
#pragma unroll
        for (unsigned j = 0; j < 16; ++j) { const unsigned c = xb_ld(&bar[XB_XCNT(j)]); sum += c; cnt += (c > 0u) ? 1u : 0u; mine = (j == x) ? c : mine; }
        if (sum == G) break;
        __builtin_amdgcn_s_sleep(1);
        if ((++sp & 255u) == 0u) { if (xb_ld(&bar[XB_TMO])) break; if (sp > XB_SPIN_CAP) { atomicAdd(&bar[XB_TMO], 1u); break; } }
    }
    nloc = mine > 0u ? mine : 1u; nx = cnt > 0u ? cnt : 1u;
}
__device__ __forceinline__ void xcd_barrier(const XcdBarrier& b, const int wv) {
    asm volatile("s_waitcnt vmcnt(0)" ::: "memory");
    __syncthreads();
    if (TID_OF(wv) == 0) {
        unsigned* bar = b.bar;
        __builtin_amdgcn_s_waitcnt(0);
        unsigned nloc = b.st[0], nx = b.st[1];
        if (nloc == 0u) { xcd_barrier_complete(bar, b.x, nloc, nx); b.st[0] = nloc; b.st[1] = nx; }
        const unsigned old = xb_add(&bar[XB_XSUB(b.x)], 1u);
        const unsigned gen = old / nloc;
        if (old + 1u == (gen + 1u) * nloc) {
            __builtin_amdgcn_fence(__ATOMIC_RELEASE, "agent");
            asm volatile("s_waitcnt vmcnt(0)" ::: "memory");
            const unsigned og = xb_add(&bar[XB_TOP], 1u);
            const unsigned tg = og / nx;
            if (og + 1u == (tg + 1u) * nx) xb_add(&bar[XB_TOPGEN], 1u);
            else XB_SPIN(xb_ld(&bar[XB_TOPGEN]) == tg, bar);
            __builtin_amdgcn_fence(__ATOMIC_ACQUIRE, "agent");
            xb_add(&bar[XB_XGEN(b.x)], 1u);
            asm volatile("s_waitcnt vmcnt(0)" ::: "memory");
        } else {
            XB_SPIN(xb_ld(&bar[XB_XGEN(b.x)]) == gen, bar);
            __builtin_amdgcn_fence(__ATOMIC_ACQUIRE, "agent");
            asm volatile("s_waitcnt vmcnt(0)" ::: "memory");
        }
    }
    __syncthreads();
}

struct Ctx {
    LAS unsigned char* lds;
    int tid, lane, wave, vcu, G, gw, NGW;
};
__device__ __forceinline__ Ctx make_ctx(unsigned char* lds_raw, const int wv) {
    Ctx C; int l = lane_id(); asm volatile("" : "+v"(l));
    C.lds = (LAS unsigned char*)lds_raw; C.tid = wv * 64 + l; C.lane = l; C.wave = wv;
    C.G = gridDim.x; { const int bx = blockIdx.x; C.vcu = (C.G % 8 == 0) ? (bx % 8) * (C.G / 8) + bx / 8 : bx; }
    C.gw = C.vcu * NW + C.wave; C.NGW = C.G * NW;
    return C;
}

__device__ __forceinline__ void transpose_item(const float* W, int ldw, int k0, int n0, bf16* WT, int K, int drow0, LAS float* scr, int lane) {
    float tv[32];
    const float* wp = W + (size_t)(k0 + (lane >> 5)) * ldw + n0 + (lane & 31);
#pragma unroll
    for (int i = 0; i < 32; ++i) tv[i] = wp[(size_t)(2 * i) * ldw];
#pragma unroll
    for (int i = 0; i < 32; ++i) scr[(2 * i + (lane >> 5)) * 33 + (lane & 31)] = tv[i];
    LDS_WAIT(); asm volatile("" ::: "memory");
    const int c = lane & 7;
#pragma unroll
    for (int j = 0; j < 4; ++j) { const int n = (lane >> 3) + 8 * j; const LAS float* s = scr + (8 * c) * 33 + n;
        v4u o; o.x = pk2(s[0 * 33], s[1 * 33]); o.y = pk2(s[2 * 33], s[3 * 33]); o.z = pk2(s[4 * 33], s[5 * 33]); o.w = pk2(s[6 * 33], s[7 * 33]);
        *(v4u*)(WT + (size_t)(drow0 + n) * K + k0 + 8 * c) = o; }
    LDS_WAIT(); asm volatile("" ::: "memory");
}
__device__ __forceinline__ void paired_src(int db, int& type, int& ch) { const int j0 = 32 * db, pn = j0 >> 8, jj = j0 & 255; type = jj >> 7; ch = 128 * pn + (jj & 127); }

__device__ __forceinline__ void convert_small(const Ctx& C, const float* w1, const float* w2, const float* win, const float* wout, unsigned char* ws) {
    LAS float* scr = (LAS float*)(C.lds + C.wave * 16384);
    constexpr int I1 = 16 * 64, I2 = 16 * 32, I3 = 16 * 160, I4 = 16 * 32, NI = I1 + I2 + I3 + I4;
    for (int it = C.gw; it < NI; it += C.NGW) {
        int r = it;
        if (r < I1) { const int kb = r / 64, db = r % 64; int type, ch; paired_src(db, type, ch); transpose_item(w1, 2048, 64 * kb, type * 1024 + ch, (bf16*)(ws + WS_W1T), 1024, 32 * db, scr, C.lane); continue; } r -= I1;
        if (r < I2) { const int kb = r / 32, db = r % 32; transpose_item(w2, 1024, 64 * kb, 32 * db, (bf16*)(ws + WS_W2T), 1024, 32 * db, scr, C.lane); continue; } r -= I2;
        if (r < I3) { const int kb = r / 160, db = r % 160; transpose_item(win, 5120, 64 * kb, 32 * db, (bf16*)(ws + WS_WINT), 1024, 32 * db, scr, C.lane); continue; } r -= I3;
        { const int kb = r / 32, db = r % 32; transpose_item(wout, 1024, 64 * kb, 32 * db, (bf16*)(ws + WS_WOUTT), 1024, 32 * db, scr, C.lane); }
    }
}
__device__ __forceinline__ void transpose_item_f8(const float* W, int ldw, int k0, int n0, unsigned char* WT, int K, int drow0, LAS float* scr, int lane) {
    float tv[32];
    const float* wp = W + (size_t)(k0 + (lane >> 5)) * ldw + n0 + (lane & 31);
#pragma unroll
    for (int i = 0; i < 32; ++i) tv[i] = wp[(size_t)(2 * i) * ldw];
#pragma unroll
    for (int i = 0; i < 32; ++i) scr[(2 * i + (lane >> 5)) * 33 + (lane & 31)] = tv[i] * 32.0f;
    LDS_WAIT(); asm volatile("" ::: "memory");
    const int n = lane >> 1, kh = (lane & 1) * 32; const LAS float* sp = scr + kh * 33 + n;
    unsigned o[8];
#pragma unroll
    for (int q = 0; q < 8; ++q) o[q] = pg8::pk4_fp8(sp[(4 * q) * 33], sp[(4 * q + 1) * 33], sp[(4 * q + 2) * 33], sp[(4 * q + 3) * 33]);
    unsigned char* dp = WT + (size_t)(drow0 + n) * K + k0 + kh;
    *(v4u*)dp = (v4u){o[0], o[1], o[2], o[3]}; *(v4u*)(dp + 16) = (v4u){o[4], o[5], o[6], o[7]};
    LDS_WAIT(); asm volatile("" ::: "memory");
}
__device__ __forceinline__ void convert_moe(const Ctx& C, const float* wg, const float* wu, const float* wd, int layer, unsigned char* ws, int it_lo, int it_hi, int widx, int nw) {
    LAS float* scr = (LAS float*)(C.lds + C.wave * 16384);
    constexpr int IGU = 16 * 128, IDN = 32 * 32, IE = IGU + IDN;
    const size_t lo = (size_t)layer * NE * 1024 * 2048;
    unsigned char* const w13 = ws + (layer ? WS_W13T_L1 : WS_W13T); unsigned char* const wdt = ws + (layer ? WS_WDT_L1 : WS_WDT);
    for (int it = it_lo + widx; it < it_hi; it += nw) {
        const int e = it / IE; int r = it % IE;
        if (r < IGU) { const int kb = r / 128, db = r % 128; int type, ch; paired_src(db, type, ch);
            transpose_item_f8((type ? wu : wg) + lo + (size_t)e * 1024 * 2048, 2048, 64 * kb, ch, w13 + (size_t)e * 4096 * 1024, 1024, 32 * db, scr, C.lane); }
        else { r -= IGU; const int kb = r / 32, db = r % 32;
            transpose_item_f8(wd + lo + (size_t)e * 2048 * 1024, 1024, 64 * kb, 32 * db, wdt + (size_t)e * 1024 * 2048, 2048, 32 * db, scr, C.lane); }
    }
}
__device__ __forceinline__ void mod_gemv(const Ctx& C, const float* c, const float* cctx, const float* mod_w, const float* mod_b, float* MV) {
    LAS float* cond = (LAS float*)C.lds;
    LAS float* red = cond + 5 * 1024;
    bool have = false;
    for (int item = blockIdx.x; item < 192; item += C.G) {
        if (!have) { for (int i = C.tid; i < 5 * 1024; i += NW * 64) { const int g = i >> 10, k = i & 1023; const float v = g < 4 ? c[g * 1024 + k] : cctx[k]; cond[i] = v * fsig(v); } have = true; }
        __syncthreads();
        const int l = item / 96, n = (item % 96) * 64 + C.lane;
        const float* W = mod_w + (size_t)l * 1024 * 6144 + n;
        float a[5] = {0.f, 0.f, 0.f, 0.f, 0.f};
        for (int kk = 0; kk < 128; kk += 32) { float w[32];
#pragma unroll
            for (int u = 0; u < 32; ++u) w[u] = W[(size_t)(C.wave * 128 + kk + u) * 6144];
#pragma unroll
            for (int u = 0; u < 32; ++u)
#pragma unroll
                for (int g = 0; g < 5; ++g) a[g] += cond[g * 1024 + C.wave * 128 + kk + u] * w[u]; }
#pragma unroll
        for (int g = 0; g < 5; ++g) red[(C.wave * 5 + g) * 64 + C.lane] = a[g];
        __syncthreads();
        if (C.wave < 5) { float s = 0.f;
#pragma unroll
            for (int w = 0; w < 8; ++w) s += red[(w * 5 + C.wave) * 64 + C.lane];
            MV[(size_t)(l * 5 + C.wave) * 6144 + n] = s + mod_b[l * 6144 + n]; }
    }
}

struct RowArgs {
    const float* src_lat; const float* src_ctx;
    const bf16* delta;
    float* dst_lat; float* dst_ctx;
    const float* gamma;
    const float* mv;
    const float* mvg;
    int i_shift, i_scale, i_gate;
    bf16* HB; unsigned char* HB8; float* AFF; const float* router_w;
    const bf16* Y; const short* INV; int rpe;
    int nrows;
};
template <bool COMBINE, bool ROUTER, bool FINAL>
__device__ __forceinline__ void row_phase(const Ctx& C, const RowArgs& A) {
    LAS float* rwT = (LAS float*)C.lds;
    if (ROUTER) { for (int i = C.tid; i < 16384; i += NW * 64) rwT[(i & 15) * 1024 + (i >> 4)] = A.router_w[i]; __syncthreads(); }
    const int rpw = (A.nrows + C.NGW - 1) / C.NGW;
    const int r_lo = C.gw * rpw, r_hi = min(A.nrows, r_lo + rpw);
    const int l4 = 4 * C.lane;
    int cur_grp = -1;
    f32x4 ga[4], sh[4], m5[4];
#pragma unroll
    for (int j = 0; j < 4; ++j) { ga[j] = (f32x4){0.f, 0.f, 0.f, 0.f}; sh[j] = ga[j]; m5[j] = ga[j]; }
    constexpr bool DELTA = ROUTER || COMBINE;
    f32x4 vn[4]; v2u dn[4];
#pragma unroll
    for (int j = 0; j < 4; ++j) { vn[j] = (f32x4){0.f, 0.f, 0.f, 0.f}; dn[j] = (v2u){0u, 0u}; }
    if (r_lo < r_hi) { const bool ic = r_lo >= NLAT; const float* s0 = (ic ? A.src_ctx + (size_t)(r_lo - NLAT) * 1024 : A.src_lat + (size_t)r_lo * 1024);
#pragma unroll
        for (int j = 0; j < 4; ++j) { vn[j] = *(const f32x4*)(s0 + l4 + 256 * j); if (DELTA) dn[j] = *(const v2u*)(A.delta + (size_t)r_lo * 1024 + l4 + 256 * j); } }
    int svn = -1;
    if (COMBINE && r_lo < r_hi) svn = (C.lane < 16) ? (int)A.INV[(size_t)r_lo * 16 + C.lane] : -1;
    for (int r = r_lo; r < r_hi; ++r) {
        const bool isctx = r >= NLAT; const int grp = isctx ? 4 : (r >> 13);
        if (grp != cur_grp) { cur_grp = grp; const float* mvn = A.mv + (size_t)grp * 6144;
#pragma unroll
            for (int j = 0; j < 4; ++j) { const int c0 = l4 + 256 * j; const f32x4 g = *(const f32x4*)(A.gamma + c0);
                if (FINAL) { ga[j] = g; }
                else { const f32x4 sc = *(const f32x4*)(mvn + A.i_scale * 1024 + c0); ga[j] = g * (sc + 1.0f); sh[j] = *(const f32x4*)(mvn + A.i_shift * 1024 + c0); }
                if (COMBINE) m5[j] = *(const f32x4*)(A.mvg + (size_t)grp * 6144 + A.i_gate * 1024 + c0); } }
        const size_t roff = isctx ? (size_t)(r - NLAT) * 1024 : (size_t)r * 1024;
        f32x4 v[4];
#pragma unroll
        for (int j = 0; j < 4; ++j) { v[j] = vn[j]; if (DELTA) v[j] += (f32x4){bflo(dn[j].x), bfhi(dn[j].x), bflo(dn[j].y), bfhi(dn[j].y)}; }
        if (r + 1 < r_hi) { const int rn = r + 1; const bool ic = rn >= NLAT; const float* s1 = (ic ? A.src_ctx + (size_t)(rn - NLAT) * 1024 : A.src_lat + (size_t)rn * 1024);
#pragma unroll
            for (int j = 0; j < 4; ++j) { vn[j] = *(const f32x4*)(s1 + l4 + 256 * j); if (DELTA) dn[j] = *(const v2u*)(A.delta + (size_t)rn * 1024 + l4 + 256 * j); } }
        if (COMBINE) {
            f32x4 acc[4];
#pragma unroll
            for (int j = 0; j < 4; ++j) acc[j] = (f32x4){0.f, 0.f, 0.f, 0.f};
            const int sv = svn;
            if (r + 1 < r_hi) svn = (C.lane < 16) ? (int)A.INV[(size_t)(r + 1) * 16 + C.lane] : -1;
            unsigned long long m = __ballot(sv >= 0);
            while (m) {
                const int e0 = __ffsll((long long)m) - 1; m &= m - 1;
                const bool two = m != 0ull; const int e1 = two ? __ffsll((long long)m) - 1 : e0; if (two) m &= m - 1;
                const bf16* y0 = A.Y + ((size_t)e0 * A.rpe + __shfl(sv, e0)) * 1024 + l4;
                const bf16* y1 = A.Y + ((size_t)e1 * A.rpe + __shfl(sv, e1)) * 1024 + l4;
                v2u w0[4], w1[4];
#pragma unroll
                for (int j = 0; j < 4; ++j) { w0[j] = *(const v2u*)(y0 + 256 * j); w1[j] = *(const v2u*)(y1 + 256 * j); }
#pragma unroll
                for (int j = 0; j < 4; ++j) { acc[j] += (f32x4){bflo(w0[j].x), bfhi(w0[j].x), bflo(w0[j].y), bfhi(w0[j].y)};
                    if (two) acc[j] += (f32x4){bflo(w1[j].x), bfhi(w1[j].x), bflo(w1[j].y), bfhi(w1[j].y)}; } }
#pragma unroll
            for (int j = 0; j < 4; ++j) v[j] += m5[j] * acc[j];
            if (!FINAL) { float* dst = (isctx ? A.dst_ctx : A.dst_lat) + roff;
#pragma unroll
                for (int j = 0; j < 4; ++j) *(f32x4*)(dst + l4 + 256 * j) = v[j]; }
        }
        float ss = 0.f;
#pragma unroll
        for (int j = 0; j < 4; ++j) ss += (v[j].x * v[j].x + v[j].y * v[j].y) + (v[j].z * v[j].z + v[j].w * v[j].w);
        const float rstd = rsqrtf(wave_sum(ss) * (1.0f / 1024.0f) + EPS);
        if (FINAL) { float* dst = A.dst_lat + roff;
#pragma unroll
            for (int j = 0; j < 4; ++j) *(f32x4*)(dst + l4 + 256 * j) = v[j] * rstd * ga[j];
            continue; }
        f32x4 hv[4];
#pragma unroll
        for (int j = 0; j < 4; ++j) { hv[j] = v[j] * rstd * ga[j] + sh[j];
            if (ROUTER) { *(unsigned*)(A.HB8 + (size_t)r * 1024 + l4 + 256 * j) = pg8::pk4_fp8(hv[j].x, hv[j].y, hv[j].z, hv[j].w); }
            else { v2u w; w.x = pk2(hv[j].x, hv[j].y); w.y = pk2(hv[j].z, hv[j].w); *(v2u*)(A.HB + (size_t)r * 1024 + l4 + 256 * j) = w; } }
        if (ROUTER) {
            float lg[16];
#pragma unroll
            for (int e = 0; e < 16; ++e) { float s = 0.f;
#pragma unroll
                for (int j = 0; j < 4; ++j) { const f32x4 w = *(const LAS f32x4*)(rwT + e * 1024 + l4 + 256 * j); s += (hv[j].x * w.x + hv[j].y * w.y) + (hv[j].z * w.z + hv[j].w * w.w); }
                lg[e] = s; }
            float t8[8], t4[4], t2[2], t1;
#pragma unroll
            for (int i = 0; i < 8; ++i) { const bool up = (C.lane & 32) != 0; const float send = up ? lg[i] : lg[i + 8], keep = up ? lg[i + 8] : lg[i]; t8[i] = keep + __shfl_xor(send, 32); }
#pragma unroll
            for (int i = 0; i < 4; ++i) { const bool up = (C.lane & 16) != 0; const float send = up ? t8[i] : t8[i + 4], keep = up ? t8[i + 4] : t8[i]; t4[i] = keep + __shfl_xor(send, 16); }
#pragma unroll
            for (int i = 0; i < 2; ++i) { const bool up = (C.lane & 8) != 0; const float send = up ? t4[i] : t4[i + 2], keep = up ? t4[i + 2] : t4[i]; t2[i] = keep + __shfl_xor(send, 8); }
            { const bool up = (C.lane & 4) != 0; const float send = up ? t2[0] : t2[1], keep = up ? t2[1] : t2[0]; t1 = keep + __shfl_xor(send, 4); }
            t1 += __shfl_xor(t1, 2); t1 += __shfl_xor(t1, 1);
            const int e = ((C.lane >> 5) & 1) * 8 + ((C.lane >> 4) & 1) * 4 + ((C.lane >> 3) & 1) * 2 + ((C.lane >> 2) & 1);
            float mx = t1;
#pragma unroll
            for (int o = 4; o < 64; o <<= 1) mx = fmaxf(mx, __shfl_xor(mx, o));
            const float p = __expf(t1 - mx); float sum = p;
#pragma unroll
            for (int o = 4; o < 64; o <<= 1) sum += __shfl_xor(sum, o);
            if ((C.lane & 3) == 0) A.AFF[(size_t)r * 16 + e] = p / sum;
        }
    }
    if (ROUTER) __syncthreads();
}

__device__ __forceinline__ void conv_phase(const Ctx& C, const bf16* U, bf16* V, const float* dw, const float* dwb, const float* lng, const float* lnb) {
    LAS unsigned* ut = (LAS unsigned*)C.lds;
    LAS float* part = (LAS float*)(C.lds + 126976);
    LAS float* stat = part + 512;
    const int cp = C.tid;
    f32x2 wt[31];
#pragma unroll
    for (int j = 0; j < 31; ++j) wt[j] = *(const f32x2*)(dw + j * 1024 + 2 * cp);
    const f32x2 bb = *(const f32x2*)(dwb + 2 * cp), gg = *(const f32x2*)(lng + 2 * cp), be = *(const f32x2*)(lnb + 2 * cp);
    for (int tile = C.vcu; tile < 1056; tile += C.G) {
        int rowbase, t0, tseq;
        if (tile < 1024) { rowbase = (tile >> 8) * T; t0 = (tile & 255) * 32; tseq = T; } else { const int tt = tile - 1024; rowbase = NLAT + (tt >> 3) * TCX; t0 = (tt & 7) * 32; tseq = TCX; }
        { v4u tv[16];
#pragma unroll
            for (int k = 0; k < 16; ++k) { const int i = 4 * k + (C.tid >> 7), t = t0 - 15 + i; tv[k] = (v4u){0u, 0u, 0u, 0u};
                if (i < 62 && t >= 0 && t < tseq) tv[k] = *(const v4u*)(U + (size_t)(rowbase + t) * 1024 + (C.tid & 127) * 8); }
#pragma unroll
            for (int k = 0; k < 16; ++k) { const int i = 4 * k + (C.tid >> 7); if (i < 62) *(LAS v4u*)(C.lds + i * 2048 + (C.tid & 127) * 16) = tv[k]; } }
        __syncthreads();
        f32x2 ov[32];
#pragma unroll
        for (int g = 0; g < 8; ++g) {
            f32x2 a[4];
#pragma unroll
            for (int oo = 0; oo < 4; ++oo) a[oo] = bb;
#pragma unroll
            for (int jj = 0; jj < 34; ++jj) { const unsigned uw = ut[(4 * g + jj) * 512 + cp]; const f32x2 uu = (f32x2){bflo(uw), bfhi(uw)};
#pragma unroll
                for (int oo = 0; oo < 4; ++oo) { const int tap = jj - oo; if (tap >= 0 && tap <= 30) a[oo] = __builtin_elementwise_fma(wt[tap], uu, a[oo]); } }
            float r8[8];
#pragma unroll
            for (int oo = 0; oo < 4; ++oo) { ov[4 * g + oo] = a[oo]; r8[2 * oo] = a[oo].x + a[oo].y; r8[2 * oo + 1] = a[oo].x * a[oo].x + a[oo].y * a[oo].y; }
            float r4[4], r2[2], r1;
#pragma unroll
            for (int i = 0; i < 4; ++i) { const bool up = (C.lane & 32) != 0; const float send = up ? r8[i] : r8[i + 4], keep = up ? r8[i + 4] : r8[i]; r4[i] = keep + __shfl_xor(send, 32); }
#pragma unroll
            for (int i = 0; i < 2; ++i) { const bool up = (C.lane & 16) != 0; const float send = up ? r4[i] : r4[i + 2], keep = up ? r4[i + 2] : r4[i]; r2[i] = keep + __shfl_xor(send, 16); }
            { const bool up = (C.lane & 8) != 0; const float send = up ? r2[0] : r2[1], keep = up ? r2[1] : r2[0]; r1 = keep + __shfl_xor(send, 8); }
            r1 += __shfl_xor(r1, 4); r1 += __shfl_xor(r1, 2); r1 += __shfl_xor(r1, 1);
            if ((C.lane & 7) == 0) { const int vi = ((C.lane >> 5) & 1) * 4 + ((C.lane >> 4) & 1) * 2 + ((C.lane >> 3) & 1); part[((4 * g + (vi >> 1)) * 8 + C.wave) * 2 + (vi & 1)] = r1; }
            asm volatile("" ::: "memory");
        }
        __syncthreads();
        if (C.tid < 32) { float s1 = 0.f, s2 = 0.f;
#pragma unroll
            for (int w = 0; w < 8; ++w) { s1 += part[(C.tid * 8 + w) * 2]; s2 += part[(C.tid * 8 + w) * 2 + 1]; }
            const float mean = s1 * (1.0f / 1024.0f), var = fmaxf(s2 * (1.0f / 1024.0f) - mean * mean, 0.f);
            stat[C.tid * 2] = mean; stat[C.tid * 2 + 1] = rsqrtf(var + EPS); }
        __syncthreads();
#pragma unroll
        for (int tk = 0; tk < 32; ++tk) { const float mean = stat[tk * 2], rstd = stat[tk * 2 + 1];
            const float y0 = (ov[tk].x - mean) * rstd * gg.x + be.x, y1 = (ov[tk].y - mean) * rstd * gg.y + be.y;
            *(unsigned*)(V + (size_t)(rowbase + t0 + tk) * 1024 + 2 * cp) = pk2(y0 * fsig(y0), y1 * fsig(y1)); }
    }
}

__device__ __forceinline__ unsigned block_excl_scan(const Ctx& C, unsigned v, LAS unsigned* wsum, unsigned& total) {
    unsigned inc = v;
#pragma unroll
    for (int o = 1; o < 64; o <<= 1) { const unsigned t = __shfl_up(inc, o); if (C.lane >= o) inc += t; }
    if (C.lane == 63) wsum[C.wave] = inc;
    __syncthreads();
    unsigned base = 0, tot = 0;
#pragma unroll
    for (int w = 0; w < NW; ++w) { const unsigned s = wsum[w]; if (w < C.wave) base += s; tot += s; }
    __syncthreads();
    total = tot;
    return base + inc - v;
}
__device__ __forceinline__ void topk_phase(const Ctx& C, int nprob, int rpe, const float* AFF, int* SEL, float* GSEL, short* INV) {
    LAS unsigned* hist = (LAS unsigned*)C.lds;
    LAS unsigned* misc = hist + 256;
    LAS unsigned* wsum = misc + 16;
    for (int prob = blockIdx.x; prob < nprob; prob += C.G) {
        const int set = prob >> 4, e = prob & 15; const bool lat = set < 4;
        const int kk = lat ? CAPL : CAPC, rowbase = lat ? set * T : NLAT + (set - 4) * TCX, slotbase = lat ? set * CAPL : 4 * CAPL + (set - 4) * CAPC;
        const int cnt = lat ? 16 : (C.tid < 256 ? 1 : 0), base = lat ? C.tid * 16 : C.tid;
        unsigned key[16];
#pragma unroll
        for (int i = 0; i < 16; ++i) key[i] = (i < cnt) ? __float_as_uint(AFF[(size_t)(rowbase + base + i) * 16 + e]) : 0u;
        unsigned prefix = 0u, mask = 0u, need = (unsigned)kk;
#pragma unroll 1
        for (int pass = 0; pass < 4; ++pass) { const int shift = 24 - 8 * pass;
            if (C.tid < 256) hist[C.tid] = 0u;
            __syncthreads();
#pragma unroll
            for (int i = 0; i < 16; ++i) if (i < cnt && (key[i] & mask) == prefix) __hip_atomic_fetch_add(&hist[(key[i] >> shift) & 255u], 1u, __ATOMIC_RELAXED, __HIP_MEMORY_SCOPE_WORKGROUP);
            __syncthreads();
            if (C.wave == 0) { unsigned h[4], tot = 0u;
#pragma unroll
                for (int b = 0; b < 4; ++b) { h[b] = hist[4 * C.lane + b]; tot += h[b]; }
                unsigned inc = tot;
#pragma unroll
                for (int o = 1; o < 64; o <<= 1) { const unsigned t = __shfl_down(inc, o); if (C.lane + o < 64) inc += t; }
                unsigned cgt = inc - tot;
#pragma unroll
                for (int b = 3; b >= 0; --b) { if (cgt < need && need <= cgt + h[b]) { misc[0] = (unsigned)(4 * C.lane + b); misc[1] = need - cgt; } cgt += h[b]; } }
            __syncthreads();
            prefix |= misc[0] << shift; mask |= 255u << shift; need = misc[1];
        }
        unsigned neq = 0u, ngt = 0u;
#pragma unroll
        for (int i = 0; i < 16; ++i) if (i < cnt) { neq += (key[i] == prefix) ? 1u : 0u; ngt += (key[i] > prefix) ? 1u : 0u; }
        unsigned tot;
        const unsigned eq_before = block_excl_scan(C, neq, wsum, tot);
        const unsigned take_eq = (need > eq_before) ? min(neq, need - eq_before) : 0u;
        unsigned slot = block_excl_scan(C, ngt + take_eq, wsum, tot);
        unsigned eqr = eq_before;
#pragma unroll
        for (int i = 0; i < 16; ++i) if (i < cnt) {
            bool sel = key[i] > prefix;
            if (key[i] == prefix) { sel = eqr < need; ++eqr; }
            const int row = rowbase + base + i;
            if (sel) { const int s = slotbase + (int)slot; ++slot; SEL[e * rpe + s] = row; GSEL[e * rpe + s] = __uint_as_float(key[i]); INV[(size_t)row * 16 + e] = (short)s; }
            else INV[(size_t)row * 16 + e] = (short)-1; }
        if (rpe == RPE0 && set == 4 && C.tid < RPE0 - (4 * CAPL + 4 * CAPC)) { const int s = 4 * CAPL + 4 * CAPC + C.tid; SEL[e * rpe + s] = 0; GSEL[e * rpe + s] = 0.f; }
        __syncthreads();
    }
}
__device__ __forceinline__ void gather_phase(const Ctx& C, int nrows, const int* SEL, const bf16* HB, bf16* XG) {
    for (int r = C.gw; r < nrows; r += C.NGW) { const int src = SEL[r];
        const v4u a = *(const v4u*)(HB + (size_t)src * 1024 + 8 * C.lane), b = *(const v4u*)(HB + (size_t)src * 1024 + 512 + 8 * C.lane);
        *(v4u*)(XG + (size_t)r * 1024 + 8 * C.lane) = a; *(v4u*)(XG + (size_t)r * 1024 + 512 + 8 * C.lane) = b; }
}

__device__ __forceinline__ f32x4 mfma16(bf16x8 a, bf16x8 b, f32x4 c) { return __builtin_amdgcn_mfma_f32_16x16x32_bf16(a, b, c, 0, 0, 0); }
#define PRJ_AT(qn, h_, row_) (PRJ + (((size_t)((qn) * NH + (h_)) * R + (size_t)(row_)) * HD))
#define DH_AT(buf, dir_, h_, row_) ((buf) + (((size_t)((dir_) * NH + (h_)) * NLAT + (size_t)(row_)) * HD))
constexpr int QROW = 272, TROW = 144;
constexpr int SC_QG = 0, SC_KT = 17408, SC_KGT = 34816  , SC_VT = 71680  , SC_SC = 108544, SC_SEG = 117760, SC_PCH = 121856  , SC_PG = 122880;
static_assert(SC_PG + 512 <= 131072, "scan LDS map");

__device__ __forceinline__ void scanA_phase(const Ctx& C, const bf16* PRJ, const float* LB, bf16* OLOC, bf16* QGG, float* SLOC, float* PTOT) {
    LAS unsigned char* L = C.lds;
    LAS float* SEG = (LAS float*)(L + SC_SEG); LAS float* PG = (LAS float*)(L + SC_PG);
    const int lane = C.lane, w = C.wave, g = lane >> 4, lr = lane & 15, k0 = 2 * lane, seg = w;
    for (int ui = C.vcu; ui < NSEQ * NGRP; ui += C.G) {
        int seq, grp; if (ui < NSEQ * 16) { seq = ui >> 4; grp = 1 + (ui & 15); } else { seq = ui - NSEQ * 16; grp = 0; }
        const int b = seq >> 4, h = (seq >> 1) & 7, dir = seq & 1, nch = grp ? 8 : 4, sgn = dir ? -1 : 1;
        const int hc = h * HD;
        f32x4 S[8];
#pragma unroll
        for (int i = 0; i < 8; ++i) S[i] = (f32x4){0.f, 0.f, 0.f, 0.f};
        if (C.tid < 128) PG[C.tid] = 1.0f;
        const int Pb = grp ? (grp - 1) * 512 : 0, rbase = grp ? b * T : NLAT + b * TCX, tlen = grp ? T : TCX;
#define ROWC(c) (rbase + (dir ? tlen - 1 - (Pb + 64 * (c)) : Pb + 64 * (c)))
        unsigned fq[8], qq[8]; v4u vv[2];
        float pl0[8], pl1[8], kk0[8], kk1[8], pg0 = 1.f, pg1 = 1.f, pt0 = 1.f, pt1 = 1.f;
#define SC_LOAD(c) do { const int rn_ = ROWC(c); \
            _Pragma("unroll") for (int i = 0; i < 8; ++i) { const int rw_ = rn_ + sgn * (8 * seg + i); fq[i] = *(const unsigned*)(PRJ_AT(1 + dir, h, rw_) + k0); qq[i] = *(const unsigned*)(PRJ_AT(0, h, rw_) + k0); } \
            _Pragma("unroll") for (int ii = 0; ii < 2; ++ii) { const int cq = C.tid + 512 * ii; vv[ii] = *(const v4u*)(PRJ_AT(3, h, rn_ + sgn * (cq & 63)) + (cq >> 6) * 8); } } while (0)
#define SC_PREP1(c) do { float run0 = 1.f, run1 = 1.f; \
            _Pragma("unroll") for (int i = 0; i < 8; ++i) { kk0[i] = bflo(fq[i]); kk1[i] = bfhi(fq[i]);          \
                run0 *= 1.f - kk0[i]; run1 *= 1.f - kk1[i]; pl0[i] = run0; pl1[i] = run1; } \
            *(LAS f32x2*)(SEG + seg * 128 + k0) = (f32x2){run0, run1}; \
            _Pragma("unroll") for (int ii = 0; ii < 2; ++ii) { const int cq = C.tid + 512 * ii, p_ = cq & 63, v0 = (cq >> 6) * 8; LAS bf16* vt = (LAS bf16*)(L + SC_VT + ((c) & 1) * 18432) + p_; \
                const unsigned wds[4] = {vv[ii].x, vv[ii].y, vv[ii].z, vv[ii].w}; \
                _Pragma("unroll") for (int j = 0; j < 4; ++j) { vt[(v0 + 2 * j) * (TROW / 2)] = (bf16)(wds[j] & 0xffffu); vt[(v0 + 2 * j + 1) * (TROW / 2)] = (bf16)(wds[j] >> 16); } } \
            pg0 = PG[k0]; pg1 = PG[k0 + 1]; } while (0)
#define SC_PREP2(c) do { const int rc_ = ROWC(c); float pb0 = 1.f, pb1 = 1.f; pt0 = 1.f; pt1 = 1.f; \
            _Pragma("unroll") for (int s = 0; s < 8; ++s) { const f32x2 t = *(const LAS f32x2*)(SEG + s * 128 + k0); if (s < seg) { pb0 *= t.x; pb1 *= t.y; } pt0 *= t.x; pt1 *= t.y; } \
            unsigned kg0[4], kg1[4]; float kprev0 = 0.f, kprev1 = 0.f; \
            _Pragma("unroll") for (int i = 0; i < 8; ++i) { const int p_ = 8 * seg + i; \
                const float P0 = pb0 * pl0[i], P1 = pb1 * pl1[i]; \
                const float qg0 = bflo(qq[i]) * P0, qg1 = bfhi(qq[i]) * P1; \
                const float kt0 = kk0[i] * __builtin_amdgcn_rcpf(fmaxf(P0, 1e-30f)), kt1 = kk1[i] * __builtin_amdgcn_rcpf(fmaxf(P1, 1e-30f)); \
                *(LAS unsigned*)(L + SC_QG + p_ * QROW + k0 * 2) = pk2(qg0, qg1); \
                *(LAS unsigned*)(L + SC_KT + p_ * QROW + k0 * 2) = pk2(kt0, kt1); \
                const float a0 = kt0 * pt0, a1 = kt1 * pt1; \
                if (i & 1) { kg0[i >> 1] = pk2(kprev0, a0); kg1[i >> 1] = pk2(kprev1, a1); } else { kprev0 = a0; kprev1 = a1; } \
                if (grp) *(unsigned*)(DH_AT(QGG, dir, h, rc_ + sgn * p_) + k0) = pk2(qg0 * pg0, qg1 * pg1); } \
            *(LAS v4u*)(L + SC_KGT + ((c) & 1) * 18432 + k0 * TROW + seg * 16) = (v4u){kg0[0], kg0[1], kg0[2], kg0[3]}; \
            *(LAS v4u*)(L + SC_KGT + ((c) & 1) * 18432 + (k0 + 1) * TROW + seg * 16) = (v4u){kg1[0], kg1[1], kg1[2], kg1[3]}; \
            if (seg == 0) *(LAS f32x2*)(L + SC_PCH + ((c) & 1) * 512 + k0 * 4) = (f32x2){pt0, pt1}; \
            if ((c) + 1 < nch) SC_LOAD((c) + 1); } while (0)
#define SC_SCORES() do { if (seg == 0) *(LAS f32x2*)(PG + k0) = (f32x2){pg0 * pt0, pg1 * pt1}; \
            const int pi = w >> 1; \
            _Pragma("unroll") for (int tt = 0; tt < 2; ++tt) { const int si = 2 * (w & 1) + tt; f32x4 acc = (f32x4){0.f, 0.f, 0.f, 0.f}; \
                _Pragma("unroll") for (int ks = 0; ks < 4; ++ks) { const bf16x8 a = *(const LAS bf16x8*)(L + SC_QG + (16 * pi + lr) * QROW + (32 * ks + 8 * g) * 2); \
                    const bf16x8 bb = *(const LAS bf16x8*)(L + SC_KT + (16 * si + lr) * QROW + (32 * ks + 8 * g) * 2); acc = mfma16(a, bb, acc); } \
                _Pragma("unroll") for (int r = 0; r < 4; ++r) { const int p_ = 16 * pi + 4 * g + r, s_ = 16 * si + lr; const float val = (s_ <= p_) ? acc[r] : 0.f; \
                    *(LAS bf16*)(L + SC_SC + p_ * TROW + s_ * 2) = (bf16)(pk2(val, 0.f) & 0xffffu); } } } while (0)
#define SC_OUTPUTS(c) do { const int rc_ = ROWC(c); const LAS unsigned char* VTc = L + SC_VT + ((c) & 1) * 18432; f32x4 O[4]; \
            _Pragma("unroll") for (int pt = 0; pt < 4; ++pt) O[pt] = (f32x4){0.f, 0.f, 0.f, 0.f}; \
            _Pragma("unroll") for (int ks = 0; ks < 4; ++ks) { \
                v4u sw; sw.x = pk2(S[2 * ks][0], S[2 * ks][1]); sw.y = pk2(S[2 * ks][2], S[2 * ks][3]); sw.z = pk2(S[2 * ks + 1][0], S[2 * ks + 1][1]); sw.w = pk2(S[2 * ks + 1][2], S[2 * ks + 1][3]); \
                const bf16x8 sb = __builtin_bit_cast(bf16x8, sw); \
                _Pragma("unroll") for (int pt = 0; pt < 4; ++pt) { const LAS unsigned char* qp = L + SC_QG + (16 * pt + lr) * QROW + (32 * ks + 4 * g) * 2; \
                    const v2u lo = *(const LAS v2u*)qp, hi = *(const LAS v2u*)(qp + 32); \
                    const bf16x8 a = __builtin_bit_cast(bf16x8, (v4u){lo.x, lo.y, hi.x, hi.y}); O[pt] = mfma16(sb, a, O[pt]); } } \
            _Pragma("unroll") for (int ks = 0; ks < 2; ++ks) { const bf16x8 bvk = *(const LAS bf16x8*)(VTc + (16 * w + lr) * TROW + (32 * ks + 8 * g) * 2); \
                _Pragma("unroll") for (int pt = 0; pt < 4; ++pt) { const bf16x8 a = *(const LAS bf16x8*)(L + SC_SC + (16 * pt + lr) * TROW + (32 * ks + 8 * g) * 2); O[pt] = mfma16(bvk, a, O[pt]); } } \
            if (grp) { _Pragma("unroll") for (int pt = 0; pt < 4; ++pt) { const int p_ = 16 * pt + lr; \
                *(v2u*)(DH_AT(OLOC, dir, h, rc_ + sgn * p_) + 16 * w + 4 * g) = (v2u){pk2(O[pt][0], O[pt][1]), pk2(O[pt][2], O[pt][3])}; } } } while (0)
#define SC_UPDATE(c) do { const LAS unsigned char* VTc = L + SC_VT + ((c) & 1) * 18432; const LAS unsigned char* KGc = L + SC_KGT + ((c) & 1) * 18432; const LAS float* PCc = (const LAS float*)(L + SC_PCH + ((c) & 1) * 512); \
            bf16x8 bv[2]; \
            _Pragma("unroll") for (int ks = 0; ks < 2; ++ks) bv[ks] = *(const LAS bf16x8*)(VTc + (16 * w + lr) * TROW + (32 * ks + 8 * g) * 2); \
            _Pragma("unroll") for (int kt = 0; kt < 8; ++kt) { const f32x4 pc = *(const LAS f32x4*)(PCc + 16 * kt + 4 * g); S[kt] = S[kt] * pc; \
                _Pragma("unroll") for (int ks = 0; ks < 2; ++ks) { const bf16x8 a = *(const LAS bf16x8*)(KGc + (16 * kt + lr) * TROW + (32 * ks + 8 * g) * 2); S[kt] = mfma16(a, bv[ks], S[kt]); } } } while (0)
        SC_LOAD(0);
        __syncthreads();
        SC_PREP1(0);
        __syncthreads();
        SC_PREP2(0);
        __syncthreads();
        SC_SCORES();
        __syncthreads();
#pragma unroll 1
        for (int c = 0; c < nch; ++c) {
            const bool more = c + 1 < nch;
            if (more) SC_PREP1(c + 1);
            SC_OUTPUTS(c);
            __syncthreads();
            if (more) SC_PREP2(c + 1);
            SC_UPDATE(c);
            __syncthreads();
            if (more) SC_SCORES();
            __syncthreads();
        }
        if (grp < 16) {
#pragma unroll
            for (int kt = 0; kt < 8; ++kt)
#pragma unroll
                for (int r = 0; r < 4; ++r) SLOC[(((size_t)seq * 16 + grp) * 128 + 16 * kt + 4 * g + r) * 128 + 16 * w + lr] = S[kt][r]; }
        if (C.tid < 128) PTOT[((size_t)seq * NGRP + grp) * 128 + C.tid] = PG[C.tid];
        __syncthreads();
#undef ROWC
#undef SC_LOAD
#undef SC_PREP1
#undef SC_PREP2
#undef SC_SCORES
#undef SC_OUTPUTS
#undef SC_UPDATE
    }
}
__device__ __forceinline__ void scanB_phase(const Ctx& C, const float* SLOC, const float* PTOT, bf16* SST) {
    for (int id = C.vcu * (NW * 64) + C.tid; id < NSEQ * 2048; id += C.G * NW * 64) {
        const int seq = id >> 11, k = ((id >> 7) & 15) * 8, v = id & 127;
        float s[8];
#pragma unroll
        for (int i = 0; i < 8; ++i) s[i] = 0.f;
#pragma unroll 4
        for (int gi = 0; gi < 16; ++gi) { const float* pt = PTOT + ((size_t)seq * NGRP + gi) * 128 + k; const float* sl = SLOC + (((size_t)seq * 16 + gi) * 128 + k) * 128 + v;
#pragma unroll
            for (int i = 0; i < 8; ++i) s[i] = pt[i] * s[i] + sl[(size_t)i * 128];
            v4u o; o.x = pk2(s[0], s[1]); o.y = pk2(s[2], s[3]); o.z = pk2(s[4], s[5]); o.w = pk2(s[6], s[7]);
            *(v4u*)(SST + (((size_t)seq * 16 + gi) * 128 + v) * 128 + k) = o; }
    }
}
__device__ __forceinline__ void readout_phase(const Ctx& C, const bf16* PRJ, const bf16* OLOC, const bf16* QGG, const bf16* SST, const float* norm_g, bf16* YH) {
    LAS unsigned char* L = C.lds;
    constexpr int ABUF = 64 * QROW;
    LAS float* OT = (LAS float*)(L + 4 * ABUF);
    const int lane = C.lane, w = C.wave, g = lane >> 4, lr = lane & 15;
    const int p = C.tid >> 3, sg = C.tid & 7;
    f32x4 ng[4];
#pragma unroll
    for (int i = 0; i < 4; ++i) ng[i] = *(const f32x4*)(norm_g + 16 * sg + 4 * i);
    for (int ui = C.vcu; ui < NB * NH * 16; ui += C.G) {
        const int j = ui & 15, h = (ui >> 4) & 7, b = ui >> 7, hc = h * HD, row00 = b * T + 512 * j;
        bf16x8 bfr[2][4];
#pragma unroll
        for (int dir = 0; dir < 2; ++dir) { const int seq = (b * 8 + h) * 2 + dir, gs = dir ? 15 - j : j;
            const bf16* Bb = SST + (((size_t)seq * 16 + gs) * 128 + 16 * w + lr) * 128;
#pragma unroll
            for (int ks = 0; ks < 4; ++ks) bfr[dir][ks] = *(const bf16x8*)(Bb + 32 * ks + 8 * g); }
        v4u ar[2][2];
#define RO_LOADA(tile) do { _Pragma("unroll") for (int dir = 0; dir < 2; ++dir) _Pragma("unroll") for (int ii = 0; ii < 2; ++ii) { const int cq = C.tid + 512 * ii; \
            ar[dir][ii] = *(const v4u*)(DH_AT(QGG, dir, h, row00 + 64 * (tile) + (cq >> 4)) + (cq & 15) * 8); } } while (0)
#define RO_WRITEA(buf) do { _Pragma("unroll") for (int dir = 0; dir < 2; ++dir) _Pragma("unroll") for (int ii = 0; ii < 2; ++ii) { const int cq = C.tid + 512 * ii; \
            *(LAS v4u*)(L + ((buf) * 2 + dir) * ABUF + (cq >> 4) * QROW + (cq & 15) * 16) = ar[dir][ii]; } } while (0)
        RO_LOADA(0); RO_WRITEA(0);
        __syncthreads();
#pragma unroll 1
        for (int t = 0; t < 8; ++t) {
            const int buf = t & 1; const size_t row = (size_t)row00 + 64 * t + p; const int c0 = hc + 16 * sg;
            if (t < 7) RO_LOADA(t + 1);
            v4u eo[2][2]; v4u eg[2];
#pragma unroll
            for (int dir = 0; dir < 2; ++dir) { const bf16* op = DH_AT(OLOC, dir, h, row) + 16 * sg; eo[dir][0] = *(const v4u*)op; eo[dir][1] = *(const v4u*)(op + 8); }
            { const bf16* gp = PRJ_AT(4, h, row) + 16 * sg; eg[0] = *(const v4u*)gp; eg[1] = *(const v4u*)(gp + 8); }
            f32x4 O[4];
#pragma unroll
            for (int pt = 0; pt < 4; ++pt) O[pt] = (f32x4){0.f, 0.f, 0.f, 0.f};
#pragma unroll
            for (int dir = 0; dir < 2; ++dir)
#pragma unroll
                for (int ks = 0; ks < 4; ++ks)
#pragma unroll
                    for (int pt = 0; pt < 4; ++pt) { const bf16x8 a = *(const LAS bf16x8*)(L + (buf * 2 + dir) * ABUF + (16 * pt + lr) * QROW + (32 * ks + 8 * g) * 2); O[pt] = mfma16(a, bfr[dir][ks], O[pt]); }
#pragma unroll
            for (int pt = 0; pt < 4; ++pt)
#pragma unroll
                for (int r = 0; r < 4; ++r) OT[(16 * pt + 4 * g + r) * 132 + 16 * w + lr] = O[pt][r];
            if (t < 7) RO_WRITEA(buf ^ 1);
            __syncthreads();
            f32x4 o[4];
#pragma unroll
            for (int i = 0; i < 4; ++i) o[i] = *(const LAS f32x4*)(OT + p * 132 + 16 * sg + 4 * i);
#pragma unroll
            for (int dir = 0; dir < 2; ++dir) { const v4u a = eo[dir][0], bq = eo[dir][1];
                o[0] += (f32x4){bflo(a.x), bfhi(a.x), bflo(a.y), bfhi(a.y)}; o[1] += (f32x4){bflo(a.z), bfhi(a.z), bflo(a.w), bfhi(a.w)};
                o[2] += (f32x4){bflo(bq.x), bfhi(bq.x), bflo(bq.y), bfhi(bq.y)}; o[3] += (f32x4){bflo(bq.z), bfhi(bq.z), bflo(bq.w), bfhi(bq.w)}; }
            float ss = 0.f;
#pragma unroll
            for (int i = 0; i < 4; ++i) ss += (o[i].x * o[i].x + o[i].y * o[i].y) + (o[i].z * o[i].z + o[i].w * o[i].w);
            ss += __shfl_xor(ss, 1); ss += __shfl_xor(ss, 2); ss += __shfl_xor(ss, 4);
            const float rstd = rsqrtf(ss * (1.0f / 128.0f) + EPS);
            const unsigned gw[8] = {eg[0].x, eg[0].y, eg[0].z, eg[0].w, eg[1].x, eg[1].y, eg[1].z, eg[1].w};
            unsigned ow[8];
#pragma unroll
            for (int i = 0; i < 8; ++i) { const float g0 = bflo(gw[i]), g1 = bfhi(gw[i]);
                const float y0 = o[i >> 1][(2 * i) & 3] * rstd * ng[i >> 1][(2 * i) & 3] * (g0 * fsig(g0));
                const float y1 = o[i >> 1][(2 * i + 1) & 3] * rstd * ng[i >> 1][(2 * i + 1) & 3] * (g1 * fsig(g1));
                ow[i] = pk2(y0, y1); }
            bf16* yp = YH + row * 1024 + c0;
            *(v4u*)yp = (v4u){ow[0], ow[1], ow[2], ow[3]}; *(v4u*)(yp + 8) = (v4u){ow[4], ow[5], ow[6], ow[7]};
            __syncthreads();
        }
#undef RO_LOADA
#undef RO_WRITEA
    }
}

constexpr int NPHASE = 22;
struct Args { const float* in[25]; float* out; unsigned char* ws; int ph_lo, ph_hi; };
constexpr int GRID_C = 256;
constexpr int TAILQ_P2 = 5, TAILQ_P4 = 9, TAILQ_P9 = 6, TAILQ_P11 = 5, TAILQ_P6 = 4, TAILQ_P17 = 3, TAILQ_P3 = 4, TAILQ_P12 = 5;
__device__ __forceinline__ int tail_waves(int nwg, int G) { const int extra = nwg % G; return extra ? (G - extra) * NW : 0; }
#define IDLE_CONVERT(first_, layer_, lo_, q_) do { const int G_ = GRID_C; if ((first_) < G_ && (int)blockIdx.x >= (first_)) { const Ctx Ct = make_ctx(lds_raw, g_wave); CArgs& pt = *opaque_args(); const int nw_ = (G_ - (first_)) * NW; \
        convert_moe(Ct, pt.in[21], pt.in[22], pt.in[23], (layer_), pt.ws, (lo_), min(MOE_ITEMS, (lo_) + (q_) * nw_), ((int)blockIdx.x - (first_)) * NW + Ct.wave, nw_); } } while (0)
__device__ __forceinline__ int idle_waves(int first, int G) { return first < G ? (G - first) * NW : 0; }
#define RANK_CONVERT(rank_, first_, layer_, lo_, q_) do { const int G_ = GRID_C; if ((first_) < G_ && (rank_) >= (first_)) { const Ctx Ct = make_ctx(lds_raw, g_wave); CArgs& pt = *opaque_args(); const int nw_ = (G_ - (first_)) * NW; \
        convert_moe(Ct, pt.in[21], pt.in[22], pt.in[23], (layer_), pt.ws, (lo_), min(MOE_ITEMS, (lo_) + (q_) * nw_), ((rank_) - (first_)) * NW + Ct.wave, nw_); } } while (0)
#define L0_R2 (TAILQ_P2 * tail_waves(NWG_P2, GRID_C))
#define L0_R4 (TAILQ_P4 * tail_waves(NWG_P4, GRID_C))
#define L0_R3 (TAILQ_P3 * tail_waves(1056, GRID_C))
#define L0_A (max(0, MOE_ITEMS - L0_R2 - L0_R3 - L0_R4))
#define L1_R6 (TAILQ_P6 * idle_waves(128, GRID_C))
#define L1_R9 (TAILQ_P9 * tail_waves(NWG_P9, GRID_C))
#define L1_R11 (TAILQ_P11 * tail_waves(NWG_P11, GRID_C))
#define L1_R12 (TAILQ_P12 * tail_waves(NSEQ * NGRP, GRID_C))
#define L1_R17 (TAILQ_P17 * idle_waves(64, GRID_C))
#define L1_B (min(MOE_ITEMS, L1_R6 + L1_R9 + L1_R11 + L1_R12))
#define NWG_P2 ((R / 256) * 8)
#define NWG_P4 ((R / 256) * 4)
#define NWG_P9 ((NE * RPE0 / 256) * 4)
#define NWG_P11 ((R / 256) * 20)
#define TAIL_CONVERT(nwg_, layer_, lo_, q_) do { const int G_ = GRID_C, extra_ = (nwg_) % G_; if (extra_ && (int)blockIdx.x >= extra_) { const Ctx Ct = make_ctx(lds_raw, g_wave); CArgs& pt = *opaque_args(); const int nw_ = (G_ - extra_) * NW; \
        convert_moe(Ct, pt.in[21], pt.in[22], pt.in[23], (layer_), pt.ws, (lo_), min(MOE_ITEMS, (lo_) + (q_) * nw_), ((int)blockIdx.x - extra_) * NW + Ct.wave, nw_); } } while (0)
typedef const __attribute__((address_space(4))) Args CArgs;
__device__ __forceinline__ CArgs* opaque_args() { unsigned long long p = (unsigned long long)__builtin_amdgcn_kernarg_segment_ptr(); asm volatile("" : "+s"(p)); return (CArgs*)p; }
__global__ void __launch_bounds__(NW * 64, 2) mk_fwd(Args args) {
    extern __shared__ __attribute__((aligned(16))) unsigned char lds_raw[];
    const int g_wave = __builtin_amdgcn_readfirstlane((int)threadIdx.x >> 6);
    const Ctx C0 = make_ctx(lds_raw, g_wave);
    unsigned char* const ws = opaque_args()->ws;
#if MK_SPLIT
    const int lo = args.ph_lo, hi = args.ph_hi;
#else
    constexpr int lo = 0, hi = NPHASE;
#endif
    volatile LAS unsigned* MISC = (volatile LAS unsigned*)(C0.lds + MISC_OFF);
    for (int u = C0.tid; u < 128; u += NW * 64) ((LAS unsigned*)(C0.lds + MISC_OFF - 320))[u] = 0u;
    __syncthreads();
    if (hi - lo > 1) (void)xcd_barrier_post((unsigned*)(ws + WS_CTL) + CW_BAR, MISC + 8, g_wave);
#ifndef MK_PHMASK
#define MK_PHMASK 0x3fffff
#endif
#define INR(k) (lo <= (k) && (k) < hi)
#define IN(k) ((((MK_PHMASK) >> (k)) & 1) && INR(k))
#ifndef MK_TIME_A
#define MK_TIME_A -2
#define MK_TIME_B -2
#endif
#define MK_TIME_PHASE (MK_TIME_A > -2 ? 1 : -1)
#define SEAM(k) do { if (INR(k) && INR((k) + 1)) { XcdBarrier b_; b_.bar = (unsigned*)(opaque_args()->ws + WS_CTL) + CW_BAR; b_.x = xb_xcc_id(); b_.st = (volatile LAS unsigned*)((LAS unsigned char*)lds_raw + MISC_OFF) + 8; xcd_barrier(b_, g_wave); } \
    if (MK_TIME_A > -2 && blockIdx.x == 0 && TID_OF(g_wave) == 0) { const unsigned long long t_ = __builtin_amdgcn_s_memrealtime(); \
        if ((k) == MK_TIME_A) ((unsigned long long*)(ws + WS_CTL))[1024] = t_; \
        if ((k) == MK_TIME_B) { const unsigned long long t0_ = ((unsigned long long*)(ws + WS_CTL))[1024]; ((float*)(ws + WS_CTL))[2050] = (float)(t_ - t0_) * 0.00125f; } } } while (0)
#ifndef MK_REP_PHASE
#define MK_REP_PHASE -1
#endif
#define REP(k) for (int _rep = 0; _rep < ((k) == MK_REP_PHASE ? 3 : 1); ++_rep, __syncthreads())

#define P_x ((const float*)pa.in[0])
#define P_ctx_in ((const float*)pa.in[2])
#define P_MV ((float*)(ws + WS_MV))
#define P_LBT ((float*)(ws + WS_LB))
#define P_AFF ((float*)(ws + WS_AFF))
#define P_INV ((short*)(ws + WS_INV))
#define P_SEL ((int*)(ws + WS_SEL))
#define P_GSEL ((float*)(ws + WS_GSEL))
#define P_CTXS ((float*)(ws + WS_CTXS))
#define P_HB ((bf16*)(ws + WS_HB))
#define P_UB ((bf16*)(ws + WS_UB))
#define P_HB8 (ws + WS_UB)
#define P_HBUF8 (ws + WS_HBUF)
#define P_XG ((bf16*)(ws + WS_XG))
#define P_PRJ ((bf16*)(ws + WS_PRJ))
#define P_OLOC ((bf16*)(ws + WS_OLOC))
#define P_QGG ((bf16*)(ws + WS_QGG))
#define P_SLOC ((float*)(ws + WS_UB))
#define P_PTOT ((float*)(ws + WS_PTOT))
#define P_SST ((bf16*)(ws + WS_SST))
#define P_YH ((bf16*)(ws + WS_UB))
#define P_out (pa.out)

    if (MK_TIME_A == -1 && blockIdx.x == 0 && TID_OF(g_wave) == 0) ((unsigned long long*)(ws + WS_CTL))[1024] = __builtin_amdgcn_s_memrealtime();
    if (IN(0)) REP(0) { const Ctx C = make_ctx(lds_raw, g_wave); CArgs& pa = *opaque_args(); unsigned char* const ws = pa.ws;
        mod_gemv(C, pa.in[1], pa.in[3], pa.in[4], pa.in[5], P_MV);
        for (int i = C.vcu * NW * 64 + C.tid; i < 2048; i += C.G * NW * 64) { const float* lg = pa.in[17]; P_LBT[i] = fsig(lg[2048 + i] - lg[i]); }
        __syncthreads();
        convert_small(C, pa.in[8], pa.in[14], pa.in[16], pa.in[19], ws);
        convert_moe(C, pa.in[21], pa.in[22], pa.in[23], 0, ws, 0, L0_A, C.gw, C.NGW);
    }
    SEAM(0);
    if (IN(1)) REP(1) { const Ctx C = make_ctx(lds_raw, g_wave); CArgs& pa = *opaque_args(); unsigned char* const ws = pa.ws; RowArgs A{}; A.src_lat = P_x; A.src_ctx = P_ctx_in; A.gamma = pa.in[6]; A.mv = P_MV; A.i_shift = 0; A.i_scale = 1; A.i_gate = 2; A.HB = P_HB; A.nrows = R;
        row_phase<false, false, false>(C, A); }
    SEAM(1);
    if (IN(2)) REP(2) { const Ctx C = make_ctx(lds_raw, g_wave); CArgs& pa = *opaque_args(); unsigned char* const ws = pa.ws; pg8::Gemm g{P_HB, (const bf16*)(ws + WS_W1T), R, 2048, 1024}; pg8::StaticOrder S; S.init(R, 2048, C.G, (int)blockIdx.x);
        pg8::EpiGated<0> E{P_UB, 1024, pa.in[9], 1024};
        pg8::gemm_phase<pg8::EpiGated<0>, pg8::StaticOrder, true, true>(C.lds, g, S, E, C.wave);
        TAIL_CONVERT(NWG_P2, 0, min(MOE_ITEMS, L0_A + L0_R3), TAILQ_P2); }
    SEAM(2);
    if (IN(3)) REP(3) { const Ctx C = make_ctx(lds_raw, g_wave); CArgs& pa = *opaque_args(); unsigned char* const ws = pa.ws; conv_phase(C, P_UB, P_HB, pa.in[10], pa.in[11], pa.in[12], pa.in[13]); RANK_CONVERT(C.vcu, 1056 % GRID_C, 0, L0_A, TAILQ_P3); }
    SEAM(3);
    if (IN(4)) REP(4) { const Ctx C = make_ctx(lds_raw, g_wave); CArgs& pa = *opaque_args(); unsigned char* const ws = pa.ws; pg8::Gemm g{P_HB, (const bf16*)(ws + WS_W2T), R, 1024, 1024}; pg8::StaticOrder S; S.init(R, 1024, C.G, (int)blockIdx.x);
        pg8::EpiDelta E{(bf16*)(ws + WS_OLOC), 1024, pa.in[15], P_MV + 2 * 1024, 6144};
        pg8::gemm_phase<pg8::EpiDelta, pg8::StaticOrder, true, true>(C.lds, g, S, E, C.wave);
        TAIL_CONVERT(NWG_P4, 0, min(MOE_ITEMS, L0_A + L0_R3 + L0_R2), TAILQ_P4); }
    SEAM(4);
    if (IN(5)) REP(5) { const Ctx C = make_ctx(lds_raw, g_wave); CArgs& pa = *opaque_args(); unsigned char* const ws = pa.ws; RowArgs A{}; A.src_lat = P_x; A.src_ctx = P_ctx_in; A.delta = (const bf16*)(ws + WS_OLOC); A.gamma = pa.in[7]; A.mv = P_MV; A.i_shift = 3; A.i_scale = 4; A.i_gate = 5; A.HB = P_HB; A.HB8 = P_HB8; A.AFF = P_AFF; A.router_w = pa.in[20]; A.nrows = R;
        row_phase<false, true, false>(C, A); }
    SEAM(5);
    if (IN(6)) REP(6) { const Ctx C = make_ctx(lds_raw, g_wave); CArgs& pa = *opaque_args(); unsigned char* const ws = pa.ws; topk_phase(C, 128, RPE0, P_AFF, P_SEL, P_GSEL, P_INV); IDLE_CONVERT(128, 1, 0, TAILQ_P6); }
    SEAM(6);
    if (IN(8)) REP(8) { const Ctx C = make_ctx(lds_raw, g_wave); CArgs& pa = *opaque_args(); unsigned char* const ws = pa.ws; pg8::Gemm g{(const bf16*)P_HB8, (const bf16*)(ws + WS_W13T), NE * RPE0, 4096, 1024}; pg8::StaticOrder S; S.init(NE * RPE0, 4096, C.G, (int)blockIdx.x, RPE0 / 256);
        pg8::EpiSwiGLU8 E{P_HBUF8, 2048, 1.0f / 32.0f};
        pg8::gemm_phase_f8<pg8::EpiSwiGLU8, pg8::StaticOrder, true, true, true, 1024>(C.lds, g, S, E, C.wave, P_SEL, (LAS unsigned*)(C.lds + GTAB_OFF)); }
    SEAM(8);
    if (IN(9)) REP(9) { const Ctx C = make_ctx(lds_raw, g_wave); CArgs& pa = *opaque_args(); unsigned char* const ws = pa.ws; pg8::Gemm g{(const bf16*)P_HBUF8, (const bf16*)(ws + WS_WDT), NE * RPE0, 1024, 2048}; pg8::StaticOrder S; S.init(NE * RPE0, 1024, C.G, (int)blockIdx.x, RPE0 / 256);
        pg8::EpiScaleRow E{P_XG, 1024, P_GSEL, 1.0f / 32.0f};
        pg8::gemm_phase_f8<pg8::EpiScaleRow, pg8::StaticOrder, true, true, true, 2048>(C.lds, g, S, E, C.wave, nullptr, (LAS unsigned*)(C.lds + GTAB_OFF));
        TAIL_CONVERT(NWG_P9, 1, L1_R6, TAILQ_P9); }
    SEAM(9);
    if (IN(10)) REP(10) { const Ctx C = make_ctx(lds_raw, g_wave); CArgs& pa = *opaque_args(); unsigned char* const ws = pa.ws; RowArgs A{}; A.src_lat = P_x; A.src_ctx = P_ctx_in; A.delta = (const bf16*)(ws + WS_OLOC); A.dst_lat = P_out; A.dst_ctx = P_CTXS; A.gamma = pa.in[6] + 1024; A.mv = P_MV; A.i_shift = 0; A.i_scale = 1; A.i_gate = 5; A.HB = P_HB;
        A.Y = P_XG; A.INV = P_INV; A.rpe = RPE0; A.nrows = R;
        A.mv = P_MV + 5 * 6144; A.mvg = P_MV; row_phase<true, false, false>(C, A); }
    SEAM(10);
    if (IN(11)) REP(11) { const Ctx C = make_ctx(lds_raw, g_wave); CArgs& pa = *opaque_args(); unsigned char* const ws = pa.ws; pg8::Gemm g{P_HB, (const bf16*)(ws + WS_WINT), R, 5120, 1024}; pg8::StaticOrder S; S.init(R, 5120, C.G, (int)blockIdx.x);
        pg8::EpiBf16 E{P_PRJ, 5120, P_LBT, R};
        pg8::gemm_phase<pg8::EpiBf16, pg8::StaticOrder, true, true>(C.lds, g, S, E, C.wave);
        TAIL_CONVERT(NWG_P11, 1, L1_R6 + L1_R9, TAILQ_P11); }
    SEAM(11);
    if (IN(12)) REP(12) { const Ctx C = make_ctx(lds_raw, g_wave); CArgs& pa = *opaque_args(); unsigned char* const ws = pa.ws; scanA_phase(C, P_PRJ, P_LBT, P_OLOC, P_QGG, P_SLOC, P_PTOT); RANK_CONVERT(C.vcu, (NSEQ * NGRP) % GRID_C, 1, L1_R6 + L1_R9 + L1_R11, TAILQ_P12); }
    SEAM(12);
    if (IN(13)) REP(13) { const Ctx C = make_ctx(lds_raw, g_wave); CArgs& pa = *opaque_args(); unsigned char* const ws = pa.ws; scanB_phase(C, P_SLOC, P_PTOT, P_SST); }
    SEAM(13);
    if (IN(14)) REP(14) { const Ctx C = make_ctx(lds_raw, g_wave); CArgs& pa = *opaque_args(); unsigned char* const ws = pa.ws; readout_phase(C, P_PRJ, P_OLOC, P_QGG, P_SST, pa.in[18], P_YH); }
    SEAM(14);
    if (IN(15)) REP(15) { const Ctx C = make_ctx(lds_raw, g_wave); CArgs& pa = *opaque_args(); unsigned char* const ws = pa.ws; pg8::Gemm g{P_YH, (const bf16*)(ws + WS_WOUTT), NLAT, 1024, 1024}; pg8::StaticOrder S; S.init(NLAT, 1024, C.G, (int)blockIdx.x);
        pg8::EpiDelta E{(bf16*)(ws + WS_OLOC), 1024, nullptr, P_MV + 5 * 6144 + 2 * 1024, 6144};
        pg8::gemm_phase<pg8::EpiDelta, pg8::StaticOrder, true, true>(C.lds, g, S, E, C.wave); }
    SEAM(15);
    if (IN(16)) REP(16) { const Ctx C = make_ctx(lds_raw, g_wave); CArgs& pa = *opaque_args(); unsigned char* const ws = pa.ws; RowArgs A{}; A.src_lat = P_out; A.delta = (const bf16*)(ws + WS_OLOC); A.gamma = pa.in[7] + 1024; A.mv = P_MV + 5 * 6144; A.i_shift = 3; A.i_scale = 4; A.i_gate = 5; A.HB = P_HB; A.HB8 = P_HB8; A.AFF = P_AFF; A.router_w = pa.in[20] + 16384; A.nrows = NLAT;
        row_phase<false, true, false>(C, A);
        convert_moe(C, pa.in[21], pa.in[22], pa.in[23], 1, ws, L1_B, max(L1_B, MOE_ITEMS - L1_R17), C.gw, C.NGW); }
    SEAM(16);
    if (IN(17)) REP(17) { const Ctx C = make_ctx(lds_raw, g_wave); CArgs& pa = *opaque_args(); unsigned char* const ws = pa.ws; topk_phase(C, 64, RPE1, P_AFF, P_SEL, P_GSEL, P_INV);
        IDLE_CONVERT(64, 1, max(L1_B, MOE_ITEMS - L1_R17), TAILQ_P17); }
    SEAM(17);
    if (IN(19)) REP(19) { const Ctx C = make_ctx(lds_raw, g_wave); CArgs& pa = *opaque_args(); unsigned char* const ws = pa.ws; pg8::Gemm g{(const bf16*)P_HB8, (const bf16*)(ws + WS_W13T_L1), NE * RPE1, 4096, 1024}; pg8::StaticOrder S; S.init(NE * RPE1, 4096, C.G, (int)blockIdx.x, RPE1 / 256);
        pg8::EpiSwiGLU8 E{P_HBUF8, 2048, 1.0f / 32.0f};
        pg8::gemm_phase_f8<pg8::EpiSwiGLU8, pg8::StaticOrder, true, true, true, 1024>(C.lds, g, S, E, C.wave, P_SEL, (LAS unsigned*)(C.lds + GTAB_OFF)); }
    SEAM(19);
    if (IN(20)) REP(20) { const Ctx C = make_ctx(lds_raw, g_wave); CArgs& pa = *opaque_args(); unsigned char* const ws = pa.ws; pg8::Gemm g{(const bf16*)P_HBUF8, (const bf16*)(ws + WS_WDT_L1), NE * RPE1, 1024, 2048}; pg8::StaticOrder S; S.init(NE * RPE1, 1024, C.G, (int)blockIdx.x, RPE1 / 256);
        pg8::EpiScaleRow E{P_XG, 1024, P_GSEL, 1.0f / 32.0f};
        pg8::gemm_phase_f8<pg8::EpiScaleRow, pg8::StaticOrder, true, true, true, 2048>(C.lds, g, S, E, C.wave, nullptr, (LAS unsigned*)(C.lds + GTAB_OFF)); }
    SEAM(20);
    if (IN(21)) REP(21) { const Ctx C = make_ctx(lds_raw, g_wave); CArgs& pa = *opaque_args(); unsigned char* const ws = pa.ws; RowArgs A{}; A.src_lat = P_out; A.delta = (const bf16*)(ws + WS_OLOC); A.dst_lat = P_out; A.gamma = pa.in[24]; A.mv = P_MV + 5 * 6144; A.mvg = P_MV + 5 * 6144; A.i_gate = 5; A.Y = P_XG; A.INV = P_INV; A.rpe = RPE1; A.nrows = NLAT;
        row_phase<true, false, true>(C, A);
        }
    if (MK_TIME_A > -2) { const Ctx C = make_ctx(lds_raw, g_wave); CArgs& pa = *opaque_args(); { XcdBarrier b_; b_.bar = (unsigned*)(pa.ws + WS_CTL) + CW_BAR; b_.x = xb_xcc_id(); b_.st = (volatile LAS unsigned*)((LAS unsigned char*)lds_raw + MISC_OFF) + 8; xcd_barrier(b_, g_wave); }
        if (blockIdx.x == 0 && C.tid == 0) { float add = ((const float*)(ws + WS_CTL))[2050]; if (MK_TIME_B == 21) { const unsigned long long t0_ = ((unsigned long long*)(ws + WS_CTL))[1024]; add = (float)(__builtin_amdgcn_s_memrealtime() - t0_) * (MK_TIME_A == -1 ? 0.0001f : 0.00125f); } pa.out[0] += add; } }
#undef IN
#undef P_x
#undef P_ctx_in
#undef P_MV
#undef P_LBT
#undef P_AFF
#undef P_INV
#undef P_SEL
#undef P_GSEL
#undef P_CTXS
#undef P_HB
#undef P_UB
#undef P_HB8
#undef P_HBUF8
#undef P_XG
#undef P_PRJ
#undef P_OLOC
#undef P_QGG
#undef P_SLOC
#undef P_PTOT
#undef P_SST
#undef P_YH
#undef P_out
#undef REP
#undef INR
#undef SEAM
}

extern "C" void kernel_launch(void* const* d_in, const int* in_sizes, int n_in, void* d_out, int out_size, void* d_ws, size_t ws_size, hipStream_t stream) {
    static int grid = 0;
    if (grid == 0) {
        if (n_in != 25 || in_sizes[0] != NLAT * D || out_size != NLAT * D || ws_size < WS_END) { fprintf(stderr, "kernel_launch: unexpected shapes (n_in %d, in0 %d, out %d, ws %zu)\n", n_in, n_in > 0 ? in_sizes[0] : -1, out_size, ws_size); grid = -1; return; }
        int dev = 0, cus = 0, per_cu = 0;
        if (hipGetDevice(&dev) != hipSuccess || hipDeviceGetAttribute(&cus, hipDeviceAttributeMultiprocessorCount, dev) != hipSuccess) { grid = -1; return; }
        if (hipFuncSetAttribute((const void*)mk_fwd, hipFuncAttributeMaxDynamicSharedMemorySize, LDS_BYTES) != hipSuccess) { fprintf(stderr, "kernel_launch: hipFuncSetAttribute failed\n"); grid = -1; return; }
        if (hipOccupancyMaxActiveBlocksPerMultiprocessor(&per_cu, (const void*)mk_fwd, NW * 64, LDS_BYTES) != hipSuccess || per_cu < 1) { fprintf(stderr, "kernel_launch: occupancy query reports %d blocks per CU\n", per_cu); (void)hipGetLastError(); grid = -1; return; }
        if (cus != GRID_C) { fprintf(stderr, "kernel_launch: built for a %d-CU device, found %d CUs\n", GRID_C, cus); grid = -1; return; }
        grid = cus;
    }
    if (grid < 0) return;
    if (hipMemsetAsync((char*)d_ws + WS_CTL, 0, CTL_ZERO_BYTES, stream) != hipSuccess) { fprintf(stderr, "kernel_launch: memset failed\n"); return; }
    Args a{};
    for (int i = 0; i < 25; ++i) a.in[i] = (const float*)d_in[i];
    a.out = (float*)d_out; a.ws = (unsigned char*)d_ws;
#if MK_SPLIT
    for (int p = 0; p < NPHASE; ++p) { a.ph_lo = p; a.ph_hi = p + 1; hipLaunchKernelGGL(mk_fwd, dim3(grid), dim3(NW * 64), LDS_BYTES, stream, a); }
#else
    a.ph_lo = 0; a.ph_hi = NPHASE;
#ifndef MK_COOP
#define MK_COOP 1
#endif
#if MK_COOP
    void* kargs[] = {&a};
    hipError_t e = hipLaunchCooperativeKernel((const void*)mk_fwd, dim3(grid), dim3(NW * 64), kargs, LDS_BYTES, stream);
    if (e != hipSuccess) fprintf(stderr, "kernel_launch: cooperative launch failed: %s (grid %d)\n", hipGetErrorString(e), grid);
#else
    hipLaunchKernelGGL(mk_fwd, dim3(grid), dim3(NW * 64), LDS_BYTES, stream, a);
#endif
#endif
}
```

```cpp
#include <hip/hip_runtime.h>
#include <hip/hip_cooperative_groups.h>
#include <cstdio>
#include <cstdint>
namespace cg = cooperative_groups;

#ifndef MK_SPLIT
#define MK_SPLIT 0
#endif

__device__ __forceinline__ int lane_id() { int l; asm volatile("v_mbcnt_lo_u32_b32 %0, -1, 0\n\tv_mbcnt_hi_u32_b32 %0, -1, %0" : "=v"(l)); return l; }
#define TID_OF(wv) ((wv) * 64 + lane_id())
namespace pg8 {
#define PG8_LAS __attribute__((address_space(3)))
typedef unsigned short bf16_t;
typedef short bf16x8 __attribute__((ext_vector_type(8)));
typedef float f32x4 __attribute__((ext_vector_type(4)));
typedef unsigned u32x4 __attribute__((ext_vector_type(4)));
constexpr int BM = 256, BK = 64, HALF = 128, HTB = HALF * BK * 2  , STAGE_BYTES = 8 * HTB, NXCD = 8, WGM = 8;

__host__ __device__ __forceinline__ int lds_byte(int r, int c) { const int st = (r >> 4) * 2 + (c >> 5), rr = r & 15, cc = c & 31, ob = rr * 64 + cc * 2; return st * 1024 + (ob ^ (((ob >> 9) & 1) << 5)); }
__host__ __device__ __forceinline__ void stage_rc(int b, int& R, int& C) { const int st = b / 1024, sb = b % 1024, swz = sb ^ (((sb >> 9) & 1) << 5); R = (st >> 1) * 16 + swz / 64; C = (st & 1) * 32 + (swz % 64) / 2; }
__host__ __device__ __forceinline__ int perm32(int rho) { const int n = rho >> 4, i = rho & 15; return 8 * (i >> 2) + 4 * n + (i & 3); }

struct Unit { int pm, pn, pb; };
struct Gemm { const bf16_t* A; const bf16_t* Bt; int M, N, K; };

struct StaticOrder {
    int nM, nN, nwg, G, c, tpe;
    __host__ __device__ void init(int M, int N, int G_, int c_, int tpe_ = 0) { nM = M / BM; nN = N / BM; nwg = nM * nN; G = G_; c = c_; tpe = tpe_; }
    __host__ __device__ bool next(int i, Unit& u) const {
        const long L = (long)i * G + c; if (L >= nwg) return false;
        int wgid = (int)L; { const int q = nwg / NXCD, r = nwg % NXCD, xcd = wgid % NXCD, off = wgid / NXCD; wgid = (xcd < r ? xcd * (q + 1) : r * (q + 1) + (xcd - r) * q) + off; }
        const int nig = WGM * nN, gid = wgid / nig, fm = gid * WGM, gsz = (nM - fm) < WGM ? (nM - fm) : WGM;
        u.pm = fm + ((wgid % nig) % gsz); u.pn = (wgid % nig) / gsz; u.pb = tpe ? (u.pm / tpe) * nN + u.pn : u.pn; return true;
    }
    __device__ __forceinline__ void a_ready(const Unit&) const {}
    __device__ __forceinline__ void done(const Unit&) const {}
};

typedef float f32x32 __attribute__((ext_vector_type(32)));
struct AccQ { f32x32 q[2][2];
    __device__ __forceinline__ f32x4 get(int ai, int bj, int m, int n) const { const int i = (m * 2 + n) * 4; const f32x32& v = q[ai][bj]; return (f32x4){v[i], v[i + 1], v[i + 2], v[i + 3]}; }
    __device__ __forceinline__ void set(int ai, int bj, int m, int n, f32x4 c) { const int i = (m * 2 + n) * 4; f32x32& v = q[ai][bj]; v[i] = c[0]; v[i + 1] = c[1]; v[i + 2] = c[2]; v[i + 3] = c[3]; }
};
__device__ __forceinline__ unsigned cvt_pk_bf16(float lo, float hi) { unsigned r; asm("v_cvt_pk_bf16_f32 %0, %1, %2" : "=v"(r) : "v"(lo), "v"(hi)); return r; }
__device__ __forceinline__ float fsigmoid(float x) { return __builtin_amdgcn_rcpf(1.0f + __expf(-x)); }

struct EpiBf16 {
    static constexpr bool PERM = true, AFTER_DRAIN = false;
    bf16_t* O; int ldc; const float* lb; int hm_rows;
    __device__ __forceinline__ void operator()(const f32x4 (&acc)[2][2][4][2], const Unit& u, int wr, int wc, int fr, int fq) const {
        const int row0 = u.pm * BM + wr * 64 + fr, col0 = u.pn * BM + wc * 32 + 8 * fq;
        const bool gate = lb != nullptr && u.pn >= 4 && u.pn < 12;
        f32x4 om[2][2];
#pragma unroll
        for (int bj = 0; bj < 2; ++bj)
#pragma unroll
            for (int n = 0; n < 2; ++n) om[bj][n] = gate ? (f32x4){1.f, 1.f, 1.f, 1.f} - *(const f32x4*)(lb + (col0 - 1024) + bj * HALF + 4 * n) : (f32x4){0.f, 0.f, 0.f, 0.f};
#pragma unroll
        for (int ai = 0; ai < 2; ++ai)
#pragma unroll
            for (int m = 0; m < 4; ++m) { const int row = row0 + ai * HALF + m * 16;
                bf16_t* rowp = hm_rows ? O + ((size_t)(2 * u.pn) * hm_rows + row) * HALF + wc * 32 + 8 * fq - 0 : O + (size_t)row * ldc + col0;
                const size_t bjstep = hm_rows ? (size_t)hm_rows * HALF : (size_t)HALF;
#pragma unroll
                for (int bj = 0; bj < 2; ++bj) { f32x4 v0 = acc[ai][bj][m][0], v1 = acc[ai][bj][m][1];
                    if (gate) {
#pragma unroll
                        for (int j = 0; j < 4; ++j) { v0[j] = om[bj][0][j] * fsigmoid(-v0[j]); v1[j] = om[bj][1][j] * fsigmoid(-v1[j]); } }
                    u32x4 w; w.x = cvt_pk_bf16(v0[0], v0[1]); w.y = cvt_pk_bf16(v0[2], v0[3]); w.z = cvt_pk_bf16(v1[0], v1[1]); w.w = cvt_pk_bf16(v1[2], v1[3]);
                    *(u32x4*)(rowp + bj * bjstep) = w; } }
    }
};
template <int MODE> struct EpiGated {
    static constexpr bool PERM = true, AFTER_DRAIN = false;
    bf16_t* O; int ldc; const float* bias; int ystride;
    __device__ __forceinline__ void operator()(const f32x4 (&acc)[2][2][4][2], const Unit& u, int wr, int wc, int fr, int fq) const {
        const int row0 = u.pm * BM + wr * 64 + fr, ch0 = u.pn * HALF + wc * 32 + 8 * fq;
        f32x4 bx[2], by[2];
#pragma unroll
        for (int n = 0; n < 2; ++n) { if (MODE == 0) { bx[n] = *(const f32x4*)(bias + ch0 + 4 * n); by[n] = *(const f32x4*)(bias + ystride + ch0 + 4 * n); } else { bx[n] = (f32x4){0.f, 0.f, 0.f, 0.f}; by[n] = bx[n]; } }
#pragma unroll
        for (int ai = 0; ai < 2; ++ai)
#pragma unroll
            for (int m = 0; m < 4; ++m) { bf16_t* rowp = O + (size_t)(row0 + ai * HALF + m * 16) * ldc + ch0;
                float r[8];
#pragma unroll
                for (int n = 0; n < 2; ++n) { const f32x4 x = acc[ai][0][m][n] + bx[n], y = acc[ai][1][m][n] + by[n];
#pragma unroll
                    for (int j = 0; j < 4; ++j) r[4 * n + j] = (MODE == 0) ? x[j] * fsigmoid(y[j]) : x[j] * fsigmoid(x[j]) * y[j]; }
                u32x4 w; w.x = cvt_pk_bf16(r[0], r[1]); w.y = cvt_pk_bf16(r[2], r[3]); w.z = cvt_pk_bf16(r[4], r[5]); w.w = cvt_pk_bf16(r[6], r[7]);
                *(u32x4*)rowp = w; }
    }
};
struct EpiDelta {
    static constexpr bool PERM = true, AFTER_DRAIN = false;
    bf16_t* O; int ldc; const float* bias; const float* gate; int gstride;
    __device__ __forceinline__ void operator()(const f32x4 (&acc)[2][2][4][2], const Unit& u, int wr, int wc, int fr, int fq) const {
        const int grp = u.pm >= 128 ? 4 : (u.pm >> 5);
        const int row0 = u.pm * BM + wr * 64 + fr, col0 = u.pn * BM + wc * 32 + 8 * fq;
        const float* gp = gate + (size_t)grp * gstride + col0;
        f32x4 gv[2][2], bv[2][2];
#pragma unroll
        for (int bj = 0; bj < 2; ++bj)
#pragma unroll
            for (int n = 0; n < 2; ++n) { gv[bj][n] = *(const f32x4*)(gp + bj * HALF + 4 * n); bv[bj][n] = bias ? *(const f32x4*)(bias + col0 + bj * HALF + 4 * n) : (f32x4){0.f, 0.f, 0.f, 0.f}; }
#pragma unroll
        for (int ai = 0; ai < 2; ++ai)
#pragma unroll
            for (int m = 0; m < 4; ++m) { bf16_t* rowp = O + (size_t)(row0 + ai * HALF + m * 16) * ldc + col0;
#pragma unroll
                for (int bj = 0; bj < 2; ++bj) { const f32x4 v0 = gv[bj][0] * (acc[ai][bj][m][0] + bv[bj][0]), v1 = gv[bj][1] * (acc[ai][bj][m][1] + bv[bj][1]);
                    u32x4 w; w.x = cvt_pk_bf16(v0[0], v0[1]); w.y = cvt_pk_bf16(v0[2], v0[3]); w.z = cvt_pk_bf16(v1[0], v1[1]); w.w = cvt_pk_bf16(v1[2], v1[3]);
                    *(u32x4*)(rowp + bj * HALF) = w; } }
    }
};
struct EpiRes {
    static constexpr bool PERM = false, AFTER_DRAIN = false;
    const float* res0; float* out0; const float* res1; float* out1; const float* bias; const float* gate; int gstride;
    __device__ __forceinline__ void operator()(const f32x4 (&acc)[2][2][4][2], const Unit& u, int wr, int wc, int fr, int fq) const {
        const bool second = u.pm >= 128; const int grp = second ? 4 : (u.pm >> 5);
        const float* res = second ? res1 : res0; float* out = second ? out1 : out0;
        const int row0 = (second ? u.pm - 128 : u.pm) * BM + wr * 64 + fr, col0 = u.pn * BM + wc * 32 + 4 * fq;
        const float* gp = gate + (size_t)grp * gstride + col0;
        const unsigned off0 = ((unsigned)row0 * 1024u + (unsigned)col0) * 4u;
#pragma unroll
        for (int bj = 0; bj < 2; ++bj) {
            f32x4 gv[2], bv[2], rv[2][2][4];
#pragma unroll
            for (int n = 0; n < 2; ++n) { gv[n] = *(const f32x4*)(gp + bj * HALF + n * 16); bv[n] = bias ? *(const f32x4*)(bias + col0 + bj * HALF + n * 16) : (f32x4){0.f, 0.f, 0.f, 0.f}; }
#pragma unroll
            for (int n = 0; n < 2; ++n)
#pragma unroll
                for (int ai = 0; ai < 2; ++ai)
#pragma unroll
                    for (int m = 0; m < 4; ++m) rv[n][ai][m] = *(const f32x4*)((const char*)res + (off0 + (unsigned)(((ai * HALF + m * 16) * 1024 + bj * HALF + n * 16) * 4)));
#pragma unroll
            for (int n = 0; n < 2; ++n)
#pragma unroll
                for (int ai = 0; ai < 2; ++ai)
#pragma unroll
                    for (int m = 0; m < 4; ++m) *(f32x4*)((char*)out + (off0 + (unsigned)(((ai * HALF + m * 16) * 1024 + bj * HALF + n * 16) * 4))) = rv[n][ai][m] + gv[n] * (acc[ai][bj][m][n] + bv[n]);
            asm volatile("" ::: "memory"); }
    }
};
struct EpiScaleRow {
    static constexpr bool PERM = true, AFTER_DRAIN = false;
    bf16_t* O; int ldc; const float* rs; float mul;
    __device__ __forceinline__ void operator()(const AccQ& acc, const Unit& u, int wr, int wc, int fr, int fq) const {
        const int row0 = u.pm * BM + wr * 64 + fr, col0 = u.pn * BM + wc * 32 + 8 * fq;
#pragma unroll
        for (int ai = 0; ai < 2; ++ai)
#pragma unroll
            for (int m = 0; m < 4; ++m) { const int row = row0 + ai * HALF + m * 16; const float s = rs[row] * mul; bf16_t* rowp = O + (size_t)row * ldc + col0;
#pragma unroll
                for (int bj = 0; bj < 2; ++bj) { const f32x4 v0 = acc.get(ai, bj, m, 0) * s, v1 = acc.get(ai, bj, m, 1) * s;
                    u32x4 w; w.x = cvt_pk_bf16(v0[0], v0[1]); w.y = cvt_pk_bf16(v0[2], v0[3]); w.z = cvt_pk_bf16(v1[0], v1[1]); w.w = cvt_pk_bf16(v1[2], v1[3]);
                    *(u32x4*)(rowp + bj * HALF) = w; }
                asm volatile("" ::: "memory"); }
    }
};

typedef unsigned u32x2 __attribute__((ext_vector_type(2)));
__device__ __forceinline__ unsigned pk4_fp8(float a, float b, float c, float d) { unsigned lo, hi; asm("v_cvt_pk_fp8_f32 %0, %1, %2" : "=v"(lo) : "v"(a), "v"(b)); asm("v_cvt_pk_fp8_f32 %0, %1, %2" : "=v"(hi) : "v"(c), "v"(d)); return (lo & 0xffffu) | (hi << 16); }
struct EpiSwiGLU8 {
    static constexpr bool PERM = true, AFTER_DRAIN = false;
    unsigned char* O; int ldc; float s;
    __device__ __forceinline__ void operator()(const AccQ& acc, const Unit& u, int wr, int wc, int fr, int fq) const {
        const int row0 = u.pm * BM + wr * 64 + fr, ch0 = u.pn * HALF + wc * 32 + 8 * fq;
#pragma unroll
        for (int ai = 0; ai < 2; ++ai)
#pragma unroll
            for (int m = 0; m < 4; ++m) { unsigned char* rowp = O + (size_t)(row0 + ai * HALF + m * 16) * ldc + ch0;
                float r[8];
#pragma unroll
                for (int n = 0; n < 2; ++n) { const f32x4 x = acc.get(ai, 0, m, n) * s, y = acc.get(ai, 1, m, n) * s;
#pragma unroll
                    for (int j = 0; j < 4; ++j) r[4 * n + j] = x[j] * fsigmoid(x[j]) * y[j]; }
                u32x2 w; w.x = pk4_fp8(r[0], r[1], r[2], r[3]); w.y = pk4_fp8(r[4], r[5], r[6], r[7]);
                *(u32x2*)rowp = w; }
    }
};


template <class Epi, class Sched, bool ALIGN_EPI = false, bool SP2 = false, bool GATHER = false>
__device__ __forceinline__ void gemm_phase(PG8_LAS unsigned char* lds, const Gemm g, const Sched& S, const Epi& E, const int wv, const int* gsel = nullptr, PG8_LAS unsigned* gtab = nullptr) {
    const int tid = TID_OF(wv), wid = wv, lane = tid & 63, wr = wid >> 2, wc = wid & 3, fr = lane & 15, fq = lane >> 4;
    const int K = g.K, nt = K / BK;
    unsigned voffA[2], voffB[2]; int gR[2]; unsigned gC2[2];
#pragma unroll
    for (int i = 0; i < 2; ++i) { int R, C; stage_rc(tid * 16 + i * 8192, R, C); const int Rb = Epi::PERM ? ((R & ~31) + perm32(R & 31)) : R;
        voffA[i] = (unsigned)(R * K + C) * 2u; voffB[i] = (unsigned)(Rb * K + C) * 2u; gR[i] = R; gC2[i] = (unsigned)C * 2u; }
    unsigned cur0[2] = {0u, 0u}, cur1[2] = {0u, 0u}, nx0[2] = {0u, 0u}, nx1[2] = {0u, 0u};
    if constexpr (GATHER) { Unit uu; for (int i = 0; S.next(i, uu); ++i) if (tid < 256) gtab[i * 256 + tid] = (unsigned)gsel[uu.pm * 256 + tid] * (unsigned)(K * 2);
        __syncthreads(); }
#define PG8_GOFFS(ui_, o0, o1) do { _Pragma("unroll") for (int i = 0; i < 2; ++i) { o0[i] = gtab[(ui_) * 256 + gR[i]] + gC2[i]; o1[i] = gtab[(ui_) * 256 + 128 + gR[i]] + gC2[i]; } } while (0)
#define PG8_STAGE_A(bufoff, ptr_plain, ptr_gather, goffs) do { if constexpr (GATHER) { PG8_STAGE(bufoff, ptr_gather, goffs); } else { PG8_STAGE(bufoff, ptr_plain, voffA); } } while (0)
    const size_t kstep = (size_t)(BK * 2);
    const size_t hstep = (size_t)HALF * K * 2;
    const size_t tstep = 2 * hstep;
    const unsigned ldsw = (unsigned)wid * 1024u;
    const int aoff = lds_byte(wr * 64 + fr, fq * 8), boff = lds_byte(wc * 32 + fr, fq * 8);
#define PG8_SA(b, h) (((b) * 2 + (h)) * HTB)
#define PG8_SB(b, h) ((4 + (b) * 2 + (h)) * HTB)
#define PG8_STAGE(bufoff, gbase, voff) do { _Pragma("unroll") for (int _i = 0; _i < 2; ++_i) \
        __builtin_amdgcn_global_load_lds((const unsigned*)((const char*)(gbase) + (voff)[_i]), (PG8_LAS unsigned*)(lds + (bufoff) + ldsw + _i * 8192), 16, 0, 0); } while (0)
#define PG8_LDA(dst, b, h) do { _Pragma("unroll") for (int m = 0; m < 4; ++m) _Pragma("unroll") for (int k = 0; k < 2; ++k) dst[m][k] = *(const PG8_LAS bf16x8*)(lds + PG8_SA(b, h) + aoff + m * 2048 + k * 1024); } while (0)
#define PG8_LDB(dst, b, h) do { _Pragma("unroll") for (int n = 0; n < 2; ++n) _Pragma("unroll") for (int k = 0; k < 2; ++k) dst[n][k] = *(const PG8_LAS bf16x8*)(lds + PG8_SB(b, h) + boff + n * 2048 + k * 1024); } while (0)
#define PG8_MMA(ai, bj, At, Bt) do { __builtin_amdgcn_s_setprio(1); _Pragma("unroll") for (int m = 0; m < 4; ++m) _Pragma("unroll") for (int n = 0; n < 2; ++n) _Pragma("unroll") for (int k = 0; k < 2; ++k) \
        acc[ai][bj][m][n] = __builtin_amdgcn_mfma_f32_16x16x32_bf16(Bt[n][k], At[m][k], acc[ai][bj][m][n], 0, 0, 0); __builtin_amdgcn_s_setprio(0); } while (0)
#define PG8_WAIT_V(n) asm volatile("s_waitcnt vmcnt(" #n ")" ::: "memory")
#define PG8_WAIT_L(n) asm volatile("s_waitcnt lgkmcnt(" #n ")" ::: "memory")
#define PG8_BAR __builtin_amdgcn_s_barrier()
#define PG8_SCHED __builtin_amdgcn_sched_barrier(0)
    Unit cur, nxt; int ui = 0;
    if (!S.next(0, cur)) return;
    f32x4 acc[2][2][4][2];
#pragma unroll
    for (int a = 0; a < 2; ++a)
#pragma unroll
        for (int b = 0; b < 2; ++b)
#pragma unroll
            for (int m = 0; m < 4; ++m)
#pragma unroll
                for (int n = 0; n < 2; ++n) acc[a][b][m][n] = (f32x4){0.f, 0.f, 0.f, 0.f};
    bf16x8 At[4][2], B0[2][2], B1[2][2];
    const char* cA = (const char*)g.A + (size_t)cur.pm * tstep; const char* cB = (const char*)g.Bt + (size_t)cur.pb * tstep;
    const char* const gA = (const char*)g.A;
    if constexpr (GATHER) PG8_GOFFS(0, cur0, cur1);
    S.a_ready(cur);
    if constexpr (SP2) {
        PG8_STAGE(PG8_SB(0, 0), cB, voffB); PG8_STAGE(PG8_SB(0, 1), cB + hstep, voffB); PG8_STAGE_A(PG8_SA(0, 0), cA, gA, cur0); PG8_STAGE_A(PG8_SA(0, 1), cA + hstep, gA, cur1);
        if (wr == 1) PG8_BAR;
        PG8_WAIT_V(2); PG8_BAR;
        PG8_STAGE(PG8_SB(1, 0), cB + kstep, voffB); PG8_STAGE_A(PG8_SA(1, 0), cA + kstep, gA + kstep, cur0); PG8_STAGE(PG8_SB(1, 1), cB + hstep + kstep, voffB);
        PG8_WAIT_V(6); PG8_BAR;
    } else {
        PG8_STAGE(PG8_SB(0, 0), cB, voffB); PG8_STAGE_A(PG8_SA(0, 0), cA, gA, cur0); PG8_STAGE(PG8_SB(0, 1), cB + hstep, voffB); PG8_STAGE_A(PG8_SA(0, 1), cA + hstep, gA, cur1);
        if (wr == 1) PG8_BAR;
        PG8_WAIT_V(4); PG8_BAR;
        PG8_STAGE(PG8_SB(1, 0), cB + kstep, voffB); PG8_STAGE_A(PG8_SA(1, 0), cA + kstep, gA + kstep, cur0); PG8_STAGE(PG8_SB(1, 1), cB + hstep + kstep, voffB);
        PG8_WAIT_V(6); PG8_BAR;
    }
    for (;;) {
        const bool has_next = S.next(ui + 1, nxt);
        if constexpr (GATHER) { if (has_next) PG8_GOFFS(ui + 1, nx0, nx1); else { _Pragma("unroll") for (int i = 0; i < 2; ++i) { nx0[i] = cur0[i]; nx1[i] = cur1[i]; } } }
        const char* nA = has_next ? (const char*)g.A + (size_t)nxt.pm * tstep : cA; const char* nB = has_next ? (const char*)g.Bt + (size_t)nxt.pb * tstep : cB;
#pragma unroll 1
        for (int t = 0; t < nt; t += 2) {
            const bool last = (t == nt - 2);
            const char* a1 = cA + (size_t)(t + 1) * kstep;
            const char* a2 = last ? nA : cA + (size_t)(t + 2) * kstep; const char* b2 = last ? nB : cB + (size_t)(t + 2) * kstep;
            const char* a3 = a2 + kstep; const char* b3 = b2 + kstep;
            const char* ga1 = gA + (size_t)(t + 1) * kstep; const char* ga2 = last ? gA : gA + (size_t)(t + 2) * kstep; const char* ga3 = ga2 + kstep;
            unsigned o2h0[2], o2h1[2];
#pragma unroll
            for (int i = 0; i < 2; ++i) { o2h0[i] = last ? nx0[i] : cur0[i]; o2h1[i] = last ? nx1[i] : cur1[i]; }
            if (last && has_next) S.a_ready(nxt);
            if constexpr (SP2) {
            PG8_LDB(B0, 0, 0); PG8_LDB(B1, 0, 1); PG8_SCHED; PG8_LDA(At, 0, 0); PG8_STAGE_A(PG8_SA(1, 1), a1 + hstep, ga1, cur1);
            PG8_WAIT_V(8); PG8_WAIT_L(0); PG8_BAR; PG8_MMA(0, 0, At, B0); PG8_MMA(0, 1, At, B1); PG8_BAR; PG8_SCHED;
            PG8_LDA(At, 0, 1); PG8_STAGE(PG8_SB(0, 0), b2, voffB); PG8_STAGE(PG8_SB(0, 1), b2 + hstep, voffB); PG8_STAGE_A(PG8_SA(0, 0), a2, ga2, o2h0);
            PG8_WAIT_V(8); PG8_WAIT_L(0); PG8_BAR; PG8_MMA(1, 0, At, B0); PG8_MMA(1, 1, At, B1); PG8_BAR; PG8_SCHED;
            PG8_LDB(B0, 1, 0); PG8_LDB(B1, 1, 1); PG8_SCHED; PG8_LDA(At, 1, 0); PG8_STAGE_A(PG8_SA(0, 1), a2 + hstep, ga2, o2h1);
            PG8_WAIT_V(8); PG8_WAIT_L(0); PG8_BAR; PG8_MMA(0, 0, At, B0); PG8_MMA(0, 1, At, B1); PG8_BAR; PG8_SCHED;
            PG8_LDA(At, 1, 1); PG8_STAGE(PG8_SB(1, 0), b3, voffB); PG8_STAGE(PG8_SB(1, 1), b3 + hstep, voffB); PG8_STAGE_A(PG8_SA(1, 0), a3, ga3, o2h0);
            PG8_WAIT_V(8); PG8_WAIT_L(0); PG8_BAR; PG8_MMA(1, 0, At, B0); PG8_MMA(1, 1, At, B1); PG8_BAR; PG8_SCHED;
            } else {
            PG8_LDB(B0, 0, 0); PG8_SCHED; PG8_LDA(At, 0, 0); PG8_STAGE_A(PG8_SA(1, 1), a1 + hstep, ga1, cur1);
            PG8_WAIT_L(8); PG8_BAR; PG8_WAIT_L(0); PG8_MMA(0, 0, At, B0); PG8_BAR; PG8_SCHED;
            PG8_LDB(B1, 0, 1); PG8_STAGE(PG8_SB(0, 0), b2, voffB);
            PG8_BAR; PG8_WAIT_L(0); PG8_MMA(0, 1, At, B1); PG8_BAR;
            PG8_LDA(At, 0, 1); PG8_STAGE_A(PG8_SA(0, 0), a2, ga2, o2h0);
            PG8_BAR; PG8_WAIT_L(0); PG8_MMA(1, 0, At, B0); PG8_BAR; PG8_SCHED;
            PG8_STAGE(PG8_SB(0, 1), b2 + hstep, voffB);
            PG8_WAIT_V(6); PG8_BAR; PG8_MMA(1, 1, At, B1); PG8_BAR;
            PG8_LDB(B0, 1, 0); PG8_SCHED; PG8_LDA(At, 1, 0); PG8_STAGE_A(PG8_SA(0, 1), a2 + hstep, ga2, o2h1);
            PG8_WAIT_L(8); PG8_BAR; PG8_WAIT_L(0); PG8_MMA(0, 0, At, B0); PG8_BAR; PG8_SCHED;
            PG8_LDB(B1, 1, 1); PG8_STAGE(PG8_SB(1, 0), b3, voffB);
            PG8_BAR; PG8_WAIT_L(0); PG8_MMA(0, 1, At, B1); PG8_BAR;
            PG8_LDA(At, 1, 1); PG8_STAGE_A(PG8_SA(1, 0), a3, ga3, o2h0);
            PG8_BAR; PG8_WAIT_L(0); PG8_MMA(1, 0, At, B0); PG8_BAR; PG8_SCHED;
            PG8_STAGE(PG8_SB(1, 1), b3 + hstep, voffB);
            PG8_WAIT_V(6); PG8_BAR; PG8_MMA(1, 1, At, B1); PG8_BAR;
            }
        }
        if constexpr (ALIGN_EPI) { if (wr == 0) PG8_BAR; }
        if constexpr (!Epi::AFTER_DRAIN) { int tq = tid; asm volatile("" : "+v"(tq)); const int lq = tq & 63; E(acc, cur, wr, wc, lq & 15, lq >> 4); S.done(cur); }
        if (!has_next) break;
#pragma unroll
        for (int a = 0; a < 2; ++a)
#pragma unroll
            for (int b = 0; b < 2; ++b)
#pragma unroll
                for (int m = 0; m < 4; ++m)
#pragma unroll
                    for (int n = 0; n < 2; ++n) acc[a][b][m][n] = (f32x4){0.f, 0.f, 0.f, 0.f};
        cur = nxt; cA = nA; cB = nB; ++ui;
#pragma unroll
        for (int i = 0; i < 2; ++i) { cur0[i] = nx0[i]; cur1[i] = nx1[i]; }
        if constexpr (ALIGN_EPI) { if (wr == 1) PG8_BAR; }
    }
    PG8_WAIT_V(0);
    if constexpr (!ALIGN_EPI) { if (wr == 0) PG8_BAR; }
    PG8_BAR;
    if constexpr (Epi::AFTER_DRAIN) { E.fused(acc, cur, wr, wc, fr, fq, lds, wid, lane); S.done(cur); }
#undef PG8_SA
#undef PG8_SB
#undef PG8_STAGE
#undef PG8_STAGE_A
#undef PG8_GOFFS
#undef PG8_LDA
#undef PG8_LDB
#undef PG8_MMA
#undef PG8_WAIT_V
#undef PG8_WAIT_L
#undef PG8_BAR
#undef PG8_SCHED
}
typedef int v4i_t __attribute__((ext_vector_type(4)));
typedef int v8i_t __attribute__((ext_vector_type(8)));
typedef short s16x16_ld __attribute__((ext_vector_type(16), aligned(16)));
typedef v8i_t v8i_ld __attribute__((aligned(16)));
template <class Epi, class Sched, bool ALIGN_EPI = false, bool SP2 = false, bool GATHER = false, int KC = 0>
__device__ __forceinline__ void gemm_phase_f8(PG8_LAS unsigned char* lds, const Gemm g, const Sched& S, const Epi& E, const int wv, const int* gsel = nullptr, PG8_LAS unsigned* gtab = nullptr) {
    const int tid = TID_OF(wv), wid = wv, lane = tid & 63, wr = wid >> 2, wc = wid & 3, fr = lane & 15, fq = lane >> 4;
    const int K = KC ? KC : g.K, nt = K / 128;
    unsigned voffA[2], voffB[2]; int gR[2]; unsigned gC2[2];
#pragma unroll
    for (int i = 0; i < 2; ++i) { int R, C; stage_rc(tid * 16 + i * 8192, R, C); const int Rb = Epi::PERM ? ((R & ~31) + perm32(R & 31)) : R;
        voffA[i] = (unsigned)(R * K) + (unsigned)C * 2u; voffB[i] = (unsigned)(Rb * K) + (unsigned)C * 2u; gR[i] = R; gC2[i] = (unsigned)C * 2u; }
    unsigned cur0[2] = {0u, 0u}, cur1[2] = {0u, 0u}, nx0[2] = {0u, 0u}, nx1[2] = {0u, 0u};
    if constexpr (GATHER) { Unit uu; for (int i = 0; S.next(i, uu); ++i) if (tid < 256) ((PG8_LAS float*)gtab)[i * 256 + tid] = __uint_as_float((unsigned)(gsel ? gsel[uu.pm * 256 + tid] : uu.pm * 256 + tid) * (unsigned)K);
        __syncthreads(); }
#define PG8_GOFFS(ui_, o0, o1) do { _Pragma("unroll") for (int i = 0; i < 2; ++i) { o0[i] = __float_as_uint(((const PG8_LAS float*)gtab)[(ui_) * 256 + gR[i]]) + gC2[i]; o1[i] = __float_as_uint(((const PG8_LAS float*)gtab)[(ui_) * 256 + 128 + gR[i]]) + gC2[i]; } } while (0)
#define PG8_STAGE_A(bufoff, ptr_plain, ptr_gather, goffs) do { if constexpr (GATHER) { PG8_STAGE(bufoff, ptr_gather, goffs); } else { PG8_STAGE(bufoff, ptr_plain, voffA); } } while (0)
#define PG8_STAGE_AG(bufoff, ptr_plain, ptr_gather, u_, h_) do { if constexpr (GATHER) { unsigned go_[2]; _Pragma("unroll") for (int i = 0; i < 2; ++i) go_[i] = __float_as_uint(((const PG8_LAS float*)gtab)[(u_) * 256 + (h_) * 128 + lR[i]]) + lC2[i]; PG8_STAGE(bufoff, ptr_gather, go_); } else { PG8_STAGE(bufoff, ptr_plain, lvA); } } while (0)
    const size_t kstep = (size_t)(BK * 2);
    const size_t hstep = (size_t)HALF * K;
    const size_t tstep = 2 * hstep;
    const unsigned ldsw = (unsigned)wid * 1024u;
    const int aoff = lds_byte(wr * 64 + fr, fq * 16), boff = lds_byte(wc * 32 + fr, fq * 16);
#define PG8_SA(b, h) (((b) * 2 + (h)) * HTB)
#define PG8_SB(b, h) ((4 + (b) * 2 + (h)) * HTB)
#define PG8_STAGE(bufoff, gbase, voff) do { _Pragma("unroll") for (int _i = 0; _i < 2; ++_i) \
        __builtin_amdgcn_global_load_lds((const unsigned*)((const char*)(gbase) + (voff)[_i]), (PG8_LAS unsigned*)(lds + (bufoff) + ldsw + _i * 8192), 16, 0, 0); } while (0)
#define PG8_LDA(dst, b, h) do { _Pragma("unroll") for (int m = 0; m < 4; ++m) { const bf16x8 lo_ = *(const PG8_LAS bf16x8*)(lds + PG8_SA(b, h) + aoffv + m * 2048), hi_ = *(const PG8_LAS bf16x8*)(lds + PG8_SA(b, h) + aoffv + m * 2048 + 16); dst[m] = __builtin_bit_cast(v8i_t, __builtin_shufflevector(lo_, hi_, 0, 1, 2, 3, 4, 5, 6, 7, 8, 9, 10, 11, 12, 13, 14, 15)); } } while (0)
#define PG8_LDB(dst, b, h) do { _Pragma("unroll") for (int n = 0; n < 2; ++n) { const bf16x8 lo_ = *(const PG8_LAS bf16x8*)(lds + PG8_SB(b, h) + boffv + n * 2048), hi_ = *(const PG8_LAS bf16x8*)(lds + PG8_SB(b, h) + boffv + n * 2048 + 16); dst[n] = __builtin_bit_cast(v8i_t, __builtin_shufflevector(lo_, hi_, 0, 1, 2, 3, 4, 5, 6, 7, 8, 9, 10, 11, 12, 13, 14, 15)); } } while (0)
#define aoffv laoff
#define boffv lboff
#define PG8_MMA(ai, bj, At, Bt) do { __builtin_amdgcn_s_setprio(1); _Pragma("unroll") for (int m = 0; m < 4; ++m) _Pragma("unroll") for (int n = 0; n < 2; ++n) \
        acc.set(ai, bj, m, n, __builtin_amdgcn_mfma_scale_f32_16x16x128_f8f6f4(Bt[n], At[m], acc.get(ai, bj, m, n), 0, 0, 0, 0x7f7f7f7f, 0, 0x7f7f7f7f)); __builtin_amdgcn_s_setprio(0); } while (0)
#define PG8_WAIT_V(n) asm volatile("s_waitcnt vmcnt(" #n ")" ::: "memory")
#define PG8_WAIT_L(n) asm volatile("s_waitcnt lgkmcnt(" #n ")" ::: "memory")
#define PG8_BAR __builtin_amdgcn_s_barrier()
#define PG8_SCHED __builtin_amdgcn_sched_barrier(0)
    Unit cur, nxt; int ui = 0;
    if (!S.next(0, cur)) return;
    AccQ acc;
#pragma unroll
    for (int a = 0; a < 2; ++a)
#pragma unroll
        for (int b = 0; b < 2; ++b)
#pragma unroll
            for (int e = 0; e < 32; ++e) acc.q[a][b][e] = 0.f;
    v8i_t At[4], B0[2], B1[2];
    const char* cA = (const char*)g.A + (size_t)cur.pm * tstep; const char* cB = (const char*)g.Bt + (size_t)cur.pb * tstep;
    const char* const gA = (const char*)g.A;
    if constexpr (GATHER) PG8_GOFFS(0, cur0, cur1);
    S.a_ready(cur);
    if constexpr (SP2) {
        PG8_STAGE(PG8_SB(0, 0), cB, voffB); PG8_STAGE(PG8_SB(0, 1), cB + hstep, voffB); PG8_STAGE_A(PG8_SA(0, 0), cA, gA, cur0); PG8_STAGE_A(PG8_SA(0, 1), cA + hstep, gA, cur1);
        if (wr == 1) PG8_BAR;
        PG8_WAIT_V(2); PG8_BAR;
        PG8_STAGE(PG8_SB(1, 0), cB + kstep, voffB); PG8_STAGE_A(PG8_SA(1, 0), cA + kstep, gA + kstep, cur0); PG8_STAGE(PG8_SB(1, 1), cB + hstep + kstep, voffB);
        PG8_WAIT_V(6); PG8_BAR;
    } else {
        PG8_STAGE(PG8_SB(0, 0), cB, voffB); PG8_STAGE_A(PG8_SA(0, 0), cA, gA, cur0); PG8_STAGE(PG8_SB(0, 1), cB + hstep, voffB); PG8_STAGE_A(PG8_SA(0, 1), cA + hstep, gA, cur1);
        if (wr == 1) PG8_BAR;
        PG8_WAIT_V(4); PG8_BAR;
        PG8_STAGE(PG8_SB(1, 0), cB + kstep, voffB); PG8_STAGE_A(PG8_SA(1, 0), cA + kstep, gA + kstep, cur0); PG8_STAGE(PG8_SB(1, 1), cB + hstep + kstep, voffB);
        PG8_WAIT_V(6); PG8_BAR;
    }
    for (;;) {
        const bool has_next = S.next(ui + 1, nxt);
        const char* nA = has_next ? (const char*)g.A + (size_t)nxt.pm * tstep : cA; const char* nB = has_next ? (const char*)g.Bt + (size_t)nxt.pb * tstep : cB;
#pragma unroll 1
        for (int t = 0; t < nt; t += 2) {
            const bool last = (t == nt - 2);
            unsigned lvA[2], lvB[2], lC2[2]; int lR[2];
            { int tq = tid; asm volatile("" : "+v"(tq));
#pragma unroll
              for (int i = 0; i < 2; ++i) { int R, C; stage_rc(tq * 16 + i * 8192, R, C); const int Rb = Epi::PERM ? ((R & ~31) + perm32(R & 31)) : R;
                  lvA[i] = (unsigned)(R * K) + (unsigned)C * 2u; lvB[i] = (unsigned)(Rb * K) + (unsigned)C * 2u; lR[i] = R; lC2[i] = (unsigned)C * 2u; } }
            int laoff, lboff; { int tq = tid; asm volatile("" : "+v"(tq)); const int lq = tq & 63, lfr = lq & 15, lfq = lq >> 4, lw = tq >> 6; laoff = lds_byte((lw >> 2) * 64 + lfr, lfq * 16); lboff = lds_byte((lw & 3) * 32 + lfr, lfq * 16); }
            const char* a1 = cA + (size_t)(t + 1) * kstep;
            const char* a2 = last ? nA : cA + (size_t)(t + 2) * kstep; const char* b2 = last ? nB : cB + (size_t)(t + 2) * kstep;
            const char* a3 = a2 + kstep; const char* b3 = b2 + kstep;
            const char* ga1 = gA + (size_t)(t + 1) * kstep; const char* ga2 = last ? gA : gA + (size_t)(t + 2) * kstep; const char* ga3 = ga2 + kstep;
            const int u2 = (last && has_next) ? ui + 1 : ui;
            if (last && has_next) S.a_ready(nxt);
            if constexpr (SP2) {
            PG8_LDB(B0, 0, 0); PG8_LDB(B1, 0, 1); PG8_SCHED; PG8_LDA(At, 0, 0); PG8_STAGE_AG(PG8_SA(1, 1), a1 + hstep, ga1, ui, 1);
            PG8_WAIT_V(8); PG8_WAIT_L(0); PG8_BAR; PG8_MMA(0, 0, At, B0); PG8_MMA(0, 1, At, B1); PG8_BAR; PG8_SCHED;
            PG8_LDA(At, 0, 1); PG8_STAGE(PG8_SB(0, 0), b2, lvB); PG8_STAGE(PG8_SB(0, 1), b2 + hstep, lvB); PG8_STAGE_AG(PG8_SA(0, 0), a2, ga2, u2, 0);
            PG8_WAIT_V(8); PG8_WAIT_L(0); PG8_BAR; PG8_MMA(1, 0, At, B0); PG8_MMA(1, 1, At, B1); PG8_BAR; PG8_SCHED;
            PG8_LDB(B0, 1, 0); PG8_LDB(B1, 1, 1); PG8_SCHED; PG8_LDA(At, 1, 0); PG8_STAGE_AG(PG8_SA(0, 1), a2 + hstep, ga2, u2, 1);
            PG8_WAIT_V(8); PG8_WAIT_L(0); PG8_BAR; PG8_MMA(0, 0, At, B0); PG8_MMA(0, 1, At, B1); PG8_BAR; PG8_SCHED;
            PG8_LDA(At, 1, 1); PG8_STAGE(PG8_SB(1, 0), b3, lvB); PG8_STAGE(PG8_SB(1, 1), b3 + hstep, lvB); PG8_STAGE_AG(PG8_SA(1, 0), a3, ga3, u2, 0);
            PG8_WAIT_V(8); PG8_WAIT_L(0); PG8_BAR; PG8_MMA(1, 0, At, B0); PG8_MMA(1, 1, At, B1); PG8_BAR; PG8_SCHED;
            } else {
            PG8_LDB(B0, 0, 0); PG8_SCHED; PG8_LDA(At, 0, 0); PG8_STAGE_AG(PG8_SA(1, 1), a1 + hstep, ga1, ui, 1);
            PG8_WAIT_L(8); PG8_BAR; PG8_WAIT_L(0); PG8_MMA(0, 0, At, B0); PG8_BAR; PG8_SCHED;
            PG8_LDB(B1, 0, 1); PG8_STAGE(PG8_SB(0, 0), b2, lvB);
            PG8_BAR; PG8_WAIT_L(0); PG8_MMA(0, 1, At, B1); PG8_BAR;
            PG8_LDA(At, 0, 1); PG8_STAGE_AG(PG8_SA(0, 0), a2, ga2, u2, 0);
            PG8_BAR; PG8_WAIT_L(0); PG8_MMA(1, 0, At, B0); PG8_BAR; PG8_SCHED;
            PG8_STAGE(PG8_SB(0, 1), b2 + hstep, lvB);
            PG8_WAIT_V(6); PG8_BAR; PG8_MMA(1, 1, At, B1); PG8_BAR;
            PG8_LDB(B0, 1, 0); PG8_SCHED; PG8_LDA(At, 1, 0); PG8_STAGE_AG(PG8_SA(0, 1), a2 + hstep, ga2, u2, 1);
            PG8_WAIT_L(8); PG8_BAR; PG8_WAIT_L(0); PG8_MMA(0, 0, At, B0); PG8_BAR; PG8_SCHED;
            PG8_LDB(B1, 1, 1); PG8_STAGE(PG8_SB(1, 0), b3, lvB);
            PG8_BAR; PG8_WAIT_L(0); PG8_MMA(0, 1, At, B1); PG8_BAR;
            PG8_LDA(At, 1, 1); PG8_STAGE_AG(PG8_SA(1, 0), a3, ga3, u2, 0);
            PG8_BAR; PG8_WAIT_L(0); PG8_MMA(1, 0, At, B0); PG8_BAR; PG8_SCHED;
            PG8_STAGE(PG8_SB(1, 1), b3 + hstep, lvB);
            PG8_WAIT_V(6); PG8_BAR; PG8_MMA(1, 1, At, B1); PG8_BAR;
            }
        }
        if constexpr (ALIGN_EPI) { if (wr == 0) PG8_BAR; }
        if constexpr (!Epi::AFTER_DRAIN) { int tq = tid; asm volatile("" : "+v"(tq)); const int lq = tq & 63; E(acc, cur, wr, wc, lq & 15, lq >> 4); S.done(cur); }
        if (!has_next) break;
#pragma unroll
        for (int a = 0; a < 2; ++a)
#pragma unroll
            for (int b = 0; b < 2; ++b)
#pragma unroll
                for (int e = 0; e < 32; ++e) acc.q[a][b][e] = 0.f;
        cur = nxt; cA = nA; cB = nB; ++ui;

        if constexpr (ALIGN_EPI) { if (wr == 1) PG8_BAR; }
    }
    PG8_WAIT_V(0);
    if constexpr (!ALIGN_EPI) { if (wr == 0) PG8_BAR; }
    PG8_BAR;
    if constexpr (Epi::AFTER_DRAIN) { E.fused(acc, cur, wr, wc, fr, fq, lds, wid, lane); S.done(cur); }
#undef PG8_SA
#undef PG8_SB
#undef PG8_STAGE
#undef PG8_STAGE_A
#undef PG8_STAGE_AG
#undef PG8_GOFFS
#undef PG8_LDA
#undef PG8_LDB
#undef aoffv
#undef boffv
#undef PG8_MMA
#undef PG8_WAIT_V
#undef PG8_WAIT_L
#undef PG8_BAR
#undef PG8_SCHED
}
}

constexpr int NW = 8;
constexpr int D = 1024, NB = 4, T = 8192, TCX = 256, NLAT = NB * T, NCTX = NB * TCX, R = NLAT + NCTX;
constexpr int NE = 16, FF = 2048, CAPL = 1024, CAPC = 32;
constexpr int RPE0 = 4352, RPE1 = 4096;
constexpr int HD = 128, NH = 8, NSEQ = NB * NH * 2;
constexpr int NGRP = 17;
constexpr float EPS = 1e-6f;

constexpr size_t MiB = 1u << 20;
constexpr size_t WS_CTL = 0, CTL_ZERO_BYTES = 64 * 1024;
constexpr size_t WS_MV = 1 * MiB;
constexpr size_t WS_LB = WS_MV + 256 * 1024;
constexpr size_t WS_AFF = 2 * MiB;
constexpr size_t WS_INV = 5 * MiB;
constexpr size_t WS_SEL = 7 * MiB;
constexpr size_t WS_GSEL = 7 * MiB + 512 * 1024;
constexpr size_t WS_CTXS = 8 * MiB;
constexpr size_t WS_W1T = 12 * MiB, WS_W2T = 16 * MiB, WS_WINT = 18 * MiB, WS_WOUTT = 28 * MiB;
constexpr size_t WS_PTOT = 30 * MiB;
constexpr size_t WS_W13T = 32 * MiB;
constexpr size_t WS_WDT = 160 * MiB;
constexpr size_t WS_W13T_L1 = 96 * MiB, WS_WDT_L1 = 192 * MiB;
constexpr int MOE_ITEMS = 16 * (16 * 128 + 32 * 32);
constexpr size_t WS_HB = 224 * MiB;
constexpr size_t WS_UB = 290 * MiB;
constexpr size_t WS_XG = 356 * MiB;
constexpr size_t WS_HBUF = 492 * MiB;
constexpr size_t WS_PRJ = 356 * MiB;
constexpr size_t WS_OLOC = 764 * MiB;
constexpr size_t WS_QGG = 892 * MiB;
constexpr size_t WS_SST = 32 * MiB;
constexpr size_t WS_END = 1020 * MiB;
static_assert(WS_PRJ + (size_t)R * 5120 * 2 <= WS_OLOC && WS_HBUF + (size_t)16 * RPE0 * 2048 * 2 <= WS_OLOC && WS_XG + (size_t)16 * RPE0 * 1024 * 2 <= WS_HBUF, "ws map");
static_assert(WS_HB + (size_t)R * 1024 * 2 <= WS_UB && WS_UB + (size_t)R * 1024 * 2 <= WS_XG && WS_QGG + (size_t)2 * NLAT * 1024 * 2 <= WS_END, "ws map 2");

constexpr int CW_BAR = 4096;
constexpr int LDS_BYTES = 155648;
constexpr int GTAB_OFF = 131072;
constexpr int MISC_OFF = 131072 + 20 * 1024 + 320;
static_assert(MISC_OFF + 192 <= LDS_BYTES, "LDS map");

#define GAS __attribute__((address_space(1)))
#define LAS __attribute__((address_space(3)))
typedef unsigned short bf16;
typedef unsigned v4u __attribute__((ext_vector_type(4)));
typedef unsigned v2u __attribute__((ext_vector_type(2)));
typedef float f32x4 __attribute__((ext_vector_type(4)));
typedef float f32x2 __attribute__((ext_vector_type(2)));
typedef short bf16x8 __attribute__((ext_vector_type(8)));
typedef short bf16x4 __attribute__((ext_vector_type(4)));
#define LDS_WAIT() asm volatile("s_waitcnt lgkmcnt(0)" ::: "memory")
__device__ __forceinline__ unsigned pk2(float lo, float hi) { return pg8::cvt_pk_bf16(lo, hi); }
__device__ __forceinline__ float bflo(unsigned w) { return __uint_as_float(w << 16); }
__device__ __forceinline__ float bfhi(unsigned w) { return __uint_as_float(w & 0xffff0000u); }
__device__ __forceinline__ float fsig(float x) { return __builtin_amdgcn_rcpf(1.0f + __expf(-x)); }
__device__ __forceinline__ float wave_sum(float v) {
#pragma unroll
    for (int o = 1; o < 64; o <<= 1) v += __shfl_xor(v, o);
    return v;
}

#define XB_TMO      128
#define XB_XCNT(j)  (256  + 64 * (j))
#define XB_XSUB(j)  (1280 + 64 * (j))
#define XB_XGEN(j)  (2304 + 64 * (j))
#define XB_TOP      3328
#define XB_TOPGEN   3392
#define XCD_BAR_WORDS 3456
#define XB_SPIN_CAP (1u << 20)
__device__ __forceinline__ unsigned xb_ld(unsigned* p)              { return __hip_atomic_load(p, __ATOMIC_RELAXED, __HIP_MEMORY_SCOPE_AGENT); }
__device__ __forceinline__ unsigned xb_add(unsigned* p, unsigned v) { return __hip_atomic_fetch_add(p, v, __ATOMIC_RELAXED, __HIP_MEMORY_SCOPE_AGENT); }
__device__ __forceinline__ unsigned xb_xcc_id() { return (unsigned)__builtin_amdgcn_s_getreg((3 << 11) | 20) & 0xFu; }
#define XB_SPIN(cond, bar) do { unsigned _sp = 0; while (cond) { __builtin_amdgcn_s_sleep(1); \
    if ((++_sp & 255u) == 0u) { if (xb_ld(&(bar)[XB_TMO])) break; if (_sp > XB_SPIN_CAP) { atomicAdd(&(bar)[XB_TMO], 1u); break; } } } } while (0)
struct XcdBarrier { unsigned* bar; unsigned x; volatile LAS unsigned* st; };
__device__ __forceinline__ XcdBarrier xcd_barrier_post(unsigned* bar, volatile LAS unsigned* st, const int wv) {
    XcdBarrier b; b.bar = bar; b.x = xb_xcc_id(); b.st = st;
    if (TID_OF(wv) == 0) (void)xb_add(&bar[XB_XCNT(b.x)], 1u);
    return b;
}
__device__ __forceinline__ void xcd_barrier_complete(unsigned* bar, unsigned x, unsigned& nloc, unsigned& nx) {
    const unsigned G = gridDim.x * gridDim.y * gridDim.z;
    unsigned sum, cnt, mine, sp = 0u;
    for (;;) {
        sum = 0u; cnt = 0u; mine = 0u;
#pragma unroll
        for (unsigned j = 0; j < 16; ++j) { const unsigned c = xb_ld(&bar[XB_XCNT(j)]); sum += c; cnt += (c > 0u) ? 1u : 0u; mine = (j == x) ? c : mine; }
        if (sum == G) break;
        __builtin_amdgcn_s_sleep(1);
        if ((++sp & 255u) == 0u) { if (xb_ld(&bar[XB_TMO])) break; if (sp > XB_SPIN_CAP) { atomicAdd(&bar[XB_TMO], 1u); break; } }
    }
    nloc = mine > 0u ? mine : 1u; nx = cnt > 0u ? cnt : 1u;
}
__device__ __forceinline__ void xcd_barrier(const XcdBarrier& b, const int wv) {
    asm volatile("s_waitcnt vmcnt(0)" ::: "memory");
    __syncthreads();
    if (TID_OF(wv) == 0) {
        unsigned* bar = b.bar;
        __builtin_amdgcn_s_waitcnt(0);
        unsigned nloc = b.st[0], nx = b.st[1];
        if (nloc == 0u) { xcd_barrier_complete(bar, b.x, nloc, nx); b.st[0] = nloc; b.st[1] = nx; }
        const unsigned old = xb_add(&bar[XB_XSUB(b.x)], 1u);
        const unsigned gen = old / nloc;
        if (old + 1u == (gen + 1u) * nloc) {
            __builtin_amdgcn_fence(__ATOMIC_RELEASE, "agent");
            asm volatile("s_waitcnt vmcnt(0)" ::: "memory");
            const unsigned og = xb_add(&bar[XB_TOP], 1u);
            const unsigned tg = og / nx;
            if (og + 1u == (tg + 1u) * nx) xb_add(&bar[XB_TOPGEN], 1u);
            else XB_SPIN(xb_ld(&bar[XB_TOPGEN]) == tg, bar);
            __builtin_amdgcn_fence(__ATOMIC_ACQUIRE, "agent");
            xb_add(&bar[XB_XGEN(b.x)], 1u);
            asm volatile("s_waitcnt vmcnt(0)" ::: "memory");
        } else {
            XB_SPIN(xb_ld(&bar[XB_XGEN(b.x)]) == gen, bar);
            __builtin_amdgcn_fence(__ATOMIC_ACQUIRE, "agent");
            asm volatile("s_waitcnt vmcnt(0)" ::: "memory");
        }
    }
    __syncthreads();
}

struct Ctx {
    LAS unsigned char* lds;
    int tid, lane, wave, vcu, G, gw, NGW;
};
__device__ __forceinline__ Ctx make_ctx(unsigned char* lds_raw, const int wv) {
    Ctx C; int l = lane_id(); asm volatile("" : "+v"(l));
    C.lds = (LAS unsigned char*)lds_raw; C.tid = wv * 64 + l; C.lane = l; C.wave = wv;
    C.G = gridDim.x; { const int bx = blockIdx.x; C.vcu = (C.G % 8 == 0) ? (bx % 8) * (C.G / 8) + bx / 8 : bx; }
    C.gw = C.vcu * NW + C.wave; C.NGW = C.G * NW;
    return C;
}

__device__ __forceinline__ void transpose_item(const float* W, int ldw, int k0, int n0, bf16* WT, int K, int drow0, LAS float* scr, int lane) {
    float tv[32];
    const float* wp = W + (size_t)(k0 + (lane >> 5)) * ldw + n0 + (lane & 31);
#pragma unroll
    for (int i = 0; i < 32; ++i) tv[i] = __builtin_nontemporal_load(wp + (size_t)(2 * i) * ldw);
#pragma unroll
    for (int i = 0; i < 32; ++i) scr[(2 * i + (lane >> 5)) * 33 + (lane & 31)] = tv[i];
    LDS_WAIT(); asm volatile("" ::: "memory");
    const int c = lane & 7;
#pragma unroll
    for (int j = 0; j < 4; ++j) { const int n = (lane >> 3) + 8 * j; const LAS float* s = scr + (8 * c) * 33 + n;
        v4u o; o.x = pk2(s[0 * 33], s[1 * 33]); o.y = pk2(s[2 * 33], s[3 * 33]); o.z = pk2(s[4 * 33], s[5 * 33]); o.w = pk2(s[6 * 33], s[7 * 33]);
        *(v4u*)(WT + (size_t)(drow0 + n) * K + k0 + 8 * c) = o; }
    LDS_WAIT(); asm volatile("" ::: "memory");
}
__device__ __forceinline__ void paired_src(int db, int& type, int& ch) { const int j0 = 32 * db, pn = j0 >> 8, jj = j0 & 255; type = jj >> 7; ch = 128 * pn + (jj & 127); }

__device__ __forceinline__ void convert_small(const Ctx& C, const float* w1, const float* w2, const float* win, const float* wout, unsigned char* ws) {
    LAS float* scr = (LAS float*)(C.lds + C.wave * 16384);
    constexpr int I1 = 16 * 64, I2 = 16 * 32, I3 = 16 * 160, I4 = 16 * 32, NI = I1 + I2 + I3 + I4;
    for (int it = C.gw; it < NI; it += C.NGW) {
        int r = it;
        if (r < I1) { const int kb = r / 64, db = r % 64; int type, ch; paired_src(db, type, ch); transpose_item(w1, 2048, 64 * kb, type * 1024 + ch, (bf16*)(ws + WS_W1T), 1024, 32 * db, scr, C.lane); continue; } r -= I1;
        if (r < I2) { const int kb = r / 32, db = r % 32; transpose_item(w2, 1024, 64 * kb, 32 * db, (bf16*)(ws + WS_W2T), 1024, 32 * db, scr, C.lane); continue; } r -= I2;
        if (r < I3) { const int kb = r / 160, db = r % 160; transpose_item(win, 5120, 64 * kb, 32 * db, (bf16*)(ws + WS_WINT), 1024, 32 * db, scr, C.lane); continue; } r -= I3;
        { const int kb = r / 32, db = r % 32; transpose_item(wout, 1024, 64 * kb, 32 * db, (bf16*)(ws + WS_WOUTT), 1024, 32 * db, scr, C.lane); }
    }
}
__device__ __forceinline__ void transpose_item_f8(const float* W, int ldw, int k0, int n0, unsigned char* WT, int K, int drow0, LAS float* scr, int lane) {
    float tv[32];
    const float* wp = W + (size_t)(k0 + (lane >> 5)) * ldw + n0 + (lane & 31);
#pragma unroll
    for (int i = 0; i < 32; ++i) tv[i] = __builtin_nontemporal_load(wp + (size_t)(2 * i) * ldw);
#pragma unroll
    for (int i = 0; i < 32; ++i) scr[(2 * i + (lane >> 5)) * 33 + (lane & 31)] = tv[i] * 32.0f;
    LDS_WAIT(); asm volatile("" ::: "memory");
    const int n = lane >> 1, kh = (lane & 1) * 32; const LAS float* sp = scr + kh * 33 + n;
    unsigned o[8];
#pragma unroll
    for (int q = 0; q < 8; ++q) o[q] = pg8::pk4_fp8(sp[(4 * q) * 33], sp[(4 * q + 1) * 33], sp[(4 * q + 2) * 33], sp[(4 * q + 3) * 33]);
    unsigned char* dp = WT + (size_t)(drow0 + n) * K + k0 + kh;
    *(v4u*)dp = (v4u){o[0], o[1], o[2], o[3]}; *(v4u*)(dp + 16) = (v4u){o[4], o[5], o[6], o[7]};
    LDS_WAIT(); asm volatile("" ::: "memory");
}
__device__ __forceinline__ void convert_moe(const Ctx& C, const float* wg, const float* wu, const float* wd, int layer, unsigned char* ws, int it_lo, int it_hi, int widx, int nw) {
    LAS float* scr = (LAS float*)(C.lds + C.wave * 16384);
    constexpr int IGU = 16 * 128, IDN = 32 * 32, IE = IGU + IDN;
    const size_t lo = (size_t)layer * NE * 1024 * 2048;
    unsigned char* const w13 = ws + (layer ? WS_W13T_L1 : WS_W13T); unsigned char* const wdt = ws + (layer ? WS_WDT_L1 : WS_WDT);
    for (int it = it_lo + widx; it < it_hi; it += nw) {
        const int e = it / IE; int r = it % IE;
        if (r < IGU) { const int kb = r / 128, db = r % 128; int type, ch; paired_src(db, type, ch);
            transpose_item_f8((type ? wu : wg) + lo + (size_t)e * 1024 * 2048, 2048, 64 * kb, ch, w13 + (size_t)e * 4096 * 1024, 1024, 32 * db, scr, C.lane); }
        else { r -= IGU; const int kb = r / 32, db = r % 32;
            transpose_item_f8(wd + lo + (size_t)e * 2048 * 1024, 1024, 64 * kb, 32 * db, wdt + (size_t)e * 1024 * 2048, 2048, 32 * db, scr, C.lane); }
    }
}
__device__ __forceinline__ void mod_gemv(const Ctx& C, const float* c, const float* cctx, const float* mod_w, const float* mod_b, float* MV) {
    LAS float* cond = (LAS float*)C.lds;
    LAS float* red = cond + 5 * 1024;
    bool have = false;
    for (int item = blockIdx.x; item < 192; item += C.G) {
        if (!have) { for (int i = C.tid; i < 5 * 1024; i += NW * 64) { const int g = i >> 10, k = i & 1023; const float v = g < 4 ? c[g * 1024 + k] : cctx[k]; cond[i] = v * fsig(v); } have = true; }
        __syncthreads();
        const int l = item / 96, n = (item % 96) * 64 + C.lane;
        const float* W = mod_w + (size_t)l * 1024 * 6144 + n;
        float a[5] = {0.f, 0.f, 0.f, 0.f, 0.f};
        for (int kk = 0; kk < 128; kk += 32) { float w[32];
#pragma unroll
            for (int u = 0; u < 32; ++u) w[u] = W[(size_t)(C.wave * 128 + kk + u) * 6144];
#pragma unroll
            for (int u = 0; u < 32; ++u)
#pragma unroll
                for (int g = 0; g < 5; ++g) a[g] += cond[g * 1024 + C.wave * 128 + kk + u] * w[u]; }
#pragma unroll
        for (int g = 0; g < 5; ++g) red[(C.wave * 5 + g) * 64 + C.lane] = a[g];
        __syncthreads();
        if (C.wave < 5) { float s = 0.f;
#pragma unroll
            for (int w = 0; w < 8; ++w) s += red[(w * 5 + C.wave) * 64 + C.lane];
            MV[(size_t)(l * 5 + C.wave) * 6144 + n] = s + mod_b[l * 6144 + n]; }
    }
}

struct RowArgs {
    const float* src_lat; const float* src_ctx;
    const bf16* delta;
    float* dst_lat; float* dst_ctx;
    const float* gamma;
    const float* mv;
    const float* mvg;
    int i_shift, i_scale, i_gate;
    bf16* HB; unsigned char* HB8; float* AFF; const float* router_w;
    const bf16* Y; const short* INV; int rpe;
    int nrows;
};
template <bool COMBINE, bool ROUTER, bool FINAL>
__device__ __forceinline__ void row_phase(const Ctx& C, const RowArgs& A) {
    LAS float* rwT = (LAS float*)C.lds;
    if (ROUTER) { for (int i = C.tid; i < 16384; i += NW * 64) rwT[(i & 15) * 1024 + (i >> 4)] = A.router_w[i]; __syncthreads(); }
    const int rpw = (A.nrows + C.NGW - 1) / C.NGW;
    const int r_lo = C.gw * rpw, r_hi = min(A.nrows, r_lo + rpw);
    const int l4 = 4 * C.lane;
    int cur_grp = -1;
    f32x4 ga[4], sh[4], m5[4];
#pragma unroll
    for (int j = 0; j < 4; ++j) { ga[j] = (f32x4){0.f, 0.f, 0.f, 0.f}; sh[j] = ga[j]; m5[j] = ga[j]; }
    constexpr bool DELTA = ROUTER || COMBINE;
    f32x4 vn[4]; v2u dn[4];
#pragma unroll
    for (int j = 0; j < 4; ++j) { vn[j] = (f32x4){0.f, 0.f, 0.f, 0.f}; dn[j] = (v2u){0u, 0u}; }
    if (r_lo < r_hi) { const bool ic = r_lo >= NLAT; const float* s0 = (ic ? A.src_ctx + (size_t)(r_lo - NLAT) * 1024 : A.src_lat + (size_t)r_lo * 1024);
#pragma unroll
        for (int j = 0; j < 4; ++j) { vn[j] = *(const f32x4*)(s0 + l4 + 256 * j); if (DELTA) dn[j] = *(const v2u*)(A.delta + (size_t)r_lo * 1024 + l4 + 256 * j); } }
    int svn = -1;
    if (COMBINE && r_lo < r_hi) svn = (C.lane < 16) ? (int)A.INV[(size_t)r_lo * 16 + C.lane] : -1;
    for (int r = r_lo; r < r_hi; ++r) {
        const bool isctx = r >= NLAT; const int grp = isctx ? 4 : (r >> 13);
        if (grp != cur_grp) { cur_grp = grp; const float* mvn = A.mv + (size_t)grp * 6144;
#pragma unroll
            for (int j = 0; j < 4; ++j) { const int c0 = l4 + 256 * j; const f32x4 g = *(const f32x4*)(A.gamma + c0);
                if (FINAL) { ga[j] = g; }
                else { const f32x4 sc = *(const f32x4*)(mvn + A.i_scale * 1024 + c0); ga[j] = g * (sc + 1.0f); sh[j] = *(const f32x4*)(mvn + A.i_shift * 1024 + c0); }
                if (COMBINE) m5[j] = *(const f32x4*)(A.mvg + (size_t)grp * 6144 + A.i_gate * 1024 + c0); } }
        const size_t roff = isctx ? (size_t)(r - NLAT) * 1024 : (size_t)r * 1024;
        f32x4 v[4];
#pragma unroll
        for (int j = 0; j < 4; ++j) { v[j] = vn[j]; if (DELTA) v[j] += (f32x4){bflo(dn[j].x), bfhi(dn[j].x), bflo(dn[j].y), bfhi(dn[j].y)}; }
        if (r + 1 < r_hi) { const int rn = r + 1; const bool ic = rn >= NLAT; const float* s1 = (ic ? A.src_ctx + (size_t)(rn - NLAT) * 1024 : A.src_lat + (size_t)rn * 1024);
#pragma unroll
            for (int j = 0; j < 4; ++j) { vn[j] = *(const f32x4*)(s1 + l4 + 256 * j); if (DELTA) dn[j] = *(const v2u*)(A.delta + (size_t)rn * 1024 + l4 + 256 * j); } }
        if (COMBINE) {
            f32x4 acc[4];
#pragma unroll
            for (int j = 0; j < 4; ++j) acc[j] = (f32x4){0.f, 0.f, 0.f, 0.f};
            const int sv = svn;
            if (r + 1 < r_hi) svn = (C.lane < 16) ? (int)A.INV[(size_t)(r + 1) * 16 + C.lane] : -1;
            unsigned long long m = __ballot(sv >= 0);
            while (m) {
                const int e0 = __ffsll((long long)m) - 1; m &= m - 1;
                const bool two = m != 0ull; const int e1 = two ? __ffsll((long long)m) - 1 : e0; if (two) m &= m - 1;
                const bf16* y0 = A.Y + ((size_t)e0 * A.rpe + __shfl(sv, e0)) * 1024 + l4;
                const bf16* y1 = A.Y + ((size_t)e1 * A.rpe + __shfl(sv, e1)) * 1024 + l4;
                v2u w0[4], w1[4];
#pragma unroll
                for (int j = 0; j < 4; ++j) { w0[j] = *(const v2u*)(y0 + 256 * j); w1[j] = *(const v2u*)(y1 + 256 * j); }
#pragma unroll
                for (int j = 0; j < 4; ++j) { acc[j] += (f32x4){bflo(w0[j].x), bfhi(w0[j].x), bflo(w0[j].y), bfhi(w0[j].y)};
                    if (two) acc[j] += (f32x4){bflo(w1[j].x), bfhi(w1[j].x), bflo(w1[j].y), bfhi(w1[j].y)}; } }
#pragma unroll
            for (int j = 0; j < 4; ++j) v[j] += m5[j] * acc[j];
            if (!FINAL) { float* dst = (isctx ? A.dst_ctx : A.dst_lat) + roff;
#pragma unroll
                for (int j = 0; j < 4; ++j) *(f32x4*)(dst + l4 + 256 * j) = v[j]; }
        }
        float ss = 0.f;
#pragma unroll
        for (int j = 0; j < 4; ++j) ss += (v[j].x * v[j].x + v[j].y * v[j].y) + (v[j].z * v[j].z + v[j].w * v[j].w);
        const float rstd = rsqrtf(wave_sum(ss) * (1.0f / 1024.0f) + EPS);
        if (FINAL) { float* dst = A.dst_lat + roff;
#pragma unroll
            for (int j = 0; j < 4; ++j) *(f32x4*)(dst + l4 + 256 * j) = v[j] * rstd * ga[j];
            continue; }
        f32x4 hv[4];
#pragma unroll
        for (int j = 0; j < 4; ++j) { hv[j] = v[j] * rstd * ga[j] + sh[j];
            if (ROUTER) { *(unsigned*)(A.HB8 + (size_t)r * 1024 + l4 + 256 * j) = pg8::pk4_fp8(hv[j].x, hv[j].y, hv[j].z, hv[j].w); }
            else { v2u w; w.x = pk2(hv[j].x, hv[j].y); w.y = pk2(hv[j].z, hv[j].w); *(v2u*)(A.HB + (size_t)r * 1024 + l4 + 256 * j) = w; } }
        if (ROUTER) {
            float lg[16];
#pragma unroll
            for (int e = 0; e < 16; ++e) { float s = 0.f;
#pragma unroll
                for (int j = 0; j < 4; ++j) { const f32x4 w = *(const LAS f32x4*)(rwT + e * 1024 + l4 + 256 * j); s += (hv[j].x * w.x + hv[j].y * w.y) + (hv[j].z * w.z + hv[j].w * w.w); }
                lg[e] = s; }
            float t8[8], t4[4], t2[2], t1;
#pragma unroll
            for (int i = 0; i < 8; ++i) { const bool up = (C.lane & 32) != 0; const float send = up ? lg[i] : lg[i + 8], keep = up ? lg[i + 8] : lg[i]; t8[i] = keep + __shfl_xor(send, 32); }
#pragma unroll
            for (int i = 0; i < 4; ++i) { const bool up = (C.lane & 16) != 0; const float send = up ? t8[i] : t8[i + 4], keep = up ? t8[i + 4] : t8[i]; t4[i] = keep + __shfl_xor(send, 16); }
#pragma unroll
            for (int i = 0; i < 2; ++i) { const bool up = (C.lane & 8) != 0; const float send = up ? t4[i] : t4[i + 2], keep = up ? t4[i + 2] : t4[i]; t2[i] = keep + __shfl_xor(send, 8); }
            { const bool up = (C.lane & 4) != 0; const float send = up ? t2[0] : t2[1], keep = up ? t2[1] : t2[0]; t1 = keep + __shfl_xor(send, 4); }
            t1 += __shfl_xor(t1, 2); t1 += __shfl_xor(t1, 1);
            const int e = ((C.lane >> 5) & 1) * 8 + ((C.lane >> 4) & 1) * 4 + ((C.lane >> 3) & 1) * 2 + ((C.lane >> 2) & 1);
            float mx = t1;
#pragma unroll
            for (int o = 4; o < 64; o <<= 1) mx = fmaxf(mx, __shfl_xor(mx, o));
            const float p = __expf(t1 - mx); float sum = p;
#pragma unroll
            for (int o = 4; o < 64; o <<= 1) sum += __shfl_xor(sum, o);
            if ((C.lane & 3) == 0) A.AFF[(size_t)r * 16 + e] = p / sum;
        }
    }
    if (ROUTER) __syncthreads();
}

__device__ __forceinline__ void conv_phase(const Ctx& C, const bf16* U, bf16* V, const float* dw, const float* dwb, const float* lng, const float* lnb) {
    LAS unsigned* ut = (LAS unsigned*)C.lds;
    LAS float* part = (LAS float*)(C.lds + 126976);
    LAS float* stat = part + 512;
    const int cp = C.tid;
    f32x2 wt[31];
#pragma unroll
    for (int j = 0; j < 31; ++j) wt[j] = *(const f32x2*)(dw + j * 1024 + 2 * cp);
    const f32x2 bb = *(const f32x2*)(dwb + 2 * cp), gg = *(const f32x2*)(lng + 2 * cp), be = *(const f32x2*)(lnb + 2 * cp);
    for (int tile = C.vcu; tile < 1056; tile += C.G) {
        int rowbase, t0, tseq;
        if (tile < 1024) { rowbase = (tile >> 8) * T; t0 = (tile & 255) * 32; tseq = T; } else { const int tt = tile - 1024; rowbase = NLAT + (tt >> 3) * TCX; t0 = (tt & 7) * 32; tseq = TCX; }
        { v4u tv[16];
#pragma unroll
            for (int k = 0; k < 16; ++k) { const int i = 4 * k + (C.tid >> 7), t = t0 - 15 + i; tv[k] = (v4u){0u, 0u, 0u, 0u};
                if (i < 62 && t >= 0 && t < tseq) tv[k] = *(const v4u*)(U + (size_t)(rowbase + t) * 1024 + (C.tid & 127) * 8); }
#pragma unroll
            for (int k = 0; k < 16; ++k) { const int i = 4 * k + (C.tid >> 7); if (i < 62) *(LAS v4u*)(C.lds + i * 2048 + (C.tid & 127) * 16) = tv[k]; } }
        __syncthreads();
        f32x2 ov[32];
#pragma unroll
        for (int g = 0; g < 8; ++g) {
            f32x2 a[4];
#pragma unroll
            for (int oo = 0; oo < 4; ++oo) a[oo] = bb;
#pragma unroll
            for (int jj = 0; jj < 34; ++jj) { const unsigned uw = ut[(4 * g + jj) * 512 + cp]; const f32x2 uu = (f32x2){bflo(uw), bfhi(uw)};
#pragma unroll
                for (int oo = 0; oo < 4; ++oo) { const int tap = jj - oo; if (tap >= 0 && tap <= 30) a[oo] = __builtin_elementwise_fma(wt[tap], uu, a[oo]); } }
            float r8[8];
#pragma unroll
            for (int oo = 0; oo < 4; ++oo) { ov[4 * g + oo] = a[oo]; r8[2 * oo] = a[oo].x + a[oo].y; r8[2 * oo + 1] = a[oo].x * a[oo].x + a[oo].y * a[oo].y; }
            float r4[4], r2[2], r1;
#pragma unroll
            for (int i = 0; i < 4; ++i) { const bool up = (C.lane & 32) != 0; const float send = up ? r8[i] : r8[i + 4], keep = up ? r8[i + 4] : r8[i]; r4[i] = keep + __shfl_xor(send, 32); }
#pragma unroll
            for (int i = 0; i < 2; ++i) { const bool up = (C.lane & 16) != 0; const float send = up ? r4[i] : r4[i + 2], keep = up ? r4[i + 2] : r4[i]; r2[i] = keep + __shfl_xor(send, 16); }
            { const bool up = (C.lane & 8) != 0; const float send = up ? r2[0] : r2[1], keep = up ? r2[1] : r2[0]; r1 = keep + __shfl_xor(send, 8); }
            r1 += __shfl_xor(r1, 4); r1 += __shfl_xor(r1, 2); r1 += __shfl_xor(r1, 1);
            if ((C.lane & 7) == 0) { const int vi = ((C.lane >> 5) & 1) * 4 + ((C.lane >> 4) & 1) * 2 + ((C.lane >> 3) & 1); part[((4 * g + (vi >> 1)) * 8 + C.wave) * 2 + (vi & 1)] = r1; }
            asm volatile("" ::: "memory");
        }
        __syncthreads();
        if (C.tid < 32) { float s1 = 0.f, s2 = 0.f;
#pragma unroll
            for (int w = 0; w < 8; ++w) { s1 += part[(C.tid * 8 + w) * 2]; s2 += part[(C.tid * 8 + w) * 2 + 1]; }
            const float mean = s1 * (1.0f / 1024.0f), var = fmaxf(s2 * (1.0f / 1024.0f) - mean * mean, 0.f);
            stat[C.tid * 2] = mean; stat[C.tid * 2 + 1] = rsqrtf(var + EPS); }
        __syncthreads();
#pragma unroll
        for (int tk = 0; tk < 32; ++tk) { const float mean = stat[tk * 2], rstd = stat[tk * 2 + 1];
            const float y0 = (ov[tk].x - mean) * rstd * gg.x + be.x, y1 = (ov[tk].y - mean) * rstd * gg.y + be.y;
            *(unsigned*)(V + (size_t)(rowbase + t0 + tk) * 1024 + 2 * cp) = pk2(y0 * fsig(y0), y1 * fsig(y1)); }
    }
}

__device__ __forceinline__ unsigned block_excl_scan(const Ctx& C, unsigned v, LAS unsigned* wsum, unsigned& total) {
    unsigned inc = v;
#pragma unroll
    for (int o = 1; o < 64; o <<= 1) { const unsigned t = __shfl_up(inc, o); if (C.lane >= o) inc += t; }
    if (C.lane == 63) wsum[C.wave] = inc;
    __syncthreads();
    unsigned base = 0, tot = 0;
#pragma unroll
    for (int w = 0; w < NW; ++w) { const unsigned s = wsum[w]; if (w < C.wave) base += s; tot += s; }
    __syncthreads();
    total = tot;
    return base + inc - v;
}
__device__ __forceinline__ void topk_phase(const Ctx& C, int nprob, int rpe, const float* AFF, int* SEL, float* GSEL, short* INV) {
    LAS unsigned* hist = (LAS unsigned*)C.lds;
    LAS unsigned* misc = hist + 256;
    LAS unsigned* wsum = misc + 16;
    for (int prob = blockIdx.x; prob < nprob; prob += C.G) {
        const int set = prob >> 4, e = prob & 15; const bool lat = set < 4;
        const int kk = lat ? CAPL : CAPC, rowbase = lat ? set * T : NLAT + (set - 4) * TCX, slotbase = lat ? set * CAPL : 4 * CAPL + (set - 4) * CAPC;
        const int cnt = lat ? 16 : (C.tid < 256 ? 1 : 0), base = lat ? C.tid * 16 : C.tid;
        unsigned key[16];
#pragma unroll
        for (int i = 0; i < 16; ++i) key[i] = (i < cnt) ? __float_as_uint(AFF[(size_t)(rowbase + base + i) * 16 + e]) : 0u;
        unsigned prefix = 0u, mask = 0u, need = (unsigned)kk;
#pragma unroll 1
        for (int pass = 0; pass < 4; ++pass) { const int shift = 24 - 8 * pass;
            if (C.tid < 256) hist[C.tid] = 0u;
            __syncthreads();
#pragma unroll
            for (int i = 0; i < 16; ++i) if (i < cnt && (key[i] & mask) == prefix) __hip_atomic_fetch_add(&hist[(key[i] >> shift) & 255u], 1u, __ATOMIC_RELAXED, __HIP_MEMORY_SCOPE_WORKGROUP);
            __syncthreads();
            if (C.wave == 0) { unsigned h[4], tot = 0u;
#pragma unroll
                for (int b = 0; b < 4; ++b) { h[b] = hist[4 * C.lane + b]; tot += h[b]; }
                unsigned inc = tot;
#pragma unroll
                for (int o = 1; o < 64; o <<= 1) { const unsigned t = __shfl_down(inc, o); if (C.lane + o < 64) inc += t; }
                unsigned cgt = inc - tot;
#pragma unroll
                for (int b = 3; b >= 0; --b) { if (cgt < need && need <= cgt + h[b]) { misc[0] = (unsigned)(4 * C.lane + b); misc[1] = need - cgt; } cgt += h[b]; } }
            __syncthreads();
            prefix |= misc[0] << shift; mask |= 255u << shift; need = misc[1];
        }
        unsigned neq = 0u, ngt = 0u;
#pragma unroll
        for (int i = 0; i < 16; ++i) if (i < cnt) { neq += (key[i] == prefix) ? 1u : 0u; ngt += (key[i] > prefix) ? 1u : 0u; }
        unsigned tot;
        const unsigned eq_before = block_excl_scan(C, neq, wsum, tot);
        const unsigned take_eq = (need > eq_before) ? min(neq, need - eq_before) : 0u;
        unsigned slot = block_excl_scan(C, ngt + take_eq, wsum, tot);
        unsigned eqr = eq_before;
#pragma unroll
        for (int i = 0; i < 16; ++i) if (i < cnt) {
            bool sel = key[i] > prefix;
            if (key[i] == prefix) { sel = eqr < need; ++eqr; }
            const int row = rowbase + base + i;
            if (sel) { const int s = slotbase + (int)slot; ++slot; SEL[e * rpe + s] = row; GSEL[e * rpe + s] = __uint_as_float(key[i]); INV[(size_t)row * 16 + e] = (short)s; }
            else INV[(size_t)row * 16 + e] = (short)-1; }
        if (rpe == RPE0 && set == 4 && C.tid < RPE0 - (4 * CAPL + 4 * CAPC)) { const int s = 4 * CAPL + 4 * CAPC + C.tid; SEL[e * rpe + s] = 0; GSEL[e * rpe + s] = 0.f; }
        __syncthreads();
    }
}
__device__ __forceinline__ void gather_phase(const Ctx& C, int nrows, const int* SEL, const bf16* HB, bf16* XG) {
    for (int r = C.gw; r < nrows; r += C.NGW) { const int src = SEL[r];
        const v4u a = *(const v4u*)(HB + (size_t)src * 1024 + 8 * C.lane), b = *(const v4u*)(HB + (size_t)src * 1024 + 512 + 8 * C.lane);
        *(v4u*)(XG + (size_t)r * 1024 + 8 * C.lane) = a; *(v4u*)(XG + (size_t)r * 1024 + 512 + 8 * C.lane) = b; }
}

__device__ __forceinline__ f32x4 mfma16(bf16x8 a, bf16x8 b, f32x4 c) { return __builtin_amdgcn_mfma_f32_16x16x32_bf16(a, b, c, 0, 0, 0); }
#define PRJ_AT(qn, h_, row_) (PRJ + (((size_t)((qn) * NH + (h_)) * R + (size_t)(row_)) * HD))
#define DH_AT(buf, dir_, h_, row_) ((buf) + (((size_t)((dir_) * NH + (h_)) * NLAT + (size_t)(row_)) * HD))
constexpr int QROW = 272, TROW = 144;
constexpr int SC_QG = 0, SC_KT = 17408, SC_KGT = 34816  , SC_VT = 71680  , SC_SC = 108544, SC_SEG = 117760, SC_PCH = 121856  , SC_PG = 122880;
static_assert(SC_PG + 512 <= 131072, "scan LDS map");

__device__ __forceinline__ void scanA_phase(const Ctx& C, const bf16* PRJ, const float* LB, bf16* OLOC, bf16* QGG, float* SLOC, float* PTOT) {
    LAS unsigned char* L = C.lds;
    LAS float* SEG = (LAS float*)(L + SC_SEG); LAS float* PG = (LAS float*)(L + SC_PG);
    const int lane = C.lane, w = C.wave, g = lane >> 4, lr = lane & 15, k0 = 2 * lane, seg = w;
    for (int ui = C.vcu; ui < NSEQ * NGRP; ui += C.G) {
        int seq, grp; if (ui < NSEQ * 16) { seq = ui >> 4; grp = 1 + (ui & 15); } else { seq = ui - NSEQ * 16; grp = 0; }
        const int b = seq >> 4, h = (seq >> 1) & 7, dir = seq & 1, nch = grp ? 8 : 4, sgn = dir ? -1 : 1;
        const int hc = h * HD;
        f32x4 S[8];
#pragma unroll
        for (int i = 0; i < 8; ++i) S[i] = (f32x4){0.f, 0.f, 0.f, 0.f};
        if (C.tid < 128) PG[C.tid] = 1.0f;
        const int Pb = grp ? (grp - 1) * 512 : 0, rbase = grp ? b * T : NLAT + b * TCX, tlen = grp ? T : TCX;
#define ROWC(c) (rbase + (dir ? tlen - 1 - (Pb + 64 * (c)) : Pb + 64 * (c)))
        unsigned fq[8], qq[8]; v4u vv[2];
        float pl0[8], pl1[8], kk0[8], kk1[8], pg0 = 1.f, pg1 = 1.f, pt0 = 1.f, pt1 = 1.f;
#define SC_LOAD(c) do { const int rn_ = ROWC(c); \
            _Pragma("unroll") for (int i = 0; i < 8; ++i) { const int rw_ = rn_ + sgn * (8 * seg + i); fq[i] = *(const unsigned*)(PRJ_AT(1 + dir, h, rw_) + k0); qq[i] = *(const unsigned*)(PRJ_AT(0, h, rw_) + k0); } \
            _Pragma("unroll") for (int ii = 0; ii < 2; ++ii) { const int cq = C.tid + 512 * ii; vv[ii] = *(const v4u*)(PRJ_AT(3, h, rn_ + sgn * (cq & 63)) + (cq >> 6) * 8); } } while (0)
#define SC_PREP1(c) do { float run0 = 1.f, run1 = 1.f; \
            _Pragma("unroll") for (int i = 0; i < 8; ++i) { kk0[i] = bflo(fq[i]); kk1[i] = bfhi(fq[i]);          \
                run0 *= 1.f - kk0[i]; run1 *= 1.f - kk1[i]; pl0[i] = run0; pl1[i] = run1; } \
            *(LAS f32x2*)(SEG + seg * 128 + k0) = (f32x2){run0, run1}; \
            _Pragma("unroll") for (int ii = 0; ii < 2; ++ii) { const int cq = C.tid + 512 * ii, p_ = cq & 63, v0 = (cq >> 6) * 8; LAS bf16* vt = (LAS bf16*)(L + SC_VT + ((c) & 1) * 18432) + p_; \
                const unsigned wds[4] = {vv[ii].x, vv[ii].y, vv[ii].z, vv[ii].w}; \
                _Pragma("unroll") for (int j = 0; j < 4; ++j) { vt[(v0 + 2 * j) * (TROW / 2)] = (bf16)(wds[j] & 0xffffu); vt[(v0 + 2 * j + 1) * (TROW / 2)] = (bf16)(wds[j] >> 16); } } \
            pg0 = PG[k0]; pg1 = PG[k0 + 1]; } while (0)
#define SC_PREP2(c) do { const int rc_ = ROWC(c); float pb0 = 1.f, pb1 = 1.f; pt0 = 1.f; pt1 = 1.f; \
            _Pragma("unroll") for (int s = 0; s < 8; ++s) { const f32x2 t = *(const LAS f32x2*)(SEG + s * 128 + k0); if (s < seg) { pb0 *= t.x; pb1 *= t.y; } pt0 *= t.x; pt1 *= t.y; } \
            unsigned kg0[4], kg1[4]; float kprev0 = 0.f, kprev1 = 0.f; \
            _Pragma("unroll") for (int i = 0; i < 8; ++i) { const int p_ = 8 * seg + i; \
                const float P0 = pb0 * pl0[i], P1 = pb1 * pl1[i]; \
                const float qg0 = bflo(qq[i]) * P0, qg1 = bfhi(qq[i]) * P1; \
                const float kt0 = kk0[i] * __builtin_amdgcn_rcpf(fmaxf(P0, 1e-30f)), kt1 = kk1[i] * __builtin_amdgcn_rcpf(fmaxf(P1, 1e-30f)); \
                *(LAS unsigned*)(L + SC_QG + p_ * QROW + k0 * 2) = pk2(qg0, qg1); \
                *(LAS unsigned*)(L + SC_KT + p_ * QROW + k0 * 2) = pk2(kt0, kt1); \
                const float a0 = kt0 * pt0, a1 = kt1 * pt1; \
                if (i & 1) { kg0[i >> 1] = pk2(kprev0, a0); kg1[i >> 1] = pk2(kprev1, a1); } else { kprev0 = a0; kprev1 = a1; } \
                if (grp) *(unsigned*)(DH_AT(QGG, dir, h, rc_ + sgn * p_) + k0) = pk2(qg0 * pg0, qg1 * pg1); } \
            *(LAS v4u*)(L + SC_KGT + ((c) & 1) * 18432 + k0 * TROW + seg * 16) = (v4u){kg0[0], kg0[1], kg0[2], kg0[3]}; \
            *(LAS v4u*)(L + SC_KGT + ((c) & 1) * 18432 + (k0 + 1) * TROW + seg * 16) = (v4u){kg1[0], kg1[1], kg1[2], kg1[3]}; \
            if (seg == 0) *(LAS f32x2*)(L + SC_PCH + ((c) & 1) * 512 + k0 * 4) = (f32x2){pt0, pt1}; \
            if ((c) + 1 < nch) SC_LOAD((c) + 1); } while (0)
#define SC_SCORES() do { if (seg == 0) *(LAS f32x2*)(PG + k0) = (f32x2){pg0 * pt0, pg1 * pt1}; \
            const int pi = w >> 1; \
            _Pragma("unroll") for (int tt = 0; tt < 2; ++tt) { const int si = 2 * (w & 1) + tt; f32x4 acc = (f32x4){0.f, 0.f, 0.f, 0.f}; \
                _Pragma("unroll") for (int ks = 0; ks < 4; ++ks) { const bf16x8 a = *(const LAS bf16x8*)(L + SC_QG + (16 * pi + lr) * QROW + (32 * ks + 8 * g) * 2); \
                    const bf16x8 bb = *(const LAS bf16x8*)(L + SC_KT + (16 * si + lr) * QROW + (32 * ks + 8 * g) * 2); acc = mfma16(a, bb, acc); } \
                _Pragma("unroll") for (int r = 0; r < 4; ++r) { const int p_ = 16 * pi + 4 * g + r, s_ = 16 * si + lr; const float val = (s_ <= p_) ? acc[r] : 0.f; \
                    *(LAS bf16*)(L + SC_SC + p_ * TROW + s_ * 2) = (bf16)(pk2(val, 0.f) & 0xffffu); } } } while (0)
#define SC_OUTPUTS(c) do { const int rc_ = ROWC(c); const LAS unsigned char* VTc = L + SC_VT + ((c) & 1) * 18432; f32x4 O[4]; \
            _Pragma("unroll") for (int pt = 0; pt < 4; ++pt) O[pt] = (f32x4){0.f, 0.f, 0.f, 0.f}; \
            _Pragma("unroll") for (int ks = 0; ks < 4; ++ks) { \
                v4u sw; sw.x = pk2(S[2 * ks][0], S[2 * ks][1]); sw.y = pk2(S[2 * ks][2], S[2 * ks][3]); sw.z = pk2(S[2 * ks + 1][0], S[2 * ks + 1][1]); sw.w = pk2(S[2 * ks + 1][2], S[2 * ks + 1][3]); \
                const bf16x8 sb = __builtin_bit_cast(bf16x8, sw); \
                _Pragma("unroll") for (int pt = 0; pt < 4; ++pt) { const LAS unsigned char* qp = L + SC_QG + (16 * pt + lr) * QROW + (32 * ks + 4 * g) * 2; \
                    const v2u lo = *(const LAS v2u*)qp, hi = *(const LAS v2u*)(qp + 32); \
                    const bf16x8 a = __builtin_bit_cast(bf16x8, (v4u){lo.x, lo.y, hi.x, hi.y}); O[pt] = mfma16(sb, a, O[pt]); } } \
            _Pragma("unroll") for (int ks = 0; ks < 2; ++ks) { const bf16x8 bvk = *(const LAS bf16x8*)(VTc + (16 * w + lr) * TROW + (32 * ks + 8 * g) * 2); \
                _Pragma("unroll") for (int pt = 0; pt < 4; ++pt) { const bf16x8 a = *(const LAS bf16x8*)(L + SC_SC + (16 * pt + lr) * TROW + (32 * ks + 8 * g) * 2); O[pt] = mfma16(bvk, a, O[pt]); } } \
            if (grp) { _Pragma("unroll") for (int pt = 0; pt < 4; ++pt) { const int p_ = 16 * pt + lr; \
                *(v2u*)(DH_AT(OLOC, dir, h, rc_ + sgn * p_) + 16 * w + 4 * g) = (v2u){pk2(O[pt][0], O[pt][1]), pk2(O[pt][2], O[pt][3])}; } } } while (0)
#define SC_UPDATE(c) do { const LAS unsigned char* VTc = L + SC_VT + ((c) & 1) * 18432; const LAS unsigned char* KGc = L + SC_KGT + ((c) & 1) * 18432; const LAS float* PCc = (const LAS float*)(L + SC_PCH + ((c) & 1) * 512); \
            bf16x8 bv[2]; \
            _Pragma("unroll") for (int ks = 0; ks < 2; ++ks) bv[ks] = *(const LAS bf16x8*)(VTc + (16 * w + lr) * TROW + (32 * ks + 8 * g) * 2); \
            _Pragma("unroll") for (int kt = 0; kt < 8; ++kt) { const f32x4 pc = *(const LAS f32x4*)(PCc + 16 * kt + 4 * g); S[kt] = S[kt] * pc; \
                _Pragma("unroll") for (int ks = 0; ks < 2; ++ks) { const bf16x8 a = *(const LAS bf16x8*)(KGc + (16 * kt + lr) * TROW + (32 * ks + 8 * g) * 2); S[kt] = mfma16(a, bv[ks], S[kt]); } } } while (0)
        SC_LOAD(0);
        __syncthreads();
        SC_PREP1(0);
        __syncthreads();
        SC_PREP2(0);
        __syncthreads();
        SC_SCORES();
        __syncthreads();
#pragma unroll 1
        for (int c = 0; c < nch; ++c) {
            const bool more = c + 1 < nch;
            if (more) SC_PREP1(c + 1);
            SC_OUTPUTS(c);
            __syncthreads();
            if (more) SC_PREP2(c + 1);
            SC_UPDATE(c);
            __syncthreads();
            if (more) SC_SCORES();
            __syncthreads();
        }
        if (grp < 16) {
#pragma unroll
            for (int kt = 0; kt < 8; ++kt)
#pragma unroll
                for (int r = 0; r < 4; ++r) SLOC[(((size_t)seq * 16 + grp) * 128 + 16 * kt + 4 * g + r) * 128 + 16 * w + lr] = S[kt][r]; }
        if (C.tid < 128) PTOT[((size_t)seq * NGRP + grp) * 128 + C.tid] = PG[C.tid];
        __syncthreads();
#undef ROWC
#undef SC_LOAD
#undef SC_PREP1
#undef SC_PREP2
#undef SC_SCORES
#undef SC_OUTPUTS
#undef SC_UPDATE
    }
}
__device__ __forceinline__ void scanB_phase(const Ctx& C, const float* SLOC, const float* PTOT, bf16* SST) {
    for (int id = C.vcu * (NW * 64) + C.tid; id < NSEQ * 2048; id += C.G * NW * 64) {
        const int seq = id >> 11, k = ((id >> 7) & 15) * 8, v = id & 127;
        float s[8];
#pragma unroll
        for (int i = 0; i < 8; ++i) s[i] = 0.f;
#pragma unroll 4
        for (int gi = 0; gi < 16; ++gi) { const float* pt = PTOT + ((size_t)seq * NGRP + gi) * 128 + k; const float* sl = SLOC + (((size_t)seq * 16 + gi) * 128 + k) * 128 + v;
#pragma unroll
            for (int i = 0; i < 8; ++i) s[i] = pt[i] * s[i] + sl[(size_t)i * 128];
            v4u o; o.x = pk2(s[0], s[1]); o.y = pk2(s[2], s[3]); o.z = pk2(s[4], s[5]); o.w = pk2(s[6], s[7]);
            *(v4u*)(SST + (((size_t)seq * 16 + gi) * 128 + v) * 128 + k) = o; }
    }
}
__device__ __forceinline__ void readout_phase(const Ctx& C, const bf16* PRJ, const bf16* OLOC, const bf16* QGG, const bf16* SST, const float* norm_g, bf16* YH) {
    LAS unsigned char* L = C.lds;
    constexpr int ABUF = 64 * QROW;
    LAS float* OT = (LAS float*)(L + 4 * ABUF);
    const int lane = C.lane, w = C.wave, g = lane >> 4, lr = lane & 15;
    const int p = C.tid >> 3, sg = C.tid & 7;
    f32x4 ng[4];
#pragma unroll
    for (int i = 0; i < 4; ++i) ng[i] = *(const f32x4*)(norm_g + 16 * sg + 4 * i);
    for (int ui = C.vcu; ui < NB * NH * 16; ui += C.G) {
        const int j = ui & 15, h = (ui >> 4) & 7, b = ui >> 7, hc = h * HD, row00 = b * T + 512 * j;
        bf16x8 bfr[2][4];
#pragma unroll
        for (int dir = 0; dir < 2; ++dir) { const int seq = (b * 8 + h) * 2 + dir, gs = dir ? 15 - j : j;
            const bf16* Bb = SST + (((size_t)seq * 16 + gs) * 128 + 16 * w + lr) * 128;
#pragma unroll
            for (int ks = 0; ks < 4; ++ks) bfr[dir][ks] = *(const bf16x8*)(Bb + 32 * ks + 8 * g); }
        v4u ar[2][2];
#define RO_LOADA(tile) do { _Pragma("unroll") for (int dir = 0; dir < 2; ++dir) _Pragma("unroll") for (int ii = 0; ii < 2; ++ii) { const int cq = C.tid + 512 * ii; \
            ar[dir][ii] = *(const v4u*)(DH_AT(QGG, dir, h, row00 + 64 * (tile) + (cq >> 4)) + (cq & 15) * 8); } } while (0)
#define RO_WRITEA(buf) do { _Pragma("unroll") for (int dir = 0; dir < 2; ++dir) _Pragma("unroll") for (int ii = 0; ii < 2; ++ii) { const int cq = C.tid + 512 * ii; \
            *(LAS v4u*)(L + ((buf) * 2 + dir) * ABUF + (cq >> 4) * QROW + (cq & 15) * 16) = ar[dir][ii]; } } while (0)
        RO_LOADA(0); RO_WRITEA(0);
        __syncthreads();
#pragma unroll 1
        for (int t = 0; t < 8; ++t) {
            const int buf = t & 1; const size_t row = (size_t)row00 + 64 * t + p; const int c0 = hc + 16 * sg;
            if (t < 7) RO_LOADA(t + 1);
            v4u eo[2][2]; v4u eg[2];
#pragma unroll
            for (int dir = 0; dir < 2; ++dir) { const bf16* op = DH_AT(OLOC, dir, h, row) + 16 * sg; eo[dir][0] = *(const v4u*)op; eo[dir][1] = *(const v4u*)(op + 8); }
            { const bf16* gp = PRJ_AT(4, h, row) + 16 * sg; eg[0] = *(const v4u*)gp; eg[1] = *(const v4u*)(gp + 8); }
            f32x4 O[4];
#pragma unroll
            for (int pt = 0; pt < 4; ++pt) O[pt] = (f32x4){0.f, 0.f, 0.f, 0.f};
#pragma unroll
            for (int dir = 0; dir < 2; ++dir)
#pragma unroll
                for (int ks = 0; ks < 4; ++ks)
#pragma unroll
                    for (int pt = 0; pt < 4; ++pt) { const bf16x8 a = *(const LAS bf16x8*)(L + (buf * 2 + dir) * ABUF + (16 * pt + lr) * QROW + (32 * ks + 8 * g) * 2); O[pt] = mfma16(a, bfr[dir][ks], O[pt]); }
#pragma unroll
            for (int pt = 0; pt < 4; ++pt)
#pragma unroll
                for (int r = 0; r < 4; ++r) OT[(16 * pt + 4 * g + r) * 132 + 16 * w + lr] = O[pt][r];
            if (t < 7) RO_WRITEA(buf ^ 1);
            __syncthreads();
            f32x4 o[4];
#pragma unroll
            for (int i = 0; i < 4; ++i) o[i] = *(const LAS f32x4*)(OT + p * 132 + 16 * sg + 4 * i);
#pragma unroll
            for (int dir = 0; dir < 2; ++dir) { const v4u a = eo[dir][0], bq = eo[dir][1];
                o[0] += (f32x4){bflo(a.x), bfhi(a.x), bflo(a.y), bfhi(a.y)}; o[1] += (f32x4){bflo(a.z), bfhi(a.z), bflo(a.w), bfhi(a.w)};
                o[2] += (f32x4){bflo(bq.x), bfhi(bq.x), bflo(bq.y), bfhi(bq.y)}; o[3] += (f32x4){bflo(bq.z), bfhi(bq.z), bflo(bq.w), bfhi(bq.w)}; }
            float ss = 0.f;
#pragma unroll
            for (int i = 0; i < 4; ++i) ss += (o[i].x * o[i].x + o[i].y * o[i].y) + (o[i].z * o[i].z + o[i].w * o[i].w);
            ss += __shfl_xor(ss, 1); ss += __shfl_xor(ss, 2); ss += __shfl_xor(ss, 4);
            const float rstd = rsqrtf(ss * (1.0f / 128.0f) + EPS);
            const unsigned gw[8] = {eg[0].x, eg[0].y, eg[0].z, eg[0].w, eg[1].x, eg[1].y, eg[1].z, eg[1].w};
            unsigned ow[8];
#pragma unroll
            for (int i = 0; i < 8; ++i) { const float g0 = bflo(gw[i]), g1 = bfhi(gw[i]);
                const float y0 = o[i >> 1][(2 * i) & 3] * rstd * ng[i >> 1][(2 * i) & 3] * (g0 * fsig(g0));
                const float y1 = o[i >> 1][(2 * i + 1) & 3] * rstd * ng[i >> 1][(2 * i + 1) & 3] * (g1 * fsig(g1));
                ow[i] = pk2(y0, y1); }
            bf16* yp = YH + row * 1024 + c0;
            *(v4u*)yp = (v4u){ow[0], ow[1], ow[2], ow[3]}; *(v4u*)(yp + 8) = (v4u){ow[4], ow[5], ow[6], ow[7]};
            __syncthreads();
        }
#undef RO_LOADA
#undef RO_WRITEA
    }
}

constexpr int NPHASE = 22;
struct Args { const float* in[25]; float* out; unsigned char* ws; int ph_lo, ph_hi; };
constexpr int GRID_C = 256;
constexpr int TAILQ_P2 = 5, TAILQ_P4 = 9, TAILQ_P9 = 6, TAILQ_P11 = 5, TAILQ_P6 = 4, TAILQ_P17 = 3, TAILQ_P3 = 4, TAILQ_P12 = 5;
__device__ __forceinline__ int tail_waves(int nwg, int G) { const int extra = nwg % G; return extra ? (G - extra) * NW : 0; }
#define IDLE_CONVERT(first_, layer_, lo_, q_) do { const int G_ = GRID_C; if ((first_) < G_ && (int)blockIdx.x >= (first_)) { const Ctx Ct = make_ctx(lds_raw, g_wave); CArgs& pt = *opaque_args(); const int nw_ = (G_ - (first_)) * NW; \
        convert_moe(Ct, pt.in[21], pt.in[22], pt.in[23], (layer_), pt.ws, (lo_), min(MOE_ITEMS, (lo_) + (q_) * nw_), ((int)blockIdx.x - (first_)) * NW + Ct.wave, nw_); } } while (0)
__device__ __forceinline__ int idle_waves(int first, int G) { return first < G ? (G - first) * NW : 0; }
#define RANK_CONVERT(rank_, first_, layer_, lo_, q_) do { const int G_ = GRID_C; if ((first_) < G_ && (rank_) >= (first_)) { const Ctx Ct = make_ctx(lds_raw, g_wave); CArgs& pt = *opaque_args(); const int nw_ = (G_ - (first_)) * NW; \
        convert_moe(Ct, pt.in[21], pt.in[22], pt.in[23], (layer_), pt.ws, (lo_), min(MOE_ITEMS, (lo_) + (q_) * nw_), ((rank_) - (first_)) * NW + Ct.wave, nw_); } } while (0)
#define L0_R2 (TAILQ_P2 * tail_waves(NWG_P2, GRID_C))
#define L0_R4 (TAILQ_P4 * tail_waves(NWG_P4, GRID_C))
#define L0_R3 (TAILQ_P3 * tail_waves(1056, GRID_C))
#define L0_A (max(0, MOE_ITEMS - L0_R2 - L0_R3 - L0_R4))
#define L1_R6 (TAILQ_P6 * idle_waves(128, GRID_C))
#define L1_R9 (TAILQ_P9 * tail_waves(NWG_P9, GRID_C))
#define L1_R11 (TAILQ_P11 * tail_waves(NWG_P11, GRID_C))
#define L1_R12 (TAILQ_P12 * tail_waves(NSEQ * NGRP, GRID_C))
#define L1_R17 (TAILQ_P17 * idle_waves(64, GRID_C))
#define L1_B (min(MOE_ITEMS, L1_R6 + L1_R9 + L1_R11 + L1_R12))
#define NWG_P2 ((R / 256) * 8)
#define NWG_P4 ((R / 256) * 4)
#define NWG_P9 ((NE * RPE0 / 256) * 4)
#define NWG_P11 ((R / 256) * 20)
#define TAIL_CONVERT(nwg_, layer_, lo_, q_) do { const int G_ = GRID_C, extra_ = (nwg_) % G_; if (extra_ && (int)blockIdx.x >= extra_) { const Ctx Ct = make_ctx(lds_raw, g_wave); CArgs& pt = *opaque_args(); const int nw_ = (G_ - extra_) * NW; \
        convert_moe(Ct, pt.in[21], pt.in[22], pt.in[23], (layer_), pt.ws, (lo_), min(MOE_ITEMS, (lo_) + (q_) * nw_), ((int)blockIdx.x - extra_) * NW + Ct.wave, nw_); } } while (0)
typedef const __attribute__((address_space(4))) Args CArgs;
__device__ __forceinline__ CArgs* opaque_args() { unsigned long long p = (unsigned long long)__builtin_amdgcn_kernarg_segment_ptr(); asm volatile("" : "+s"(p)); return (CArgs*)p; }
__global__ void __launch_bounds__(NW * 64, 2) mk_fwd(Args args) {
    extern __shared__ __attribute__((aligned(16))) unsigned char lds_raw[];
    const int g_wave = __builtin_amdgcn_readfirstlane((int)threadIdx.x >> 6);
    const Ctx C0 = make_ctx(lds_raw, g_wave);
    unsigned char* const ws = opaque_args()->ws;
#if MK_SPLIT
    const int lo = args.ph_lo, hi = args.ph_hi;
#else
    constexpr int lo = 0, hi = NPHASE;
#endif
    volatile LAS unsigned* MISC = (volatile LAS unsigned*)(C0.lds + MISC_OFF);
    for (int u = C0.tid; u < 128; u += NW * 64) ((LAS unsigned*)(C0.lds + MISC_OFF - 320))[u] = 0u;
    __syncthreads();
    if (hi - lo > 1) (void)xcd_barrier_post((unsigned*)(ws + WS_CTL) + CW_BAR, MISC + 8, g_wave);
#ifndef MK_PHMASK
#define MK_PHMASK 0x3fffff
#endif
#define INR(k) (lo <= (k) && (k) < hi)
#define IN(k) ((((MK_PHMASK) >> (k)) & 1) && INR(k))
#ifndef MK_TIME_A
#define MK_TIME_A -2
#define MK_TIME_B -2
#endif
#define MK_TIME_PHASE (MK_TIME_A > -2 ? 1 : -1)
#define SEAM(k) do { if (INR(k) && INR((k) + 1)) { XcdBarrier b_; b_.bar = (unsigned*)(opaque_args()->ws + WS_CTL) + CW_BAR; b_.x = xb_xcc_id(); b_.st = (volatile LAS unsigned*)((LAS unsigned char*)lds_raw + MISC_OFF) + 8; xcd_barrier(b_, g_wave); } \
    if (MK_TIME_A > -2 && blockIdx.x == 0 && TID_OF(g_wave) == 0) { const unsigned long long t_ = __builtin_amdgcn_s_memrealtime(); \
        if ((k) == MK_TIME_A) ((unsigned long long*)(ws + WS_CTL))[1024] = t_; \
        if ((k) == MK_TIME_B) { const unsigned long long t0_ = ((unsigned long long*)(ws + WS_CTL))[1024]; ((float*)(ws + WS_CTL))[2050] = (float)(t_ - t0_) * 0.00125f; } } } while (0)
#ifndef MK_REP_PHASE
#define MK_REP_PHASE -1
#endif
#define REP(k) for (int _rep = 0; _rep < ((k) == MK_REP_PHASE ? 3 : 1); ++_rep, __syncthreads())

#define P_x ((const float*)pa.in[0])
#define P_ctx_in ((const float*)pa.in[2])
#define P_MV ((float*)(ws + WS_MV))
#define P_LBT ((float*)(ws + WS_LB))
#define P_AFF ((float*)(ws + WS_AFF))
#define P_INV ((short*)(ws + WS_INV))
#define P_SEL ((int*)(ws + WS_SEL))
#define P_GSEL ((float*)(ws + WS_GSEL))
#define P_CTXS ((float*)(ws + WS_CTXS))
#define P_HB ((bf16*)(ws + WS_HB))
#define P_UB ((bf16*)(ws + WS_UB))
#define P_HB8 (ws + WS_UB)
#define P_HBUF8 (ws + WS_HBUF)
#define P_XG ((bf16*)(ws + WS_XG))
#define P_PRJ ((bf16*)(ws + WS_PRJ))
#define P_OLOC ((bf16*)(ws + WS_OLOC))
#define P_QGG ((bf16*)(ws + WS_QGG))
#define P_SLOC ((float*)(ws + WS_UB))
#define P_PTOT ((float*)(ws + WS_PTOT))
#define P_SST ((bf16*)(ws + WS_SST))
#define P_YH ((bf16*)(ws + WS_UB))
#define P_out (pa.out)

    if (MK_TIME_A == -1 && blockIdx.x == 0 && TID_OF(g_wave) == 0) ((unsigned long long*)(ws + WS_CTL))[1024] = __builtin_amdgcn_s_memrealtime();
    if (IN(0)) REP(0) { const Ctx C = make_ctx(lds_raw, g_wave); CArgs& pa = *opaque_args(); unsigned char* const ws = pa.ws;
        mod_gemv(C, pa.in[1], pa.in[3], pa.in[4], pa.in[5], P_MV);
        for (int i = C.vcu * NW * 64 + C.tid; i < 2048; i += C.G * NW * 64) { const float* lg = pa.in[17]; P_LBT[i] = fsig(lg[2048 + i] - lg[i]); }
        __syncthreads();
        convert_small(C, pa.in[8], pa.in[14], pa.in[16], pa.in[19], ws);
        convert_moe(C, pa.in[21], pa.in[22], pa.in[23], 0, ws, 0, L0_A, C.gw, C.NGW);
    }
    SEAM(0);
    if (IN(1)) REP(1) { const Ctx C = make_ctx(lds_raw, g_wave); CArgs& pa = *opaque_args(); unsigned char* const ws = pa.ws; RowArgs A{}; A.src_lat = P_x; A.src_ctx = P_ctx_in; A.gamma = pa.in[6]; A.mv = P_MV; A.i_shift = 0; A.i_scale = 1; A.i_gate = 2; A.HB = P_HB; A.nrows = R;
        row_phase<false, false, false>(C, A); }
    SEAM(1);
    if (IN(2)) REP(2) { const Ctx C = make_ctx(lds_raw, g_wave); CArgs& pa = *opaque_args(); unsigned char* const ws = pa.ws; pg8::Gemm g{P_HB, (const bf16*)(ws + WS_W1T), R, 2048, 1024}; pg8::StaticOrder S; S.init(R, 2048, C.G, (int)blockIdx.x);
        pg8::EpiGated<0> E{P_UB, 1024, pa.in[9], 1024};
        pg8::gemm_phase<pg8::EpiGated<0>, pg8::StaticOrder, true, true>(C.lds, g, S, E, C.wave);
        TAIL_CONVERT(NWG_P2, 0, min(MOE_ITEMS, L0_A + L0_R3), TAILQ_P2); }
    SEAM(2);
    if (IN(3)) REP(3) { const Ctx C = make_ctx(lds_raw, g_wave); CArgs& pa = *opaque_args(); unsigned char* const ws = pa.ws; conv_phase(C, P_UB, P_HB, pa.in[10], pa.in[11], pa.in[12], pa.in[13]); RANK_CONVERT(C.vcu, 1056 % GRID_C, 0, L0_A, TAILQ_P3); }
    SEAM(3);
    if (IN(4)) REP(4) { const Ctx C = make_ctx(lds_raw, g_wave); CArgs& pa = *opaque_args(); unsigned char* const ws = pa.ws; pg8::Gemm g{P_HB, (const bf16*)(ws + WS_W2T), R, 1024, 1024}; pg8::StaticOrder S; S.init(R, 1024, C.G, (int)blockIdx.x);
        pg8::EpiDelta E{(bf16*)(ws + WS_OLOC), 1024, pa.in[15], P_MV + 2 * 1024, 6144};
        pg8::gemm_phase<pg8::EpiDelta, pg8::StaticOrder, true, true>(C.lds, g, S, E, C.wave);
        TAIL_CONVERT(NWG_P4, 0, min(MOE_ITEMS, L0_A + L0_R3 + L0_R2), TAILQ_P4); }
    SEAM(4);
    if (IN(5)) REP(5) { const Ctx C = make_ctx(lds_raw, g_wave); CArgs& pa = *opaque_args(); unsigned char* const ws = pa.ws; RowArgs A{}; A.src_lat = P_x; A.src_ctx = P_ctx_in; A.delta = (const bf16*)(ws + WS_OLOC); A.gamma = pa.in[7]; A.mv = P_MV; A.i_shift = 3; A.i_scale = 4; A.i_gate = 5; A.HB = P_HB; A.HB8 = P_HB8; A.AFF = P_AFF; A.router_w = pa.in[20]; A.nrows = R;
        row_phase<false, true, false>(C, A); }
    SEAM(5);
    if (IN(6)) REP(6) { const Ctx C = make_ctx(lds_raw, g_wave); CArgs& pa = *opaque_args(); unsigned char* const ws = pa.ws; topk_phase(C, 128, RPE0, P_AFF, P_SEL, P_GSEL, P_INV); IDLE_CONVERT(128, 1, 0, TAILQ_P6); }
    SEAM(6);
    if (IN(8)) REP(8) { const Ctx C = make_ctx(lds_raw, g_wave); CArgs& pa = *opaque_args(); unsigned char* const ws = pa.ws; pg8::Gemm g{(const bf16*)P_HB8, (const bf16*)(ws + WS_W13T), NE * RPE0, 4096, 1024}; pg8::StaticOrder S; S.init(NE * RPE0, 4096, C.G, (int)blockIdx.x, RPE0 / 256);
        pg8::EpiSwiGLU8 E{P_HBUF8, 2048, 1.0f / 32.0f};
        pg8::gemm_phase_f8<pg8::EpiSwiGLU8, pg8::StaticOrder, true, true, true, 1024>(C.lds, g, S, E, C.wave, P_SEL, (LAS unsigned*)(C.lds + GTAB_OFF)); }
    SEAM(8);
    if (IN(9)) REP(9) { const Ctx C = make_ctx(lds_raw, g_wave); CArgs& pa = *opaque_args(); unsigned char* const ws = pa.ws; pg8::Gemm g{(const bf16*)P_HBUF8, (const bf16*)(ws + WS_WDT), NE * RPE0, 1024, 2048}; pg8::StaticOrder S; S.init(NE * RPE0, 1024, C.G, (int)blockIdx.x, RPE0 / 256);
        pg8::EpiScaleRow E{P_XG, 1024, P_GSEL, 1.0f / 32.0f};
        pg8::gemm_phase_f8<pg8::EpiScaleRow, pg8::StaticOrder, true, true, true, 2048>(C.lds, g, S, E, C.wave, nullptr, (LAS unsigned*)(C.lds + GTAB_OFF));
        TAIL_CONVERT(NWG_P9, 1, L1_R6, TAILQ_P9); }
    SEAM(9);
    if (IN(10)) REP(10) { const Ctx C = make_ctx(lds_raw, g_wave); CArgs& pa = *opaque_args(); unsigned char* const ws = pa.ws; RowArgs A{}; A.src_lat = P_x; A.src_ctx = P_ctx_in; A.delta = (const bf16*)(ws + WS_OLOC); A.dst_lat = P_out; A.dst_ctx = P_CTXS; A.gamma = pa.in[6] + 1024; A.mv = P_MV; A.i_shift = 0; A.i_scale = 1; A.i_gate = 5; A.HB = P_HB;
        A.Y = P_XG; A.INV = P_INV; A.rpe = RPE0; A.nrows = R;
        A.mv = P_MV + 5 * 6144; A.mvg = P_MV; row_phase<true, false, false>(C, A); }
    SEAM(10);
    if (IN(11)) REP(11) { const Ctx C = make_ctx(lds_raw, g_wave); CArgs& pa = *opaque_args(); unsigned char* const ws = pa.ws; pg8::Gemm g{P_HB, (const bf16*)(ws + WS_WINT), R, 5120, 1024}; pg8::StaticOrder S; S.init(R, 5120, C.G, (int)blockIdx.x);
        pg8::EpiBf16 E{P_PRJ, 5120, P_LBT, R};
        pg8::gemm_phase<pg8::EpiBf16, pg8::StaticOrder, true, true>(C.lds, g, S, E, C.wave);
        TAIL_CONVERT(NWG_P11, 1, L1_R6 + L1_R9, TAILQ_P11); }
    SEAM(11);
    if (IN(12)) REP(12) { const Ctx C = make_ctx(lds_raw, g_wave); CArgs& pa = *opaque_args(); unsigned char* const ws = pa.ws; scanA_phase(C, P_PRJ, P_LBT, P_OLOC, P_QGG, P_SLOC, P_PTOT); RANK_CONVERT(C.vcu, (NSEQ * NGRP) % GRID_C, 1, L1_R6 + L1_R9 + L1_R11, TAILQ_P12); }
    SEAM(12);
    if (IN(13)) REP(13) { const Ctx C = make_ctx(lds_raw, g_wave); CArgs& pa = *opaque_args(); unsigned char* const ws = pa.ws; scanB_phase(C, P_SLOC, P_PTOT, P_SST); }
    SEAM(13);
    if (IN(14)) REP(14) { const Ctx C = make_ctx(lds_raw, g_wave); CArgs& pa = *opaque_args(); unsigned char* const ws = pa.ws; readout_phase(C, P_PRJ, P_OLOC, P_QGG, P_SST, pa.in[18], P_YH); }
    SEAM(14);
    if (IN(15)) REP(15) { const Ctx C = make_ctx(lds_raw, g_wave); CArgs& pa = *opaque_args(); unsigned char* const ws = pa.ws; pg8::Gemm g{P_YH, (const bf16*)(ws + WS_WOUTT), NLAT, 1024, 1024}; pg8::StaticOrder S; S.init(NLAT, 1024, C.G, (int)blockIdx.x);
        pg8::EpiDelta E{(bf16*)(ws + WS_OLOC), 1024, nullptr, P_MV + 5 * 6144 + 2 * 1024, 6144};
        pg8::gemm_phase<pg8::EpiDelta, pg8::StaticOrder, true, true>(C.lds, g, S, E, C.wave); }
    SEAM(15);
    if (IN(16)) REP(16) { const Ctx C = make_ctx(lds_raw, g_wave); CArgs& pa = *opaque_args(); unsigned char* const ws = pa.ws; RowArgs A{}; A.src_lat = P_out; A.delta = (const bf16*)(ws + WS_OLOC); A.gamma = pa.in[7] + 1024; A.mv = P_MV + 5 * 6144; A.i_shift = 3; A.i_scale = 4; A.i_gate = 5; A.HB = P_HB; A.HB8 = P_HB8; A.AFF = P_AFF; A.router_w = pa.in[20] + 16384; A.nrows = NLAT;
        row_phase<false, true, false>(C, A);
        convert_moe(C, pa.in[21], pa.in[22], pa.in[23], 1, ws, L1_B, max(L1_B, MOE_ITEMS - L1_R17), C.gw, C.NGW); }
    SEAM(16);
    if (IN(17)) REP(17) { const Ctx C = make_ctx(lds_raw, g_wave); CArgs& pa = *opaque_args(); unsigned char* const ws = pa.ws; topk_phase(C, 64, RPE1, P_AFF, P_SEL, P_GSEL, P_INV);
        IDLE_CONVERT(64, 1, max(L1_B, MOE_ITEMS - L1_R17), TAILQ_P17); }
    SEAM(17);
    if (IN(19)) REP(19) { const Ctx C = make_ctx(lds_raw, g_wave); CArgs& pa = *opaque_args(); unsigned char* const ws = pa.ws; pg8::Gemm g{(const bf16*)P_HB8, (const bf16*)(ws + WS_W13T_L1), NE * RPE1, 4096, 1024}; pg8::StaticOrder S; S.init(NE * RPE1, 4096, C.G, (int)blockIdx.x, RPE1 / 256);
        pg8::EpiSwiGLU8 E{P_HBUF8, 2048, 1.0f / 32.0f};
        pg8::gemm_phase_f8<pg8::EpiSwiGLU8, pg8::StaticOrder, true, true, true, 1024>(C.lds, g, S, E, C.wave, P_SEL, (LAS unsigned*)(C.lds + GTAB_OFF)); }
    SEAM(19);
    if (IN(20)) REP(20) { const Ctx C = make_ctx(lds_raw, g_wave); CArgs& pa = *opaque_args(); unsigned char* const ws = pa.ws; pg8::Gemm g{(const bf16*)P_HBUF8, (const bf16*)(ws + WS_WDT_L1), NE * RPE1, 1024, 2048}; pg8::StaticOrder S; S.init(NE * RPE1, 1024, C.G, (int)blockIdx.x, RPE1 / 256);
        pg8::EpiScaleRow E{P_XG, 1024, P_GSEL, 1.0f / 32.0f};
        pg8::gemm_phase_f8<pg8::EpiScaleRow, pg8::StaticOrder, true, true, true, 2048>(C.lds, g, S, E, C.wave, nullptr, (LAS unsigned*)(C.lds + GTAB_OFF)); }
    SEAM(20);
    if (IN(21)) REP(21) { const Ctx C = make_ctx(lds_raw, g_wave); CArgs& pa = *opaque_args(); unsigned char* const ws = pa.ws; RowArgs A{}; A.src_lat = P_out; A.delta = (const bf16*)(ws + WS_OLOC); A.dst_lat = P_out; A.gamma = pa.in[24]; A.mv = P_MV + 5 * 6144; A.mvg = P_MV + 5 * 6144; A.i_gate = 5; A.Y = P_XG; A.INV = P_INV; A.rpe = RPE1; A.nrows = NLAT;
        row_phase<true, false, true>(C, A);
        }
    if (MK_TIME_A > -2) { const Ctx C = make_ctx(lds_raw, g_wave); CArgs& pa = *opaque_args(); { XcdBarrier b_; b_.bar = (unsigned*)(pa.ws + WS_CTL) + CW_BAR; b_.x = xb_xcc_id(); b_.st = (volatile LAS unsigned*)((LAS unsigned char*)lds_raw + MISC_OFF) + 8; xcd_barrier(b_, g_wave); }
        if (blockIdx.x == 0 && C.tid == 0) { float add = ((const float*)(ws + WS_CTL))[2050]; if (MK_TIME_B == 21) { const unsigned long long t0_ = ((unsigned long long*)(ws + WS_CTL))[1024]; add = (float)(__builtin_amdgcn_s_memrealtime() - t0_) * (MK_TIME_A == -1 ? 0.0001f : 0.00125f); } pa.out[0] += add; } }
#undef IN
#undef P_x
#undef P_ctx_in
#undef P_MV
#undef P_LBT
#undef P_AFF
#undef P_INV
#undef P_SEL
#undef P_GSEL
#undef P_CTXS
#undef P_HB
#undef P_UB
#undef P_HB8
#undef P_HBUF8
#undef P_XG
#undef P_PRJ
#undef P_OLOC
#undef P_QGG
#undef P_SLOC
#undef P_PTOT
#undef P_SST
#undef P_YH
#undef P_out
#undef REP
#undef INR
#undef SEAM
}

extern "C" void kernel_launch(void* const* d_in, const int* in_sizes, int n_in, void* d_out, int out_size, void* d_ws, size_t ws_size, hipStream_t stream) {
    static int grid = 0;
    if (grid == 0) {
        if (n_in != 25 || in_sizes[0] != NLAT * D || out_size != NLAT * D || ws_size < WS_END) { fprintf(stderr, "kernel_launch: unexpected shapes (n_in %d, in0 %d, out %d, ws %zu)\n", n_in, n_in > 0 ? in_sizes[0] : -1, out_size, ws_size); grid = -1; return; }
        int dev = 0, cus = 0, per_cu = 0;
        if (hipGetDevice(&dev) != hipSuccess || hipDeviceGetAttribute(&cus, hipDeviceAttributeMultiprocessorCount, dev) != hipSuccess) { grid = -1; return; }
        if (hipFuncSetAttribute((const void*)mk_fwd, hipFuncAttributeMaxDynamicSharedMemorySize, LDS_BYTES) != hipSuccess) { fprintf(stderr, "kernel_launch: hipFuncSetAttribute failed\n"); grid = -1; return; }
        if (hipOccupancyMaxActiveBlocksPerMultiprocessor(&per_cu, (const void*)mk_fwd, NW * 64, LDS_BYTES) != hipSuccess || per_cu < 1) { fprintf(stderr, "kernel_launch: occupancy query reports %d blocks per CU\n", per_cu); (void)hipGetLastError(); grid = -1; return; }
        if (cus != GRID_C) { fprintf(stderr, "kernel_launch: built for a %d-CU device, found %d CUs\n", GRID_C, cus); grid = -1; return; }
        grid = cus;
    }
    if (grid < 0) return;
    if (hipMemsetAsync((char*)d_ws + WS_CTL, 0, CTL_ZERO_BYTES, stream) != hipSuccess) { fprintf(stderr, "kernel_launch: memset failed\n"); return; }
    Args a{};
    for (int i = 0; i < 25; ++i) a.in[i] = (const float*)d_in[i];
    a.out = (float*)d_out; a.ws = (unsigned char*)d_ws;
#if MK_SPLIT
    for (int p = 0; p < NPHASE; ++p) { a.ph_lo = p; a.ph_hi = p + 1; hipLaunchKernelGGL(mk_fwd, dim3(grid), dim3(NW * 64), LDS_BYTES, stream, a); }
#else
    a.ph_lo = 0; a.ph_hi = NPHASE;
#ifndef MK_COOP
#define MK_COOP 1
#endif
#if MK_COOP
    void* kargs[] = {&a};
    hipError_t e = hipLaunchCooperativeKernel((const void*)mk_fwd, dim3(grid), dim3(NW * 64), kargs, LDS_BYTES, stream);
    if (e != hipSuccess) fprintf(stderr, "kernel_launch: cooperative launch failed: %s (grid %d)\n", hipGetErrorString(e), grid);
#else
    hipLaunchKernelGGL(mk_fwd, dim3(grid), dim3(NW * 64), LDS_BYTES, stream, a);
#endif
#endif
}
```

```cpp
#include <hip/hip_runtime.h>
#include <hip/hip_cooperative_groups.h>
#include <cstdio>
#include <cstdint>
namespace cg = cooperative_groups;

#ifndef MK_SPLIT
#define MK_SPLIT 0
#endif

__device__ __forceinline__ int lane_id() { int l; asm volatile("v_mbcnt_lo_u32_b32 %0, -1, 0\n\tv_mbcnt_hi_u32_b32 %0, -1, %0" : "=v"(l)); return l; }
#define TID_OF(wv) ((wv) * 64 + lane_id())
namespace pg8 {
#define PG8_LAS __attribute__((address_space(3)))
typedef unsigned short bf16_t;
typedef short bf16x8 __attribute__((ext_vector_type(8)));
typedef float f32x4 __attribute__((ext_vector_type(4)));
typedef unsigned u32x4 __attribute__((ext_vector_type(4)));
constexpr int BM = 256, BK = 64, HALF = 128, HTB = HALF * BK * 2  , STAGE_BYTES = 8 * HTB, NXCD = 8, WGM = 8;

__host__ __device__ __forceinline__ int lds_byte(int r, int c) { const int st = (r >> 4) * 2 + (c >> 5), rr = r & 15, cc = c & 31, ob = rr * 64 + cc * 2; return st * 1024 + (ob ^ (((ob >> 9) & 1) << 5)); }
__host__ __device__ __forceinline__ void stage_rc(int b, int& R, int& C) { const int st = b / 1024, sb = b % 1024, swz = sb ^ (((sb >> 9) & 1) << 5); R = (st >> 1) * 16 + swz / 64; C = (st & 1) * 32 + (swz % 64) / 2; }
__host__ __device__ __forceinline__ int perm32(int rho) { const int n = rho >> 4, i = rho & 15; return 8 * (i >> 2) + 4 * n + (i & 3); }

struct Unit { int pm, pn, pb; };
struct Gemm { const bf16_t* A; const bf16_t* Bt; int M, N, K; };

struct StaticOrder {
    int nM, nN, nwg, G, c, tpe;
    __host__ __device__ void init(int M, int N, int G_, int c_, int tpe_ = 0) { nM = M / BM; nN = N / BM; nwg = nM * nN; G = G_; c = c_; tpe = tpe_; }
    __host__ __device__ bool next(int i, Unit& u) const {
        const long L = (long)i * G + c; if (L >= nwg) return false;
        int wgid = (int)L; { const int q = nwg / NXCD, r = nwg % NXCD, xcd = wgid % NXCD, off = wgid / NXCD; wgid = (xcd < r ? xcd * (q + 1) : r * (q + 1) + (xcd - r) * q) + off; }
        const int nig = WGM * nN, gid = wgid / nig, fm = gid * WGM, gsz = (nM - fm) < WGM ? (nM - fm) : WGM;
        u.pm = fm + ((wgid % nig) % gsz); u.pn = (wgid % nig) / gsz; u.pb = tpe ? (u.pm / tpe) * nN + u.pn : u.pn; return true;
    }
    __device__ __forceinline__ void a_ready(const Unit&) const {}
    __device__ __forceinline__ void done(const Unit&) const {}
};

typedef float f32x32 __attribute__((ext_vector_type(32)));
struct AccQ { f32x32 q[2][2];
    __device__ __forceinline__ f32x4 get(int ai, int bj, int m, int n) const { const int i = (m * 2 + n) * 4; const f32x32& v = q[ai][bj]; return (f32x4){v[i], v[i + 1], v[i + 2], v[i + 3]}; }
    __device__ __forceinline__ void set(int ai, int bj, int m, int n, f32x4 c) { const int i = (m * 2 + n) * 4; f32x32& v = q[ai][bj]; v[i] = c[0]; v[i + 1] = c[1]; v[i + 2] = c[2]; v[i + 3] = c[3]; }
};
__device__ __forceinline__ unsigned cvt_pk_bf16(float lo, float hi) { unsigned r; asm("v_cvt_pk_bf16_f32 %0, %1, %2" : "=v"(r) : "v"(lo), "v"(hi)); return r; }
__device__ __forceinline__ float fsigmoid(float x) { return __builtin_amdgcn_rcpf(1.0f + __expf(-x)); }

struct EpiBf16 {
    static constexpr bool PERM = true, AFTER_DRAIN = false;
    bf16_t* O; int ldc; const float* lb; int hm_rows;
    __device__ __forceinline__ void operator()(const f32x4 (&acc)[2][2][4][2], const Unit& u, int wr, int wc, int fr, int fq) const {
        const int row0 = u.pm * BM + wr * 64 + fr, col0 = u.pn * BM + wc * 32 + 8 * fq;
        const bool gate = lb != nullptr && u.pn >= 4 && u.pn < 12;
        f32x4 om[2][2];
#pragma unroll
        for (int bj = 0; bj < 2; ++bj)
#pragma unroll
            for (int n = 0; n < 2; ++n) om[bj][n] = gate ? (f32x4){1.f, 1.f, 1.f, 1.f} - *(const f32x4*)(lb + (col0 - 1024) + bj * HALF + 4 * n) : (f32x4){0.f, 0.f, 0.f, 0.f};
#pragma unroll
        for (int ai = 0; ai < 2; ++ai)
#pragma unroll
            for (int m = 0; m < 4; ++m) { const int row = row0 + ai * HALF + m * 16;
                bf16_t* rowp = hm_rows ? O + ((size_t)(2 * u.pn) * hm_rows + row) * HALF + wc * 32 + 8 * fq - 0 : O + (size_t)row * ldc + col0;
                const size_t bjstep = hm_rows ? (size_t)hm_rows * HALF : (size_t)HALF;
#pragma unroll
                for (int bj = 0; bj < 2; ++bj) { f32x4 v0 = acc[ai][bj][m][0], v1 = acc[ai][bj][m][1];
                    if (gate) {
#pragma unroll
                        for (int j = 0; j < 4; ++j) { v0[j] = om[bj][0][j] * fsigmoid(-v0[j]); v1[j] = om[bj][1][j] * fsigmoid(-v1[j]); } }
                    u32x4 w; w.x = cvt_pk_bf16(v0[0], v0[1]); w.y = cvt_pk_bf16(v0[2], v0[3]); w.z = cvt_pk_bf16(v1[0], v1[1]); w.w = cvt_pk_bf16(v1[2], v1[3]);
                    *(u32x4*)(rowp + bj * bjstep) = w; } }
    }
};
template <int MODE> struct EpiGated {
    static constexpr bool PERM = true, AFTER_DRAIN = false;
    bf16_t* O; int ldc; const float* bias; int ystride;
    __device__ __forceinline__ void operator()(const f32x4 (&acc)[2][2][4][2], const Unit& u, int wr, int wc, int fr, int fq) const {
        const int row0 = u.pm * BM + wr * 64 + fr, ch0 = u.pn * HALF + wc * 32 + 8 * fq;
        f32x4 bx[2], by[2];
#pragma unroll
        for (int n = 0; n < 2; ++n) { if (MODE == 0) { bx[n] = *(const f32x4*)(bias + ch0 + 4 * n); by[n] = *(const f32x4*)(bias + ystride + ch0 + 4 * n); } else { bx[n] = (f32x4){0.f, 0.f, 0.f, 0.f}; by[n] = bx[n]; } }
#pragma unroll
        for (int ai = 0; ai < 2; ++ai)
#pragma unroll
            for (int m = 0; m < 4; ++m) { bf16_t* rowp = O + (size_t)(row0 + ai * HALF + m * 16) * ldc + ch0;
                float r[8];
#pragma unroll
                for (int n = 0; n < 2; ++n) { const f32x4 x = acc[ai][0][m][n] + bx[n], y = acc[ai][1][m][n] + by[n];
#pragma unroll
                    for (int j = 0; j < 4; ++j) r[4 * n + j] = (MODE == 0) ? x[j] * fsigmoid(y[j]) : x[j] * fsigmoid(x[j]) * y[j]; }
                u32x4 w; w.x = cvt_pk_bf16(r[0], r[1]); w.y = cvt_pk_bf16(r[2], r[3]); w.z = cvt_pk_bf16(r[4], r[5]); w.w = cvt_pk_bf16(r[6], r[7]);
                *(u32x4*)rowp = w; }
    }
};
struct EpiDelta {
    static constexpr bool PERM = true, AFTER_DRAIN = false;
    bf16_t* O; int ldc; const float* bias; const float* gate; int gstride;
    __device__ __forceinline__ void operator()(const f32x4 (&acc)[2][2][4][2], const Unit& u, int wr, int wc, int fr, int fq) const {
        const int grp = u.pm >= 128 ? 4 : (u.pm >> 5);
        const int row0 = u.pm * BM + wr * 64 + fr, col0 = u.pn * BM + wc * 32 + 8 * fq;
        const float* gp = gate + (size_t)grp * gstride + col0;
        f32x4 gv[2][2], bv[2][2];
#pragma unroll
        for (int bj = 0; bj < 2; ++bj)
#pragma unroll
            for (int n = 0; n < 2; ++n) { gv[bj][n] = *(const f32x4*)(gp + bj * HALF + 4 * n); bv[bj][n] = bias ? *(const f32x4*)(bias + col0 + bj * HALF + 4 * n) : (f32x4){0.f, 0.f, 0.f, 0.f}; }
#pragma unroll
        for (int ai = 0; ai < 2; ++ai)
#pragma unroll
            for (int m = 0; m < 4; ++m) { bf16_t* rowp = O + (size_t)(row0 + ai * HALF + m * 16) * ldc + col0;
#pragma unroll
                for (int bj = 0; bj < 2; ++bj) { const f32x4 v0 = gv[bj][0] * (acc[ai][bj][m][0] + bv[bj][0]), v1 = gv[bj][1] * (acc[ai][bj][m][1] + bv[bj][1]);
                    u32x4 w; w.x = cvt_pk_bf16(v0[0], v0[1]); w.y = cvt_pk_bf16(v0[2], v0[3]); w.z = cvt_pk_bf16(v1[0], v1[1]); w.w = cvt_pk_bf16(v1[2], v1[3]);
                    *(u32x4*)(rowp + bj * HALF) = w; } }
    }
};
struct EpiRes {
    static constexpr bool PERM = false, AFTER_DRAIN = false;
    const float* res0; float* out0; const float* res1; float* out1; const float* bias; const float* gate; int gstride;
    __device__ __forceinline__ void operator()(const f32x4 (&acc)[2][2][4][2], const Unit& u, int wr, int wc, int fr, int fq) const {
        const bool second = u.pm >= 128; const int grp = second ? 4 : (u.pm >> 5);
        const float* res = second ? res1 : res0; float* out = second ? out1 : out0;
        const int row0 = (second ? u.pm - 128 : u.pm) * BM + wr * 64 + fr, col0 = u.pn * BM + wc * 32 + 4 * fq;
        const float* gp = gate + (size_t)grp * gstride + col0;
        const unsigned off0 = ((unsigned)row0 * 1024u + (unsigned)col0) * 4u;
#pragma unroll
        for (int bj = 0; bj < 2; ++bj) {
            f32x4 gv[2], bv[2], rv[2][2][4];
#pragma unroll
            for (int n = 0; n < 2; ++n) { gv[n] = *(const f32x4*)(gp + bj * HALF + n * 16); bv[n] = bias ? *(const f32x4*)(bias + col0 + bj * HALF + n * 16) : (f32x4){0.f, 0.f, 0.f, 0.f}; }
#pragma unroll
            for (int n = 0; n < 2; ++n)
#pragma unroll
                for (int ai = 0; ai < 2; ++ai)
#pragma unroll
                    for (int m = 0; m < 4; ++m) rv[n][ai][m] = *(const f32x4*)((const char*)res + (off0 + (unsigned)(((ai * HALF + m * 16) * 1024 + bj * HALF + n * 16) * 4)));
#pragma unroll
            for (int n = 0; n < 2; ++n)
#pragma unroll
                for (int ai = 0; ai < 2; ++ai)
#pragma unroll
                    for (int m = 0; m < 4; ++m) *(f32x4*)((char*)out + (off0 + (unsigned)(((ai * HALF + m * 16) * 1024 + bj * HALF + n * 16) * 4))) = rv[n][ai][m] + gv[n] * (acc[ai][bj][m][n] + bv[n]);
            asm volatile("" ::: "memory"); }
    }
};
struct EpiScaleRow {
    static constexpr bool PERM = true, AFTER_DRAIN = false;
    bf16_t* O; int ldc; const float* rs; float mul;
    __device__ __forceinline__ void operator()(const AccQ& acc, const Unit& u, int wr, int wc, int fr, int fq) const {
        const int row0 = u.pm * BM + wr * 64 + fr, col0 = u.pn * BM + wc * 32 + 8 * fq;
#pragma unroll
        for (int ai = 0; ai < 2; ++ai)
#pragma unroll
            for (int m = 0; m < 4; ++m) { const int row = row0 + ai * HALF + m * 16; const float s = rs[row] * mul; bf16_t* rowp = O + (size_t)row * ldc + col0;
#pragma unroll
                for (int bj = 0; bj < 2; ++bj) { const f32x4 v0 = acc.get(ai, bj, m, 0) * s, v1 = acc.get(ai, bj, m, 1) * s;
                    u32x4 w; w.x = cvt_pk_bf16(v0[0], v0[1]); w.y = cvt_pk_bf16(v0[2], v0[3]); w.z = cvt_pk_bf16(v1[0], v1[1]); w.w = cvt_pk_bf16(v1[2], v1[3]);
                    *(u32x4*)(rowp + bj * HALF) = w; }
                asm volatile("" ::: "memory"); }
    }
};

typedef unsigned u32x2 __attribute__((ext_vector_type(2)));
__device__ __forceinline__ unsigned pk4_fp8(float a, float b, float c, float d) { unsigned lo, hi; asm("v_cvt_pk_fp8_f32 %0, %1, %2" : "=v"(lo) : "v"(a), "v"(b)); asm("v_cvt_pk_fp8_f32 %0, %1, %2" : "=v"(hi) : "v"(c), "v"(d)); return (lo & 0xffffu) | (hi << 16); }
struct EpiSwiGLU8 {
    static constexpr bool PERM = true, AFTER_DRAIN = false;
    unsigned char* O; int ldc; float s;
    __device__ __forceinline__ void operator()(const AccQ& acc, const Unit& u, int wr, int wc, int fr, int fq) const {
        const int row0 = u.pm * BM + wr * 64 + fr, ch0 = u.pn * HALF + wc * 32 + 8 * fq;
#pragma unroll
        for (int ai = 0; ai < 2; ++ai)
#pragma unroll
            for (int m = 0; m < 4; ++m) { unsigned char* rowp = O + (size_t)(row0 + ai * HALF + m * 16) * ldc + ch0;
                float r[8];
#pragma unroll
                for (int n = 0; n < 2; ++n) { const f32x4 x = acc.get(ai, 0, m, n) * s, y = acc.get(ai, 1, m, n) * s;
#pragma unroll
                    for (int j = 0; j < 4; ++j) r[4 * n + j] = x[j] * fsigmoid(x[j]) * y[j]; }
                u32x2 w; w.x = pk4_fp8(r[0], r[1], r[2], r[3]); w.y = pk4_fp8(r[4], r[5], r[6], r[7]);
                *(u32x2*)rowp = w; }
    }
};


template <class Epi, class Sched, bool ALIGN_EPI = false, bool SP2 = false, bool GATHER = false>
__device__ __forceinline__ void gemm_phase(PG8_LAS unsigned char* lds, const Gemm g, const Sched& S, const Epi& E, const int wv, const int* gsel = nullptr, PG8_LAS unsigned* gtab = nullptr) {
    const int tid = TID_OF(wv), wid = wv, lane = tid & 63, wr = wid >> 2, wc = wid & 3, fr = lane & 15, fq = lane >> 4;
    const int K = g.K, nt = K / BK;
    unsigned voffA[2], voffB[2]; int gR[2]; unsigned gC2[2];
#pragma unroll
    for (int i = 0; i < 2; ++i) { int R, C; stage_rc(tid * 16 + i * 8192, R, C); const int Rb = Epi::PERM ? ((R & ~31) + perm32(R & 31)) : R;
        voffA[i] = (unsigned)(R * K + C) * 2u; voffB[i] = (unsigned)(Rb * K + C) * 2u; gR[i] = R; gC2[i] = (unsigned)C * 2u; }
    unsigned cur0[2] = {0u, 0u}, cur1[2] = {0u, 0u}, nx0[2] = {0u, 0u}, nx1[2] = {0u, 0u};
    if constexpr (GATHER) { Unit uu; for (int i = 0; S.next(i, uu); ++i) if (tid < 256) gtab[i * 256 + tid] = (unsigned)gsel[uu.pm * 256 + tid] * (unsigned)(K * 2);
        __syncthreads(); }
#define PG8_GOFFS(ui_, o0, o1) do { _Pragma("unroll") for (int i = 0; i < 2; ++i) { o0[i] = gtab[(ui_) * 256 + gR[i]] + gC2[i]; o1[i] = gtab[(ui_) * 256 + 128 + gR[i]] + gC2[i]; } } while (0)
#define PG8_STAGE_A(bufoff, ptr_plain, ptr_gather, goffs) do { if constexpr (GATHER) { PG8_STAGE(bufoff, ptr_gather, goffs); } else { PG8_STAGE(bufoff, ptr_plain, voffA); } } while (0)
    const size_t kstep = (size_t)(BK * 2);
    const size_t hstep = (size_t)HALF * K * 2;
    const size_t tstep = 2 * hstep;
    const unsigned ldsw = (unsigned)wid * 1024u;
    const int aoff = lds_byte(wr * 64 + fr, fq * 8), boff = lds_byte(wc * 32 + fr, fq * 8);
#define PG8_SA(b, h) (((b) * 2 + (h)) * HTB)
#define PG8_SB(b, h) ((4 + (b) * 2 + (h)) * HTB)
#define PG8_STAGE(bufoff, gbase, voff) do { _Pragma("unroll") for (int _i = 0; _i < 2; ++_i) \
        __builtin_amdgcn_global_load_lds((const unsigned*)((const char*)(gbase) + (voff)[_i]), (PG8_LAS unsigned*)(lds + (bufoff) + ldsw + _i * 8192), 16, 0, 0); } while (0)
#define PG8_LDA(dst, b, h) do { _Pragma("unroll") for (int m = 0; m < 4; ++m) _Pragma("unroll") for (int k = 0; k < 2; ++k) dst[m][k] = *(const PG8_LAS bf16x8*)(lds + PG8_SA(b, h) + aoff + m * 2048 + k * 1024); } while (0)
#define PG8_LDB(dst, b, h) do { _Pragma("unroll") for (int n = 0; n < 2; ++n) _Pragma("unroll") for (int k = 0; k < 2; ++k) dst[n][k] = *(const PG8_LAS bf16x8*)(lds + PG8_SB(b, h) + boff + n * 2048 + k * 1024); } while (0)
#define PG8_MMA(ai, bj, At, Bt) do { __builtin_amdgcn_s_setprio(1); _Pragma("unroll") for (int m = 0; m < 4; ++m) _Pragma("unroll") for (int n = 0; n < 2; ++n) _Pragma("unroll") for (int k = 0; k < 2; ++k) \
        acc[ai][bj][m][n] = __builtin_amdgcn_mfma_f32_16x16x32_bf16(Bt[n][k], At[m][k], acc[ai][bj][m][n], 0, 0, 0); __builtin_amdgcn_s_setprio(0); } while (0)
#define PG8_WAIT_V(n) asm volatile("s_waitcnt vmcnt(" #n ")" ::: "memory")
#define PG8_WAIT_L(n) asm volatile("s_waitcnt lgkmcnt(" #n ")" ::: "memory")
#define PG8_BAR __builtin_amdgcn_s_barrier()
#define PG8_SCHED __builtin_amdgcn_sched_barrier(0)
    Unit cur, nxt; int ui = 0;
    if (!S.next(0, cur)) return;
    f32x4 acc[2][2][4][2];
#pragma unroll
    for (int a = 0; a < 2; ++a)
#pragma unroll
        for (int b = 0; b < 2; ++b)
#pragma unroll
            for (int m = 0; m < 4; ++m)
#pragma unroll
                for (int n = 0; n < 2; ++n) acc[a][b][m][n] = (f32x4){0.f, 0.f, 0.f, 0.f};
    bf16x8 At[4][2], B0[2][2], B1[2][2];
    const char* cA = (const char*)g.A + (size_t)cur.pm * tstep; const char* cB = (const char*)g.Bt + (size_t)cur.pb * tstep;
    const char* const gA = (const char*)g.A;
    if constexpr (GATHER) PG8_GOFFS(0, cur0, cur1);
    S.a_ready(cur);
    if constexpr (SP2) {
        PG8_STAGE(PG8_SB(0, 0), cB, voffB); PG8_STAGE(PG8_SB(0, 1), cB + hstep, voffB); PG8_STAGE_A(PG8_SA(0, 0), cA, gA, cur0); PG8_STAGE_A(PG8_SA(0, 1), cA + hstep, gA, cur1);
        if (wr == 1) PG8_BAR;
        PG8_WAIT_V(2); PG8_BAR;
        PG8_STAGE(PG8_SB(1, 0), cB + kstep, voffB); PG8_STAGE_A(PG8_SA(1, 0), cA + kstep, gA + kstep, cur0); PG8_STAGE(PG8_SB(1, 1), cB + hstep + kstep, voffB);
        PG8_WAIT_V(6); PG8_BAR;
    } else {
        PG8_STAGE(PG8_SB(0, 0), cB, voffB); PG8_STAGE_A(PG8_SA(0, 0), cA, gA, cur0); PG8_STAGE(PG8_SB(0, 1), cB + hstep, voffB); PG8_STAGE_A(PG8_SA(0, 1), cA + hstep, gA, cur1);
        if (wr == 1) PG8_BAR;
        PG8_WAIT_V(4); PG8_BAR;
        PG8_STAGE(PG8_SB(1, 0), cB + kstep, voffB); PG8_STAGE_A(PG8_SA(1, 0), cA + kstep, gA + kstep, cur0); PG8_STAGE(PG8_SB(1, 1), cB + hstep + kstep, voffB);
        PG8_WAIT_V(6); PG8_BAR;
    }
    for (;;) {
        const bool has_next = S.next(ui + 1, nxt);
        if constexpr (GATHER) { if (has_next) PG8_GOFFS(ui + 1, nx0, nx1); else { _Pragma("unroll") for (int i = 0; i < 2; ++i) { nx0[i] = cur0[i]; nx1[i] = cur1[i]; } } }
        const char* nA = has_next ? (const char*)g.A + (size_t)nxt.pm * tstep : cA; const char* nB = has_next ? (const char*)g.Bt + (size_t)nxt.pb * tstep : cB;
#pragma unroll 1
        for (int t = 0; t < nt; t += 2) {
            const bool last = (t == nt - 2);
            const char* a1 = cA + (size_t)(t + 1) * kstep;
            const char* a2 = last ? nA : cA + (size_t)(t + 2) * kstep; const char* b2 = last ? nB : cB + (size_t)(t + 2) * kstep;
            const char* a3 = a2 + kstep; const char* b3 = b2 + kstep;
            const char* ga1 = gA + (size_t)(t + 1) * kstep; const char* ga2 = last ? gA : gA + (size_t)(t + 2) * kstep; const char* ga3 = ga2 + kstep;
            unsigned o2h0[2], o2h1[2];
#pragma unroll
            for (int i = 0; i < 2; ++i) { o2h0[i] = last ? nx0[i] : cur0[i]; o2h1[i] = last ? nx1[i] : cur1[i]; }
            if (last && has_next) S.a_ready(nxt);
            if constexpr (SP2) {
            PG8_LDB(B0, 0, 0); PG8_LDB(B1, 0, 1); PG8_SCHED; PG8_LDA(At, 0, 0); PG8_STAGE_A(PG8_SA(1, 1), a1 + hstep, ga1, cur1);
            PG8_WAIT_V(8); PG8_WAIT_L(0); PG8_BAR; PG8_MMA(0, 0, At, B0); PG8_MMA(0, 1, At, B1); PG8_BAR; PG8_SCHED;
            PG8_LDA(At, 0, 1); PG8_STAGE(PG8_SB(0, 0), b2, voffB); PG8_STAGE(PG8_SB(0, 1), b2 + hstep, voffB); PG8_STAGE_A(PG8_SA(0, 0), a2, ga2, o2h0);
            PG8_WAIT_V(8); PG8_WAIT_L(0); PG8_BAR; PG8_MMA(1, 0, At, B0); PG8_MMA(1, 1, At, B1); PG8_BAR; PG8_SCHED;
            PG8_LDB(B0, 1, 0); PG8_LDB(B1, 1, 1); PG8_SCHED; PG8_LDA(At, 1, 0); PG8_STAGE_A(PG8_SA(0, 1), a2 + hstep, ga2, o2h1);
            PG8_WAIT_V(8); PG8_WAIT_L(0); PG8_BAR; PG8_MMA(0, 0, At, B0); PG8_MMA(0, 1, At, B1); PG8_BAR; PG8_SCHED;
            PG8_LDA(At, 1, 1); PG8_STAGE(PG8_SB(1, 0), b3, voffB); PG8_STAGE(PG8_SB(1, 1), b3 + hstep, voffB); PG8_STAGE_A(PG8_SA(1, 0), a3, ga3, o2h0);
            PG8_WAIT_V(8); PG8_WAIT_L(0); PG8_BAR; PG8_MMA(1, 0, At, B0); PG8_MMA(1, 1, At, B1); PG8_BAR; PG8_SCHED;
            } else {
            PG8_LDB(B0, 0, 0); PG8_SCHED; PG8_LDA(At, 0, 0); PG8_STAGE_A(PG8_SA(1, 1), a1 + hstep, ga1, cur1);
            PG8_WAIT_L(8); PG8_BAR; PG8_WAIT_L(0); PG8_MMA(0, 0, At, B0); PG8_BAR; PG8_SCHED;
            PG8_LDB(B1, 0, 1); PG8_STAGE(PG8_SB(0, 0), b2, voffB);
            PG8_BAR; PG8_WAIT_L(0); PG8_MMA(0, 1, At, B1); PG8_BAR;
            PG8_LDA(At, 0, 1); PG8_STAGE_A(PG8_SA(0, 0), a2, ga2, o2h0);
            PG8_BAR; PG8_WAIT_L(0); PG8_MMA(1, 0, At, B0); PG8_BAR; PG8_SCHED;
            PG8_STAGE(PG8_SB(0, 1), b2 + hstep, voffB);
            PG8_WAIT_V(6); PG8_BAR; PG8_MMA(1, 1, At, B1); PG8_BAR;
            PG8_LDB(B0, 1, 0); PG8_SCHED; PG8_LDA(At, 1, 0); PG8_STAGE_A(PG8_SA(0, 1), a2 + hstep, ga2, o2h1);
            PG8_WAIT_L(8); PG8_BAR; PG8_WAIT_L(0); PG8_MMA(0, 0, At, B0); PG8_BAR; PG8_SCHED;
            PG8_LDB(B1, 1, 1); PG8_STAGE(PG8_SB(1, 0), b3, voffB);
            PG8_BAR; PG8_WAIT_L(0); PG8_MMA(0, 1, At, B1); PG8_BAR;
            PG8_LDA(At, 1, 1); PG8_STAGE_A(PG8_SA(1, 0), a3, ga3, o2h0);
            PG8_BAR; PG8_WAIT_L(0); PG8_MMA(1, 0, At, B0); PG8_BAR; PG8_SCHED;
            PG8_STAGE(PG8_SB(1, 1), b3 + hstep, voffB);
            PG8_WAIT_V(6); PG8_BAR; PG8_MMA(1, 1, At, B1); PG8_BAR;
            }
        }
        if constexpr (ALIGN_EPI) { if (wr == 0) PG8_BAR; }
        if constexpr (!Epi::AFTER_DRAIN) { int tq = tid; asm volatile("" : "+v"(tq)); const int lq = tq & 63; E(acc, cur, wr, wc, lq & 15, lq >> 4); S.done(cur); }
        if (!has_next) break;
#pragma unroll
        for (int a = 0; a < 2; ++a)
#pragma unroll
            for (int b = 0; b < 2; ++b)
#pragma unroll
                for (int m = 0; m < 4; ++m)
#pragma unroll
                    for (int n = 0; n < 2; ++n) acc[a][b][m][n] = (f32x4){0.f, 0.f, 0.f, 0.f};
        cur = nxt; cA = nA; cB = nB; ++ui;
#pragma unroll
        for (int i = 0; i < 2; ++i) { cur0[i] = nx0[i]; cur1[i] = nx1[i]; }
        if constexpr (ALIGN_EPI) { if (wr == 1) PG8_BAR; }
    }
    PG8_WAIT_V(0);
    if constexpr (!ALIGN_EPI) { if (wr == 0) PG8_BAR; }
    PG8_BAR;
    if constexpr (Epi::AFTER_DRAIN) { E.fused(acc, cur, wr, wc, fr, fq, lds, wid, lane); S.done(cur); }
#undef PG8_SA
#undef PG8_SB
#undef PG8_STAGE
#undef PG8_STAGE_A
#undef PG8_GOFFS
#undef PG8_LDA
#undef PG8_LDB
#undef PG8_MMA
#undef PG8_WAIT_V
#undef PG8_WAIT_L
#undef PG8_BAR
#undef PG8_SCHED
}
typedef int v4i_t __attribute__((ext_vector_type(4)));
typedef int v8i_t __attribute__((ext_vector_type(8)));
typedef short s16x16_ld __attribute__((ext_vector_type(16), aligned(16)));
typedef v8i_t v8i_ld __attribute__((aligned(16)));
template <class Epi, class Sched, bool ALIGN_EPI = false, bool SP2 = false, bool GATHER = false, int KC = 0>
__device__ __forceinline__ void gemm_phase_f8(PG8_LAS unsigned char* lds, const Gemm g, const Sched& S, const Epi& E, const int wv, const int* gsel = nullptr, PG8_LAS unsigned* gtab = nullptr) {
    const int tid = TID_OF(wv), wid = wv, lane = tid & 63, wr = wid >> 2, wc = wid & 3, fr = lane & 15, fq = lane >> 4;
    const int K = KC ? KC : g.K, nt = K / 128;
    unsigned voffA[2], voffB[2]; int gR[2]; unsigned gC2[2];
#pragma unroll
    for (int i = 0; i < 2; ++i) { int R, C; stage_rc(tid * 16 + i * 8192, R, C); const int Rb = Epi::PERM ? ((R & ~31) + perm32(R & 31)) : R;
        voffA[i] = (unsigned)(R * K) + (unsigned)C * 2u; voffB[i] = (unsigned)(Rb * K) + (unsigned)C * 2u; gR[i] = R; gC2[i] = (unsigned)C * 2u; }
    unsigned cur0[2] = {0u, 0u}, cur1[2] = {0u, 0u}, nx0[2] = {0u, 0u}, nx1[2] = {0u, 0u};
    if constexpr (GATHER) { Unit uu; for (int i = 0; S.next(i, uu); ++i) if (tid < 256) ((PG8_LAS float*)gtab)[i * 256 + tid] = __uint_as_float((unsigned)(gsel ? gsel[uu.pm * 256 + tid] : uu.pm * 256 + tid) * (unsigned)K);
        __syncthreads(); }
#define PG8_GOFFS(ui_, o0, o1) do { _Pragma("unroll") for (int i = 0; i < 2; ++i) { o0[i] = __float_as_uint(((const PG8_LAS float*)gtab)[(ui_) * 256 + gR[i]]) + gC2[i]; o1[i] = __float_as_uint(((const PG8_LAS float*)gtab)[(ui_) * 256 + 128 + gR[i]]) + gC2[i]; } } while (0)
#define PG8_STAGE_A(bufoff, ptr_plain, ptr_gather, goffs) do { if constexpr (GATHER) { PG8_STAGE(bufoff, ptr_gather, goffs); } else { PG8_STAGE(bufoff, ptr_plain, voffA); } } while (0)
#define PG8_STAGE_AG(bufoff, ptr_plain, ptr_gather, u_, h_) do { if constexpr (GATHER) { unsigned go_[2]; _Pragma("unroll") for (int i = 0; i < 2; ++i) go_[i] = __float_as_uint(((const PG8_LAS float*)gtab)[(u_) * 256 + (h_) * 128 + lR[i]]) + lC2[i]; PG8_STAGE(bufoff, ptr_gather, go_); } else { PG8_STAGE(bufoff, ptr_plain, lvA); } } while (0)
    const size_t kstep = (size_t)(BK * 2);
    const size_t hstep = (size_t)HALF * K;
    const size_t tstep = 2 * hstep;
    const unsigned ldsw = (unsigned)wid * 1024u;
    const int aoff = lds_byte(wr * 64 + fr, fq * 16), boff = lds_byte(wc * 32 + fr, fq * 16);
#define PG8_SA(b, h) (((b) * 2 + (h)) * HTB)
#define PG8_SB(b, h) ((4 + (b) * 2 + (h)) * HTB)
#define PG8_STAGE(bufoff, gbase, voff) do { _Pragma("unroll") for (int _i = 0; _i < 2; ++_i) \
        __builtin_amdgcn_global_load_lds((const unsigned*)((const char*)(gbase) + (voff)[_i]), (PG8_LAS unsigned*)(lds + (bufoff) + ldsw + _i * 8192), 16, 0, 0); } while (0)
#define PG8_LDA(dst, b, h) do { _Pragma("unroll") for (int m = 0; m < 4; ++m) { const bf16x8 lo_ = *(const PG8_LAS bf16x8*)(lds + PG8_SA(b, h) + aoffv + m * 2048), hi_ = *(const PG8_LAS bf16x8*)(lds + PG8_SA(b, h) + aoffv + m * 2048 + 16); dst[m] = __builtin_bit_cast(v8i_t, __builtin_shufflevector(lo_, hi_, 0, 1, 2, 3, 4, 5, 6, 7, 8, 9, 10, 11, 12, 13, 14, 15)); } } while (0)
#define PG8_LDB(dst, b, h) do { _Pragma("unroll") for (int n = 0; n < 2; ++n) { const bf16x8 lo_ = *(const PG8_LAS bf16x8*)(lds + PG8_SB(b, h) + boffv + n * 2048), hi_ = *(const PG8_LAS bf16x8*)(lds + PG8_SB(b, h) + boffv + n * 2048 + 16); dst[n] = __builtin_bit_cast(v8i_t, __builtin_shufflevector(lo_, hi_, 0, 1, 2, 3, 4, 5, 6, 7, 8, 9, 10, 11, 12, 13, 14, 15)); } } while (0)
#define aoffv laoff
#define boffv lboff
#define PG8_MMA(ai, bj, At, Bt) do { __builtin_amdgcn_s_setprio(1); _Pragma("unroll") for (int m = 0; m < 4; ++m) _Pragma("unroll") for (int n = 0; n < 2; ++n) \
        acc.set(ai, bj, m, n, __builtin_amdgcn_mfma_scale_f32_16x16x128_f8f6f4(Bt[n], At[m], acc.get(ai, bj, m, n), 0, 0, 0, 0x7f7f7f7f, 0, 0x7f7f7f7f)); __builtin_amdgcn_s_setprio(0); } while (0)
#define PG8_WAIT_V(n) asm volatile("s_waitcnt vmcnt(" #n ")" ::: "memory")
#define PG8_WAIT_L(n) asm volatile("s_waitcnt lgkmcnt(" #n ")" ::: "memory")
#define PG8_BAR __builtin_amdgcn_s_barrier()
#define PG8_SCHED __builtin_amdgcn_sched_barrier(0)
    Unit cur, nxt; int ui = 0;
    if (!S.next(0, cur)) return;
    AccQ acc;
#pragma unroll
    for (int a = 0; a < 2; ++a)
#pragma unroll
        for (int b = 0; b < 2; ++b)
#pragma unroll
            for (int e = 0; e < 32; ++e) acc.q[a][b][e] = 0.f;
    v8i_t At[4], B0[2], B1[2];
    const char* cA = (const char*)g.A + (size_t)cur.pm * tstep; const char* cB = (const char*)g.Bt + (size_t)cur.pb * tstep;
    const char* const gA = (const char*)g.A;
    if constexpr (GATHER) PG8_GOFFS(0, cur0, cur1);
    S.a_ready(cur);
    if constexpr (SP2) {
        PG8_STAGE(PG8_SB(0, 0), cB, voffB); PG8_STAGE(PG8_SB(0, 1), cB + hstep, voffB); PG8_STAGE_A(PG8_SA(0, 0), cA, gA, cur0); PG8_STAGE_A(PG8_SA(0, 1), cA + hstep, gA, cur1);
        if (wr == 1) PG8_BAR;
        PG8_WAIT_V(2); PG8_BAR;
        PG8_STAGE(PG8_SB(1, 0), cB + kstep, voffB); PG8_STAGE_A(PG8_SA(1, 0), cA + kstep, gA + kstep, cur0); PG8_STAGE(PG8_SB(1, 1), cB + hstep + kstep, voffB);
        PG8_WAIT_V(6); PG8_BAR;
    } else {
        PG8_STAGE(PG8_SB(0, 0), cB, voffB); PG8_STAGE_A(PG8_SA(0, 0), cA, gA, cur0); PG8_STAGE(PG8_SB(0, 1), cB + hstep, voffB); PG8_STAGE_A(PG8_SA(0, 1), cA + hstep, gA, cur1);
        if (wr == 1) PG8_BAR;
        PG8_WAIT_V(4); PG8_BAR;
        PG8_STAGE(PG8_SB(1, 0), cB + kstep, voffB); PG8_STAGE_A(PG8_SA(1, 0), cA + kstep, gA + kstep, cur0); PG8_STAGE(PG8_SB(1, 1), cB + hstep + kstep, voffB);
        PG8_WAIT_V(6); PG8_BAR;
    }
    for (;;) {
        const bool has_next = S.next(ui + 1, nxt);
        const char* nA = has_next ? (const char*)g.A + (size_t)nxt.pm * tstep : cA; const char* nB = has_next ? (const char*)g.Bt + (size_t)nxt.pb * tstep : cB;
#pragma unroll 1
        for (int t = 0; t < nt; t += 2) {
            const bool last = (t == nt - 2);
            unsigned lvA[2], lvB[2], lC2[2]; int lR[2];
            { int tq = tid; asm volatile("" : "+v"(tq));
#pragma unroll
              for (int i = 0; i < 2; ++i) { int R, C; stage_rc(tq * 16 + i * 8192, R, C); const int Rb = Epi::PERM ? ((R & ~31) + perm32(R & 31)) : R;
                  lvA[i] = (unsigned)(R * K) + (unsigned)C * 2u; lvB[i] = (unsigned)(Rb * K) + (unsigned)C * 2u; lR[i] = R; lC2[i] = (unsigned)C * 2u; } }
            int laoff, lboff; { int tq = tid; asm volatile("" : "+v"(tq)); const int lq = tq & 63, lfr = lq & 15, lfq = lq >> 4, lw = tq >> 6; laoff = lds_byte((lw >> 2) * 64 + lfr, lfq * 16); lboff = lds_byte((lw & 3) * 32 + lfr, lfq * 16); }
            const char* a1 = cA + (size_t)(t + 1) * kstep;
            const char* a2 = last ? nA : cA + (size_t)(t + 2) * kstep; const char* b2 = last ? nB : cB + (size_t)(t + 2) * kstep;
            const char* a3 = a2 + kstep; const char* b3 = b2 + kstep;
            const char* ga1 = gA + (size_t)(t + 1) * kstep; const char* ga2 = last ? gA : gA + (size_t)(t + 2) * kstep; const char* ga3 = ga2 + kstep;
            const int u2 = (last && has_next) ? ui + 1 : ui;
            if (last && has_next) S.a_ready(nxt);
            if constexpr (SP2) {
            PG8_LDB(B0, 0, 0); PG8_LDB(B1, 0, 1); PG8_SCHED; PG8_LDA(At, 0, 0); PG8_STAGE_AG(PG8_SA(1, 1), a1 + hstep, ga1, ui, 1);
            PG8_WAIT_V(8); PG8_WAIT_L(0); PG8_BAR; PG8_MMA(0, 0, At, B0); PG8_MMA(0, 1, At, B1); PG8_BAR; PG8_SCHED;
            PG8_LDA(At, 0, 1); PG8_STAGE(PG8_SB(0, 0), b2, lvB); PG8_STAGE(PG8_SB(0, 1), b2 + hstep, lvB); PG8_STAGE_AG(PG8_SA(0, 0), a2, ga2, u2, 0);
            PG8_WAIT_V(8); PG8_WAIT_L(0); PG8_BAR; PG8_MMA(1, 0, At, B0); PG8_MMA(1, 1, At, B1); PG8_BAR; PG8_SCHED;
            PG8_LDB(B0, 1, 0); PG8_LDB(B1, 1, 1); PG8_SCHED; PG8_LDA(At, 1, 0); PG8_STAGE_AG(PG8_SA(0, 1), a2 + hstep, ga2, u2, 1);
            PG8_WAIT_V(8); PG8_WAIT_L(0); PG8_BAR; PG8_MMA(0, 0, At, B0); PG8_MMA(0, 1, At, B1); PG8_BAR; PG8_SCHED;
            PG8_LDA(At, 1, 1); PG8_STAGE(PG8_SB(1, 0), b3, lvB); PG8_STAGE(PG8_SB(1, 1), b3 + hstep, lvB); PG8_STAGE_AG(PG8_SA(1, 0), a3, ga3, u2, 0);
            PG8_WAIT_V(8); PG8_WAIT_L(0); PG8_BAR; PG8_MMA(1, 0, At, B0); PG8_MMA(1, 1, At, B1); PG8_BAR; PG8_SCHED;
            } else {
            PG8_LDB(B0, 0, 0); PG8_SCHED; PG8_LDA(At, 0, 0); PG8_STAGE_AG(PG8_SA(1, 1), a1 + hstep, ga1, ui, 1);
            PG8_WAIT_L(8); PG8_BAR; PG8_WAIT_L(0); PG8_MMA(0, 0, At, B0); PG8_BAR; PG8_SCHED;
            PG8_LDB(B1, 0, 1); PG8_STAGE(PG8_SB(0, 0), b2, lvB);
            PG8_BAR; PG8_WAIT_L(0); PG8_MMA(0, 1, At, B1); PG8_BAR;
            PG8_LDA(At, 0, 1); PG8_STAGE_AG(PG8_SA(0, 0), a2, ga2, u2, 0);
            PG8_BAR; PG8_WAIT_L(0); PG8_MMA(1, 0, At, B0); PG8_BAR; PG8_SCHED;
            PG8_STAGE(PG8_SB(0, 1), b2 + hstep, lvB);
            PG8_WAIT_V(6); PG8_BAR; PG8_MMA(1, 1, At, B1); PG8_BAR;
            PG8_LDB(B0, 1, 0); PG8_SCHED; PG8_LDA(At, 1, 0); PG8_STAGE_AG(PG8_SA(0, 1), a2 + hstep, ga2, u2, 1);
            PG8_WAIT_L(8); PG8_BAR; PG8_WAIT_L(0); PG8_MMA(0, 0, At, B0); PG8_BAR; PG8_SCHED;
            PG8_LDB(B1, 1, 1); PG8_STAGE(PG8_SB(1, 0), b3, lvB);
            PG8_BAR; PG8_WAIT_L(0); PG8_MMA(0, 1, At, B1); PG8_BAR;
            PG8_LDA(At, 1, 1); PG8_STAGE_AG(PG8_SA(1, 0), a3, ga3, u2, 0);
            PG8_BAR; PG8_WAIT_L(0); PG8_MMA(1, 0, At, B0); PG8_BAR; PG8_SCHED;
            PG8_STAGE(PG8_SB(1, 1), b3 + hstep, lvB);
            PG8_WAIT_V(6); PG8_BAR; PG8_MMA(1, 1, At, B1); PG8_BAR;
            }
        }
        if constexpr (ALIGN_EPI) { if (wr == 0) PG8_BAR; }
        if constexpr (!Epi::AFTER_DRAIN) { int tq = tid; asm volatile("" : "+v"(tq)); const int lq = tq & 63; E(acc, cur, wr, wc, lq & 15, lq >> 4); S.done(cur); }
        if (!has_next) break;
#pragma unroll
        for (int a = 0; a < 2; ++a)
#pragma unroll
            for (int b = 0; b < 2; ++b)
#pragma unroll
                for (int e = 0; e < 32; ++e) acc.q[a][b][e] = 0.f;
        cur = nxt; cA = nA; cB = nB; ++ui;

        if constexpr (ALIGN_EPI) { if (wr == 1) PG8_BAR; }
    }
    PG8_WAIT_V(0);
    if constexpr (!ALIGN_EPI) { if (wr == 0) PG8_BAR; }
    PG8_BAR;
    if constexpr (Epi::AFTER_DRAIN) { E.fused(acc, cur, wr, wc, fr, fq, lds, wid, lane); S.done(cur); }
#undef PG8_SA
#undef PG8_SB
#undef PG8_STAGE
#undef PG8_STAGE_A
#undef PG8_STAGE_AG
#undef PG8_GOFFS
#undef PG8_LDA
#undef PG8_LDB
#undef aoffv
#undef boffv
#undef PG8_MMA
#undef PG8_WAIT_V
#undef PG8_WAIT_L
#undef PG8_BAR
#undef PG8_SCHED
}
}

constexpr int NW = 8;
constexpr int D = 1024, NB = 4, T = 8192, TCX = 256, NLAT = NB * T, NCTX = NB * TCX, R = NLAT + NCTX;
constexpr int NE = 16, FF = 2048, CAPL = 1024, CAPC = 32;
constexpr int RPE0 = 4352, RPE1 = 4096;
constexpr int HD = 128, NH = 8, NSEQ = NB * NH * 2;
constexpr int NGRP = 17;
constexpr float EPS = 1e-6f;

constexpr size_t MiB = 1u << 20;
constexpr size_t WS_CTL = 0, CTL_ZERO_BYTES = 64 * 1024;
constexpr size_t WS_MV = 1 * MiB;
constexpr size_t WS_LB = WS_MV + 256 * 1024;
constexpr size_t WS_AFF = 2 * MiB;
constexpr size_t WS_INV = 5 * MiB;
constexpr size_t WS_SEL = 7 * MiB;
constexpr size_t WS_GSEL = 7 * MiB + 512 * 1024;
constexpr size_t WS_CTXS = 8 * MiB;
constexpr size_t WS_W1T = 12 * MiB, WS_W2T = 16 * MiB, WS_WINT = 18 * MiB, WS_WOUTT = 28 * MiB;
constexpr size_t WS_PTOT = 30 * MiB;
constexpr size_t WS_W13T = 32 * MiB;
constexpr size_t WS_WDT = 160 * MiB;
constexpr size_t WS_W13T_L1 = 96 * MiB, WS_WDT_L1 = 192 * MiB;
constexpr int MOE_ITEMS = 16 * (16 * 128 + 32 * 32);
constexpr size_t WS_HB = 224 * MiB;
constexpr size_t WS_UB = 290 * MiB;
constexpr size_t WS_XG = 356 * MiB;
constexpr size_t WS_HBUF = 492 * MiB;
constexpr size_t WS_PRJ = 356 * MiB;
constexpr size_t WS_OLOC = 764 * MiB;
constexpr size_t WS_QGG = 892 * MiB;
constexpr size_t WS_SST = 32 * MiB;
constexpr size_t WS_END = 1020 * MiB;
static_assert(WS_PRJ + (size_t)R * 5120 * 2 <= WS_OLOC && WS_HBUF + (size_t)16 * RPE0 * 2048 * 2 <= WS_OLOC && WS_XG + (size_t)16 * RPE0 * 1024 * 2 <= WS_HBUF, "ws map");
static_assert(WS_HB + (size_t)R * 1024 * 2 <= WS_UB && WS_UB + (size_t)R * 1024 * 2 <= WS_XG && WS_QGG + (size_t)2 * NLAT * 1024 * 2 <= WS_END, "ws map 2");

constexpr int CW_BAR = 4096;
constexpr int LDS_BYTES = 155648;
constexpr int GTAB_OFF = 131072;
constexpr int MISC_OFF = 131072 + 20 * 1024 + 320;
static_assert(MISC_OFF + 192 <= LDS_BYTES, "LDS map");

#define GAS __attribute__((address_space(1)))
#define LAS __attribute__((address_space(3)))
typedef unsigned short bf16;
typedef unsigned v4u __attribute__((ext_vector_type(4)));
typedef unsigned v2u __attribute__((ext_vector_type(2)));
typedef float f32x4 __attribute__((ext_vector_type(4)));
typedef float f32x2 __attribute__((ext_vector_type(2)));
typedef short bf16x8 __attribute__((ext_vector_type(8)));
typedef short bf16x4 __attribute__((ext_vector_type(4)));
#define LDS_WAIT() asm volatile("s_waitcnt lgkmcnt(0)" ::: "memory")
__device__ __forceinline__ unsigned pk2(float lo, float hi) { return pg8::cvt_pk_bf16(lo, hi); }
__device__ __forceinline__ float bflo(unsigned w) { return __uint_as_float(w << 16); }
__device__ __forceinline__ float bfhi(unsigned w) { return __uint_as_float(w & 0xffff0000u); }
__device__ __forceinline__ float fsig(float x) { return __builtin_amdgcn_rcpf(1.0f + __expf(-x)); }
__device__ __forceinline__ float wave_sum(float v) {
#pragma unroll
    for (int o = 1; o < 64; o <<= 1) v += __shfl_xor(v, o);
    return v;
}

#define XB_TMO      128
#define XB_XCNT(j)  (256  + 64 * (j))
#define XB_XSUB(j)  (1280 + 64 * (j))
#define XB_XGEN(j)  (2304 + 64 * (j))
#define XB_TOP      3328
#define XB_TOPGEN   3392
#define XCD_BAR_WORDS 3456
#define XB_SPIN_CAP (1u << 20)
__device__ __forceinline__ unsigned xb_ld(unsigned* p)              { return __hip_atomic_load(p, __ATOMIC_RELAXED, __HIP_MEMORY_SCOPE_AGENT); }
__device__ __forceinline__ unsigned xb_add(unsigned* p, unsigned v) { return __hip_atomic_fetch_add(p, v, __ATOMIC_RELAXED, __HIP_MEMORY_SCOPE_AGENT); }
__device__ __forceinline__ unsigned xb_xcc_id() { return (unsigned)__builtin_amdgcn_s_getreg((3 << 11) | 20) & 0xFu; }
#define XB_SPIN(cond, bar) do { unsigned _sp = 0; while (cond) { __builtin_amdgcn_s_sleep(1); \
    if ((++_sp & 255u) == 0u) { if (xb_ld(&(bar)[XB_TMO])) break; if (_sp > XB_SPIN_CAP) { atomicAdd(&(bar)[XB_TMO], 1u); break; } } } } while (0)
struct XcdBarrier { unsigned* bar; unsigned x; volatile LAS unsigned* st; };
__device__ __forceinline__ XcdBarrier xcd_barrier_post(unsigned* bar, volatile LAS unsigned* st, const int wv) {
    XcdBarrier b; b.bar = bar; b.x = xb_xcc_id(); b.st = st;
    if (TID_OF(wv) == 0) (void)xb_add(&bar[XB_XCNT(b.x)], 1u);
    return b;
}
__device__ __forceinline__ void xcd_barrier_complete(unsigned* bar, unsigned x, unsigned& nloc, unsigned& nx) {
    const unsigned G = gridDim.x * gridDim.y * gridDim.z;
    unsigned sum, cnt, mine, sp = 0u;
    for (;;) {
        sum = 0u; cnt = 0u; mine = 0u;
#pragma unroll
        for (unsigned j = 0; j < 16; ++j) { const unsigned c = xb_ld(&bar[XB_XCNT(j)]); sum += c; cnt += (c > 0u) ? 1u : 0u; mine = (j == x) ? c : mine; }
        if (sum == G) break;
        __builtin_amdgcn_s_sleep(1);
        if ((++sp & 255u) == 0u) { if (xb_ld(&bar[XB_TMO])) break; if (sp > XB_SPIN_CAP) { atomicAdd(&bar[XB_TMO], 1u); break; } }
    }
    nloc = mine > 0u ? mine : 1u; nx = cnt > 0u ? cnt : 1u;
}
__device__ __forceinline__ void xcd_barrier(const XcdBarrier& b, const int wv) {
    asm volatile("s_waitcnt vmcnt(0)" ::: "memory");
    __syncthreads();
    if (TID_OF(wv) == 0) {
        unsigned* bar = b.bar;
        __builtin_amdgcn_s_waitcnt(0);
        unsigned nloc = b.st[0], nx = b.st[1];
        if (nloc == 0u) { xcd_barrier_complete(bar, b.x, nloc, nx); b.st[0] = nloc; b.st[1] = nx; }
        const unsigned old = xb_add(&bar[XB_XSUB(b.x)], 1u);
        const unsigned gen = old / nloc;
        if (old + 1u == (gen + 1u) * nloc) {
            __builtin_amdgcn_fence(__ATOMIC_RELEASE, "agent");
            asm volatile("s_waitcnt vmcnt(0)" ::: "memory");
            const unsigned og = xb_add(&bar[XB_TOP], 1u);
            const unsigned tg = og / nx;
            if (og + 1u == (tg + 1u) * nx) xb_add(&bar[XB_TOPGEN], 1u);
            else XB_SPIN(xb_ld(&bar[XB_TOPGEN]) == tg, bar);
            __builtin_amdgcn_fence(__ATOMIC_ACQUIRE, "agent");
            xb_add(&bar[XB_XGEN(b.x)], 1u);
            asm volatile("s_waitcnt vmcnt(0)" ::: "memory");
        } else {
            XB_SPIN(xb_ld(&bar[XB_XGEN(b.x)]) == gen, bar);
            __builtin_amdgcn_fence(__ATOMIC_ACQUIRE, "agent");
            asm volatile("s_waitcnt vmcnt(0)" ::: "memory");
        }
    }
    __syncthreads();
}

struct Ctx {
    LAS unsigned char* lds;
    int tid, lane, wave, vcu, G, gw, NGW;
};
__device__ __forceinline__ Ctx make_ctx(unsigned char* lds_raw, const int wv) {
    Ctx C; int l = lane_id(); asm volatile("" : "+v"(l));
    C.lds = (LAS unsigned char*)lds_raw; C.tid = wv * 64 + l; C.lane = l; C.wave = wv;
    C.G = gridDim.x; { const int bx = blockIdx.x; C.vcu = (C.G % 8 == 0) ? (bx % 8) * (C.G / 8) + bx / 8 : bx; }
    C.gw = C.vcu * NW + C.wave; C.NGW = C.G * NW;
    return C;
}

__device__ __forceinline__ void transpose_item(const float* W, int ldw, int k0, int n0, bf16* WT, int K, int drow0, LAS float* scr, int lane) {
    float tv[32];
    const float* wp = W + (size_t)(k0 + (lane >> 5)) * ldw + n0 + (lane & 31);
#pragma unroll
    for (int i = 0; i < 32; ++i) tv[i] = __builtin_nontemporal_load(wp + (size_t)(2 * i) * ldw);
#pragma unroll
    for (int i = 0; i < 32; ++i) scr[(2 * i + (lane >> 5)) * 33 + (lane & 31)] = tv[i];
    LDS_WAIT(); asm volatile("" ::: "memory");
    const int c = lane & 7;
#pragma unroll
    for (int j = 0; j < 4; ++j) { const int n = (lane >> 3) + 8 * j; const LAS float* s = scr + (8 * c) * 33 + n;
        v4u o; o.x = pk2(s[0 * 33], s[1 * 33]); o.y = pk2(s[2 * 33], s[3 * 33]); o.z = pk2(s[4 * 33], s[5 * 33]); o.w = pk2(s[6 * 33], s[7 * 33]);
        *(v4u*)(WT + (size_t)(drow0 + n) * K + k0 + 8 * c) = o; }
    LDS_WAIT(); asm volatile("" ::: "memory");
}
__device__ __forceinline__ void paired_src(int db, int& type, int& ch) { const int j0 = 32 * db, pn = j0 >> 8, jj = j0 & 255; type = jj >> 7; ch = 128 * pn + (jj & 127); }

__device__ __forceinline__ void convert_small(const Ctx& C, const float* w1, const float* w2, const float* win, const float* wout, unsigned char* ws) {
    LAS float* scr = (LAS float*)(C.lds + C.wave * 16384);
    constexpr int I1 = 16 * 64, I2 = 16 * 32, I3 = 16 * 160, I4 = 16 * 32, NI = I1 + I2 + I3 + I4;
    for (int it = C.gw; it < NI; it += C.NGW) {
        int r = it;
        if (r < I1) { const int kb = r / 64, db = r % 64; int type, ch; paired_src(db, type, ch); transpose_item(w1, 2048, 64 * kb, type * 1024 + ch, (bf16*)(ws + WS_W1T), 1024, 32 * db, scr, C.lane); continue; } r -= I1;
        if (r < I2) { const int kb = r / 32, db = r % 32; transpose_item(w2, 1024, 64 * kb, 32 * db, (bf16*)(ws + WS_W2T), 1024, 32 * db, scr, C.lane); continue; } r -= I2;
        if (r < I3) { const int kb = r / 160, db = r % 160; transpose_item(win, 5120, 64 * kb, 32 * db, (bf16*)(ws + WS_WINT), 1024, 32 * db, scr, C.lane); continue; } r -= I3;
        { const int kb = r / 32, db = r % 32; transpose_item(wout, 1024, 64 * kb, 32 * db, (bf16*)(ws + WS_WOUTT), 1024, 32 * db, scr, C.lane); }
    }
}
__device__ __forceinline__ void transpose_item_f8(const float* W, int ldw, int k0, int n0, unsigned char* WT, int K, int drow0, LAS float* scr, int lane) {
    float tv[32];
    const float* wp = W + (size_t)(k0 + (lane >> 5)) * ldw + n0 + (lane & 31);
#pragma unroll
    for (int i = 0; i < 32; ++i) tv[i] = __builtin_nontemporal_load(wp + (size_t)(2 * i) * ldw);
#pragma unroll
    for (int i = 0; i < 32; ++i) scr[(2 * i + (lane >> 5)) * 33 + (lane & 31)] = tv[i] * 32.0f;
    LDS_WAIT(); asm volatile("" ::: "memory");
    const int n = lane >> 1, kh = (lane & 1) * 32; const LAS float* sp = scr + kh * 33 + n;
    unsigned o[8];
#pragma unroll
    for (int q = 0; q < 8; ++q) o[q] = pg8::pk4_fp8(sp[(4 * q) * 33], sp[(4 * q + 1) * 33], sp[(4 * q + 2) * 33], sp[(4 * q + 3) * 33]);
    unsigned char* dp = WT + (size_t)(drow0 + n) * K + k0 + kh;
    __builtin_nontemporal_store((v4u){o[0], o[1], o[2], o[3]}, (v4u*)dp); __builtin_nontemporal_store((v4u){o[4], o[5], o[6], o[7]}, (v4u*)(dp + 16));
    LDS_WAIT(); asm volatile("" ::: "memory");
}
__device__ __forceinline__ void convert_moe(const Ctx& C, const float* wg, const float* wu, const float* wd, int layer, unsigned char* ws, int it_lo, int it_hi, int widx, int nw) {
    LAS float* scr = (LAS float*)(C.lds + C.wave * 16384);
    constexpr int IGU = 16 * 128, IDN = 32 * 32, IE = IGU + IDN;
    const size_t lo = (size_t)layer * NE * 1024 * 2048;
    unsigned char* const w13 = ws + (layer ? WS_W13T_L1 : WS_W13T); unsigned char* const wdt = ws + (layer ? WS_WDT_L1 : WS_WDT);
    for (int it = it_lo + widx; it < it_hi; it += nw) {
        const int e = it / IE; int r = it % IE;
        if (r < IGU) { const int kb = r / 128, db = r % 128; int type, ch; paired_src(db, type, ch);
            transpose_item_f8((type ? wu : wg) + lo + (size_t)e * 1024 * 2048, 2048, 64 * kb, ch, w13 + (size_t)e * 4096 * 1024, 1024, 32 * db, scr, C.lane); }
        else { r -= IGU; const int kb = r / 32, db = r % 32;
            transpose_item_f8(wd + lo + (size_t)e * 2048 * 1024, 1024, 64 * kb, 32 * db, wdt + (size_t)e * 1024 * 2048, 2048, 32 * db, scr, C.lane); }
    }
}
__device__ __forceinline__ void mod_gemv(const Ctx& C, const float* c, const float* cctx, const float* mod_w, const float* mod_b, float* MV) {
    LAS float* cond = (LAS float*)C.lds;
    LAS float* red = cond + 5 * 1024;
    bool have = false;
    for (int item = blockIdx.x; item < 192; item += C.G) {
        if (!have) { for (int i = C.tid; i < 5 * 1024; i += NW * 64) { const int g = i >> 10, k = i & 1023; const float v = g < 4 ? c[g * 1024 + k] : cctx[k]; cond[i] = v * fsig(v); } have = true; }
        __syncthreads();
        const int l = item / 96, n = (item % 96) * 64 + C.lane;
        const float* W = mod_w + (size_t)l * 1024 * 6144 + n;
        float a[5] = {0.f, 0.f, 0.f, 0.f, 0.f};
        for (int kk = 0; kk < 128; kk += 32) { float w[32];
#pragma unroll
            for (int u = 0; u < 32; ++u) w[u] = __builtin_nontemporal_load(W + (size_t)(C.wave * 128 + kk + u) * 6144);
#pragma unroll
            for (int u = 0; u < 32; ++u)
#pragma unroll
                for (int g = 0; g < 5; ++g) a[g] += cond[g * 1024 + C.wave * 128 + kk + u] * w[u]; }
#pragma unroll
        for (int g = 0; g < 5; ++g) red[(C.wave * 5 + g) * 64 + C.lane] = a[g];
        __syncthreads();
        if (C.wave < 5) { float s = 0.f;
#pragma unroll
            for (int w = 0; w < 8; ++w) s += red[(w * 5 + C.wave) * 64 + C.lane];
            MV[(size_t)(l * 5 + C.wave) * 6144 + n] = s + mod_b[l * 6144 + n]; }
    }
}

struct RowArgs {
    const float* src_lat; const float* src_ctx;
    const bf16* delta;
    float* dst_lat; float* dst_ctx;
    const float* gamma;
    const float* mv;
    const float* mvg;
    int i_shift, i_scale, i_gate;
    bf16* HB; unsigned char* HB8; float* AFF; const float* router_w;
    const bf16* Y; const short* INV; int rpe;
    int nrows;
};
template <bool COMBINE, bool ROUTER, bool FINAL>
__device__ __forceinline__ void row_phase(const Ctx& C, const RowArgs& A) {
    LAS float* rwT = (LAS float*)C.lds;
    if (ROUTER) { for (int i = C.tid; i < 16384; i += NW * 64) rwT[(i & 15) * 1024 + (i >> 4)] = A.router_w[i]; __syncthreads(); }
    const int rpw = (A.nrows + C.NGW - 1) / C.NGW;
    const int r_lo = C.gw * rpw, r_hi = min(A.nrows, r_lo + rpw);
    const int l4 = 4 * C.lane;
    int cur_grp = -1;
    f32x4 ga[4], sh[4], m5[4];
#pragma unroll
    for (int j = 0; j < 4; ++j) { ga[j] = (f32x4){0.f, 0.f, 0.f, 0.f}; sh[j] = ga[j]; m5[j] = ga[j]; }
    constexpr bool DELTA = ROUTER || COMBINE;
    f32x4 vn[4]; v2u dn[4];
#pragma unroll
    for (int j = 0; j < 4; ++j) { vn[j] = (f32x4){0.f, 0.f, 0.f, 0.f}; dn[j] = (v2u){0u, 0u}; }
    if (r_lo < r_hi) { const bool ic = r_lo >= NLAT; const float* s0 = (ic ? A.src_ctx + (size_t)(r_lo - NLAT) * 1024 : A.src_lat + (size_t)r_lo * 1024);
#pragma unroll
        for (int j = 0; j < 4; ++j) { vn[j] = *(const f32x4*)(s0 + l4 + 256 * j); if (DELTA) dn[j] = *(const v2u*)(A.delta + (size_t)r_lo * 1024 + l4 + 256 * j); } }
    int svn = -1;
    if (COMBINE && r_lo < r_hi) svn = (C.lane < 16) ? (int)A.INV[(size_t)r_lo * 16 + C.lane] : -1;
    for (int r = r_lo; r < r_hi; ++r) {
        const bool isctx = r >= NLAT; const int grp = isctx ? 4 : (r >> 13);
        if (grp != cur_grp) { cur_grp = grp; const float* mvn = A.mv + (size_t)grp * 6144;
#pragma unroll
            for (int j = 0; j < 4; ++j) { const int c0 = l4 + 256 * j; const f32x4 g = *(const f32x4*)(A.gamma + c0);
                if (FINAL) { ga[j] = g; }
                else { const f32x4 sc = *(const f32x4*)(mvn + A.i_scale * 1024 + c0); ga[j] = g * (sc + 1.0f); sh[j] = *(const f32x4*)(mvn + A.i_shift * 1024 + c0); }
                if (COMBINE) m5[j] = *(const f32x4*)(A.mvg + (size_t)grp * 6144 + A.i_gate * 1024 + c0); } }
        const size_t roff = isctx ? (size_t)(r - NLAT) * 1024 : (size_t)r * 1024;
        f32x4 v[4];
#pragma unroll
        for (int j = 0; j < 4; ++j) { v[j] = vn[j]; if (DELTA) v[j] += (f32x4){bflo(dn[j].x), bfhi(dn[j].x), bflo(dn[j].y), bfhi(dn[j].y)}; }
        if (r + 1 < r_hi) { const int rn = r + 1; const bool ic = rn >= NLAT; const float* s1 = (ic ? A.src_ctx + (size_t)(rn - NLAT) * 1024 : A.src_lat + (size_t)rn * 1024);
#pragma unroll
            for (int j = 0; j < 4; ++j) { vn[j] = *(const f32x4*)(s1 + l4 + 256 * j); if (DELTA) dn[j] = *(const v2u*)(A.delta + (size_t)rn * 1024 + l4 + 256 * j); } }
        if (COMBINE) {
            f32x4 acc[4];
#pragma unroll
            for (int j = 0; j < 4; ++j) acc[j] = (f32x4){0.f, 0.f, 0.f, 0.f};
            const int sv = svn;
            if (r + 1 < r_hi) svn = (C.lane < 16) ? (int)A.INV[(size_t)(r + 1) * 16 + C.lane] : -1;
            unsigned long long m = __ballot(sv >= 0);
            while (m) {
                const int e0 = __ffsll((long long)m) - 1; m &= m - 1;
                const bool two = m != 0ull; const int e1 = two ? __ffsll((long long)m) - 1 : e0; if (two) m &= m - 1;
                const bf16* y0 = A.Y + ((size_t)e0 * A.rpe + __shfl(sv, e0)) * 1024 + l4;
                const bf16* y1 = A.Y + ((size_t)e1 * A.rpe + __shfl(sv, e1)) * 1024 + l4;
                v2u w0[4], w1[4];
#pragma unroll
                for (int j = 0; j < 4; ++j) { w0[j] = *(const v2u*)(y0 + 256 * j); w1[j] = *(const v2u*)(y1 + 256 * j); }
#pragma unroll
                for (int j = 0; j < 4; ++j) { acc[j] += (f32x4){bflo(w0[j].x), bfhi(w0[j].x), bflo(w0[j].y), bfhi(w0[j].y)};
                    if (two) acc[j] += (f32x4){bflo(w1[j].x), bfhi(w1[j].x), bflo(w1[j].y), bfhi(w1[j].y)}; } }
#pragma unroll
            for (int j = 0; j < 4; ++j) v[j] += m5[j] * acc[j];
            if (!FINAL) { float* dst = (isctx ? A.dst_ctx : A.dst_lat) + roff;
#pragma unroll
                for (int j = 0; j < 4; ++j) *(f32x4*)(dst + l4 + 256 * j) = v[j]; }
        }
        float ss = 0.f;
#pragma unroll
        for (int j = 0; j < 4; ++j) ss += (v[j].x * v[j].x + v[j].y * v[j].y) + (v[j].z * v[j].z + v[j].w * v[j].w);
        const float rstd = rsqrtf(wave_sum(ss) * (1.0f / 1024.0f) + EPS);
        if (FINAL) { float* dst = A.dst_lat + roff;
#pragma unroll
            for (int j = 0; j < 4; ++j) *(f32x4*)(dst + l4 + 256 * j) = v[j] * rstd * ga[j];
            continue; }
        f32x4 hv[4];
#pragma unroll
        for (int j = 0; j < 4; ++j) { hv[j] = v[j] * rstd * ga[j] + sh[j];
            if (ROUTER) { *(unsigned*)(A.HB8 + (size_t)r * 1024 + l4 + 256 * j) = pg8::pk4_fp8(hv[j].x, hv[j].y, hv[j].z, hv[j].w); }
            else { v2u w; w.x = pk2(hv[j].x, hv[j].y); w.y = pk2(hv[j].z, hv[j].w); *(v2u*)(A.HB + (size_t)r * 1024 + l4 + 256 * j) = w; } }
        if (ROUTER) {
            float lg[16];
#pragma unroll
            for (int e = 0; e < 16; ++e) { float s = 0.f;
#pragma unroll
                for (int j = 0; j < 4; ++j) { const f32x4 w = *(const LAS f32x4*)(rwT + e * 1024 + l4 + 256 * j); s += (hv[j].x * w.x + hv[j].y * w.y) + (hv[j].z * w.z + hv[j].w * w.w); }
                lg[e] = s; }
            float t8[8], t4[4], t2[2], t1;
#pragma unroll
            for (int i = 0; i < 8; ++i) { const bool up = (C.lane & 32) != 0; const float send = up ? lg[i] : lg[i + 8], keep = up ? lg[i + 8] : lg[i]; t8[i] = keep + __shfl_xor(send, 32); }
#pragma unroll
            for (int i = 0; i < 4; ++i) { const bool up = (C.lane & 16) != 0; const float send = up ? t8[i] : t8[i + 4], keep = up ? t8[i + 4] : t8[i]; t4[i] = keep + __shfl_xor(send, 16); }
#pragma unroll
            for (int i = 0; i < 2; ++i) { const bool up = (C.lane & 8) != 0; const float send = up ? t4[i] : t4[i + 2], keep = up ? t4[i + 2] : t4[i]; t2[i] = keep + __shfl_xor(send, 8); }
            { const bool up = (C.lane & 4) != 0; const float send = up ? t2[0] : t2[1], keep = up ? t2[1] : t2[0]; t1 = keep + __shfl_xor(send, 4); }
            t1 += __shfl_xor(t1, 2); t1 += __shfl_xor(t1, 1);
            const int e = ((C.lane >> 5) & 1) * 8 + ((C.lane >> 4) & 1) * 4 + ((C.lane >> 3) & 1) * 2 + ((C.lane >> 2) & 1);
            float mx = t1;
#pragma unroll
            for (int o = 4; o < 64; o <<= 1) mx = fmaxf(mx, __shfl_xor(mx, o));
            const float p = __expf(t1 - mx); float sum = p;
#pragma unroll
            for (int o = 4; o < 64; o <<= 1) sum += __shfl_xor(sum, o);
            if ((C.lane & 3) == 0) A.AFF[(size_t)r * 16 + e] = p / sum;
        }
    }
    if (ROUTER) __syncthreads();
}

__device__ __forceinline__ void conv_phase(const Ctx& C, const bf16* U, bf16* V, const float* dw, const float* dwb, const float* lng, const float* lnb) {
    LAS unsigned* ut = (LAS unsigned*)C.lds;
    LAS float* part = (LAS float*)(C.lds + 126976);
    LAS float* stat = part + 512;
    const int cp = C.tid;
    f32x2 wt[31];
#pragma unroll
    for (int j = 0; j < 31; ++j) wt[j] = *(const f32x2*)(dw + j * 1024 + 2 * cp);
    const f32x2 bb = *(const f32x2*)(dwb + 2 * cp), gg = *(const f32x2*)(lng + 2 * cp), be = *(const f32x2*)(lnb + 2 * cp);
    for (int tile = C.vcu; tile < 1056; tile += C.G) {
        int rowbase, t0, tseq;
        if (tile < 1024) { rowbase = (tile >> 8) * T; t0 = (tile & 255) * 32; tseq = T; } else { const int tt = tile - 1024; rowbase = NLAT + (tt >> 3) * TCX; t0 = (tt & 7) * 32; tseq = TCX; }
        { v4u tv[16];
#pragma unroll
            for (int k = 0; k < 16; ++k) { const int i = 4 * k + (C.tid >> 7), t = t0 - 15 + i; tv[k] = (v4u){0u, 0u, 0u, 0u};
                if (i < 62 && t >= 0 && t < tseq) tv[k] = *(const v4u*)(U + (size_t)(rowbase + t) * 1024 + (C.tid & 127) * 8); }
#pragma unroll
            for (int k = 0; k < 16; ++k) { const int i = 4 * k + (C.tid >> 7); if (i < 62) *(LAS v4u*)(C.lds + i * 2048 + (C.tid & 127) * 16) = tv[k]; } }
        __syncthreads();
        f32x2 ov[32];
#pragma unroll
        for (int g = 0; g < 8; ++g) {
            f32x2 a[4];
#pragma unroll
            for (int oo = 0; oo < 4; ++oo) a[oo] = bb;
#pragma unroll
            for (int jj = 0; jj < 34; ++jj) { const unsigned uw = ut[(4 * g + jj) * 512 + cp]; const f32x2 uu = (f32x2){bflo(uw), bfhi(uw)};
#pragma unroll
                for (int oo = 0; oo < 4; ++oo) { const int tap = jj - oo; if (tap >= 0 && tap <= 30) a[oo] = __builtin_elementwise_fma(wt[tap], uu, a[oo]); } }
            float r8[8];
#pragma unroll
            for (int oo = 0; oo < 4; ++oo) { ov[4 * g + oo] = a[oo]; r8[2 * oo] = a[oo].x + a[oo].y; r8[2 * oo + 1] = a[oo].x * a[oo].x + a[oo].y * a[oo].y; }
            float r4[4], r2[2], r1;
#pragma unroll
            for (int i = 0; i < 4; ++i) { const bool up = (C.lane & 32) != 0; const float send = up ? r8[i] : r8[i + 4], keep = up ? r8[i + 4] : r8[i]; r4[i] = keep + __shfl_xor(send, 32); }
#pragma unroll
            for (int i = 0; i < 2; ++i) { const bool up = (C.lane & 16) != 0; const float send = up ? r4[i] : r4[i + 2], keep = up ? r4[i + 2] : r4[i]; r2[i] = keep + __shfl_xor(send, 16); }
            { const bool up = (C.lane & 8) != 0; const float send = up ? r2[0] : r2[1], keep = up ? r2[1] : r2[0]; r1 = keep + __shfl_xor(send, 8); }
            r1 += __shfl_xor(r1, 4); r1 += __shfl_xor(r1, 2); r1 += __shfl_xor(r1, 1);
            if ((C.lane & 7) == 0) { const int vi = ((C.lane >> 5) & 1) * 4 + ((C.lane >> 4) & 1) * 2 + ((C.lane >> 3) & 1); part[((4 * g + (vi >> 1)) * 8 + C.wave) * 2 + (vi & 1)] = r1; }
            asm volatile("" ::: "memory");
        }
        __syncthreads();
        if (C.tid < 32) { float s1 = 0.f, s2 = 0.f;
#pragma unroll
            for (int w = 0; w < 8; ++w) { s1 += part[(C.tid * 8 + w) * 2]; s2 += part[(C.tid * 8 + w) * 2 + 1]; }
            const float mean = s1 * (1.0f / 1024.0f), var = fmaxf(s2 * (1.0f / 1024.0f) - mean * mean, 0.f);
            stat[C.tid * 2] = mean; stat[C.tid * 2 + 1] = rsqrtf(var + EPS); }
        __syncthreads();
#pragma unroll
        for (int tk = 0; tk < 32; ++tk) { const float mean = stat[tk * 2], rstd = stat[tk * 2 + 1];
            const float y0 = (ov[tk].x - mean) * rstd * gg.x + be.x, y1 = (ov[tk].y - mean) * rstd * gg.y + be.y;
            *(unsigned*)(V + (size_t)(rowbase + t0 + tk) * 1024 + 2 * cp) = pk2(y0 * fsig(y0), y1 * fsig(y1)); }
    }
}

__device__ __forceinline__ unsigned block_excl_scan(const Ctx& C, unsigned v, LAS unsigned* wsum, unsigned& total) {
    unsigned inc = v;
#pragma unroll
    for (int o = 1; o < 64; o <<= 1) { const unsigned t = __shfl_up(inc, o); if (C.lane >= o) inc += t; }
    if (C.lane == 63) wsum[C.wave] = inc;
    __syncthreads();
    unsigned base = 0, tot = 0;
#pragma unroll
    for (int w = 0; w < NW; ++w) { const unsigned s = wsum[w]; if (w < C.wave) base += s; tot += s; }
    __syncthreads();
    total = tot;
    return base + inc - v;
}
__device__ __forceinline__ void topk_phase(const Ctx& C, int nprob, int rpe, const float* AFF, int* SEL, float* GSEL, short* INV) {
    LAS unsigned* hist = (LAS unsigned*)C.lds;
    LAS unsigned* misc = hist + 256;
    LAS unsigned* wsum = misc + 16;
    for (int prob = blockIdx.x; prob < nprob; prob += C.G) {
        const int set = prob >> 4, e = prob & 15; const bool lat = set < 4;
        const int kk = lat ? CAPL : CAPC, rowbase = lat ? set * T : NLAT + (set - 4) * TCX, slotbase = lat ? set * CAPL : 4 * CAPL + (set - 4) * CAPC;
        const int cnt = lat ? 16 : (C.tid < 256 ? 1 : 0), base = lat ? C.tid * 16 : C.tid;
        unsigned key[16];
#pragma unroll
        for (int i = 0; i < 16; ++i) key[i] = (i < cnt) ? __float_as_uint(AFF[(size_t)(rowbase + base + i) * 16 + e]) : 0u;
        unsigned prefix = 0u, mask = 0u, need = (unsigned)kk;
#pragma unroll 1
        for (int pass = 0; pass < 4; ++pass) { const int shift = 24 - 8 * pass;
            if (C.tid < 256) hist[C.tid] = 0u;
            __syncthreads();
#pragma unroll
            for (int i = 0; i < 16; ++i) if (i < cnt && (key[i] & mask) == prefix) __hip_atomic_fetch_add(&hist[(key[i] >> shift) & 255u], 1u, __ATOMIC_RELAXED, __HIP_MEMORY_SCOPE_WORKGROUP);
            __syncthreads();
            if (C.wave == 0) { unsigned h[4], tot = 0u;
#pragma unroll
                for (int b = 0; b < 4; ++b) { h[b] = hist[4 * C.lane + b]; tot += h[b]; }
                unsigned inc = tot;
#pragma unroll
                for (int o = 1; o < 64; o <<= 1) { const unsigned t = __shfl_down(inc, o); if (C.lane + o < 64) inc += t; }
                unsigned cgt = inc - tot;
#pragma unroll
                for (int b = 3; b >= 0; --b) { if (cgt < need && need <= cgt + h[b]) { misc[0] = (unsigned)(4 * C.lane + b); misc[1] = need - cgt; } cgt += h[b]; } }
            __syncthreads();
            prefix |= misc[0] << shift; mask |= 255u << shift; need = misc[1];
        }
        unsigned neq = 0u, ngt = 0u;
#pragma unroll
        for (int i = 0; i < 16; ++i) if (i < cnt) { neq += (key[i] == prefix) ? 1u : 0u; ngt += (key[i] > prefix) ? 1u : 0u; }
        unsigned tot;
        const unsigned eq_before = block_excl_scan(C, neq, wsum, tot);
        const unsigned take_eq = (need > eq_before) ? min(neq, need - eq_before) : 0u;
        unsigned slot = block_excl_scan(C, ngt + take_eq, wsum, tot);
        unsigned eqr = eq_before;
#pragma unroll
        for (int i = 0; i < 16; ++i) if (i < cnt) {
            bool sel = key[i] > prefix;
            if (key[i] == prefix) { sel = eqr < need; ++eqr; }
            const int row = rowbase + base + i;
            if (sel) { const int s = slotbase + (int)slot; ++slot; SEL[e * rpe + s] = row; GSEL[e * rpe + s] = __uint_as_float(key[i]); INV[(size_t)row * 16 + e] = (short)s; }
            else INV[(size_t)row * 16 + e] = (short)-1; }
        if (rpe == RPE0 && set == 4 && C.tid < RPE0 - (4 * CAPL + 4 * CAPC)) { const int s = 4 * CAPL + 4 * CAPC + C.tid; SEL[e * rpe + s] = 0; GSEL[e * rpe + s] = 0.f; }
        __syncthreads();
    }
}
__device__ __forceinline__ void gather_phase(const Ctx& C, int nrows, const int* SEL, const bf16* HB, bf16* XG) {
    for (int r = C.gw; r < nrows; r += C.NGW) { const int src = SEL[r];
        const v4u a = *(const v4u*)(HB + (size_t)src * 1024 + 8 * C.lane), b = *(const v4u*)(HB + (size_t)src * 1024 + 512 + 8 * C.lane);
        *(v4u*)(XG + (size_t)r * 1024 + 8 * C.lane) = a; *(v4u*)(XG + (size_t)r * 1024 + 512 + 8 * C.lane) = b; }
}

__device__ __forceinline__ f32x4 mfma16(bf16x8 a, bf16x8 b, f32x4 c) { return __builtin_amdgcn_mfma_f32_16x16x32_bf16(a, b, c, 0, 0, 0); }
#define PRJ_AT(qn, h_, row_) (PRJ + (((size_t)((qn) * NH + (h_)) * R + (size_t)(row_)) * HD))
#define DH_AT(buf, dir_, h_, row_) ((buf) + (((size_t)((dir_) * NH + (h_)) * NLAT + (size_t)(row_)) * HD))
constexpr int QROW = 272, TROW = 144;
constexpr int SC_QG = 0, SC_KT = 17408, SC_KGT = 34816  , SC_VT = 71680  , SC_SC = 108544, SC_SEG = 117760, SC_PCH = 121856  , SC_PG = 122880;
static_assert(SC_PG + 512 <= 131072, "scan LDS map");

__device__ __forceinline__ void scanA_phase(const Ctx& C, const bf16* PRJ, const float* LB, bf16* OLOC, bf16* QGG, float* SLOC, float* PTOT) {
    LAS unsigned char* L = C.lds;
    LAS float* SEG = (LAS float*)(L + SC_SEG); LAS float* PG = (LAS float*)(L + SC_PG);
    const int lane = C.lane, w = C.wave, g = lane >> 4, lr = lane & 15, k0 = 2 * lane, seg = w;
    for (int ui = C.vcu; ui < NSEQ * NGRP; ui += C.G) {
        int seq, grp; if (ui < NSEQ * 16) { seq = ui >> 4; grp = 1 + (ui & 15); } else { seq = ui - NSEQ * 16; grp = 0; }
        const int b = seq >> 4, h = (seq >> 1) & 7, dir = seq & 1, nch = grp ? 8 : 4, sgn = dir ? -1 : 1;
        const int hc = h * HD;
        f32x4 S[8];
#pragma unroll
        for (int i = 0; i < 8; ++i) S[i] = (f32x4){0.f, 0.f, 0.f, 0.f};
        if (C.tid < 128) PG[C.tid] = 1.0f;
        const int Pb = grp ? (grp - 1) * 512 : 0, rbase = grp ? b * T : NLAT + b * TCX, tlen = grp ? T : TCX;
#define ROWC(c) (rbase + (dir ? tlen - 1 - (Pb + 64 * (c)) : Pb + 64 * (c)))
        unsigned fq[8], qq[8]; v4u vv[2];
        float pl0[8], pl1[8], kk0[8], kk1[8], pg0 = 1.f, pg1 = 1.f, pt0 = 1.f, pt1 = 1.f;
#define SC_LOAD(c) do { const int rn_ = ROWC(c); \
            _Pragma("unroll") for (int i = 0; i < 8; ++i) { const int rw_ = rn_ + sgn * (8 * seg + i); fq[i] = *(const unsigned*)(PRJ_AT(1 + dir, h, rw_) + k0); qq[i] = *(const unsigned*)(PRJ_AT(0, h, rw_) + k0); } \
            _Pragma("unroll") for (int ii = 0; ii < 2; ++ii) { const int cq = C.tid + 512 * ii; vv[ii] = *(const v4u*)(PRJ_AT(3, h, rn_ + sgn * (cq & 63)) + (cq >> 6) * 8); } } while (0)
#define SC_PREP1(c) do { float run0 = 1.f, run1 = 1.f; \
            _Pragma("unroll") for (int i = 0; i < 8; ++i) { kk0[i] = bflo(fq[i]); kk1[i] = bfhi(fq[i]);          \
                run0 *= 1.f - kk0[i]; run1 *= 1.f - kk1[i]; pl0[i] = run0; pl1[i] = run1; } \
            *(LAS f32x2*)(SEG + seg * 128 + k0) = (f32x2){run0, run1}; \
            _Pragma("unroll") for (int ii = 0; ii < 2; ++ii) { const int cq = C.tid + 512 * ii, p_ = cq & 63, v0 = (cq >> 6) * 8; LAS bf16* vt = (LAS bf16*)(L + SC_VT + ((c) & 1) * 18432) + p_; \
                const unsigned wds[4] = {vv[ii].x, vv[ii].y, vv[ii].z, vv[ii].w}; \
                _Pragma("unroll") for (int j = 0; j < 4; ++j) { vt[(v0 + 2 * j) * (TROW / 2)] = (bf16)(wds[j] & 0xffffu); vt[(v0 + 2 * j + 1) * (TROW / 2)] = (bf16)(wds[j] >> 16); } } \
            pg0 = PG[k0]; pg1 = PG[k0 + 1]; } while (0)
#define SC_PREP2(c) do { const int rc_ = ROWC(c); float pb0 = 1.f, pb1 = 1.f; pt0 = 1.f; pt1 = 1.f; \
            _Pragma("unroll") for (int s = 0; s < 8; ++s) { const f32x2 t = *(const LAS f32x2*)(SEG + s * 128 + k0); if (s < seg) { pb0 *= t.x; pb1 *= t.y; } pt0 *= t.x; pt1 *= t.y; } \
            unsigned kg0[4], kg1[4]; float kprev0 = 0.f, kprev1 = 0.f; \
            _Pragma("unroll") for (int i = 0; i < 8; ++i) { const int p_ = 8 * seg + i; \
                const float P0 = pb0 * pl0[i], P1 = pb1 * pl1[i]; \
                const float qg0 = bflo(qq[i]) * P0, qg1 = bfhi(qq[i]) * P1; \
                const float kt0 = kk0[i] * __builtin_amdgcn_rcpf(fmaxf(P0, 1e-30f)), kt1 = kk1[i] * __builtin_amdgcn_rcpf(fmaxf(P1, 1e-30f)); \
                *(LAS unsigned*)(L + SC_QG + p_ * QROW + k0 * 2) = pk2(qg0, qg1); \
                *(LAS unsigned*)(L + SC_KT + p_ * QROW + k0 * 2) = pk2(kt0, kt1); \
                const float a0 = kt0 * pt0, a1 = kt1 * pt1; \
                if (i & 1) { kg0[i >> 1] = pk2(kprev0, a0); kg1[i >> 1] = pk2(kprev1, a1); } else { kprev0 = a0; kprev1 = a1; } \
                if (grp) *(unsigned*)(DH_AT(QGG, dir, h, rc_ + sgn * p_) + k0) = pk2(qg0 * pg0, qg1 * pg1); } \
            *(LAS v4u*)(L + SC_KGT + ((c) & 1) * 18432 + k0 * TROW + seg * 16) = (v4u){kg0[0], kg0[1], kg0[2], kg0[3]}; \
            *(LAS v4u*)(L + SC_KGT + ((c) & 1) * 18432 + (k0 + 1) * TROW + seg * 16) = (v4u){kg1[0], kg1[1], kg1[2], kg1[3]}; \
            if (seg == 0) *(LAS f32x2*)(L + SC_PCH + ((c) & 1) * 512 + k0 * 4) = (f32x2){pt0, pt1}; \
            if ((c) + 1 < nch) SC_LOAD((c) + 1); } while (0)
#define SC_SCORES() do { if (seg == 0) *(LAS f32x2*)(PG + k0) = (f32x2){pg0 * pt0, pg1 * pt1}; \
            const int pi = w >> 1; \
            _Pragma("unroll") for (int tt = 0; tt < 2; ++tt) { const int si = 2 * (w & 1) + tt; f32x4 acc = (f32x4){0.f, 0.f, 0.f, 0.f}; \
                _Pragma("unroll") for (int ks = 0; ks < 4; ++ks) { const bf16x8 a = *(const LAS bf16x8*)(L + SC_QG + (16 * pi + lr) * QROW + (32 * ks + 8 * g) * 2); \
                    const bf16x8 bb = *(const LAS bf16x8*)(L + SC_KT + (16 * si + lr) * QROW + (32 * ks + 8 * g) * 2); acc = mfma16(a, bb, acc); } \
                _Pragma("unroll") for (int r = 0; r < 4; ++r) { const int p_ = 16 * pi + 4 * g + r, s_ = 16 * si + lr; const float val = (s_ <= p_) ? acc[r] : 0.f; \
                    *(LAS bf16*)(L + SC_SC + p_ * TROW + s_ * 2) = (bf16)(pk2(val, 0.f) & 0xffffu); } } } while (0)
#define SC_OUTPUTS(c) do { const int rc_ = ROWC(c); const LAS unsigned char* VTc = L + SC_VT + ((c) & 1) * 18432; f32x4 O[4]; \
            _Pragma("unroll") for (int pt = 0; pt < 4; ++pt) O[pt] = (f32x4){0.f, 0.f, 0.f, 0.f}; \
            _Pragma("unroll") for (int ks = 0; ks < 4; ++ks) { \
                v4u sw; sw.x = pk2(S[2 * ks][0], S[2 * ks][1]); sw.y = pk2(S[2 * ks][2], S[2 * ks][3]); sw.z = pk2(S[2 * ks + 1][0], S[2 * ks + 1][1]); sw.w = pk2(S[2 * ks + 1][2], S[2 * ks + 1][3]); \
                const bf16x8 sb = __builtin_bit_cast(bf16x8, sw); \
                _Pragma("unroll") for (int pt = 0; pt < 4; ++pt) { const LAS unsigned char* qp = L + SC_QG + (16 * pt + lr) * QROW + (32 * ks + 4 * g) * 2; \
                    const v2u lo = *(const LAS v2u*)qp, hi = *(const LAS v2u*)(qp + 32); \
                    const bf16x8 a = __builtin_bit_cast(bf16x8, (v4u){lo.x, lo.y, hi.x, hi.y}); O[pt] = mfma16(sb, a, O[pt]); } } \
            _Pragma("unroll") for (int ks = 0; ks < 2; ++ks) { const bf16x8 bvk = *(const LAS bf16x8*)(VTc + (16 * w + lr) * TROW + (32 * ks + 8 * g) * 2); \
                _Pragma("unroll") for (int pt = 0; pt < 4; ++pt) { const bf16x8 a = *(const LAS bf16x8*)(L + SC_SC + (16 * pt + lr) * TROW + (32 * ks + 8 * g) * 2); O[pt] = mfma16(bvk, a, O[pt]); } } \
            if (grp) { _Pragma("unroll") for (int pt = 0; pt < 4; ++pt) { const int p_ = 16 * pt + lr; \
                *(v2u*)(DH_AT(OLOC, dir, h, rc_ + sgn * p_) + 16 * w + 4 * g) = (v2u){pk2(O[pt][0], O[pt][1]), pk2(O[pt][2], O[pt][3])}; } } } while (0)
#define SC_UPDATE(c) do { const LAS unsigned char* VTc = L + SC_VT + ((c) & 1) * 18432; const LAS unsigned char* KGc = L + SC_KGT + ((c) & 1) * 18432; const LAS float* PCc = (const LAS float*)(L + SC_PCH + ((c) & 1) * 512); \
            bf16x8 bv[2]; \
            _Pragma("unroll") for (int ks = 0; ks < 2; ++ks) bv[ks] = *(const LAS bf16x8*)(VTc + (16 * w + lr) * TROW + (32 * ks + 8 * g) * 2); \
            _Pragma("unroll") for (int kt = 0; kt < 8; ++kt) { const f32x4 pc = *(const LAS f32x4*)(PCc + 16 * kt + 4 * g); S[kt] = S[kt] * pc; \
                _Pragma("unroll") for (int ks = 0; ks < 2; ++ks) { const bf16x8 a = *(const LAS bf16x8*)(KGc + (16 * kt + lr) * TROW + (32 * ks + 8 * g) * 2); S[kt] = mfma16(a, bv[ks], S[kt]); } } } while (0)
        SC_LOAD(0);
        __syncthreads();
        SC_PREP1(0);
        __syncthreads();
        SC_PREP2(0);
        __syncthreads();
        SC_SCORES();
        __syncthreads();
#pragma unroll 1
        for (int c = 0; c < nch; ++c) {
            const bool more = c + 1 < nch;
            if (more) SC_PREP1(c + 1);
            SC_OUTPUTS(c);
            __syncthreads();
            if (more) SC_PREP2(c + 1);
            SC_UPDATE(c);
            __syncthreads();
            if (more) SC_SCORES();
            __syncthreads();
        }
        if (grp < 16) {
#pragma unroll
            for (int kt = 0; kt < 8; ++kt)
#pragma unroll
                for (int r = 0; r < 4; ++r) SLOC[(((size_t)seq * 16 + grp) * 128 + 16 * kt + 4 * g + r) * 128 + 16 * w + lr] = S[kt][r]; }
        if (C.tid < 128) PTOT[((size_t)seq * NGRP + grp) * 128 + C.tid] = PG[C.tid];
        __syncthreads();
#undef ROWC
#undef SC_LOAD
#undef SC_PREP1
#undef SC_PREP2
#undef SC_SCORES
#undef SC_OUTPUTS
#undef SC_UPDATE
    }
}
__device__ __forceinline__ void scanB_phase(const Ctx& C, const float* SLOC, const float* PTOT, bf16* SST) {
    for (int id = C.vcu * (NW * 64) + C.tid; id < NSEQ * 2048; id += C.G * NW * 64) {
        const int seq = id >> 11, k = ((id >> 7) & 15) * 8, v = id & 127;
        float s[8];
#pragma unroll
        for (int i = 0; i < 8; ++i) s[i] = 0.f;
#pragma unroll 4
        for (int gi = 0; gi < 16; ++gi) { const float* pt = PTOT + ((size_t)seq * NGRP + gi) * 128 + k; const float* sl = SLOC + (((size_t)seq * 16 + gi) * 128 + k) * 128 + v;
#pragma unroll
            for (int i = 0; i < 8; ++i) s[i] = pt[i] * s[i] + sl[(size_t)i * 128];
            v4u o; o.x = pk2(s[0], s[1]); o.y = pk2(s[2], s[3]); o.z = pk2(s[4], s[5]); o.w = pk2(s[6], s[7]);
            *(v4u*)(SST + (((size_t)seq * 16 + gi) * 128 + v) * 128 + k) = o; }
    }
}
__device__ __forceinline__ void readout_phase(const Ctx& C, const bf16* PRJ, const bf16* OLOC, const bf16* QGG, const bf16* SST, const float* norm_g, bf16* YH) {
    LAS unsigned char* L = C.lds;
    constexpr int ABUF = 64 * QROW;
    LAS float* OT = (LAS float*)(L + 4 * ABUF);
    const int lane = C.lane, w = C.wave, g = lane >> 4, lr = lane & 15;
    const int p = C.tid >> 3, sg = C.tid & 7;
    f32x4 ng[4];
#pragma unroll
    for (int i = 0; i < 4; ++i) ng[i] = *(const f32x4*)(norm_g + 16 * sg + 4 * i);
    for (int ui = C.vcu; ui < NB * NH * 16; ui += C.G) {
        const int j = ui & 15, h = (ui >> 4) & 7, b = ui >> 7, hc = h * HD, row00 = b * T + 512 * j;
        bf16x8 bfr[2][4];
#pragma unroll
        for (int dir = 0; dir < 2; ++dir) { const int seq = (b * 8 + h) * 2 + dir, gs = dir ? 15 - j : j;
            const bf16* Bb = SST + (((size_t)seq * 16 + gs) * 128 + 16 * w + lr) * 128;
#pragma unroll
            for (int ks = 0; ks < 4; ++ks) bfr[dir][ks] = *(const bf16x8*)(Bb + 32 * ks + 8 * g); }
        v4u ar[2][2];
#define RO_LOADA(tile) do { _Pragma("unroll") for (int dir = 0; dir < 2; ++dir) _Pragma("unroll") for (int ii = 0; ii < 2; ++ii) { const int cq = C.tid + 512 * ii; \
            ar[dir][ii] = *(const v4u*)(DH_AT(QGG, dir, h, row00 + 64 * (tile) + (cq >> 4)) + (cq & 15) * 8); } } while (0)
#define RO_WRITEA(buf) do { _Pragma("unroll") for (int dir = 0; dir < 2; ++dir) _Pragma("unroll") for (int ii = 0; ii < 2; ++ii) { const int cq = C.tid + 512 * ii; \
            *(LAS v4u*)(L + ((buf) * 2 + dir) * ABUF + (cq >> 4) * QROW + (cq & 15) * 16) = ar[dir][ii]; } } while (0)
        RO_LOADA(0); RO_WRITEA(0);
        __syncthreads();
#pragma unroll 1
        for (int t = 0; t < 8; ++t) {
            const int buf = t & 1; const size_t row = (size_t)row00 + 64 * t + p; const int c0 = hc + 16 * sg;
            if (t < 7) RO_LOADA(t + 1);
            v4u eo[2][2]; v4u eg[2];
#pragma unroll
            for (int dir = 0; dir < 2; ++dir) { const bf16* op = DH_AT(OLOC, dir, h, row) + 16 * sg; eo[dir][0] = *(const v4u*)op; eo[dir][1] = *(const v4u*)(op + 8); }
            { const bf16* gp = PRJ_AT(4, h, row) + 16 * sg; eg[0] = *(const v4u*)gp; eg[1] = *(const v4u*)(gp + 8); }
            f32x4 O[4];
#pragma unroll
            for (int pt = 0; pt < 4; ++pt) O[pt] = (f32x4){0.f, 0.f, 0.f, 0.f};
#pragma unroll
            for (int dir = 0; dir < 2; ++dir)
#pragma unroll
                for (int ks = 0; ks < 4; ++ks)
#pragma unroll
                    for (int pt = 0; pt < 4; ++pt) { const bf16x8 a = *(const LAS bf16x8*)(L + (buf * 2 + dir) * ABUF + (16 * pt + lr) * QROW + (32 * ks + 8 * g) * 2); O[pt] = mfma16(a, bfr[dir][ks], O[pt]); }
#pragma unroll
            for (int pt = 0; pt < 4; ++pt)
#pragma unroll
                for (int r = 0; r < 4; ++r) OT[(16 * pt + 4 * g + r) * 132 + 16 * w + lr] = O[pt][r];
            if (t < 7) RO_WRITEA(buf ^ 1);
            __syncthreads();
            f32x4 o[4];
#pragma unroll
            for (int i = 0; i < 4; ++i) o[i] = *(const LAS f32x4*)(OT + p * 132 + 16 * sg + 4 * i);
#pragma unroll
            for (int dir = 0; dir < 2; ++dir) { const v4u a = eo[dir][0], bq = eo[dir][1];
                o[0] += (f32x4){bflo(a.x), bfhi(a.x), bflo(a.y), bfhi(a.y)}; o[1] += (f32x4){bflo(a.z), bfhi(a.z), bflo(a.w), bfhi(a.w)};
                o[2] += (f32x4){bflo(bq.x), bfhi(bq.x), bflo(bq.y), bfhi(bq.y)}; o[3] += (f32x4){bflo(bq.z), bfhi(bq.z), bflo(bq.w), bfhi(bq.w)}; }
            float ss = 0.f;
#pragma unroll
            for (int i = 0; i < 4; ++i) ss += (o[i].x * o[i].x + o[i].y * o[i].y) + (o[i].z * o[i].z + o[i].w * o[i].w);
            ss += __shfl_xor(ss, 1); ss += __shfl_xor(ss, 2); ss += __shfl_xor(ss, 4);
            const float rstd = rsqrtf(ss * (1.0f / 128.0f) + EPS);
            const unsigned gw[8] = {eg[0].x, eg[0].y, eg[0].z, eg[0].w, eg[1].x, eg[1].y, eg[1].z, eg[1].w};
            unsigned ow[8];
#pragma unroll
            for (int i = 0; i < 8; ++i) { const float g0 = bflo(gw[i]), g1 = bfhi(gw[i]);
                const float y0 = o[i >> 1][(2 * i) & 3] * rstd * ng[i >> 1][(2 * i) & 3] * (g0 * fsig(g0));
                const float y1 = o[i >> 1][(2 * i + 1) & 3] * rstd * ng[i >> 1][(2 * i + 1) & 3] * (g1 * fsig(g1));
                ow[i] = pk2(y0, y1); }
            bf16* yp = YH + row * 1024 + c0;
            *(v4u*)yp = (v4u){ow[0], ow[1], ow[2], ow[3]}; *(v4u*)(yp + 8) = (v4u){ow[4], ow[5], ow[6], ow[7]};
            __syncthreads();
        }
#undef RO_LOADA
#undef RO_WRITEA
    }
}

constexpr int NPHASE = 22;
struct Args { const float* in[25]; float* out; unsigned char* ws; int ph_lo, ph_hi; };
constexpr int GRID_C = 256;
constexpr int TAILQ_P2 = 5, TAILQ_P4 = 9, TAILQ_P9 = 6, TAILQ_P11 = 5, TAILQ_P6 = 4, TAILQ_P17 = 3, TAILQ_P3 = 4, TAILQ_P12 = 5;
__device__ __forceinline__ int tail_waves(int nwg, int G) { const int extra = nwg % G; return extra ? (G - extra) * NW : 0; }
#define IDLE_CONVERT(first_, layer_, lo_, q_) do { const int G_ = GRID_C; if ((first_) < G_ && (int)blockIdx.x >= (first_)) { const Ctx Ct = make_ctx(lds_raw, g_wave); CArgs& pt = *opaque_args(); const int nw_ = (G_ - (first_)) * NW; \
        convert_moe(Ct, pt.in[21], pt.in[22], pt.in[23], (layer_), pt.ws, (lo_), min(MOE_ITEMS, (lo_) + (q_) * nw_), ((int)blockIdx.x - (first_)) * NW + Ct.wave, nw_); } } while (0)
__device__ __forceinline__ int idle_waves(int first, int G) { return first < G ? (G - first) * NW : 0; }
#define RANK_CONVERT(rank_, first_, layer_, lo_, q_) do { const int G_ = GRID_C; if ((first_) < G_ && (rank_) >= (first_)) { const Ctx Ct = make_ctx(lds_raw, g_wave); CArgs& pt = *opaque_args(); const int nw_ = (G_ - (first_)) * NW; \
        convert_moe(Ct, pt.in[21], pt.in[22], pt.in[23], (layer_), pt.ws, (lo_), min(MOE_ITEMS, (lo_) + (q_) * nw_), ((rank_) - (first_)) * NW + Ct.wave, nw_); } } while (0)
#define L0_R2 (TAILQ_P2 * tail_waves(NWG_P2, GRID_C))
#define L0_R4 (TAILQ_P4 * tail_waves(NWG_P4, GRID_C))
#define L0_R3 (TAILQ_P3 * tail_waves(1056, GRID_C))
#define L0_A (max(0, MOE_ITEMS - L0_R2 - L0_R3 - L0_R4))
#define L1_R6 (TAILQ_P6 * idle_waves(128, GRID_C))
#define L1_R9 (TAILQ_P9 * tail_waves(NWG_P9, GRID_C))
#define L1_R11 (TAILQ_P11 * tail_waves(NWG_P11, GRID_C))
#define L1_R12 (TAILQ_P12 * tail_waves(NSEQ * NGRP, GRID_C))
#define L1_R17 (TAILQ_P17 * idle_waves(64, GRID_C))
#define L1_B (min(MOE_ITEMS, L1_R6 + L1_R9 + L1_R11 + L1_R12))
#define NWG_P2 ((R / 256) * 8)
#define NWG_P4 ((R / 256) * 4)
#define NWG_P9 ((NE * RPE0 / 256) * 4)
#define NWG_P11 ((R / 256) * 20)
#define TAIL_CONVERT(nwg_, layer_, lo_, q_) do { const int G_ = GRID_C, extra_ = (nwg_) % G_; if (extra_ && (int)blockIdx.x >= extra_) { const Ctx Ct = make_ctx(lds_raw, g_wave); CArgs& pt = *opaque_args(); const int nw_ = (G_ - extra_) * NW; \
        convert_moe(Ct, pt.in[21], pt.in[22], pt.in[23], (layer_), pt.ws, (lo_), min(MOE_ITEMS, (lo_) + (q_) * nw_), ((int)blockIdx.x - extra_) * NW + Ct.wave, nw_); } } while (0)
typedef const __attribute__((address_space(4))) Args CArgs;
__device__ __forceinline__ CArgs* opaque_args() { unsigned long long p = (unsigned long long)__builtin_amdgcn_kernarg_segment_ptr(); asm volatile("" : "+s"(p)); return (CArgs*)p; }
__global__ void __launch_bounds__(NW * 64, 2) mk_fwd(Args args) {
    extern __shared__ __attribute__((aligned(16))) unsigned char lds_raw[];
    const int g_wave = __builtin_amdgcn_readfirstlane((int)threadIdx.x >> 6);
    const Ctx C0 = make_ctx(lds_raw, g_wave);
    unsigned char* const ws = opaque_args()->ws;
#if MK_SPLIT
    const int lo = args.ph_lo, hi = args.ph_hi;
#else
    constexpr int lo = 0, hi = NPHASE;
#endif
    volatile LAS unsigned* MISC = (volatile LAS unsigned*)(C0.lds + MISC_OFF);
    for (int u = C0.tid; u < 128; u += NW * 64) ((LAS unsigned*)(C0.lds + MISC_OFF - 320))[u] = 0u;
    __syncthreads();
    if (hi - lo > 1) (void)xcd_barrier_post((unsigned*)(ws + WS_CTL) + CW_BAR, MISC + 8, g_wave);
#ifndef MK_PHMASK
#define MK_PHMASK 0x3fffff
#endif
#define INR(k) (lo <= (k) && (k) < hi)
#define IN(k) ((((MK_PHMASK) >> (k)) & 1) && INR(k))
#ifndef MK_TIME_A
#define MK_TIME_A -2
#define MK_TIME_B -2
#endif
#define MK_TIME_PHASE (MK_TIME_A > -2 ? 1 : -1)
#define SEAM(k) do { if (INR(k) && INR((k) + 1)) { XcdBarrier b_; b_.bar = (unsigned*)(opaque_args()->ws + WS_CTL) + CW_BAR; b_.x = xb_xcc_id(); b_.st = (volatile LAS unsigned*)((LAS unsigned char*)lds_raw + MISC_OFF) + 8; xcd_barrier(b_, g_wave); } \
    if (MK_TIME_A > -2 && blockIdx.x == 0 && TID_OF(g_wave) == 0) { const unsigned long long t_ = __builtin_amdgcn_s_memrealtime(); \
        if ((k) == MK_TIME_A) ((unsigned long long*)(ws + WS_CTL))[1024] = t_; \
        if ((k) == MK_TIME_B) { const unsigned long long t0_ = ((unsigned long long*)(ws + WS_CTL))[1024]; ((float*)(ws + WS_CTL))[2050] = (float)(t_ - t0_) * 0.00125f; } } } while (0)
#ifndef MK_REP_PHASE
#define MK_REP_PHASE -1
#endif
#define REP(k) for (int _rep = 0; _rep < ((k) == MK_REP_PHASE ? 3 : 1); ++_rep, __syncthreads())

#define P_x ((const float*)pa.in[0])
#define P_ctx_in ((const float*)pa.in[2])
#define P_MV ((float*)(ws + WS_MV))
#define P_LBT ((float*)(ws + WS_LB))
#define P_AFF ((float*)(ws + WS_AFF))
#define P_INV ((short*)(ws + WS_INV))
#define P_SEL ((int*)(ws + WS_SEL))
#define P_GSEL ((float*)(ws + WS_GSEL))
#define P_CTXS ((float*)(ws + WS_CTXS))
#define P_HB ((bf16*)(ws + WS_HB))
#define P_UB ((bf16*)(ws + WS_UB))
#define P_HB8 (ws + WS_UB)
#define P_HBUF8 (ws + WS_HBUF)
#define P_XG ((bf16*)(ws + WS_XG))
#define P_PRJ ((bf16*)(ws + WS_PRJ))
#define P_OLOC ((bf16*)(ws + WS_OLOC))
#define P_QGG ((bf16*)(ws + WS_QGG))
#define P_SLOC ((float*)(ws + WS_UB))
#define P_PTOT ((float*)(ws + WS_PTOT))
#define P_SST ((bf16*)(ws + WS_SST))
#define P_YH ((bf16*)(ws + WS_UB))
#define P_out (pa.out)

    if (MK_TIME_A == -1 && blockIdx.x == 0 && TID_OF(g_wave) == 0) ((unsigned long long*)(ws + WS_CTL))[1024] = __builtin_amdgcn_s_memrealtime();
    if (IN(0)) REP(0) { const Ctx C = make_ctx(lds_raw, g_wave); CArgs& pa = *opaque_args(); unsigned char* const ws = pa.ws;
        mod_gemv(C, pa.in[1], pa.in[3], pa.in[4], pa.in[5], P_MV);
        for (int i = C.vcu * NW * 64 + C.tid; i < 2048; i += C.G * NW * 64) { const float* lg = pa.in[17]; P_LBT[i] = fsig(lg[2048 + i] - lg[i]); }
        __syncthreads();
        convert_small(C, pa.in[8], pa.in[14], pa.in[16], pa.in[19], ws);
        convert_moe(C, pa.in[21], pa.in[22], pa.in[23], 0, ws, 0, L0_A, C.gw, C.NGW);
    }
    SEAM(0);
    if (IN(1)) REP(1) { const Ctx C = make_ctx(lds_raw, g_wave); CArgs& pa = *opaque_args(); unsigned char* const ws = pa.ws; RowArgs A{}; A.src_lat = P_x; A.src_ctx = P_ctx_in; A.gamma = pa.in[6]; A.mv = P_MV; A.i_shift = 0; A.i_scale = 1; A.i_gate = 2; A.HB = P_HB; A.nrows = R;
        row_phase<false, false, false>(C, A); }
    SEAM(1);
    if (IN(2)) REP(2) { const Ctx C = make_ctx(lds_raw, g_wave); CArgs& pa = *opaque_args(); unsigned char* const ws = pa.ws; pg8::Gemm g{P_HB, (const bf16*)(ws + WS_W1T), R, 2048, 1024}; pg8::StaticOrder S; S.init(R, 2048, C.G, (int)blockIdx.x);
        pg8::EpiGated<0> E{P_UB, 1024, pa.in[9], 1024};
        pg8::gemm_phase<pg8::EpiGated<0>, pg8::StaticOrder, true, true>(C.lds, g, S, E, C.wave);
        TAIL_CONVERT(NWG_P2, 0, min(MOE_ITEMS, L0_A + L0_R3), TAILQ_P2); }
    SEAM(2);
    if (IN(3)) REP(3) { const Ctx C = make_ctx(lds_raw, g_wave); CArgs& pa = *opaque_args(); unsigned char* const ws = pa.ws; conv_phase(C, P_UB, P_HB, pa.in[10], pa.in[11], pa.in[12], pa.in[13]); RANK_CONVERT(C.vcu, 1056 % GRID_C, 0, L0_A, TAILQ_P3); }
    SEAM(3);
    if (IN(4)) REP(4) { const Ctx C = make_ctx(lds_raw, g_wave); CArgs& pa = *opaque_args(); unsigned char* const ws = pa.ws; pg8::Gemm g{P_HB, (const bf16*)(ws + WS_W2T), R, 1024, 1024}; pg8::StaticOrder S; S.init(R, 1024, C.G, (int)blockIdx.x);
        pg8::EpiDelta E{(bf16*)(ws + WS_OLOC), 1024, pa.in[15], P_MV + 2 * 1024, 6144};
        pg8::gemm_phase<pg8::EpiDelta, pg8::StaticOrder, true, true>(C.lds, g, S, E, C.wave);
        TAIL_CONVERT(NWG_P4, 0, min(MOE_ITEMS, L0_A + L0_R3 + L0_R2), TAILQ_P4); }
    SEAM(4);
    if (IN(5)) REP(5) { const Ctx C = make_ctx(lds_raw, g_wave); CArgs& pa = *opaque_args(); unsigned char* const ws = pa.ws; RowArgs A{}; A.src_lat = P_x; A.src_ctx = P_ctx_in; A.delta = (const bf16*)(ws + WS_OLOC); A.gamma = pa.in[7]; A.mv = P_MV; A.i_shift = 3; A.i_scale = 4; A.i_gate = 5; A.HB = P_HB; A.HB8 = P_HB8; A.AFF = P_AFF; A.router_w = pa.in[20]; A.nrows = R;
        row_phase<false, true, false>(C, A); }
    SEAM(5);
    if (IN(6)) REP(6) { const Ctx C = make_ctx(lds_raw, g_wave); CArgs& pa = *opaque_args(); unsigned char* const ws = pa.ws; topk_phase(C, 128, RPE0, P_AFF, P_SEL, P_GSEL, P_INV); IDLE_CONVERT(128, 1, 0, TAILQ_P6); }
    SEAM(6);
    if (IN(8)) REP(8) { const Ctx C = make_ctx(lds_raw, g_wave); CArgs& pa = *opaque_args(); unsigned char* const ws = pa.ws; pg8::Gemm g{(const bf16*)P_HB8, (const bf16*)(ws + WS_W13T), NE * RPE0, 4096, 1024}; pg8::StaticOrder S; S.init(NE * RPE0, 4096, C.G, (int)blockIdx.x, RPE0 / 256);
        pg8::EpiSwiGLU8 E{P_HBUF8, 2048, 1.0f / 32.0f};
        pg8::gemm_phase_f8<pg8::EpiSwiGLU8, pg8::StaticOrder, true, true, true, 1024>(C.lds, g, S, E, C.wave, P_SEL, (LAS unsigned*)(C.lds + GTAB_OFF)); }
    SEAM(8);
    if (IN(9)) REP(9) { const Ctx C = make_ctx(lds_raw, g_wave); CArgs& pa = *opaque_args(); unsigned char* const ws = pa.ws; pg8::Gemm g{(const bf16*)P_HBUF8, (const bf16*)(ws + WS_WDT), NE * RPE0, 1024, 2048}; pg8::StaticOrder S; S.init(NE * RPE0, 1024, C.G, (int)blockIdx.x, RPE0 / 256);
        pg8::EpiScaleRow E{P_XG, 1024, P_GSEL, 1.0f / 32.0f};
        pg8::gemm_phase_f8<pg8::EpiScaleRow, pg8::StaticOrder, true, true, true, 2048>(C.lds, g, S, E, C.wave, nullptr, (LAS unsigned*)(C.lds + GTAB_OFF));
        TAIL_CONVERT(NWG_P9, 1, L1_R6, TAILQ_P9); }
    SEAM(9);
    if (IN(10)) REP(10) { const Ctx C = make_ctx(lds_raw, g_wave); CArgs& pa = *opaque_args(); unsigned char* const ws = pa.ws; RowArgs A{}; A.src_lat = P_x; A.src_ctx = P_ctx_in; A.delta = (const bf16*)(ws + WS_OLOC); A.dst_lat = P_out; A.dst_ctx = P_CTXS; A.gamma = pa.in[6] + 1024; A.mv = P_MV; A.i_shift = 0; A.i_scale = 1; A.i_gate = 5; A.HB = P_HB;
        A.Y = P_XG; A.INV = P_INV; A.rpe = RPE0; A.nrows = R;
        A.mv = P_MV + 5 * 6144; A.mvg = P_MV; row_phase<true, false, false>(C, A); }
    SEAM(10);
    if (IN(11)) REP(11) { const Ctx C = make_ctx(lds_raw, g_wave); CArgs& pa = *opaque_args(); unsigned char* const ws = pa.ws; pg8::Gemm g{P_HB, (const bf16*)(ws + WS_WINT), R, 5120, 1024}; pg8::StaticOrder S; S.init(R, 5120, C.G, (int)blockIdx.x);
        pg8::EpiBf16 E{P_PRJ, 5120, P_LBT, R};
        pg8::gemm_phase<pg8::EpiBf16, pg8::StaticOrder, true, true>(C.lds, g, S, E, C.wave);
        TAIL_CONVERT(NWG_P11, 1, L1_R6 + L1_R9, TAILQ_P11); }
    SEAM(11);
    if (IN(12)) REP(12) { const Ctx C = make_ctx(lds_raw, g_wave); CArgs& pa = *opaque_args(); unsigned char* const ws = pa.ws; scanA_phase(C, P_PRJ, P_LBT, P_OLOC, P_QGG, P_SLOC, P_PTOT); RANK_CONVERT(C.vcu, (NSEQ * NGRP) % GRID_C, 1, L1_R6 + L1_R9 + L1_R11, TAILQ_P12); }
    SEAM(12);
    if (IN(13)) REP(13) { const Ctx C = make_ctx(lds_raw, g_wave); CArgs& pa = *opaque_args(); unsigned char* const ws = pa.ws; scanB_phase(C, P_SLOC, P_PTOT, P_SST); }
    SEAM(13);
    if (IN(14)) REP(14) { const Ctx C = make_ctx(lds_raw, g_wave); CArgs& pa = *opaque_args(); unsigned char* const ws = pa.ws; readout_phase(C, P_PRJ, P_OLOC, P_QGG, P_SST, pa.in[18], P_YH); }
    SEAM(14);
    if (IN(15)) REP(15) { const Ctx C = make_ctx(lds_raw, g_wave); CArgs& pa = *opaque_args(); unsigned char* const ws = pa.ws; pg8::Gemm g{P_YH, (const bf16*)(ws + WS_WOUTT), NLAT, 1024, 1024}; pg8::StaticOrder S; S.init(NLAT, 1024, C.G, (int)blockIdx.x);
        pg8::EpiDelta E{(bf16*)(ws + WS_OLOC), 1024, nullptr, P_MV + 5 * 6144 + 2 * 1024, 6144};
        pg8::gemm_phase<pg8::EpiDelta, pg8::StaticOrder, true, true>(C.lds, g, S, E, C.wave); }
    SEAM(15);
    if (IN(16)) REP(16) { const Ctx C = make_ctx(lds_raw, g_wave); CArgs& pa = *opaque_args(); unsigned char* const ws = pa.ws; RowArgs A{}; A.src_lat = P_out; A.delta = (const bf16*)(ws + WS_OLOC); A.gamma = pa.in[7] + 1024; A.mv = P_MV + 5 * 6144; A.i_shift = 3; A.i_scale = 4; A.i_gate = 5; A.HB = P_HB; A.HB8 = P_HB8; A.AFF = P_AFF; A.router_w = pa.in[20] + 16384; A.nrows = NLAT;
        row_phase<false, true, false>(C, A);
        convert_moe(C, pa.in[21], pa.in[22], pa.in[23], 1, ws, L1_B, max(L1_B, MOE_ITEMS - L1_R17), C.gw, C.NGW); }
    SEAM(16);
    if (IN(17)) REP(17) { const Ctx C = make_ctx(lds_raw, g_wave); CArgs& pa = *opaque_args(); unsigned char* const ws = pa.ws; topk_phase(C, 64, RPE1, P_AFF, P_SEL, P_GSEL, P_INV);
        IDLE_CONVERT(64, 1, max(L1_B, MOE_ITEMS - L1_R17), TAILQ_P17); }
    SEAM(17);
    if (IN(19)) REP(19) { const Ctx C = make_ctx(lds_raw, g_wave); CArgs& pa = *opaque_args(); unsigned char* const ws = pa.ws; pg8::Gemm g{(const bf16*)P_HB8, (const bf16*)(ws + WS_W13T_L1), NE * RPE1, 4096, 1024}; pg8::StaticOrder S; S.init(NE * RPE1, 4096, C.G, (int)blockIdx.x, RPE1 / 256);
        pg8::EpiSwiGLU8 E{P_HBUF8, 2048, 1.0f / 32.0f};
        pg8::gemm_phase_f8<pg8::EpiSwiGLU8, pg8::StaticOrder, true, true, true, 1024>(C.lds, g, S, E, C.wave, P_SEL, (LAS unsigned*)(C.lds + GTAB_OFF)); }
    SEAM(19);
    if (IN(20)) REP(20) { const Ctx C = make_ctx(lds_raw, g_wave); CArgs& pa = *opaque_args(); unsigned char* const ws = pa.ws; pg8::Gemm g{(const bf16*)P_HBUF8, (const bf16*)(ws + WS_WDT_L1), NE * RPE1, 1024, 2048}; pg8::StaticOrder S; S.init(NE * RPE1, 1024, C.G, (int)blockIdx.x, RPE1 / 256);
        pg8::EpiScaleRow E{P_XG, 1024, P_GSEL, 1.0f / 32.0f};
        pg8::gemm_phase_f8<pg8::EpiScaleRow, pg8::StaticOrder, true, true, true, 2048>(C.lds, g, S, E, C.wave, nullptr, (LAS unsigned*)(C.lds + GTAB_OFF)); }
    SEAM(20);
    if (IN(21)) REP(21) { const Ctx C = make_ctx(lds_raw, g_wave); CArgs& pa = *opaque_args(); unsigned char* const ws = pa.ws; RowArgs A{}; A.src_lat = P_out; A.delta = (const bf16*)(ws + WS_OLOC); A.dst_lat = P_out; A.gamma = pa.in[24]; A.mv = P_MV + 5 * 6144; A.mvg = P_MV + 5 * 6144; A.i_gate = 5; A.Y = P_XG; A.INV = P_INV; A.rpe = RPE1; A.nrows = NLAT;
        row_phase<true, false, true>(C, A);
        }
    if (MK_TIME_A > -2) { const Ctx C = make_ctx(lds_raw, g_wave); CArgs& pa = *opaque_args(); { XcdBarrier b_; b_.bar = (unsigned*)(pa.ws + WS_CTL) + CW_BAR; b_.x = xb_xcc_id(); b_.st = (volatile LAS unsigned*)((LAS unsigned char*)lds_raw + MISC_OFF) + 8; xcd_barrier(b_, g_wave); }
        if (blockIdx.x == 0 && C.tid == 0) { float add = ((const float*)(ws + WS_CTL))[2050]; if (MK_TIME_B == 21) { const unsigned long long t0_ = ((unsigned long long*)(ws + WS_CTL))[1024]; add = (float)(__builtin_amdgcn_s_memrealtime() - t0_) * (MK_TIME_A == -1 ? 0.0001f : 0.00125f); } pa.out[0] += add; } }
#undef IN
#undef P_x
#undef P_ctx_in
#undef P_MV
#undef P_LBT
#undef P_AFF
#undef P_INV
#undef P_SEL
#undef P_GSEL
#undef P_CTXS
#undef P_HB
#undef P_UB
#undef P_HB8
#undef P_HBUF8
#undef P_XG
#undef P_PRJ
#undef P_OLOC
#undef P_QGG
#undef P_SLOC
#undef P_PTOT
#undef P_SST
#undef P_YH
#undef P_out
#undef REP
#undef INR
#undef SEAM
}

extern "C" void kernel_launch(void* const* d_in, const int* in_sizes, int n_in, void* d_out, int out_size, void* d_ws, size_t ws_size, hipStream_t stream) {
    static int grid = 0;
    if (grid == 0) {
        if (n_in != 25 || in_sizes[0] != NLAT * D || out_size != NLAT * D || ws_size < WS_END) { fprintf(stderr, "kernel_launch: unexpected shapes (n_in %d, in0 %d, out %d, ws %zu)\n", n_in, n_in > 0 ? in_sizes[0] : -1, out_size, ws_size); grid = -1; return; }
        int dev = 0, cus = 0, per_cu = 0;
        if (hipGetDevice(&dev) != hipSuccess || hipDeviceGetAttribute(&cus, hipDeviceAttributeMultiprocessorCount, dev) != hipSuccess) { grid = -1; return; }
        if (hipFuncSetAttribute((const void*)mk_fwd, hipFuncAttributeMaxDynamicSharedMemorySize, LDS_BYTES) != hipSuccess) { fprintf(stderr, "kernel_launch: hipFuncSetAttribute failed\n"); grid = -1; return; }
        if (hipOccupancyMaxActiveBlocksPerMultiprocessor(&per_cu, (const void*)mk_fwd, NW * 64, LDS_BYTES) != hipSuccess || per_cu < 1) { fprintf(stderr, "kernel_launch: occupancy query reports %d blocks per CU\n", per_cu); (void)hipGetLastError(); grid = -1; return; }
        if (cus != GRID_C) { fprintf(stderr, "kernel_launch: built for a %d-CU device, found %d CUs\n", GRID_C, cus); grid = -1; return; }
        grid = cus;
    }
    if (grid < 0) return;
    if (hipMemsetAsync((char*)d_ws + WS_CTL, 0, CTL_ZERO_BYTES, stream) != hipSuccess) { fprintf(stderr, "kernel_launch: memset failed\n"); return; }
    Args a{};
    for (int i = 0; i < 25; ++i) a.in[i] = (const float*)d_in[i];
    a.out = (float*)d_out; a.ws = (unsigned char*)d_ws;
#if MK_SPLIT
    for (int p = 0; p < NPHASE; ++p) { a.ph_lo = p; a.ph_hi = p + 1; hipLaunchKernelGGL(mk_fwd, dim3(grid), dim3(NW * 64), LDS_BYTES, stream, a); }
#else
    a.ph_lo = 0; a.ph_hi = NPHASE;
#ifndef MK_COOP
#define MK_COOP 1
#endif
#if MK_COOP
    void* kargs[] = {&a};
    hipError_t e = hipLaunchCooperativeKernel((const void*)mk_fwd, dim3(grid), dim3(NW * 64), kargs, LDS_BYTES, stream);
    if (e != hipSuccess) fprintf(stderr, "kernel_launch: cooperative launch failed: %s (grid %d)\n", hipGetErrorString(e), grid);
#else
    hipLaunchKernelGGL(mk_fwd, dim3(grid), dim3(NW * 64), LDS_BYTES, stream, a);
#endif
#endif
}
```

```cpp
#include <hip/hip_runtime.h>
#include <hip/hip_cooperative_groups.h>
#include <cstdio>
#include <cstdint>
namespace cg = cooperative_groups;

#ifndef MK_SPLIT
#define MK_SPLIT 0
#endif

__device__ __forceinline__ int lane_id() { int l; asm volatile("v_mbcnt_lo_u32_b32 %0, -1, 0\n\tv_mbcnt_hi_u32_b32 %0, -1, %0" : "=v"(l)); return l; }
#define TID_OF(wv) ((wv) * 64 + lane_id())
namespace pg8 {
#define PG8_LAS __attribute__((address_space(3)))
typedef unsigned short bf16_t;
typedef short bf16x8 __attribute__((ext_vector_type(8)));
typedef float f32x4 __attribute__((ext_vector_type(4)));
typedef unsigned u32x4 __attribute__((ext_vector_type(4)));
constexpr int BM = 256, BK = 64, HALF = 128, HTB = HALF * BK * 2  , STAGE_BYTES = 8 * HTB, NXCD = 8, WGM = 8;

__host__ __device__ __forceinline__ int lds_byte(int r, int c) { const int st = (r >> 4) * 2 + (c >> 5), rr = r & 15, cc = c & 31, ob = rr * 64 + cc * 2; return st * 1024 + (ob ^ (((ob >> 9) & 1) << 5)); }
__host__ __device__ __forceinline__ void stage_rc(int b, int& R, int& C) { const int st = b / 1024, sb = b % 1024, swz = sb ^ (((sb >> 9) & 1) << 5); R = (st >> 1) * 16 + swz / 64; C = (st & 1) * 32 + (swz % 64) / 2; }
__host__ __device__ __forceinline__ int perm32(int rho) { const int n = rho >> 4, i = rho & 15; return 8 * (i >> 2) + 4 * n + (i & 3); }

struct Unit { int pm, pn, pb; };
struct Gemm { const bf16_t* A; const bf16_t* Bt; int M, N, K; };

struct StaticOrder {
    int nM, nN, nwg, G, c, tpe;
    __host__ __device__ void init(int M, int N, int G_, int c_, int tpe_ = 0) { nM = M / BM; nN = N / BM; nwg = nM * nN; G = G_; c = c_; tpe = tpe_; }
    __host__ __device__ bool next(int i, Unit& u) const {
        const long L = (long)i * G + c; if (L >= nwg) return false;
        int wgid = (int)L; { const int q = nwg / NXCD, r = nwg % NXCD, xcd = wgid % NXCD, off = wgid / NXCD; wgid = (xcd < r ? xcd * (q + 1) : r * (q + 1) + (xcd - r) * q) + off; }
        const int nig = WGM * nN, gid = wgid / nig, fm = gid * WGM, gsz = (nM - fm) < WGM ? (nM - fm) : WGM;
        u.pm = fm + ((wgid % nig) % gsz); u.pn = (wgid % nig) / gsz; u.pb = tpe ? (u.pm / tpe) * nN + u.pn : u.pn; return true;
    }
    __device__ __forceinline__ void a_ready(const Unit&) const {}
    __device__ __forceinline__ void done(const Unit&) const {}
};

typedef float f32x32 __attribute__((ext_vector_type(32)));
struct AccQ { f32x32 q[2][2];
    __device__ __forceinline__ f32x4 get(int ai, int bj, int m, int n) const { const int i = (m * 2 + n) * 4; const f32x32& v = q[ai][bj]; return (f32x4){v[i], v[i + 1], v[i + 2], v[i + 3]}; }
    __device__ __forceinline__ void set(int ai, int bj, int m, int n, f32x4 c) { const int i = (m * 2 + n) * 4; f32x32& v = q[ai][bj]; v[i] = c[0]; v[i + 1] = c[1]; v[i + 2] = c[2]; v[i + 3] = c[3]; }
};
__device__ __forceinline__ unsigned cvt_pk_bf16(float lo, float hi) { unsigned r; asm("v_cvt_pk_bf16_f32 %0, %1, %2" : "=v"(r) : "v"(lo), "v"(hi)); return r; }
__device__ __forceinline__ float fsigmoid(float x) { return __builtin_amdgcn_rcpf(1.0f + __expf(-x)); }

struct EpiBf16 {
    static constexpr bool PERM = true, AFTER_DRAIN = false;
    bf16_t* O; int ldc; const float* lb; int hm_rows;
    __device__ __forceinline__ void operator()(const f32x4 (&acc)[2][2][4][2], const Unit& u, int wr, int wc, int fr, int fq) const {
        const int row0 = u.pm * BM + wr * 64 + fr, col0 = u.pn * BM + wc * 32 + 8 * fq;
        const bool gate = lb != nullptr && u.pn >= 4 && u.pn < 12;
        f32x4 om[2][2];
#pragma unroll
        for (int bj = 0; bj < 2; ++bj)
#pragma unroll
            for (int n = 0; n < 2; ++n) om[bj][n] = gate ? (f32x4){1.f, 1.f, 1.f, 1.f} - *(const f32x4*)(lb + (col0 - 1024) + bj * HALF + 4 * n) : (f32x4){0.f, 0.f, 0.f, 0.f};
#pragma unroll
        for (int ai = 0; ai < 2; ++ai)
#pragma unroll
            for (int m = 0; m < 4; ++m) { const int row = row0 + ai * HALF + m * 16;
                bf16_t* rowp = hm_rows ? O + ((size_t)(2 * u.pn) * hm_rows + row) * HALF + wc * 32 + 8 * fq - 0 : O + (size_t)row * ldc + col0;
                const size_t bjstep = hm_rows ? (size_t)hm_rows * HALF : (size_t)HALF;
#pragma unroll
                for (int bj = 0; bj < 2; ++bj) { f32x4 v0 = acc[ai][bj][m][0], v1 = acc[ai][bj][m][1];
                    if (gate) {
#pragma unroll
                        for (int j = 0; j < 4; ++j) { v0[j] = om[bj][0][j] * fsigmoid(-v0[j]); v1[j] = om[bj][1][j] * fsigmoid(-v1[j]); } }
                    u32x4 w; w.x = cvt_pk_bf16(v0[0], v0[1]); w.y = cvt_pk_bf16(v0[2], v0[3]); w.z = cvt_pk_bf16(v1[0], v1[1]); w.w = cvt_pk_bf16(v1[2], v1[3]);
                    *(u32x4*)(rowp + bj * bjstep) = w; } }
    }
};
template <int MODE> struct EpiGated {
    static constexpr bool PERM = true, AFTER_DRAIN = false;
    bf16_t* O; int ldc; const float* bias; int ystride;
    __device__ __forceinline__ void operator()(const f32x4 (&acc)[2][2][4][2], const Unit& u, int wr, int wc, int fr, int fq) const {
        const int row0 = u.pm * BM + wr * 64 + fr, ch0 = u.pn * HALF + wc * 32 + 8 * fq;
        f32x4 bx[2], by[2];
#pragma unroll
        for (int n = 0; n < 2; ++n) { if (MODE == 0) { bx[n] = *(const f32x4*)(bias + ch0 + 4 * n); by[n] = *(const f32x4*)(bias + ystride + ch0 + 4 * n); } else { bx[n] = (f32x4){0.f, 0.f, 0.f, 0.f}; by[n] = bx[n]; } }
#pragma unroll
        for (int ai = 0; ai < 2; ++ai)
#pragma unroll
            for (int m = 0; m < 4; ++m) { bf16_t* rowp = O + (size_t)(row0 + ai * HALF + m * 16) * ldc + ch0;
                float r[8];
#pragma unroll
                for (int n = 0; n < 2; ++n) { const f32x4 x = acc[ai][0][m][n] + bx[n], y = acc[ai][1][m][n] + by[n];
#pragma unroll
                    for (int j = 0; j < 4; ++j) r[4 * n + j] = (MODE == 0) ? x[j] * fsigmoid(y[j]) : x[j] * fsigmoid(x[j]) * y[j]; }
                u32x4 w; w.x = cvt_pk_bf16(r[0], r[1]); w.y = cvt_pk_bf16(r[2], r[3]); w.z = cvt_pk_bf16(r[4], r[5]); w.w = cvt_pk_bf16(r[6], r[7]);
                *(u32x4*)rowp = w; }
    }
};
struct EpiDelta {
    static constexpr bool PERM = true, AFTER_DRAIN = false;
    bf16_t* O; int ldc; const float* bias; const float* gate; int gstride;
    __device__ __forceinline__ void operator()(const f32x4 (&acc)[2][2][4][2], const Unit& u, int wr, int wc, int fr, int fq) const {
        const int grp = u.pm >= 128 ? 4 : (u.pm >> 5);
        const int row0 = u.pm * BM + wr * 64 + fr, col0 = u.pn * BM + wc * 32 + 8 * fq;
        const float* gp = gate + (size_t)grp * gstride + col0;
        f32x4 gv[2][2], bv[2][2];
#pragma unroll
        for (int bj = 0; bj < 2; ++bj)
#pragma unroll
            for (int n = 0; n < 2; ++n) { gv[bj][n] = *(const f32x4*)(gp + bj * HALF + 4 * n); bv[bj][n] = bias ? *(const f32x4*)(bias + col0 + bj * HALF + 4 * n) : (f32x4){0.f, 0.f, 0.f, 0.f}; }
#pragma unroll
        for (int ai = 0; ai < 2; ++ai)
#pragma unroll
            for (int m = 0; m < 4; ++m) { bf16_t* rowp = O + (size_t)(row0 + ai * HALF + m * 16) * ldc + col0;
#pragma unroll
                for (int bj = 0; bj < 2; ++bj) { const f32x4 v0 = gv[bj][0] * (acc[ai][bj][m][0] + bv[bj][0]), v1 = gv[bj][1] * (acc[ai][bj][m][1] + bv[bj][1]);
                    u32x4 w; w.x = cvt_pk_bf16(v0[0], v0[1]); w.y = cvt_pk_bf16(v0[2], v0[3]); w.z = cvt_pk_bf16(v1[0], v1[1]); w.w = cvt_pk_bf16(v1[2], v1[3]);
                    *(u32x4*)(rowp + bj * HALF) = w; } }
    }
};
struct EpiRes {
    static constexpr bool PERM = false, AFTER_DRAIN = false;
    const float* res0; float* out0; const float* res1; float* out1; const float* bias; const float* gate; int gstride;
    __device__ __forceinline__ void operator()(const f32x4 (&acc)[2][2][4][2], const Unit& u, int wr, int wc, int fr, int fq) const {
        const bool second = u.pm >= 128; const int grp = second ? 4 : (u.pm >> 5);
        const float* res = second ? res1 : res0; float* out = second ? out1 : out0;
        const int row0 = (second ? u.pm - 128 : u.pm) * BM + wr * 64 + fr, col0 = u.pn * BM + wc * 32 + 4 * fq;
        const float* gp = gate + (size_t)grp * gstride + col0;
        const unsigned off0 = ((unsigned)row0 * 1024u + (unsigned)col0) * 4u;
#pragma unroll
        for (int bj = 0; bj < 2; ++bj) {
            f32x4 gv[2], bv[2], rv[2][2][4];
#pragma unroll
            for (int n = 0; n < 2; ++n) { gv[n] = *(const f32x4*)(gp + bj * HALF + n * 16); bv[n] = bias ? *(const f32x4*)(bias + col0 + bj * HALF + n * 16) : (f32x4){0.f, 0.f, 0.f, 0.f}; }
#pragma unroll
            for (int n = 0; n < 2; ++n)
#pragma unroll
                for (int ai = 0; ai < 2; ++ai)
#pragma unroll
                    for (int m = 0; m < 4; ++m) rv[n][ai][m] = *(const f32x4*)((const char*)res + (off0 + (unsigned)(((ai * HALF + m * 16) * 1024 + bj * HALF + n * 16) * 4)));
#pragma unroll
            for (int n = 0; n < 2; ++n)
#pragma unroll
                for (int ai = 0; ai < 2; ++ai)
#pragma unroll
                    for (int m = 0; m < 4; ++m) *(f32x4*)((char*)out + (off0 + (unsigned)(((ai * HALF + m * 16) * 1024 + bj * HALF + n * 16) * 4))) = rv[n][ai][m] + gv[n] * (acc[ai][bj][m][n] + bv[n]);
            asm volatile("" ::: "memory"); }
    }
};
struct EpiScaleRow {
    static constexpr bool PERM = true, AFTER_DRAIN = false;
    bf16_t* O; int ldc; const float* rs; float mul;
    __device__ __forceinline__ void operator()(const AccQ& acc, const Unit& u, int wr, int wc, int fr, int fq) const {
        const int row0 = u.pm * BM + wr * 64 + fr, col0 = u.pn * BM + wc * 32 + 8 * fq;
#pragma unroll
        for (int ai = 0; ai < 2; ++ai)
#pragma unroll
            for (int m = 0; m < 4; ++m) { const int row = row0 + ai * HALF + m * 16; const float s = rs[row] * mul; bf16_t* rowp = O + (size_t)row * ldc + col0;
#pragma unroll
                for (int bj = 0; bj < 2; ++bj) { const f32x4 v0 = acc.get(ai, bj, m, 0) * s, v1 = acc.get(ai, bj, m, 1) * s;
                    u32x4 w; w.x = cvt_pk_bf16(v0[0], v0[1]); w.y = cvt_pk_bf16(v0[2], v0[3]); w.z = cvt_pk_bf16(v1[0], v1[1]); w.w = cvt_pk_bf16(v1[2], v1[3]);
                    *(u32x4*)(rowp + bj * HALF) = w; }
                asm volatile("" ::: "memory"); }
    }
};

typedef unsigned u32x2 __attribute__((ext_vector_type(2)));
__device__ __forceinline__ unsigned pk4_fp8(float a, float b, float c, float d) { unsigned lo, hi; asm("v_cvt_pk_fp8_f32 %0, %1, %2" : "=v"(lo) : "v"(a), "v"(b)); asm("v_cvt_pk_fp8_f32 %0, %1, %2" : "=v"(hi) : "v"(c), "v"(d)); return (lo & 0xffffu) | (hi << 16); }
struct EpiSwiGLU8 {
    static constexpr bool PERM = true, AFTER_DRAIN = false;
    unsigned char* O; int ldc; float s;
    __device__ __forceinline__ void operator()(const AccQ& acc, const Unit& u, int wr, int wc, int fr, int fq) const {
        const int row0 = u.pm * BM + wr * 64 + fr, ch0 = u.pn * HALF + wc * 32 + 8 * fq;
#pragma unroll
        for (int ai = 0; ai < 2; ++ai)
#pragma unroll
            for (int m = 0; m < 4; ++m) { unsigned char* rowp = O + (size_t)(row0 + ai * HALF + m * 16) * ldc + ch0;
                float r[8];
#pragma unroll
                for (int n = 0; n < 2; ++n) { const f32x4 x = acc.get(ai, 0, m, n) * s, y = acc.get(ai, 1, m, n) * s;
#pragma unroll
                    for (int j = 0; j < 4; ++j) r[4 * n + j] = x[j] * fsigmoid(x[j]) * y[j]; }
                u32x2 w; w.x = pk4_fp8(r[0], r[1], r[2], r[3]); w.y = pk4_fp8(r[4], r[5], r[6], r[7]);
                *(u32x2*)rowp = w; }
    }
};


template <class Epi, class Sched, bool ALIGN_EPI = false, bool SP2 = false, bool GATHER = false>
__device__ __forceinline__ void gemm_phase(PG8_LAS unsigned char* lds, const Gemm g, const Sched& S, const Epi& E, const int wv, const int* gsel = nullptr, PG8_LAS unsigned* gtab = nullptr) {
    const int tid = TID_OF(wv), wid = wv, lane = tid & 63, wr = wid >> 2, wc = wid & 3, fr = lane & 15, fq = lane >> 4;
    const int K = g.K, nt = K / BK;
    unsigned voffA[2], voffB[2]; int gR[2]; unsigned gC2[2];
#pragma unroll
    for (int i = 0; i < 2; ++i) { int R, C; stage_rc(tid * 16 + i * 8192, R, C); const int Rb = Epi::PERM ? ((R & ~31) + perm32(R & 31)) : R;
        voffA[i] = (unsigned)(R * K + C) * 2u; voffB[i] = (unsigned)(Rb * K + C) * 2u; gR[i] = R; gC2[i] = (unsigned)C * 2u; }
    unsigned cur0[2] = {0u, 0u}, cur1[2] = {0u, 0u}, nx0[2] = {0u, 0u}, nx1[2] = {0u, 0u};
    if constexpr (GATHER) { Unit uu; for (int i = 0; S.next(i, uu); ++i) if (tid < 256) gtab[i * 256 + tid] = (unsigned)gsel[uu.pm * 256 + tid] * (unsigned)(K * 2);
        __syncthreads(); }
#define PG8_GOFFS(ui_, o0, o1) do { _Pragma("unroll") for (int i = 0; i < 2; ++i) { o0[i] = gtab[(ui_) * 256 + gR[i]] + gC2[i]; o1[i] = gtab[(ui_) * 256 + 128 + gR[i]] + gC2[i]; } } while (0)
#define PG8_STAGE_A(bufoff, ptr_plain, ptr_gather, goffs) do { if constexpr (GATHER) { PG8_STAGE(bufoff, ptr_gather, goffs); } else { PG8_STAGE(bufoff, ptr_plain, voffA); } } while (0)
    const size_t kstep = (size_t)(BK * 2);
    const size_t hstep = (size_t)HALF * K * 2;
    const size_t tstep = 2 * hstep;
    const unsigned ldsw = (unsigned)wid * 1024u;
    const int aoff = lds_byte(wr * 64 + fr, fq * 8), boff = lds_byte(wc * 32 + fr, fq * 8);
#define PG8_SA(b, h) (((b) * 2 + (h)) * HTB)
#define PG8_SB(b, h) ((4 + (b) * 2 + (h)) * HTB)
#define PG8_STAGE(bufoff, gbase, voff) do { _Pragma("unroll") for (int _i = 0; _i < 2; ++_i) \
        __builtin_amdgcn_global_load_lds((const unsigned*)((const char*)(gbase) + (voff)[_i]), (PG8_LAS unsigned*)(lds + (bufoff) + ldsw + _i * 8192), 16, 0, 0); } while (0)
#define PG8_LDA(dst, b, h) do { _Pragma("unroll") for (int m = 0; m < 4; ++m) _Pragma("unroll") for (int k = 0; k < 2; ++k) dst[m][k] = *(const PG8_LAS bf16x8*)(lds + PG8_SA(b, h) + aoff + m * 2048 + k * 1024); } while (0)
#define PG8_LDB(dst, b, h) do { _Pragma("unroll") for (int n = 0; n < 2; ++n) _Pragma("unroll") for (int k = 0; k < 2; ++k) dst[n][k] = *(const PG8_LAS bf16x8*)(lds + PG8_SB(b, h) + boff + n * 2048 + k * 1024); } while (0)
#define PG8_MMA(ai, bj, At, Bt) do { __builtin_amdgcn_s_setprio(1); _Pragma("unroll") for (int m = 0; m < 4; ++m) _Pragma("unroll") for (int n = 0; n < 2; ++n) _Pragma("unroll") for (int k = 0; k < 2; ++k) \
        acc[ai][bj][m][n] = __builtin_amdgcn_mfma_f32_16x16x32_bf16(Bt[n][k], At[m][k], acc[ai][bj][m][n], 0, 0, 0); __builtin_amdgcn_s_setprio(0); } while (0)
#define PG8_WAIT_V(n) asm volatile("s_waitcnt vmcnt(" #n ")" ::: "memory")
#define PG8_WAIT_L(n) asm volatile("s_waitcnt lgkmcnt(" #n ")" ::: "memory")
#define PG8_BAR __builtin_amdgcn_s_barrier()
#define PG8_SCHED __builtin_amdgcn_sched_barrier(0)
    Unit cur, nxt; int ui = 0;
    if (!S.next(0, cur)) return;
    f32x4 acc[2][2][4][2];
#pragma unroll
    for (int a = 0; a < 2; ++a)
#pragma unroll
        for (int b = 0; b < 2; ++b)
#pragma unroll
            for (int m = 0; m < 4; ++m)
#pragma unroll
                for (int n = 0; n < 2; ++n) acc[a][b][m][n] = (f32x4){0.f, 0.f, 0.f, 0.f};
    bf16x8 At[4][2], B0[2][2], B1[2][2];
    const char* cA = (const char*)g.A + (size_t)cur.pm * tstep; const char* cB = (const char*)g.Bt + (size_t)cur.pb * tstep;
    const char* const gA = (const char*)g.A;
    if constexpr (GATHER) PG8_GOFFS(0, cur0, cur1);
    S.a_ready(cur);
    if constexpr (SP2) {
        PG8_STAGE(PG8_SB(0, 0), cB, voffB); PG8_STAGE(PG8_SB(0, 1), cB + hstep, voffB); PG8_STAGE_A(PG8_SA(0, 0), cA, gA, cur0); PG8_STAGE_A(PG8_SA(0, 1), cA + hstep, gA, cur1);
        if (wr == 1) PG8_BAR;
        PG8_WAIT_V(2); PG8_BAR;
        PG8_STAGE(PG8_SB(1, 0), cB + kstep, voffB); PG8_STAGE_A(PG8_SA(1, 0), cA + kstep, gA + kstep, cur0); PG8_STAGE(PG8_SB(1, 1), cB + hstep + kstep, voffB);
        PG8_WAIT_V(6); PG8_BAR;
    } else {
        PG8_STAGE(PG8_SB(0, 0), cB, voffB); PG8_STAGE_A(PG8_SA(0, 0), cA, gA, cur0); PG8_STAGE(PG8_SB(0, 1), cB + hstep, voffB); PG8_STAGE_A(PG8_SA(0, 1), cA + hstep, gA, cur1);
        if (wr == 1) PG8_BAR;
        PG8_WAIT_V(4); PG8_BAR;
        PG8_STAGE(PG8_SB(1, 0), cB + kstep, voffB); PG8_STAGE_A(PG8_SA(1, 0), cA + kstep, gA + kstep, cur0); PG8_STAGE(PG8_SB(1, 1), cB + hstep + kstep, voffB);
        PG8_WAIT_V(6); PG8_BAR;
    }
    for (;;) {
        const bool has_next = S.next(ui + 1, nxt);
        if constexpr (GATHER) { if (has_next) PG8_GOFFS(ui + 1, nx0, nx1); else { _Pragma("unroll") for (int i = 0; i < 2; ++i) { nx0[i] = cur0[i]; nx1[i] = cur1[i]; } } }
        const char* nA = has_next ? (const char*)g.A + (size_t)nxt.pm * tstep : cA; const char* nB = has_next ? (const char*)g.Bt + (size_t)nxt.pb * tstep : cB;
#pragma unroll 1
        for (int t = 0; t < nt; t += 2) {
            const bool last = (t == nt - 2);
            const char* a1 = cA + (size_t)(t + 1) * kstep;
            const char* a2 = last ? nA : cA + (size_t)(t + 2) * kstep; const char* b2 = last ? nB : cB + (size_t)(t + 2) * kstep;
            const char* a3 = a2 + kstep; const char* b3 = b2 + kstep;
            const char* ga1 = gA + (size_t)(t + 1) * kstep; const char* ga2 = last ? gA : gA + (size_t)(t + 2) * kstep; const char* ga3 = ga2 + kstep;
            unsigned o2h0[2], o2h1[2];
#pragma unroll
            for (int i = 0; i < 2; ++i) { o2h0[i] = last ? nx0[i] : cur0[i]; o2h1[i] = last ? nx1[i] : cur1[i]; }
            if (last && has_next) S.a_ready(nxt);
            if constexpr (SP2) {
            PG8_LDB(B0, 0, 0); PG8_LDB(B1, 0, 1); PG8_SCHED; PG8_LDA(At, 0, 0); PG8_STAGE_A(PG8_SA(1, 1), a1 + hstep, ga1, cur1);
            PG8_WAIT_V(8); PG8_WAIT_L(0); PG8_BAR; PG8_MMA(0, 0, At, B0); PG8_MMA(0, 1, At, B1); PG8_BAR; PG8_SCHED;
            PG8_LDA(At, 0, 1); PG8_STAGE(PG8_SB(0, 0), b2, voffB); PG8_STAGE(PG8_SB(0, 1), b2 + hstep, voffB); PG8_STAGE_A(PG8_SA(0, 0), a2, ga2, o2h0);
            PG8_WAIT_V(8); PG8_WAIT_L(0); PG8_BAR; PG8_MMA(1, 0, At, B0); PG8_MMA(1, 1, At, B1); PG8_BAR; PG8_SCHED;
            PG8_LDB(B0, 1, 0); PG8_LDB(B1, 1, 1); PG8_SCHED; PG8_LDA(At, 1, 0); PG8_STAGE_A(PG8_SA(0, 1), a2 + hstep, ga2, o2h1);
            PG8_WAIT_V(8); PG8_WAIT_L(0); PG8_BAR; PG8_MMA(0, 0, At, B0); PG8_MMA(0, 1, At, B1); PG8_BAR; PG8_SCHED;
            PG8_LDA(At, 1, 1); PG8_STAGE(PG8_SB(1, 0), b3, voffB); PG8_STAGE(PG8_SB(1, 1), b3 + hstep, voffB); PG8_STAGE_A(PG8_SA(1, 0), a3, ga3, o2h0);
            PG8_WAIT_V(8); PG8_WAIT_L(0); PG8_BAR; PG8_MMA(1, 0, At, B0); PG8_MMA(1, 1, At, B1); PG8_BAR; PG8_SCHED;
            } else {
            PG8_LDB(B0, 0, 0); PG8_SCHED; PG8_LDA(At, 0, 0); PG8_STAGE_A(PG8_SA(1, 1), a1 + hstep, ga1, cur1);
            PG8_WAIT_L(8); PG8_BAR; PG8_WAIT_L(0); PG8_MMA(0, 0, At, B0); PG8_BAR; PG8_SCHED;
            PG8_LDB(B1, 0, 1); PG8_STAGE(PG8_SB(0, 0), b2, voffB);
            PG8_BAR; PG8_WAIT_L(0); PG8_MMA(0, 1, At, B1); PG8_BAR;
            PG8_LDA(At, 0, 1); PG8_STAGE_A(PG8_SA(0, 0), a2, ga2, o2h0);
            PG8_BAR; PG8_WAIT_L(0); PG8_MMA(1, 0, At, B0); PG8_BAR; PG8_SCHED;
            PG8_STAGE(PG8_SB(0, 1), b2 + hstep, voffB);
            PG8_WAIT_V(6); PG8_BAR; PG8_MMA(1, 1, At, B1); PG8_BAR;
            PG8_LDB(B0, 1, 0); PG8_SCHED; PG8_LDA(At, 1, 0); PG8_STAGE_A(PG8_SA(0, 1), a2 + hstep, ga2, o2h1);
            PG8_WAIT_L(8); PG8_BAR; PG8_WAIT_L(0); PG8_MMA(0, 0, At, B0); PG8_BAR; PG8_SCHED;
            PG8_LDB(B1, 1, 1); PG8_STAGE(PG8_SB(1, 0), b3, voffB);
            PG8_BAR; PG8_WAIT_L(0); PG8_MMA(0, 1, At, B1); PG8_BAR;
            PG8_LDA(At, 1, 1); PG8_STAGE_A(PG8_SA(1, 0), a3, ga3, o2h0);
            PG8_BAR; PG8_WAIT_L(0); PG8_MMA(1, 0, At, B0); PG8_BAR; PG8_SCHED;
            PG8_STAGE(PG8_SB(1, 1), b3 + hstep, voffB);
            PG8_WAIT_V(6); PG8_BAR; PG8_MMA(1, 1, At, B1); PG8_BAR;
            }
        }
        if constexpr (ALIGN_EPI) { if (wr == 0) PG8_BAR; }
        if constexpr (!Epi::AFTER_DRAIN) { int tq = tid; asm volatile("" : "+v"(tq)); const int lq = tq & 63; E(acc, cur, wr, wc, lq & 15, lq >> 4); S.done(cur); }
        if (!has_next) break;
#pragma unroll
        for (int a = 0; a < 2; ++a)
#pragma unroll
            for (int b = 0; b < 2; ++b)
#pragma unroll
                for (int m = 0; m < 4; ++m)
#pragma unroll
                    for (int n = 0; n < 2; ++n) acc[a][b][m][n] = (f32x4){0.f, 0.f, 0.f, 0.f};
        cur = nxt; cA = nA; cB = nB; ++ui;
#pragma unroll
        for (int i = 0; i < 2; ++i) { cur0[i] = nx0[i]; cur1[i] = nx1[i]; }
        if constexpr (ALIGN_EPI) { if (wr == 1) PG8_BAR; }
    }
    PG8_WAIT_V(0);
    if constexpr (!ALIGN_EPI) { if (wr == 0) PG8_BAR; }
    PG8_BAR;
    if constexpr (Epi::AFTER_DRAIN) { E.fused(acc, cur, wr, wc, fr, fq, lds, wid, lane); S.done(cur); }
#undef PG8_SA
#undef PG8_SB
#undef PG8_STAGE
#undef PG8_STAGE_A
#undef PG8_GOFFS
#undef PG8_LDA
#undef PG8_LDB
#undef PG8_MMA
#undef PG8_WAIT_V
#undef PG8_WAIT_L
#undef PG8_BAR
#undef PG8_SCHED
}
typedef int v4i_t __attribute__((ext_vector_type(4)));
typedef int v8i_t __attribute__((ext_vector_type(8)));
typedef short s16x16_ld __attribute__((ext_vector_type(16), aligned(16)));
typedef v8i_t v8i_ld __attribute__((aligned(16)));
template <class Epi, class Sched, bool ALIGN_EPI = false, bool SP2 = false, bool GATHER = false, int KC = 0>
__device__ __forceinline__ void gemm_phase_f8(PG8_LAS unsigned char* lds, const Gemm g, const Sched& S, const Epi& E, const int wv, const int* gsel = nullptr, PG8_LAS unsigned* gtab = nullptr) {
    const int tid = TID_OF(wv), wid = wv, lane = tid & 63, wr = wid >> 2, wc = wid & 3, fr = lane & 15, fq = lane >> 4;
    const int K = KC ? KC : g.K, nt = K / 128;
    unsigned voffA[2], voffB[2]; int gR[2]; unsigned gC2[2];
#pragma unroll
    for (int i = 0; i < 2; ++i) { int R, C; stage_rc(tid * 16 + i * 8192, R, C); const int Rb = Epi::PERM ? ((R & ~31) + perm32(R & 31)) : R;
        voffA[i] = (unsigned)(R * K) + (unsigned)C * 2u; voffB[i] = (unsigned)(Rb * K) + (unsigned)C * 2u; gR[i] = R; gC2[i] = (unsigned)C * 2u; }
    unsigned cur0[2] = {0u, 0u}, cur1[2] = {0u, 0u}, nx0[2] = {0u, 0u}, nx1[2] = {0u, 0u};
    if constexpr (GATHER) { Unit uu; for (int i = 0; S.next(i, uu); ++i) if (tid < 256) ((PG8_LAS float*)gtab)[i * 256 + tid] = __uint_as_float((unsigned)(gsel ? gsel[uu.pm * 256 + tid] : uu.pm * 256 + tid) * (unsigned)K);
        __syncthreads(); }
#define PG8_GOFFS(ui_, o0, o1) do { _Pragma("unroll") for (int i = 0; i < 2; ++i) { o0[i] = __float_as_uint(((const PG8_LAS float*)gtab)[(ui_) * 256 + gR[i]]) + gC2[i]; o1[i] = __float_as_uint(((const PG8_LAS float*)gtab)[(ui_) * 256 + 128 + gR[i]]) + gC2[i]; } } while (0)
#define PG8_STAGE_A(bufoff, ptr_plain, ptr_gather, goffs) do { if constexpr (GATHER) { PG8_STAGE(bufoff, ptr_gather, goffs); } else { PG8_STAGE(bufoff, ptr_plain, voffA); } } while (0)
#define PG8_STAGE_AG(bufoff, ptr_plain, ptr_gather, u_, h_) do { if constexpr (GATHER) { unsigned go_[2]; _Pragma("unroll") for (int i = 0; i < 2; ++i) go_[i] = __float_as_uint(((const PG8_LAS float*)gtab)[(u_) * 256 + (h_) * 128 + lR[i]]) + lC2[i]; PG8_STAGE(bufoff, ptr_gather, go_); } else { PG8_STAGE(bufoff, ptr_plain, lvA); } } while (0)
    const size_t kstep = (size_t)(BK * 2);
    const size_t hstep = (size_t)HALF * K;
    const size_t tstep = 2 * hstep;
    const unsigned ldsw = (unsigned)wid * 1024u;
    const int aoff = lds_byte(wr * 64 + fr, fq * 16), boff = lds_byte(wc * 32 + fr, fq * 16);
#define PG8_SA(b, h) (((b) * 2 + (h)) * HTB)
#define PG8_SB(b, h) ((4 + (b) * 2 + (h)) * HTB)
#define PG8_STAGE(bufoff, gbase, voff) do { _Pragma("unroll") for (int _i = 0; _i < 2; ++_i) \
        __builtin_amdgcn_global_load_lds((const unsigned*)((const char*)(gbase) + (voff)[_i]), (PG8_LAS unsigned*)(lds + (bufoff) + ldsw + _i * 8192), 16, 0, 0); } while (0)
#define PG8_LDA(dst, b, h) do { _Pragma("unroll") for (int m = 0; m < 4; ++m) { const bf16x8 lo_ = *(const PG8_LAS bf16x8*)(lds + PG8_SA(b, h) + aoffv + m * 2048), hi_ = *(const PG8_LAS bf16x8*)(lds + PG8_SA(b, h) + aoffv + m * 2048 + 16); dst[m] = __builtin_bit_cast(v8i_t, __builtin_shufflevector(lo_, hi_, 0, 1, 2, 3, 4, 5, 6, 7, 8, 9, 10, 11, 12, 13, 14, 15)); } } while (0)
#define PG8_LDB(dst, b, h) do { _Pragma("unroll") for (int n = 0; n < 2; ++n) { const bf16x8 lo_ = *(const PG8_LAS bf16x8*)(lds + PG8_SB(b, h) + boffv + n * 2048), hi_ = *(const PG8_LAS bf16x8*)(lds + PG8_SB(b, h) + boffv + n * 2048 + 16); dst[n] = __builtin_bit_cast(v8i_t, __builtin_shufflevector(lo_, hi_, 0, 1, 2, 3, 4, 5, 6, 7, 8, 9, 10, 11, 12, 13, 14, 15)); } } while (0)
#define aoffv laoff
#define boffv lboff
#define PG8_MMA(ai, bj, At, Bt) do { __builtin_amdgcn_s_setprio(1); _Pragma("unroll") for (int m = 0; m < 4; ++m) _Pragma("unroll") for (int n = 0; n < 2; ++n) \
        acc.set(ai, bj, m, n, __builtin_amdgcn_mfma_scale_f32_16x16x128_f8f6f4(Bt[n], At[m], acc.get(ai, bj, m, n), 0, 0, 0, 0x7f7f7f7f, 0, 0x7f7f7f7f)); __builtin_amdgcn_s_setprio(0); } while (0)
#define PG8_WAIT_V(n) asm volatile("s_waitcnt vmcnt(" #n ")" ::: "memory")
#define PG8_WAIT_L(n) asm volatile("s_waitcnt lgkmcnt(" #n ")" ::: "memory")
#define PG8_BAR __builtin_amdgcn_s_barrier()
#define PG8_SCHED __builtin_amdgcn_sched_barrier(0)
    Unit cur, nxt; int ui = 0;
    if (!S.next(0, cur)) return;
    AccQ acc;
#pragma unroll
    for (int a = 0; a < 2; ++a)
#pragma unroll
        for (int b = 0; b < 2; ++b)
#pragma unroll
            for (int e = 0; e < 32; ++e) acc.q[a][b][e] = 0.f;
    v8i_t At[4], B0[2], B1[2];
    const char* cA = (const char*)g.A + (size_t)cur.pm * tstep; const char* cB = (const char*)g.Bt + (size_t)cur.pb * tstep;
    const char* const gA = (const char*)g.A;
    if constexpr (GATHER) PG8_GOFFS(0, cur0, cur1);
    S.a_ready(cur);
    if constexpr (SP2) {
        PG8_STAGE(PG8_SB(0, 0), cB, voffB); PG8_STAGE(PG8_SB(0, 1), cB + hstep, voffB); PG8_STAGE_A(PG8_SA(0, 0), cA, gA, cur0); PG8_STAGE_A(PG8_SA(0, 1), cA + hstep, gA, cur1);
        if (wr == 1) PG8_BAR;
        PG8_WAIT_V(2); PG8_BAR;
        PG8_STAGE(PG8_SB(1, 0), cB + kstep, voffB); PG8_STAGE_A(PG8_SA(1, 0), cA + kstep, gA + kstep, cur0); PG8_STAGE(PG8_SB(1, 1), cB + hstep + kstep, voffB);
        PG8_WAIT_V(6); PG8_BAR;
    } else {
        PG8_STAGE(PG8_SB(0, 0), cB, voffB); PG8_STAGE_A(PG8_SA(0, 0), cA, gA, cur0); PG8_STAGE(PG8_SB(0, 1), cB + hstep, voffB); PG8_STAGE_A(PG8_SA(0, 1), cA + hstep, gA, cur1);
        if (wr == 1) PG8_BAR;
        PG8_WAIT_V(4); PG8_BAR;
        PG8_STAGE(PG8_SB(1, 0), cB + kstep, voffB); PG8_STAGE_A(PG8_SA(1, 0), cA + kstep, gA + kstep, cur0); PG8_STAGE(PG8_SB(1, 1), cB + hstep + kstep, voffB);
        PG8_WAIT_V(6); PG8_BAR;
    }
    for (;;) {
        const bool has_next = S.next(ui + 1, nxt);
        const char* nA = has_next ? (const char*)g.A + (size_t)nxt.pm * tstep : cA; const char* nB = has_next ? (const char*)g.Bt + (size_t)nxt.pb * tstep : cB;
#pragma unroll 1
        for (int t = 0; t < nt; t += 2) {
            const bool last = (t == nt - 2);
            unsigned lvA[2], lvB[2], lC2[2]; int lR[2];
            { int tq = tid; asm volatile("" : "+v"(tq));
#pragma unroll
              for (int i = 0; i < 2; ++i) { int R, C; stage_rc(tq * 16 + i * 8192, R, C); const int Rb = Epi::PERM ? ((R & ~31) + perm32(R & 31)) : R;
                  lvA[i] = (unsigned)(R * K) + (unsigned)C * 2u; lvB[i] = (unsigned)(Rb * K) + (unsigned)C * 2u; lR[i] = R; lC2[i] = (unsigned)C * 2u; } }
            int laoff, lboff; { int tq = tid; asm volatile("" : "+v"(tq)); const int lq = tq & 63, lfr = lq & 15, lfq = lq >> 4, lw = tq >> 6; laoff = lds_byte((lw >> 2) * 64 + lfr, lfq * 16); lboff = lds_byte((lw & 3) * 32 + lfr, lfq * 16); }
            const char* a1 = cA + (size_t)(t + 1) * kstep;
            const char* a2 = last ? nA : cA + (size_t)(t + 2) * kstep; const char* b2 = last ? nB : cB + (size_t)(t + 2) * kstep;
            const char* a3 = a2 + kstep; const char* b3 = b2 + kstep;
            const char* ga1 = gA + (size_t)(t + 1) * kstep; const char* ga2 = last ? gA : gA + (size_t)(t + 2) * kstep; const char* ga3 = ga2 + kstep;
            const int u2 = (last && has_next) ? ui + 1 : ui;
            if (last && has_next) S.a_ready(nxt);
            if constexpr (SP2) {
            PG8_LDB(B0, 0, 0); PG8_LDB(B1, 0, 1); PG8_SCHED; PG8_LDA(At, 0, 0); PG8_STAGE_AG(PG8_SA(1, 1), a1 + hstep, ga1, ui, 1);
            PG8_WAIT_V(8); PG8_WAIT_L(0); PG8_BAR; PG8_MMA(0, 0, At, B0); PG8_MMA(0, 1, At, B1); PG8_BAR; PG8_SCHED;
            PG8_LDA(At, 0, 1); PG8_STAGE(PG8_SB(0, 0), b2, lvB); PG8_STAGE(PG8_SB(0, 1), b2 + hstep, lvB); PG8_STAGE_AG(PG8_SA(0, 0), a2, ga2, u2, 0);
            PG8_WAIT_V(8); PG8_WAIT_L(0); PG8_BAR; PG8_MMA(1, 0, At, B0); PG8_MMA(1, 1, At, B1); PG8_BAR; PG8_SCHED;
            PG8_LDB(B0, 1, 0); PG8_LDB(B1, 1, 1); PG8_SCHED; PG8_LDA(At, 1, 0); PG8_STAGE_AG(PG8_SA(0, 1), a2 + hstep, ga2, u2, 1);
            PG8_WAIT_V(8); PG8_WAIT_L(0); PG8_BAR; PG8_MMA(0, 0, At, B0); PG8_MMA(0, 1, At, B1); PG8_BAR; PG8_SCHED;
            PG8_LDA(At, 1, 1); PG8_STAGE(PG8_SB(1, 0), b3, lvB); PG8_STAGE(PG8_SB(1, 1), b3 + hstep, lvB); PG8_STAGE_AG(PG8_SA(1, 0), a3, ga3, u2, 0);
            PG8_WAIT_V(8); PG8_WAIT_L(0); PG8_BAR; PG8_MMA(1, 0, At, B0); PG8_MMA(1, 1, At, B1); PG8_BAR; PG8_SCHED;
            } else {
            PG8_LDB(B0, 0, 0); PG8_SCHED; PG8_LDA(At, 0, 0); PG8_STAGE_AG(PG8_SA(1, 1), a1 + hstep, ga1, ui, 1);
            PG8_WAIT_L(8); PG8_BAR; PG8_WAIT_L(0); PG8_MMA(0, 0, At, B0); PG8_BAR; PG8_SCHED;
            PG8_LDB(B1, 0, 1); PG8_STAGE(PG8_SB(0, 0), b2, lvB);
            PG8_BAR; PG8_WAIT_L(0); PG8_MMA(0, 1, At, B1); PG8_BAR;
            PG8_LDA(At, 0, 1); PG8_STAGE_AG(PG8_SA(0, 0), a2, ga2, u2, 0);
            PG8_BAR; PG8_WAIT_L(0); PG8_MMA(1, 0, At, B0); PG8_BAR; PG8_SCHED;
            PG8_STAGE(PG8_SB(0, 1), b2 + hstep, lvB);
            PG8_WAIT_V(6); PG8_BAR; PG8_MMA(1, 1, At, B1); PG8_BAR;
            PG8_LDB(B0, 1, 0); PG8_SCHED; PG8_LDA(At, 1, 0); PG8_STAGE_AG(PG8_SA(0, 1), a2 + hstep, ga2, u2, 1);
            PG8_WAIT_L(8); PG8_BAR; PG8_WAIT_L(0); PG8_MMA(0, 0, At, B0); PG8_BAR; PG8_SCHED;
            PG8_LDB(B1, 1, 1); PG8_STAGE(PG8_SB(1, 0), b3, lvB);
            PG8_BAR; PG8_WAIT_L(0); PG8_MMA(0, 1, At, B1); PG8_BAR;
            PG8_LDA(At, 1, 1); PG8_STAGE_AG(PG8_SA(1, 0), a3, ga3, u2, 0);
            PG8_BAR; PG8_WAIT_L(0); PG8_MMA(1, 0, At, B0); PG8_BAR; PG8_SCHED;
            PG8_STAGE(PG8_SB(1, 1), b3 + hstep, lvB);
            PG8_WAIT_V(6); PG8_BAR; PG8_MMA(1, 1, At, B1); PG8_BAR;
            }
        }
        if constexpr (ALIGN_EPI) { if (wr == 0) PG8_BAR; }
        if constexpr (!Epi::AFTER_DRAIN) { int tq = tid; asm volatile("" : "+v"(tq)); const int lq = tq & 63; E(acc, cur, wr, wc, lq & 15, lq >> 4); S.done(cur); }
        if (!has_next) break;
#pragma unroll
        for (int a = 0; a < 2; ++a)
#pragma unroll
            for (int b = 0; b < 2; ++b)
#pragma unroll
                for (int e = 0; e < 32; ++e) acc.q[a][b][e] = 0.f;
        cur = nxt; cA = nA; cB = nB; ++ui;

        if constexpr (ALIGN_EPI) { if (wr == 1) PG8_BAR; }
    }
    PG8_WAIT_V(0);
    if constexpr (!ALIGN_EPI) { if (wr == 0) PG8_BAR; }
    PG8_BAR;
    if constexpr (Epi::AFTER_DRAIN) { E.fused(acc, cur, wr, wc, fr, fq, lds, wid, lane); S.done(cur); }
#undef PG8_SA
#undef PG8_SB
#undef PG8_STAGE
#undef PG8_STAGE_A
#undef PG8_STAGE_AG
#undef PG8_GOFFS
#undef PG8_LDA
#undef PG8_LDB
#undef aoffv
#undef boffv
#undef PG8_MMA
#undef PG8_WAIT_V
#undef PG8_WAIT_L
#undef PG8_BAR
#undef PG8_SCHED
}
}

constexpr int NW = 8;
constexpr int D = 1024, NB = 4, T = 8192, TCX = 256, NLAT = NB * T, NCTX = NB * TCX, R = NLAT + NCTX;
constexpr int NE = 16, FF = 2048, CAPL = 1024, CAPC = 32;
constexpr int RPE0 = 4352, RPE1 = 4096;
constexpr int HD = 128, NH = 8, NSEQ = NB * NH * 2;
constexpr int NGRP = 17;
constexpr float EPS = 1e-6f;

constexpr size_t MiB = 1u << 20;
constexpr size_t WS_CTL = 0, CTL_ZERO_BYTES = 64 * 1024;
constexpr size_t WS_MV = 1 * MiB;
constexpr size_t WS_LB = WS_MV + 256 * 1024;
constexpr size_t WS_AFF = 2 * MiB;
constexpr size_t WS_INV = 5 * MiB;
constexpr size_t WS_SEL = 7 * MiB;
constexpr size_t WS_GSEL = 7 * MiB + 512 * 1024;
constexpr size_t WS_CTXS = 8 * MiB;
constexpr size_t WS_W1T = 12 * MiB, WS_W2T = 16 * MiB, WS_WINT = 18 * MiB, WS_WOUTT = 28 * MiB;
constexpr size_t WS_PTOT = 30 * MiB;
constexpr size_t WS_W13T = 32 * MiB;
constexpr size_t WS_WDT = 160 * MiB;
constexpr size_t WS_W13T_L1 = 96 * MiB, WS_WDT_L1 = 192 * MiB;
constexpr int MOE_ITEMS = 16 * (16 * 128 + 32 * 32);
constexpr size_t WS_HB = 224 * MiB;
constexpr size_t WS_UB = 290 * MiB;
constexpr size_t WS_XG = 356 * MiB;
constexpr size_t WS_HBUF = 492 * MiB;
constexpr size_t WS_PRJ = 356 * MiB;
constexpr size_t WS_OLOC = 764 * MiB;
constexpr size_t WS_QGG = 892 * MiB;
constexpr size_t WS_SST = 32 * MiB;
constexpr size_t WS_END = 1020 * MiB;
static_assert(WS_PRJ + (size_t)R * 5120 * 2 <= WS_OLOC && WS_HBUF + (size_t)16 * RPE0 * 2048 * 2 <= WS_OLOC && WS_XG + (size_t)16 * RPE0 * 1024 * 2 <= WS_HBUF, "ws map");
static_assert(WS_HB + (size_t)R * 1024 * 2 <= WS_UB && WS_UB + (size_t)R * 1024 * 2 <= WS_XG && WS_QGG + (size_t)2 * NLAT * 1024 * 2 <= WS_END, "ws map 2");

constexpr int CW_BAR = 4096;
constexpr int LDS_BYTES = 155648;
constexpr int GTAB_OFF = 131072;
constexpr int MISC_OFF = 131072 + 20 * 1024 + 320;
static_assert(MISC_OFF + 192 <= LDS_BYTES, "LDS map");

#define GAS __attribute__((address_space(1)))
#define LAS __attribute__((address_space(3)))
typedef unsigned short bf16;
typedef unsigned v4u __attribute__((ext_vector_type(4)));
typedef unsigned v2u __attribute__((ext_vector_type(2)));
typedef float f32x4 __attribute__((ext_vector_type(4)));
typedef float f32x2 __attribute__((ext_vector_type(2)));
typedef short bf16x8 __attribute__((ext_vector_type(8)));
typedef short bf16x4 __attribute__((ext_vector_type(4)));
#define LDS_WAIT() asm volatile("s_waitcnt lgkmcnt(0)" ::: "memory")
__device__ __forceinline__ unsigned pk2(float lo, float hi) { return pg8::cvt_pk_bf16(lo, hi); }
__device__ __forceinline__ float bflo(unsigned w) { return __uint_as_float(w << 16); }
__device__ __forceinline__ float bfhi(unsigned w) { return __uint_as_float(w & 0xffff0000u); }
__device__ __forceinline__ float fsig(float x) { return __builtin_amdgcn_rcpf(1.0f + __expf(-x)); }
__device__ __forceinline__ float wave_sum(float v) {
#pragma unroll
    for (int o = 1; o < 64; o <<= 1) v += __shfl_xor(v, o);
    return v;
}

#define XB_TMO      128
#define XB_XCNT(j)  (256  + 64 * (j))
#define XB_XSUB(j)  (1280 + 64 * (j))
#define XB_XGEN(j)  (2304 + 64 * (j))
#define XB_TOP      3328
#define XB_TOPGEN   3392
#define XCD_BAR_WORDS 3456
#define XB_SPIN_CAP (1u << 20)
__device__ __forceinline__ unsigned xb_ld(unsigned* p)              { return __hip_atomic_load(p, __ATOMIC_RELAXED, __HIP_MEMORY_SCOPE_AGENT); }
__device__ __forceinline__ unsigned xb_add(unsigned* p, unsigned v) { return __hip_atomic_fetch_add(p, v, __ATOMIC_RELAXED, __HIP_MEMORY_SCOPE_AGENT); }
__device__ __forceinline__ unsigned xb_xcc_id() { return (unsigned)__builtin_amdgcn_s_getreg((3 << 11) | 20) & 0xFu; }
#define XB_SPIN(cond, bar) do { unsigned _sp = 0; while (cond) { __builtin_amdgcn_s_sleep(1); \
    if ((++_sp & 255u) == 0u) { if (xb_ld(&(bar)[XB_TMO])) break; if (_sp > XB_SPIN_CAP) { atomicAdd(&(bar)[XB_TMO], 1u); break; } } } } while (0)
struct XcdBarrier { unsigned* bar; unsigned x; volatile LAS unsigned* st; };
__device__ __forceinline__ XcdBarrier xcd_barrier_post(unsigned* bar, volatile LAS unsigned* st, const int wv) {
    XcdBarrier b; b.bar = bar; b.x = xb_xcc_id(); b.st = st;
    if (TID_OF(wv) == 0) (void)xb_add(&bar[XB_XCNT(b.x)], 1u);
    return b;
}
__device__ __forceinline__ void xcd_barrier_complete(unsigned* bar, unsigned x, unsigned& nloc, unsigned& nx) {
    const unsigned G = gridDim.x * gridDim.y * gridDim.z;
    unsigned sum, cnt, mine, sp = 0u;
    for (;;) {
        sum = 0u; cnt = 0u; mine = 0u;
#pragma unroll
        for (unsigned j = 0; j < 16; ++j) { const unsigned c = xb_ld(&bar[XB_XCNT(j)]); sum += c; cnt += (c > 0u) ? 1u : 0u; mine = (j == x) ? c : mine; }
        if (sum == G) break;
        __builtin_amdgcn_s_sleep(1);
        if ((++sp & 255u) == 0u) { if (xb_ld(&bar[XB_TMO])) break; if (sp > XB_SPIN_CAP) { atomicAdd(&bar[XB_TMO], 1u); break; } }
    }
    nloc = mine > 0u ? mine : 1u; nx = cnt > 0u ? cnt : 1u;
}
__device__ __forceinline__ void xcd_barrier(const XcdBarrier& b, const int wv) {
    asm volatile("s_waitcnt vmcnt(0)" ::: "memory");
    __syncthreads();
    if (TID_OF(wv) == 0) {
        unsigned* bar = b.bar;
        __builtin_amdgcn_s_waitcnt(0);
        unsigned nloc = b.st[0], nx = b.st[1];
        if (nloc == 0u) { xcd_barrier_complete(bar, b.x, nloc, nx); b.st[0] = nloc; b.st[1] = nx; }
        const unsigned old = xb_add(&bar[XB_XSUB(b.x)], 1u);
        const unsigned gen = old / nloc;
        if (old + 1u == (gen + 1u) * nloc) {
            __builtin_amdgcn_fence(__ATOMIC_RELEASE, "agent");
            asm volatile("s_waitcnt vmcnt(0)" ::: "memory");
            const unsigned og = xb_add(&bar[XB_TOP], 1u);
            const unsigned tg = og / nx;
            if (og + 1u == (tg + 1u) * nx) xb_add(&bar[XB_TOPGEN], 1u);
            else XB_SPIN(xb_ld(&bar[XB_TOPGEN]) == tg, bar);
            __builtin_amdgcn_fence(__ATOMIC_ACQUIRE, "agent");
            xb_add(&bar[XB_XGEN(b.x)], 1u);
            asm volatile("s_waitcnt vmcnt(0)" ::: "memory");
        } else {
            XB_SPIN(xb_ld(&bar[XB_XGEN(b.x)]) == gen, bar);
            __builtin_amdgcn_fence(__ATOMIC_ACQUIRE, "agent");
            asm volatile("s_waitcnt vmcnt(0)" ::: "memory");
        }
    }
    __syncthreads();
}

struct Ctx {
    LAS unsigned char* lds;
    int tid, lane, wave, vcu, G, gw, NGW;
};
__device__ __forceinline__ Ctx make_ctx(unsigned char* lds_raw, const int wv) {
    Ctx C; int l = lane_id(); asm volatile("" : "+v"(l));
    C.lds = (LAS unsigned char*)lds_raw; C.tid = wv * 64 + l; C.lane = l; C.wave = wv;
    C.G = gridDim.x; { const int bx = blockIdx.x; C.vcu = (C.G % 8 == 0) ? (bx % 8) * (C.G / 8) + bx / 8 : bx; }
    C.gw = C.vcu * NW + C.wave; C.NGW = C.G * NW;
    return C;
}

__device__ __forceinline__ void transpose_item(const float* W, int ldw, int k0, int n0, bf16* WT, int K, int drow0, LAS float* scr, int lane) {
    float tv[32];
    const float* wp = W + (size_t)(k0 + (lane >> 5)) * ldw + n0 + (lane & 31);
#pragma unroll
    for (int i = 0; i < 32; ++i) tv[i] = __builtin_nontemporal_load(wp + (size_t)(2 * i) * ldw);
#pragma unroll
    for (int i = 0; i < 32; ++i) scr[(2 * i + (lane >> 5)) * 33 + (lane & 31)] = tv[i];
    LDS_WAIT(); asm volatile("" ::: "memory");
    const int c = lane & 7;
#pragma unroll
    for (int j = 0; j < 4; ++j) { const int n = (lane >> 3) + 8 * j; const LAS float* s = scr + (8 * c) * 33 + n;
        v4u o; o.x = pk2(s[0 * 33], s[1 * 33]); o.y = pk2(s[2 * 33], s[3 * 33]); o.z = pk2(s[4 * 33], s[5 * 33]); o.w = pk2(s[6 * 33], s[7 * 33]);
        *(v4u*)(WT + (size_t)(drow0 + n) * K + k0 + 8 * c) = o; }
    LDS_WAIT(); asm volatile("" ::: "memory");
}
__device__ __forceinline__ void paired_src(int db, int& type, int& ch) { const int j0 = 32 * db, pn = j0 >> 8, jj = j0 & 255; type = jj >> 7; ch = 128 * pn + (jj & 127); }

__device__ __forceinline__ void convert_small(const Ctx& C, const float* w1, const float* w2, const float* win, const float* wout, unsigned char* ws) {
    LAS float* scr = (LAS float*)(C.lds + C.wave * 16384);
    constexpr int I1 = 16 * 64, I2 = 16 * 32, I3 = 16 * 160, I4 = 16 * 32, NI = I1 + I2 + I3 + I4;
    for (int it = C.gw; it < NI; it += C.NGW) {
        int r = it;
        if (r < I1) { const int kb = r / 64, db = r % 64; int type, ch; paired_src(db, type, ch); transpose_item(w1, 2048, 64 * kb, type * 1024 + ch, (bf16*)(ws + WS_W1T), 1024, 32 * db, scr, C.lane); continue; } r -= I1;
        if (r < I2) { const int kb = r / 32, db = r % 32; transpose_item(w2, 1024, 64 * kb, 32 * db, (bf16*)(ws + WS_W2T), 1024, 32 * db, scr, C.lane); continue; } r -= I2;
        if (r < I3) { const int kb = r / 160, db = r % 160; transpose_item(win, 5120, 64 * kb, 32 * db, (bf16*)(ws + WS_WINT), 1024, 32 * db, scr, C.lane); continue; } r -= I3;
        { const int kb = r / 32, db = r % 32; transpose_item(wout, 1024, 64 * kb, 32 * db, (bf16*)(ws + WS_WOUTT), 1024, 32 * db, scr, C.lane); }
    }
}
__device__ __forceinline__ void transpose_item_f8(const float* W, int ldw, int k0, int n0, unsigned char* WT, int K, int drow0, LAS float* scr, int lane) {
    float tv[32];
    const float* wp = W + (size_t)(k0 + (lane >> 5)) * ldw + n0 + (lane & 31);
#pragma unroll
    for (int i = 0; i < 32; ++i) tv[i] = __builtin_nontemporal_load(wp + (size_t)(2 * i) * ldw);
#pragma unroll
    for (int i = 0; i < 32; ++i) scr[(2 * i + (lane >> 5)) * 33 + (lane & 31)] = tv[i] * 32.0f;
    LDS_WAIT(); asm volatile("" ::: "memory");
    const int n = lane >> 1, kh = (lane & 1) * 32; const LAS float* sp = scr + kh * 33 + n;
    unsigned o[8];
#pragma unroll
    for (int q = 0; q < 8; ++q) o[q] = pg8::pk4_fp8(sp[(4 * q) * 33], sp[(4 * q + 1) * 33], sp[(4 * q + 2) * 33], sp[(4 * q + 3) * 33]);
    unsigned char* dp = WT + (size_t)(drow0 + n) * K + k0 + kh;
    __builtin_nontemporal_store((v4u){o[0], o[1], o[2], o[3]}, (v4u*)dp); __builtin_nontemporal_store((v4u){o[4], o[5], o[6], o[7]}, (v4u*)(dp + 16));
    LDS_WAIT(); asm volatile("" ::: "memory");
}
__device__ __forceinline__ void convert_moe(const Ctx& C, const float* wg, const float* wu, const float* wd, int layer, unsigned char* ws, int it_lo, int it_hi, int widx, int nw) {
    LAS float* scr = (LAS float*)(C.lds + C.wave * 16384);
    constexpr int IGU = 16 * 128, IDN = 32 * 32, IE = IGU + IDN;
    const size_t lo = (size_t)layer * NE * 1024 * 2048;
    unsigned char* const w13 = ws + (layer ? WS_W13T_L1 : WS_W13T); unsigned char* const wdt = ws + (layer ? WS_WDT_L1 : WS_WDT);
    for (int it = it_lo + widx; it < it_hi; it += nw) {
        const int e = it / IE; int r = it % IE;
        if (r < IGU) { const int kb = r / 128, db = r % 128; int type, ch; paired_src(db, type, ch);
            transpose_item_f8((type ? wu : wg) + lo + (size_t)e * 1024 * 2048, 2048, 64 * kb, ch, w13 + (size_t)e * 4096 * 1024, 1024, 32 * db, scr, C.lane); }
        else { r -= IGU; const int kb = r / 32, db = r % 32;
            transpose_item_f8(wd + lo + (size_t)e * 2048 * 1024, 1024, 64 * kb, 32 * db, wdt + (size_t)e * 1024 * 2048, 2048, 32 * db, scr, C.lane); }
    }
}
__device__ __forceinline__ void mod_gemv(const Ctx& C, const float* c, const float* cctx, const float* mod_w, const float* mod_b, float* MV) {
    LAS float* cond = (LAS float*)C.lds;
    LAS float* red = cond + 5 * 1024;
    bool have = false;
    for (int item = blockIdx.x; item < 192; item += C.G) {
        if (!have) { for (int i = C.tid; i < 5 * 1024; i += NW * 64) { const int g = i >> 10, k = i & 1023; const float v = g < 4 ? c[g * 1024 + k] : cctx[k]; cond[i] = v * fsig(v); } have = true; }
        __syncthreads();
        const int l = item / 96, n = (item % 96) * 64 + C.lane;
        const float* W = mod_w + (size_t)l * 1024 * 6144 + n;
        float a[5] = {0.f, 0.f, 0.f, 0.f, 0.f};
        for (int kk = 0; kk < 128; kk += 32) { float w[32];
#pragma unroll
            for (int u = 0; u < 32; ++u) w[u] = __builtin_nontemporal_load(W + (size_t)(C.wave * 128 + kk + u) * 6144);
#pragma unroll
            for (int u = 0; u < 32; ++u)
#pragma unroll
                for (int g = 0; g < 5; ++g) a[g] += cond[g * 1024 + C.wave * 128 + kk + u] * w[u]; }
#pragma unroll
        for (int g = 0; g < 5; ++g) red[(C.wave * 5 + g) * 64 + C.lane] = a[g];
        __syncthreads();
        if (C.wave < 5) { float s = 0.f;
#pragma unroll
            for (int w = 0; w < 8; ++w) s += red[(w * 5 + C.wave) * 64 + C.lane];
            MV[(size_t)(l * 5 + C.wave) * 6144 + n] = s + mod_b[l * 6144 + n]; }
    }
}

struct RowArgs {
    const float* src_lat; const float* src_ctx;
    const bf16* delta;
    float* dst_lat; float* dst_ctx;
    const float* gamma;
    const float* mv;
    const float* mvg;
    int i_shift, i_scale, i_gate;
    bf16* HB; unsigned char* HB8; float* AFF; const float* router_w;
    const bf16* Y; const short* INV; int rpe;
    int nrows;
};
template <bool COMBINE, bool ROUTER, bool FINAL>
__device__ __forceinline__ void row_phase(const Ctx& C, const RowArgs& A) {
    LAS float* rwT = (LAS float*)C.lds;
    if (ROUTER) { for (int i = C.tid; i < 16384; i += NW * 64) rwT[(i & 15) * 1024 + (i >> 4)] = A.router_w[i]; __syncthreads(); }
    const int rpw = (A.nrows + C.NGW - 1) / C.NGW;
    const int r_lo = C.gw * rpw, r_hi = min(A.nrows, r_lo + rpw);
    const int l4 = 4 * C.lane;
    int cur_grp = -1;
    f32x4 ga[4], sh[4], m5[4];
#pragma unroll
    for (int j = 0; j < 4; ++j) { ga[j] = (f32x4){0.f, 0.f, 0.f, 0.f}; sh[j] = ga[j]; m5[j] = ga[j]; }
    constexpr bool DELTA = ROUTER || COMBINE;
    f32x4 vn[4]; v2u dn[4];
#pragma unroll
    for (int j = 0; j < 4; ++j) { vn[j] = (f32x4){0.f, 0.f, 0.f, 0.f}; dn[j] = (v2u){0u, 0u}; }
    if (r_lo < r_hi) { const bool ic = r_lo >= NLAT; const float* s0 = (ic ? A.src_ctx + (size_t)(r_lo - NLAT) * 1024 : A.src_lat + (size_t)r_lo * 1024);
#pragma unroll
        for (int j = 0; j < 4; ++j) { vn[j] = COMBINE ? __builtin_nontemporal_load((const f32x4*)(s0 + l4 + 256 * j)) : *(const f32x4*)(s0 + l4 + 256 * j); if (DELTA) dn[j] = COMBINE ? __builtin_nontemporal_load((const v2u*)(A.delta + (size_t)r_lo * 1024 + l4 + 256 * j)) : *(const v2u*)(A.delta + (size_t)r_lo * 1024 + l4 + 256 * j); } }
    int svn = -1;
    if (COMBINE && r_lo < r_hi) svn = (C.lane < 16) ? (int)A.INV[(size_t)r_lo * 16 + C.lane] : -1;
    for (int r = r_lo; r < r_hi; ++r) {
        const bool isctx = r >= NLAT; const int grp = isctx ? 4 : (r >> 13);
        if (grp != cur_grp) { cur_grp = grp; const float* mvn = A.mv + (size_t)grp * 6144;
#pragma unroll
            for (int j = 0; j < 4; ++j) { const int c0 = l4 + 256 * j; const f32x4 g = *(const f32x4*)(A.gamma + c0);
                if (FINAL) { ga[j] = g; }
                else { const f32x4 sc = *(const f32x4*)(mvn + A.i_scale * 1024 + c0); ga[j] = g * (sc + 1.0f); sh[j] = *(const f32x4*)(mvn + A.i_shift * 1024 + c0); }
                if (COMBINE) m5[j] = *(const f32x4*)(A.mvg + (size_t)grp * 6144 + A.i_gate * 1024 + c0); } }
        const size_t roff = isctx ? (size_t)(r - NLAT) * 1024 : (size_t)r * 1024;
        f32x4 v[4];
#pragma unroll
        for (int j = 0; j < 4; ++j) { v[j] = vn[j]; if (DELTA) v[j] += (f32x4){bflo(dn[j].x), bfhi(dn[j].x), bflo(dn[j].y), bfhi(dn[j].y)}; }
        if (r + 1 < r_hi) { const int rn = r + 1; const bool ic = rn >= NLAT; const float* s1 = (ic ? A.src_ctx + (size_t)(rn - NLAT) * 1024 : A.src_lat + (size_t)rn * 1024);
#pragma unroll
            for (int j = 0; j < 4; ++j) { vn[j] = COMBINE ? __builtin_nontemporal_load((const f32x4*)(s1 + l4 + 256 * j)) : *(const f32x4*)(s1 + l4 + 256 * j); if (DELTA) dn[j] = COMBINE ? __builtin_nontemporal_load((const v2u*)(A.delta + (size_t)rn * 1024 + l4 + 256 * j)) : *(const v2u*)(A.delta + (size_t)rn * 1024 + l4 + 256 * j); } }
        if (COMBINE) {
            f32x4 acc[4];
#pragma unroll
            for (int j = 0; j < 4; ++j) acc[j] = (f32x4){0.f, 0.f, 0.f, 0.f};
            const int sv = svn;
            if (r + 1 < r_hi) svn = (C.lane < 16) ? (int)A.INV[(size_t)(r + 1) * 16 + C.lane] : -1;
            unsigned long long m = __ballot(sv >= 0);
            while (m) {
                const int e0 = __ffsll((long long)m) - 1; m &= m - 1;
                const bool two = m != 0ull; const int e1 = two ? __ffsll((long long)m) - 1 : e0; if (two) m &= m - 1;
                const bf16* y0 = A.Y + ((size_t)e0 * A.rpe + __shfl(sv, e0)) * 1024 + l4;
                const bf16* y1 = A.Y + ((size_t)e1 * A.rpe + __shfl(sv, e1)) * 1024 + l4;
                v2u w0[4], w1[4];
#pragma unroll
                for (int j = 0; j < 4; ++j) { w0[j] = __builtin_nontemporal_load((const v2u*)(y0 + 256 * j)); w1[j] = __builtin_nontemporal_load((const v2u*)(y1 + 256 * j)); }
#pragma unroll
                for (int j = 0; j < 4; ++j) { acc[j] += (f32x4){bflo(w0[j].x), bfhi(w0[j].x), bflo(w0[j].y), bfhi(w0[j].y)};
                    if (two) acc[j] += (f32x4){bflo(w1[j].x), bfhi(w1[j].x), bflo(w1[j].y), bfhi(w1[j].y)}; } }
#pragma unroll
            for (int j = 0; j < 4; ++j) v[j] += m5[j] * acc[j];
            if (!FINAL) { float* dst = (isctx ? A.dst_ctx : A.dst_lat) + roff;
#pragma unroll
                for (int j = 0; j < 4; ++j) __builtin_nontemporal_store(v[j], (f32x4*)(dst + l4 + 256 * j)); }
        }
        float ss = 0.f;
#pragma unroll
        for (int j = 0; j < 4; ++j) ss += (v[j].x * v[j].x + v[j].y * v[j].y) + (v[j].z * v[j].z + v[j].w * v[j].w);
        const float rstd = rsqrtf(wave_sum(ss) * (1.0f / 1024.0f) + EPS);
        if (FINAL) { float* dst = A.dst_lat + roff;
#pragma unroll
            for (int j = 0; j < 4; ++j) __builtin_nontemporal_store(v[j] * rstd * ga[j], (f32x4*)(dst + l4 + 256 * j));
            continue; }
        f32x4 hv[4];
#pragma unroll
        for (int j = 0; j < 4; ++j) { hv[j] = v[j] * rstd * ga[j] + sh[j];
            if (ROUTER) { *(unsigned*)(A.HB8 + (size_t)r * 1024 + l4 + 256 * j) = pg8::pk4_fp8(hv[j].x, hv[j].y, hv[j].z, hv[j].w); }
            else { v2u w; w.x = pk2(hv[j].x, hv[j].y); w.y = pk2(hv[j].z, hv[j].w); *(v2u*)(A.HB + (size_t)r * 1024 + l4 + 256 * j) = w; } }
        if (ROUTER) {
            float lg[16];
#pragma unroll
            for (int e = 0; e < 16; ++e) { float s = 0.f;
#pragma unroll
                for (int j = 0; j < 4; ++j) { const f32x4 w = *(const LAS f32x4*)(rwT + e * 1024 + l4 + 256 * j); s += (hv[j].x * w.x + hv[j].y * w.y) + (hv[j].z * w.z + hv[j].w * w.w); }
                lg[e] = s; }
            float t8[8], t4[4], t2[2], t1;
#pragma unroll
            for (int i = 0; i < 8; ++i) { const bool up = (C.lane & 32) != 0; const float send = up ? lg[i] : lg[i + 8], keep = up ? lg[i + 8] : lg[i]; t8[i] = keep + __shfl_xor(send, 32); }
#pragma unroll
            for (int i = 0; i < 4; ++i) { const bool up = (C.lane & 16) != 0; const float send = up ? t8[i] : t8[i + 4], keep = up ? t8[i + 4] : t8[i]; t4[i] = keep + __shfl_xor(send, 16); }
#pragma unroll
            for (int i = 0; i < 2; ++i) { const bool up = (C.lane & 8) != 0; const float send = up ? t4[i] : t4[i + 2], keep = up ? t4[i + 2] : t4[i]; t2[i] = keep + __shfl_xor(send, 8); }
            { const bool up = (C.lane & 4) != 0; const float send = up ? t2[0] : t2[1], keep = up ? t2[1] : t2[0]; t1 = keep + __shfl_xor(send, 4); }
            t1 += __shfl_xor(t1, 2); t1 += __shfl_xor(t1, 1);
            const int e = ((C.lane >> 5) & 1) * 8 + ((C.lane >> 4) & 1) * 4 + ((C.lane >> 3) & 1) * 2 + ((C.lane >> 2) & 1);
            float mx = t1;
#pragma unroll
            for (int o = 4; o < 64; o <<= 1) mx = fmaxf(mx, __shfl_xor(mx, o));
            const float p = __expf(t1 - mx); float sum = p;
#pragma unroll
            for (int o = 4; o < 64; o <<= 1) sum += __shfl_xor(sum, o);
            if ((C.lane & 3) == 0) A.AFF[(size_t)r * 16 + e] = p / sum;
        }
    }
    if (ROUTER) __syncthreads();
}

__device__ __forceinline__ void conv_phase(const Ctx& C, const bf16* U, bf16* V, const float* dw, const float* dwb, const float* lng, const float* lnb) {
    LAS unsigned* ut = (LAS unsigned*)C.lds;
    LAS float* part = (LAS float*)(C.lds + 126976);
    LAS float* stat = part + 512;
    const int cp = C.tid;
    f32x2 wt[31];
#pragma unroll
    for (int j = 0; j < 31; ++j) wt[j] = *(const f32x2*)(dw + j * 1024 + 2 * cp);
    const f32x2 bb = *(const f32x2*)(dwb + 2 * cp), gg = *(const f32x2*)(lng + 2 * cp), be = *(const f32x2*)(lnb + 2 * cp);
    for (int tile = C.vcu; tile < 1056; tile += C.G) {
        int rowbase, t0, tseq;
        if (tile < 1024) { rowbase = (tile >> 8) * T; t0 = (tile & 255) * 32; tseq = T; } else { const int tt = tile - 1024; rowbase = NLAT + (tt >> 3) * TCX; t0 = (tt & 7) * 32; tseq = TCX; }
        { v4u tv[16];
#pragma unroll
            for (int k = 0; k < 16; ++k) { const int i = 4 * k + (C.tid >> 7), t = t0 - 15 + i; tv[k] = (v4u){0u, 0u, 0u, 0u};
                if (i < 62 && t >= 0 && t < tseq) tv[k] = *(const v4u*)(U + (size_t)(rowbase + t) * 1024 + (C.tid & 127) * 8); }
#pragma unroll
            for (int k = 0; k < 16; ++k) { const int i = 4 * k + (C.tid >> 7); if (i < 62) *(LAS v4u*)(C.lds + i * 2048 + (C.tid & 127) * 16) = tv[k]; } }
        __syncthreads();
        f32x2 ov[32];
#pragma unroll
        for (int g = 0; g < 8; ++g) {
            f32x2 a[4];
#pragma unroll
            for (int oo = 0; oo < 4; ++oo) a[oo] = bb;
#pragma unroll
            for (int jj = 0; jj < 34; ++jj) { const unsigned uw = ut[(4 * g + jj) * 512 + cp]; const f32x2 uu = (f32x2){bflo(uw), bfhi(uw)};
#pragma unroll
                for (int oo = 0; oo < 4; ++oo) { const int tap = jj - oo; if (tap >= 0 && tap <= 30) a[oo] = __builtin_elementwise_fma(wt[tap], uu, a[oo]); } }
            float r8[8];
#pragma unroll
            for (int oo = 0; oo < 4; ++oo) { ov[4 * g + oo] = a[oo]; r8[2 * oo] = a[oo].x + a[oo].y; r8[2 * oo + 1] = a[oo].x * a[oo].x + a[oo].y * a[oo].y; }
            float r4[4], r2[2], r1;
#pragma unroll
            for (int i = 0; i < 4; ++i) { const bool up = (C.lane & 32) != 0; const float send = up ? r8[i] : r8[i + 4], keep = up ? r8[i + 4] : r8[i]; r4[i] = keep + __shfl_xor(send, 32); }
#pragma unroll
            for (int i = 0; i < 2; ++i) { const bool up = (C.lane & 16) != 0; const float send = up ? r4[i] : r4[i + 2], keep = up ? r4[i + 2] : r4[i]; r2[i] = keep + __shfl_xor(send, 16); }
            { const bool up = (C.lane & 8) != 0; const float send = up ? r2[0] : r2[1], keep = up ? r2[1] : r2[0]; r1 = keep + __shfl_xor(send, 8); }
            r1 += __shfl_xor(r1, 4); r1 += __shfl_xor(r1, 2); r1 += __shfl_xor(r1, 1);
            if ((C.lane & 7) == 0) { const int vi = ((C.lane >> 5) & 1) * 4 + ((C.lane >> 4) & 1) * 2 + ((C.lane >> 3) & 1); part[((4 * g + (vi >> 1)) * 8 + C.wave) * 2 + (vi & 1)] = r1; }
            asm volatile("" ::: "memory");
        }
        __syncthreads();
        if (C.tid < 32) { float s1 = 0.f, s2 = 0.f;
#pragma unroll
            for (int w = 0; w < 8; ++w) { s1 += part[(C.tid * 8 + w) * 2]; s2 += part[(C.tid * 8 + w) * 2 + 1]; }
            const float mean = s1 * (1.0f / 1024.0f), var = fmaxf(s2 * (1.0f / 1024.0f) - mean * mean, 0.f);
            stat[C.tid * 2] = mean; stat[C.tid * 2 + 1] = rsqrtf(var + EPS); }
        __syncthreads();
#pragma unroll
        for (int tk = 0; tk < 32; ++tk) { const float mean = stat[tk * 2], rstd = stat[tk * 2 + 1];
            const float y0 = (ov[tk].x - mean) * rstd * gg.x + be.x, y1 = (ov[tk].y - mean) * rstd * gg.y + be.y;
            *(unsigned*)(V + (size_t)(rowbase + t0 + tk) * 1024 + 2 * cp) = pk2(y0 * fsig(y0), y1 * fsig(y1)); }
    }
}

__device__ __forceinline__ unsigned block_excl_scan(const Ctx& C, unsigned v, LAS unsigned* wsum, unsigned& total) {
    unsigned inc = v;
#pragma unroll
    for (int o = 1; o < 64; o <<= 1) { const unsigned t = __shfl_up(inc, o); if (C.lane >= o) inc += t; }
    if (C.lane == 63) wsum[C.wave] = inc;
    __syncthreads();
    unsigned base = 0, tot = 0;
#pragma unroll
    for (int w = 0; w < NW; ++w) { const unsigned s = wsum[w]; if (w < C.wave) base += s; tot += s; }
    __syncthreads();
    total = tot;
    return base + inc - v;
}
__device__ __forceinline__ void topk_phase(const Ctx& C, int nprob, int rpe, const float* AFF, int* SEL, float* GSEL, short* INV) {
    LAS unsigned* hist = (LAS unsigned*)C.lds;
    LAS unsigned* misc = hist + 256;
    LAS unsigned* wsum = misc + 16;
    for (int prob = blockIdx.x; prob < nprob; prob += C.G) {
        const int set = prob >> 4, e = prob & 15; const bool lat = set < 4;
        const int kk = lat ? CAPL : CAPC, rowbase = lat ? set * T : NLAT + (set - 4) * TCX, slotbase = lat ? set * CAPL : 4 * CAPL + (set - 4) * CAPC;
        const int cnt = lat ? 16 : (C.tid < 256 ? 1 : 0), base = lat ? C.tid * 16 : C.tid;
        unsigned key[16];
#pragma unroll
        for (int i = 0; i < 16; ++i) key[i] = (i < cnt) ? __float_as_uint(AFF[(size_t)(rowbase + base + i) * 16 + e]) : 0u;
        unsigned prefix = 0u, mask = 0u, need = (unsigned)kk;
#pragma unroll 1
        for (int pass = 0; pass < 4; ++pass) { const int shift = 24 - 8 * pass;
            if (C.tid < 256) hist[C.tid] = 0u;
            __syncthreads();
#pragma unroll
            for (int i = 0; i < 16; ++i) if (i < cnt && (key[i] & mask) == prefix) __hip_atomic_fetch_add(&hist[(key[i] >> shift) & 255u], 1u, __ATOMIC_RELAXED, __HIP_MEMORY_SCOPE_WORKGROUP);
            __syncthreads();
            if (C.wave == 0) { unsigned h[4], tot = 0u;
#pragma unroll
                for (int b = 0; b < 4; ++b) { h[b] = hist[4 * C.lane + b]; tot += h[b]; }
                unsigned inc = tot;
#pragma unroll
                for (int o = 1; o < 64; o <<= 1) { const unsigned t = __shfl_down(inc, o); if (C.lane + o < 64) inc += t; }
                unsigned cgt = inc - tot;
#pragma unroll
                for (int b = 3; b >= 0; --b) { if (cgt < need && need <= cgt + h[b]) { misc[0] = (unsigned)(4 * C.lane + b); misc[1] = need - cgt; } cgt += h[b]; } }
            __syncthreads();
            prefix |= misc[0] << shift; mask |= 255u << shift; need = misc[1];
        }
        unsigned neq = 0u, ngt = 0u;
#pragma unroll
        for (int i = 0; i < 16; ++i) if (i < cnt) { neq += (key[i] == prefix) ? 1u : 0u; ngt += (key[i] > prefix) ? 1u : 0u; }
        unsigned tot;
        const unsigned eq_before = block_excl_scan(C, neq, wsum, tot);
        const unsigned take_eq = (need > eq_before) ? min(neq, need - eq_before) : 0u;
        unsigned slot = block_excl_scan(C, ngt + take_eq, wsum, tot);
        unsigned eqr = eq_before;
#pragma unroll
        for (int i = 0; i < 16; ++i) if (i < cnt) {
            bool sel = key[i] > prefix;
            if (key[i] == prefix) { sel = eqr < need; ++eqr; }
            const int row = rowbase + base + i;
            if (sel) { const int s = slotbase + (int)slot; ++slot; SEL[e * rpe + s] = row; GSEL[e * rpe + s] = __uint_as_float(key[i]); INV[(size_t)row * 16 + e] = (short)s; }
            else INV[(size_t)row * 16 + e] = (short)-1; }
        if (rpe == RPE0 && set == 4 && C.tid < RPE0 - (4 * CAPL + 4 * CAPC)) { const int s = 4 * CAPL + 4 * CAPC + C.tid; SEL[e * rpe + s] = 0; GSEL[e * rpe + s] = 0.f; }
        __syncthreads();
    }
}
__device__ __forceinline__ void gather_phase(const Ctx& C, int nrows, const int* SEL, const bf16* HB, bf16* XG) {
    for (int r = C.gw; r < nrows; r += C.NGW) { const int src = SEL[r];
        const v4u a = *(const v4u*)(HB + (size_t)src * 1024 + 8 * C.lane), b = *(const v4u*)(HB + (size_t)src * 1024 + 512 + 8 * C.lane);
        *(v4u*)(XG + (size_t)r * 1024 + 8 * C.lane) = a; *(v4u*)(XG + (size_t)r * 1024 + 512 + 8 * C.lane) = b; }
}

__device__ __forceinline__ f32x4 mfma16(bf16x8 a, bf16x8 b, f32x4 c) { return __builtin_amdgcn_mfma_f32_16x16x32_bf16(a, b, c, 0, 0, 0); }
#define PRJ_AT(qn, h_, row_) (PRJ + (((size_t)((qn) * NH + (h_)) * R + (size_t)(row_)) * HD))
#define DH_AT(buf, dir_, h_, row_) ((buf) + (((size_t)((dir_) * NH + (h_)) * NLAT + (size_t)(row_)) * HD))
constexpr int QROW = 272, TROW = 144;
constexpr int SC_QG = 0, SC_KT = 17408, SC_KGT = 34816  , SC_VT = 71680  , SC_SC = 108544, SC_SEG = 117760, SC_PCH = 121856  , SC_PG = 122880;
static_assert(SC_PG + 512 <= 131072, "scan LDS map");

__device__ __forceinline__ void scanA_phase(const Ctx& C, const bf16* PRJ, const float* LB, bf16* OLOC, bf16* QGG, float* SLOC, float* PTOT) {
    LAS unsigned char* L = C.lds;
    LAS float* SEG = (LAS float*)(L + SC_SEG); LAS float* PG = (LAS float*)(L + SC_PG);
    const int lane = C.lane, w = C.wave, g = lane >> 4, lr = lane & 15, k0 = 2 * lane, seg = w;
    for (int ui = C.vcu; ui < NSEQ * NGRP; ui += C.G) {
        int seq, grp; if (ui < NSEQ * 16) { seq = ui >> 4; grp = 1 + (ui & 15); } else { seq = ui - NSEQ * 16; grp = 0; }
        const int b = seq >> 4, h = (seq >> 1) & 7, dir = seq & 1, nch = grp ? 8 : 4, sgn = dir ? -1 : 1;
        const int hc = h * HD;
        f32x4 S[8];
#pragma unroll
        for (int i = 0; i < 8; ++i) S[i] = (f32x4){0.f, 0.f, 0.f, 0.f};
        if (C.tid < 128) PG[C.tid] = 1.0f;
        const int Pb = grp ? (grp - 1) * 512 : 0, rbase = grp ? b * T : NLAT + b * TCX, tlen = grp ? T : TCX;
#define ROWC(c) (rbase + (dir ? tlen - 1 - (Pb + 64 * (c)) : Pb + 64 * (c)))
        unsigned fq[8], qq[8]; v4u vv[2];
        float pl0[8], pl1[8], kk0[8], kk1[8], pg0 = 1.f, pg1 = 1.f, pt0 = 1.f, pt1 = 1.f;
#define SC_LOAD(c) do { const int rn_ = ROWC(c); \
            _Pragma("unroll") for (int i = 0; i < 8; ++i) { const int rw_ = rn_ + sgn * (8 * seg + i); fq[i] = __builtin_nontemporal_load((const unsigned*)(PRJ_AT(1 + dir, h, rw_) + k0)); qq[i] = *(const unsigned*)(PRJ_AT(0, h, rw_) + k0); } \
            _Pragma("unroll") for (int ii = 0; ii < 2; ++ii) { const int cq = C.tid + 512 * ii; vv[ii] = *(const v4u*)(PRJ_AT(3, h, rn_ + sgn * (cq & 63)) + (cq >> 6) * 8); } } while (0)
#define SC_PREP1(c) do { float run0 = 1.f, run1 = 1.f; \
            _Pragma("unroll") for (int i = 0; i < 8; ++i) { kk0[i] = bflo(fq[i]); kk1[i] = bfhi(fq[i]);          \
                run0 *= 1.f - kk0[i]; run1 *= 1.f - kk1[i]; pl0[i] = run0; pl1[i] = run1; } \
            *(LAS f32x2*)(SEG + seg * 128 + k0) = (f32x2){run0, run1}; \
            _Pragma("unroll") for (int ii = 0; ii < 2; ++ii) { const int cq = C.tid + 512 * ii, p_ = cq & 63, v0 = (cq >> 6) * 8; LAS bf16* vt = (LAS bf16*)(L + SC_VT + ((c) & 1) * 18432) + p_; \
                const unsigned wds[4] = {vv[ii].x, vv[ii].y, vv[ii].z, vv[ii].w}; \
                _Pragma("unroll") for (int j = 0; j < 4; ++j) { vt[(v0 + 2 * j) * (TROW / 2)] = (bf16)(wds[j] & 0xffffu); vt[(v0 + 2 * j + 1) * (TROW / 2)] = (bf16)(wds[j] >> 16); } } \
            pg0 = PG[k0]; pg1 = PG[k0 + 1]; } while (0)
#define SC_PREP2(c) do { const int rc_ = ROWC(c); float pb0 = 1.f, pb1 = 1.f; pt0 = 1.f; pt1 = 1.f; \
            _Pragma("unroll") for (int s = 0; s < 8; ++s) { const f32x2 t = *(const LAS f32x2*)(SEG + s * 128 + k0); if (s < seg) { pb0 *= t.x; pb1 *= t.y; } pt0 *= t.x; pt1 *= t.y; } \
            unsigned kg0[4], kg1[4]; float kprev0 = 0.f, kprev1 = 0.f; \
            _Pragma("unroll") for (int i = 0; i < 8; ++i) { const int p_ = 8 * seg + i; \
                const float P0 = pb0 * pl0[i], P1 = pb1 * pl1[i]; \
                const float qg0 = bflo(qq[i]) * P0, qg1 = bfhi(qq[i]) * P1; \
                const float kt0 = kk0[i] * __builtin_amdgcn_rcpf(fmaxf(P0, 1e-30f)), kt1 = kk1[i] * __builtin_amdgcn_rcpf(fmaxf(P1, 1e-30f)); \
                *(LAS unsigned*)(L + SC_QG + p_ * QROW + k0 * 2) = pk2(qg0, qg1); \
                *(LAS unsigned*)(L + SC_KT + p_ * QROW + k0 * 2) = pk2(kt0, kt1); \
                const float a0 = kt0 * pt0, a1 = kt1 * pt1; \
                if (i & 1) { kg0[i >> 1] = pk2(kprev0, a0); kg1[i >> 1] = pk2(kprev1, a1); } else { kprev0 = a0; kprev1 = a1; } \
                if (grp) *(unsigned*)(DH_AT(QGG, dir, h, rc_ + sgn * p_) + k0) = pk2(qg0 * pg0, qg1 * pg1); } \
            *(LAS v4u*)(L + SC_KGT + ((c) & 1) * 18432 + k0 * TROW + seg * 16) = (v4u){kg0[0], kg0[1], kg0[2], kg0[3]}; \
            *(LAS v4u*)(L + SC_KGT + ((c) & 1) * 18432 + (k0 + 1) * TROW + seg * 16) = (v4u){kg1[0], kg1[1], kg1[2], kg1[3]}; \
            if (seg == 0) *(LAS f32x2*)(L + SC_PCH + ((c) & 1) * 512 + k0 * 4) = (f32x2){pt0, pt1}; \
            if ((c) + 1 < nch) SC_LOAD((c) + 1); } while (0)
#define SC_SCORES() do { if (seg == 0) *(LAS f32x2*)(PG + k0) = (f32x2){pg0 * pt0, pg1 * pt1}; \
            const int pi = w >> 1; \
            _Pragma("unroll") for (int tt = 0; tt < 2; ++tt) { const int si = 2 * (w & 1) + tt; f32x4 acc = (f32x4){0.f, 0.f, 0.f, 0.f}; \
                _Pragma("unroll") for (int ks = 0; ks < 4; ++ks) { const bf16x8 a = *(const LAS bf16x8*)(L + SC_QG + (16 * pi + lr) * QROW + (32 * ks + 8 * g) * 2); \
                    const bf16x8 bb = *(const LAS bf16x8*)(L + SC_KT + (16 * si + lr) * QROW + (32 * ks + 8 * g) * 2); acc = mfma16(a, bb, acc); } \
                _Pragma("unroll") for (int r = 0; r < 4; ++r) { const int p_ = 16 * pi + 4 * g + r, s_ = 16 * si + lr; const float val = (s_ <= p_) ? acc[r] : 0.f; \
                    *(LAS bf16*)(L + SC_SC + p_ * TROW + s_ * 2) = (bf16)(pk2(val, 0.f) & 0xffffu); } } } while (0)
#define SC_OUTPUTS(c) do { const int rc_ = ROWC(c); const LAS unsigned char* VTc = L + SC_VT + ((c) & 1) * 18432; f32x4 O[4]; \
            _Pragma("unroll") for (int pt = 0; pt < 4; ++pt) O[pt] = (f32x4){0.f, 0.f, 0.f, 0.f}; \
            _Pragma("unroll") for (int ks = 0; ks < 4; ++ks) { \
                v4u sw; sw.x = pk2(S[2 * ks][0], S[2 * ks][1]); sw.y = pk2(S[2 * ks][2], S[2 * ks][3]); sw.z = pk2(S[2 * ks + 1][0], S[2 * ks + 1][1]); sw.w = pk2(S[2 * ks + 1][2], S[2 * ks + 1][3]); \
                const bf16x8 sb = __builtin_bit_cast(bf16x8, sw); \
                _Pragma("unroll") for (int pt = 0; pt < 4; ++pt) { const LAS unsigned char* qp = L + SC_QG + (16 * pt + lr) * QROW + (32 * ks + 4 * g) * 2; \
                    const v2u lo = *(const LAS v2u*)qp, hi = *(const LAS v2u*)(qp + 32); \
                    const bf16x8 a = __builtin_bit_cast(bf16x8, (v4u){lo.x, lo.y, hi.x, hi.y}); O[pt] = mfma16(sb, a, O[pt]); } } \
            _Pragma("unroll") for (int ks = 0; ks < 2; ++ks) { const bf16x8 bvk = *(const LAS bf16x8*)(VTc + (16 * w + lr) * TROW + (32 * ks + 8 * g) * 2); \
                _Pragma("unroll") for (int pt = 0; pt < 4; ++pt) { const bf16x8 a = *(const LAS bf16x8*)(L + SC_SC + (16 * pt + lr) * TROW + (32 * ks + 8 * g) * 2); O[pt] = mfma16(bvk, a, O[pt]); } } \
            if (grp) { _Pragma("unroll") for (int pt = 0; pt < 4; ++pt) { const int p_ = 16 * pt + lr; \
                *(v2u*)(DH_AT(OLOC, dir, h, rc_ + sgn * p_) + 16 * w + 4 * g) = (v2u){pk2(O[pt][0], O[pt][1]), pk2(O[pt][2], O[pt][3])}; } } } while (0)
#define SC_UPDATE(c) do { const LAS unsigned char* VTc = L + SC_VT + ((c) & 1) * 18432; const LAS unsigned char* KGc = L + SC_KGT + ((c) & 1) * 18432; const LAS float* PCc = (const LAS float*)(L + SC_PCH + ((c) & 1) * 512); \
            bf16x8 bv[2]; \
            _Pragma("unroll") for (int ks = 0; ks < 2; ++ks) bv[ks] = *(const LAS bf16x8*)(VTc + (16 * w + lr) * TROW + (32 * ks + 8 * g) * 2); \
            _Pragma("unroll") for (int kt = 0; kt < 8; ++kt) { const f32x4 pc = *(const LAS f32x4*)(PCc + 16 * kt + 4 * g); S[kt] = S[kt] * pc; \
                _Pragma("unroll") for (int ks = 0; ks < 2; ++ks) { const bf16x8 a = *(const LAS bf16x8*)(KGc + (16 * kt + lr) * TROW + (32 * ks + 8 * g) * 2); S[kt] = mfma16(a, bv[ks], S[kt]); } } } while (0)
        SC_LOAD(0);
        __syncthreads();
        SC_PREP1(0);
        __syncthreads();
        SC_PREP2(0);
        __syncthreads();
        SC_SCORES();
        __syncthreads();
#pragma unroll 1
        for (int c = 0; c < nch; ++c) {
            const bool more = c + 1 < nch;
            if (more) SC_PREP1(c + 1);
            SC_OUTPUTS(c);
            __syncthreads();
            if (more) SC_PREP2(c + 1);
            SC_UPDATE(c);
            __syncthreads();
            if (more) SC_SCORES();
            __syncthreads();
        }
        if (grp < 16) {
#pragma unroll
            for (int kt = 0; kt < 8; ++kt)
#pragma unroll
                for (int r = 0; r < 4; ++r) SLOC[(((size_t)seq * 16 + grp) * 128 + 16 * kt + 4 * g + r) * 128 + 16 * w + lr] = S[kt][r]; }
        if (C.tid < 128) PTOT[((size_t)seq * NGRP + grp) * 128 + C.tid] = PG[C.tid];
        __syncthreads();
#undef ROWC
#undef SC_LOAD
#undef SC_PREP1
#undef SC_PREP2
#undef SC_SCORES
#undef SC_OUTPUTS
#undef SC_UPDATE
    }
}
__device__ __forceinline__ void scanB_phase(const Ctx& C, const float* SLOC, const float* PTOT, bf16* SST) {
    for (int id = C.vcu * (NW * 64) + C.tid; id < NSEQ * 2048; id += C.G * NW * 64) {
        const int seq = id >> 11, k = ((id >> 7) & 15) * 8, v = id & 127;
        float s[8];
#pragma unroll
        for (int i = 0; i < 8; ++i) s[i] = 0.f;
#pragma unroll 4
        for (int gi = 0; gi < 16; ++gi) { const float* pt = PTOT + ((size_t)seq * NGRP + gi) * 128 + k; const float* sl = SLOC + (((size_t)seq * 16 + gi) * 128 + k) * 128 + v;
#pragma unroll
            for (int i = 0; i < 8; ++i) s[i] = pt[i] * s[i] + sl[(size_t)i * 128];
            v4u o; o.x = pk2(s[0], s[1]); o.y = pk2(s[2], s[3]); o.z = pk2(s[4], s[5]); o.w = pk2(s[6], s[7]);
            *(v4u*)(SST + (((size_t)seq * 16 + gi) * 128 + v) * 128 + k) = o; }
    }
}
__device__ __forceinline__ void readout_phase(const Ctx& C, const bf16* PRJ, const bf16* OLOC, const bf16* QGG, const bf16* SST, const float* norm_g, bf16* YH) {
    LAS unsigned char* L = C.lds;
    constexpr int ABUF = 64 * QROW;
    LAS float* OT = (LAS float*)(L + 4 * ABUF);
    const int lane = C.lane, w = C.wave, g = lane >> 4, lr = lane & 15;
    const int p = C.tid >> 3, sg = C.tid & 7;
    f32x4 ng[4];
#pragma unroll
    for (int i = 0; i < 4; ++i) ng[i] = *(const f32x4*)(norm_g + 16 * sg + 4 * i);
    for (int ui = C.vcu; ui < NB * NH * 16; ui += C.G) {
        const int j = ui & 15, h = (ui >> 4) & 7, b = ui >> 7, hc = h * HD, row00 = b * T + 512 * j;
        bf16x8 bfr[2][4];
#pragma unroll
        for (int dir = 0; dir < 2; ++dir) { const int seq = (b * 8 + h) * 2 + dir, gs = dir ? 15 - j : j;
            const bf16* Bb = SST + (((size_t)seq * 16 + gs) * 128 + 16 * w + lr) * 128;
#pragma unroll
            for (int ks = 0; ks < 4; ++ks) bfr[dir][ks] = *(const bf16x8*)(Bb + 32 * ks + 8 * g); }
        v4u ar[2][2];
#define RO_LOADA(tile) do { _Pragma("unroll") for (int dir = 0; dir < 2; ++dir) _Pragma("unroll") for (int ii = 0; ii < 2; ++ii) { const int cq = C.tid + 512 * ii; \
            ar[dir][ii] = __builtin_nontemporal_load((const v4u*)(DH_AT(QGG, dir, h, row00 + 64 * (tile) + (cq >> 4)) + (cq & 15) * 8)); } } while (0)
#define RO_WRITEA(buf) do { _Pragma("unroll") for (int dir = 0; dir < 2; ++dir) _Pragma("unroll") for (int ii = 0; ii < 2; ++ii) { const int cq = C.tid + 512 * ii; \
            *(LAS v4u*)(L + ((buf) * 2 + dir) * ABUF + (cq >> 4) * QROW + (cq & 15) * 16) = ar[dir][ii]; } } while (0)
        RO_LOADA(0); RO_WRITEA(0);
        __syncthreads();
#pragma unroll 1
        for (int t = 0; t < 8; ++t) {
            const int buf = t & 1; const size_t row = (size_t)row00 + 64 * t + p; const int c0 = hc + 16 * sg;
            if (t < 7) RO_LOADA(t + 1);
            v4u eo[2][2]; v4u eg[2];
#pragma unroll
            for (int dir = 0; dir < 2; ++dir) { const bf16* op = DH_AT(OLOC, dir, h, row) + 16 * sg; eo[dir][0] = __builtin_nontemporal_load((const v4u*)op); eo[dir][1] = __builtin_nontemporal_load((const v4u*)(op + 8)); }
            { const bf16* gp = PRJ_AT(4, h, row) + 16 * sg; eg[0] = __builtin_nontemporal_load((const v4u*)gp); eg[1] = __builtin_nontemporal_load((const v4u*)(gp + 8)); }
            f32x4 O[4];
#pragma unroll
            for (int pt = 0; pt < 4; ++pt) O[pt] = (f32x4){0.f, 0.f, 0.f, 0.f};
#pragma unroll
            for (int dir = 0; dir < 2; ++dir)
#pragma unroll
                for (int ks = 0; ks < 4; ++ks)
#pragma unroll
                    for (int pt = 0; pt < 4; ++pt) { const bf16x8 a = *(const LAS bf16x8*)(L + (buf * 2 + dir) * ABUF + (16 * pt + lr) * QROW + (32 * ks + 8 * g) * 2); O[pt] = mfma16(a, bfr[dir][ks], O[pt]); }
#pragma unroll
            for (int pt = 0; pt < 4; ++pt)
#pragma unroll
                for (int r = 0; r < 4; ++r) OT[(16 * pt + 4 * g + r) * 132 + 16 * w + lr] = O[pt][r];
            if (t < 7) RO_WRITEA(buf ^ 1);
            __syncthreads();
            f32x4 o[4];
#pragma unroll
            for (int i = 0; i < 4; ++i) o[i] = *(const LAS f32x4*)(OT + p * 132 + 16 * sg + 4 * i);
#pragma unroll
            for (int dir = 0; dir < 2; ++dir) { const v4u a = eo[dir][0], bq = eo[dir][1];
                o[0] += (f32x4){bflo(a.x), bfhi(a.x), bflo(a.y), bfhi(a.y)}; o[1] += (f32x4){bflo(a.z), bfhi(a.z), bflo(a.w), bfhi(a.w)};
                o[2] += (f32x4){bflo(bq.x), bfhi(bq.x), bflo(bq.y), bfhi(bq.y)}; o[3] += (f32x4){bflo(bq.z), bfhi(bq.z), bflo(bq.w), bfhi(bq.w)}; }
            float ss = 0.f;
#pragma unroll
            for (int i = 0; i < 4; ++i) ss += (o[i].x * o[i].x + o[i].y * o[i].y) + (o[i].z * o[i].z + o[i].w * o[i].w);
            ss += __shfl_xor(ss, 1); ss += __shfl_xor(ss, 2); ss += __shfl_xor(ss, 4);
            const float rstd = rsqrtf(ss * (1.0f / 128.0f) + EPS);
            const unsigned gw[8] = {eg[0].x, eg[0].y, eg[0].z, eg[0].w, eg[1].x, eg[1].y, eg[1].z, eg[1].w};
            unsigned ow[8];
#pragma unroll
            for (int i = 0; i < 8; ++i) { const float g0 = bflo(gw[i]), g1 = bfhi(gw[i]);
                const float y0 = o[i >> 1][(2 * i) & 3] * rstd * ng[i >> 1][(2 * i) & 3] * (g0 * fsig(g0));
                const float y1 = o[i >> 1][(2 * i + 1) & 3] * rstd * ng[i >> 1][(2 * i + 1) & 3] * (g1 * fsig(g1));
                ow[i] = pk2(y0, y1); }
            bf16* yp = YH + row * 1024 + c0;
            *(v4u*)yp = (v4u){ow[0], ow[1], ow[2], ow[3]}; *(v4u*)(yp + 8) = (v4u){ow[4], ow[5], ow[6], ow[7]};
            __syncthreads();
        }
#undef RO_LOADA
#undef RO_WRITEA
    }
}

constexpr int NPHASE = 22;
struct Args { const float* in[25]; float* out; unsigned char* ws; int ph_lo, ph_hi; };
constexpr int GRID_C = 256;
constexpr int TAILQ_P2 = 5, TAILQ_P4 = 9, TAILQ_P9 = 6, TAILQ_P11 = 5, TAILQ_P6 = 4, TAILQ_P17 = 3, TAILQ_P3 = 4, TAILQ_P12 = 5;
__device__ __forceinline__ int tail_waves(int nwg, int G) { const int extra = nwg % G; return extra ? (G - extra) * NW : 0; }
#define IDLE_CONVERT(first_, layer_, lo_, q_) do { const int G_ = GRID_C; if ((first_) < G_ && (int)blockIdx.x >= (first_)) { const Ctx Ct = make_ctx(lds_raw, g_wave); CArgs& pt = *opaque_args(); const int nw_ = (G_ - (first_)) * NW; \
        convert_moe(Ct, pt.in[21], pt.in[22], pt.in[23], (layer_), pt.ws, (lo_), min(MOE_ITEMS, (lo_) + (q_) * nw_), ((int)blockIdx.x - (first_)) * NW + Ct.wave, nw_); } } while (0)
__device__ __forceinline__ int idle_waves(int first, int G) { return first < G ? (G - first) * NW : 0; }
#define RANK_CONVERT(rank_, first_, layer_, lo_, q_) do { const int G_ = GRID_C; if ((first_) < G_ && (rank_) >= (first_)) { const Ctx Ct = make_ctx(lds_raw, g_wave); CArgs& pt = *opaque_args(); const int nw_ = (G_ - (first_)) * NW; \
        convert_moe(Ct, pt.in[21], pt.in[22], pt.in[23], (layer_), pt.ws, (lo_), min(MOE_ITEMS, (lo_) + (q_) * nw_), ((rank_) - (first_)) * NW + Ct.wave, nw_); } } while (0)
#define L0_R2 (TAILQ_P2 * tail_waves(NWG_P2, GRID_C))
#define L0_R4 (TAILQ_P4 * tail_waves(NWG_P4, GRID_C))
#define L0_R3 (TAILQ_P3 * tail_waves(1056, GRID_C))
#define L0_A (max(0, MOE_ITEMS - L0_R2 - L0_R3 - L0_R4))
#define L1_R6 (TAILQ_P6 * idle_waves(128, GRID_C))
#define L1_R9 (TAILQ_P9 * tail_waves(NWG_P9, GRID_C))
#define L1_R11 (TAILQ_P11 * tail_waves(NWG_P11, GRID_C))
#define L1_R12 (TAILQ_P12 * tail_waves(NSEQ * NGRP, GRID_C))
#define L1_R17 (TAILQ_P17 * idle_waves(64, GRID_C))
#define L1_B (min(MOE_ITEMS, L1_R6 + L1_R9 + L1_R11 + L1_R12))
#define NWG_P2 ((R / 256) * 8)
#define NWG_P4 ((R / 256) * 4)
#define NWG_P9 ((NE * RPE0 / 256) * 4)
#define NWG_P11 ((R / 256) * 20)
#define TAIL_CONVERT(nwg_, layer_, lo_, q_) do { const int G_ = GRID_C, extra_ = (nwg_) % G_; if (extra_ && (int)blockIdx.x >= extra_) { const Ctx Ct = make_ctx(lds_raw, g_wave); CArgs& pt = *opaque_args(); const int nw_ = (G_ - extra_) * NW; \
        convert_moe(Ct, pt.in[21], pt.in[22], pt.in[23], (layer_), pt.ws, (lo_), min(MOE_ITEMS, (lo_) + (q_) * nw_), ((int)blockIdx.x - extra_) * NW + Ct.wave, nw_); } } while (0)
typedef const __attribute__((address_space(4))) Args CArgs;
__device__ __forceinline__ CArgs* opaque_args() { unsigned long long p = (unsigned long long)__builtin_amdgcn_kernarg_segment_ptr(); asm volatile("" : "+s"(p)); return (CArgs*)p; }
__global__ void __launch_bounds__(NW * 64, 2) mk_fwd(Args args) {
    extern __shared__ __attribute__((aligned(16))) unsigned char lds_raw[];
    const int g_wave = __builtin_amdgcn_readfirstlane((int)threadIdx.x >> 6);
    const Ctx C0 = make_ctx(lds_raw, g_wave);
    unsigned char* const ws = opaque_args()->ws;
#if MK_SPLIT
    const int lo = args.ph_lo, hi = args.ph_hi;
#else
    constexpr int lo = 0, hi = NPHASE;
#endif
    volatile LAS unsigned* MISC = (volatile LAS unsigned*)(C0.lds + MISC_OFF);
    for (int u = C0.tid; u < 128; u += NW * 64) ((LAS unsigned*)(C0.lds + MISC_OFF - 320))[u] = 0u;
    __syncthreads();
    if (hi - lo > 1) (void)xcd_barrier_post((unsigned*)(ws + WS_CTL) + CW_BAR, MISC + 8, g_wave);
#ifndef MK_PHMASK
#define MK_PHMASK 0x3fffff
#endif
#define INR(k) (lo <= (k) && (k) < hi)
#define IN(k) ((((MK_PHMASK) >> (k)) & 1) && INR(k))
#ifndef MK_TIME_A
#define MK_TIME_A -2
#define MK_TIME_B -2
#endif
#define MK_TIME_PHASE (MK_TIME_A > -2 ? 1 : -1)
#define SEAM(k) do { if (INR(k) && INR((k) + 1)) { XcdBarrier b_; b_.bar = (unsigned*)(opaque_args()->ws + WS_CTL) + CW_BAR; b_.x = xb_xcc_id(); b_.st = (volatile LAS unsigned*)((LAS unsigned char*)lds_raw + MISC_OFF) + 8; xcd_barrier(b_, g_wave); } \
    if (MK_TIME_A > -2 && blockIdx.x == 0 && TID_OF(g_wave) == 0) { const unsigned long long t_ = __builtin_amdgcn_s_memrealtime(); \
        if ((k) == MK_TIME_A) ((unsigned long long*)(ws + WS_CTL))[1024] = t_; \
        if ((k) == MK_TIME_B) { const unsigned long long t0_ = ((unsigned long long*)(ws + WS_CTL))[1024]; ((float*)(ws + WS_CTL))[2050] = (float)(t_ - t0_) * 0.00125f; } } } while (0)
#ifndef MK_REP_PHASE
#define MK_REP_PHASE -1
#endif
#define REP(k) for (int _rep = 0; _rep < ((k) == MK_REP_PHASE ? 3 : 1); ++_rep, __syncthreads())

#define P_x ((const float*)pa.in[0])
#define P_ctx_in ((const float*)pa.in[2])
#define P_MV ((float*)(ws + WS_MV))
#define P_LBT ((float*)(ws + WS_LB))
#define P_AFF ((float*)(ws + WS_AFF))
#define P_INV ((short*)(ws + WS_INV))
#define P_SEL ((int*)(ws + WS_SEL))
#define P_GSEL ((float*)(ws + WS_GSEL))
#define P_CTXS ((float*)(ws + WS_CTXS))
#define P_HB ((bf16*)(ws + WS_HB))
#define P_UB ((bf16*)(ws + WS_UB))
#define P_HB8 (ws + WS_UB)
#define P_HBUF8 (ws + WS_HBUF)
#define P_XG ((bf16*)(ws + WS_XG))
#define P_PRJ ((bf16*)(ws + WS_PRJ))
#define P_OLOC ((bf16*)(ws + WS_OLOC))
#define P_QGG ((bf16*)(ws + WS_QGG))
#define P_SLOC ((float*)(ws + WS_UB))
#define P_PTOT ((float*)(ws + WS_PTOT))
#define P_SST ((bf16*)(ws + WS_SST))
#define P_YH ((bf16*)(ws + WS_UB))
#define P_out (pa.out)

    if (MK_TIME_A == -1 && blockIdx.x == 0 && TID_OF(g_wave) == 0) ((unsigned long long*)(ws + WS_CTL))[1024] = __builtin_amdgcn_s_memrealtime();
    if (IN(0)) REP(0) { const Ctx C = make_ctx(lds_raw, g_wave); CArgs& pa = *opaque_args(); unsigned char* const ws = pa.ws;
        mod_gemv(C, pa.in[1], pa.in[3], pa.in[4], pa.in[5], P_MV);
        for (int i = C.vcu * NW * 64 + C.tid; i < 2048; i += C.G * NW * 64) { const float* lg = pa.in[17]; P_LBT[i] = fsig(lg[2048 + i] - lg[i]); }
        __syncthreads();
        convert_small(C, pa.in[8], pa.in[14], pa.in[16], pa.in[19], ws);
        convert_moe(C, pa.in[21], pa.in[22], pa.in[23], 0, ws, 0, L0_A, C.gw, C.NGW);
    }
    SEAM(0);
    if (IN(1)) REP(1) { const Ctx C = make_ctx(lds_raw, g_wave); CArgs& pa = *opaque_args(); unsigned char* const ws = pa.ws; RowArgs A{}; A.src_lat = P_x; A.src_ctx = P_ctx_in; A.gamma = pa.in[6]; A.mv = P_MV; A.i_shift = 0; A.i_scale = 1; A.i_gate = 2; A.HB = P_HB; A.nrows = R;
        row_phase<false, false, false>(C, A); }
    SEAM(1);
    if (IN(2)) REP(2) { const Ctx C = make_ctx(lds_raw, g_wave); CArgs& pa = *opaque_args(); unsigned char* const ws = pa.ws; pg8::Gemm g{P_HB, (const bf16*)(ws + WS_W1T), R, 2048, 1024}; pg8::StaticOrder S; S.init(R, 2048, C.G, (int)blockIdx.x);
        pg8::EpiGated<0> E{P_UB, 1024, pa.in[9], 1024};
        pg8::gemm_phase<pg8::EpiGated<0>, pg8::StaticOrder, true, true>(C.lds, g, S, E, C.wave);
        TAIL_CONVERT(NWG_P2, 0, min(MOE_ITEMS, L0_A + L0_R3), TAILQ_P2); }
    SEAM(2);
    if (IN(3)) REP(3) { const Ctx C = make_ctx(lds_raw, g_wave); CArgs& pa = *opaque_args(); unsigned char* const ws = pa.ws; conv_phase(C, P_UB, P_HB, pa.in[10], pa.in[11], pa.in[12], pa.in[13]); RANK_CONVERT(C.vcu, 1056 % GRID_C, 0, L0_A, TAILQ_P3); }
    SEAM(3);
    if (IN(4)) REP(4) { const Ctx C = make_ctx(lds_raw, g_wave); CArgs& pa = *opaque_args(); unsigned char* const ws = pa.ws; pg8::Gemm g{P_HB, (const bf16*)(ws + WS_W2T), R, 1024, 1024}; pg8::StaticOrder S; S.init(R, 1024, C.G, (int)blockIdx.x);
        pg8::EpiDelta E{(bf16*)(ws + WS_OLOC), 1024, pa.in[15], P_MV + 2 * 1024, 6144};
        pg8::gemm_phase<pg8::EpiDelta, pg8::StaticOrder, true, true>(C.lds, g, S, E, C.wave);
        TAIL_CONVERT(NWG_P4, 0, min(MOE_ITEMS, L0_A + L0_R3 + L0_R2), TAILQ_P4); }
    SEAM(4);
    if (IN(5)) REP(5) { const Ctx C = make_ctx(lds_raw, g_wave); CArgs& pa = *opaque_args(); unsigned char* const ws = pa.ws; RowArgs A{}; A.src_lat = P_x; A.src_ctx = P_ctx_in; A.delta = (const bf16*)(ws + WS_OLOC); A.gamma = pa.in[7]; A.mv = P_MV; A.i_shift = 3; A.i_scale = 4; A.i_gate = 5; A.HB = P_HB; A.HB8 = P_HB8; A.AFF = P_AFF; A.router_w = pa.in[20]; A.nrows = R;
        row_phase<false, true, false>(C, A); }
    SEAM(5);
    if (IN(6)) REP(6) { const Ctx C = make_ctx(lds_raw, g_wave); CArgs& pa = *opaque_args(); unsigned char* const ws = pa.ws; topk_phase(C, 128, RPE0, P_AFF, P_SEL, P_GSEL, P_INV); IDLE_CONVERT(128, 1, 0, TAILQ_P6); }
    SEAM(6);
    if (IN(8)) REP(8) { const Ctx C = make_ctx(lds_raw, g_wave); CArgs& pa = *opaque_args(); unsigned char* const ws = pa.ws; pg8::Gemm g{(const bf16*)P_HB8, (const bf16*)(ws + WS_W13T), NE * RPE0, 4096, 1024}; pg8::StaticOrder S; S.init(NE * RPE0, 4096, C.G, (int)blockIdx.x, RPE0 / 256);
        pg8::EpiSwiGLU8 E{P_HBUF8, 2048, 1.0f / 32.0f};
        pg8::gemm_phase_f8<pg8::EpiSwiGLU8, pg8::StaticOrder, true, true, true, 1024>(C.lds, g, S, E, C.wave, P_SEL, (LAS unsigned*)(C.lds + GTAB_OFF)); }
    SEAM(8);
    if (IN(9)) REP(9) { const Ctx C = make_ctx(lds_raw, g_wave); CArgs& pa = *opaque_args(); unsigned char* const ws = pa.ws; pg8::Gemm g{(const bf16*)P_HBUF8, (const bf16*)(ws + WS_WDT), NE * RPE0, 1024, 2048}; pg8::StaticOrder S; S.init(NE * RPE0, 1024, C.G, (int)blockIdx.x, RPE0 / 256);
        pg8::EpiScaleRow E{P_XG, 1024, P_GSEL, 1.0f / 32.0f};
        pg8::gemm_phase_f8<pg8::EpiScaleRow, pg8::StaticOrder, true, true, true, 2048>(C.lds, g, S, E, C.wave, nullptr, (LAS unsigned*)(C.lds + GTAB_OFF));
        TAIL_CONVERT(NWG_P9, 1, L1_R6, TAILQ_P9); }
    SEAM(9);
    if (IN(10)) REP(10) { const Ctx C = make_ctx(lds_raw, g_wave); CArgs& pa = *opaque_args(); unsigned char* const ws = pa.ws; RowArgs A{}; A.src_lat = P_x; A.src_ctx = P_ctx_in; A.delta = (const bf16*)(ws + WS_OLOC); A.dst_lat = P_out; A.dst_ctx = P_CTXS; A.gamma = pa.in[6] + 1024; A.mv = P_MV; A.i_shift = 0; A.i_scale = 1; A.i_gate = 5; A.HB = P_HB;
        A.Y = P_XG; A.INV = P_INV; A.rpe = RPE0; A.nrows = R;
        A.mv = P_MV + 5 * 6144; A.mvg = P_MV; row_phase<true, false, false>(C, A); }
    SEAM(10);
    if (IN(11)) REP(11) { const Ctx C = make_ctx(lds_raw, g_wave); CArgs& pa = *opaque_args(); unsigned char* const ws = pa.ws; pg8::Gemm g{P_HB, (const bf16*)(ws + WS_WINT), R, 5120, 1024}; pg8::StaticOrder S; S.init(R, 5120, C.G, (int)blockIdx.x);
        pg8::EpiBf16 E{P_PRJ, 5120, P_LBT, R};
        pg8::gemm_phase<pg8::EpiBf16, pg8::StaticOrder, true, true>(C.lds, g, S, E, C.wave);
        TAIL_CONVERT(NWG_P11, 1, L1_R6 + L1_R9, TAILQ_P11); }
    SEAM(11);
    if (IN(12)) REP(12) { const Ctx C = make_ctx(lds_raw, g_wave); CArgs& pa = *opaque_args(); unsigned char* const ws = pa.ws; scanA_phase(C, P_PRJ, P_LBT, P_OLOC, P_QGG, P_SLOC, P_PTOT); RANK_CONVERT(C.vcu, (NSEQ * NGRP) % GRID_C, 1, L1_R6 + L1_R9 + L1_R11, TAILQ_P12); }
    SEAM(12);
    if (IN(13)) REP(13) { const Ctx C = make_ctx(lds_raw, g_wave); CArgs& pa = *opaque_args(); unsigned char* const ws = pa.ws; scanB_phase(C, P_SLOC, P_PTOT, P_SST); }
    SEAM(13);
    if (IN(14)) REP(14) { const Ctx C = make_ctx(lds_raw, g_wave); CArgs& pa = *opaque_args(); unsigned char* const ws = pa.ws; readout_phase(C, P_PRJ, P_OLOC, P_QGG, P_SST, pa.in[18], P_YH); }
    SEAM(14);
    if (IN(15)) REP(15) { const Ctx C = make_ctx(lds_raw, g_wave); CArgs& pa = *opaque_args(); unsigned char* const ws = pa.ws; pg8::Gemm g{P_YH, (const bf16*)(ws + WS_WOUTT), NLAT, 1024, 1024}; pg8::StaticOrder S; S.init(NLAT, 1024, C.G, (int)blockIdx.x);
        pg8::EpiDelta E{(bf16*)(ws + WS_OLOC), 1024, nullptr, P_MV + 5 * 6144 + 2 * 1024, 6144};
        pg8::gemm_phase<pg8::EpiDelta, pg8::StaticOrder, true, true>(C.lds, g, S, E, C.wave); }
    SEAM(15);
    if (IN(16)) REP(16) { const Ctx C = make_ctx(lds_raw, g_wave); CArgs& pa = *opaque_args(); unsigned char* const ws = pa.ws; RowArgs A{}; A.src_lat = P_out; A.delta = (const bf16*)(ws + WS_OLOC); A.gamma = pa.in[7] + 1024; A.mv = P_MV + 5 * 6144; A.i_shift = 3; A.i_scale = 4; A.i_gate = 5; A.HB = P_HB; A.HB8 = P_HB8; A.AFF = P_AFF; A.router_w = pa.in[20] + 16384; A.nrows = NLAT;
        row_phase<false, true, false>(C, A);
        convert_moe(C, pa.in[21], pa.in[22], pa.in[23], 1, ws, L1_B, max(L1_B, MOE_ITEMS - L1_R17), C.gw, C.NGW); }
    SEAM(16);
    if (IN(17)) REP(17) { const Ctx C = make_ctx(lds_raw, g_wave); CArgs& pa = *opaque_args(); unsigned char* const ws = pa.ws; topk_phase(C, 64, RPE1, P_AFF, P_SEL, P_GSEL, P_INV);
        IDLE_CONVERT(64, 1, max(L1_B, MOE_ITEMS - L1_R17), TAILQ_P17); }
    SEAM(17);
    if (IN(19)) REP(19) { const Ctx C = make_ctx(lds_raw, g_wave); CArgs& pa = *opaque_args(); unsigned char* const ws = pa.ws; pg8::Gemm g{(const bf16*)P_HB8, (const bf16*)(ws + WS_W13T_L1), NE * RPE1, 4096, 1024}; pg8::StaticOrder S; S.init(NE * RPE1, 4096, C.G, (int)blockIdx.x, RPE1 / 256);
        pg8::EpiSwiGLU8 E{P_HBUF8, 2048, 1.0f / 32.0f};
        pg8::gemm_phase_f8<pg8::EpiSwiGLU8, pg8::StaticOrder, true, true, true, 1024>(C.lds, g, S, E, C.wave, P_SEL, (LAS unsigned*)(C.lds + GTAB_OFF)); }
    SEAM(19);
    if (IN(20)) REP(20) { const Ctx C = make_ctx(lds_raw, g_wave); CArgs& pa = *opaque_args(); unsigned char* const ws = pa.ws; pg8::Gemm g{(const bf16*)P_HBUF8, (const bf16*)(ws + WS_WDT_L1), NE * RPE1, 1024, 2048}; pg8::StaticOrder S; S.init(NE * RPE1, 1024, C.G, (int)blockIdx.x, RPE1 / 256);
        pg8::EpiScaleRow E{P_XG, 1024, P_GSEL, 1.0f / 32.0f};
        pg8::gemm_phase_f8<pg8::EpiScaleRow, pg8::StaticOrder, true, true, true, 2048>(C.lds, g, S, E, C.wave, nullptr, (LAS unsigned*)(C.lds + GTAB_OFF)); }
    SEAM(20);
    if (IN(21)) REP(21) { const Ctx C = make_ctx(lds_raw, g_wave); CArgs& pa = *opaque_args(); unsigned char* const ws = pa.ws; RowArgs A{}; A.src_lat = P_out; A.delta = (const bf16*)(ws + WS_OLOC); A.dst_lat = P_out; A.gamma = pa.in[24]; A.mv = P_MV + 5 * 6144; A.mvg = P_MV + 5 * 6144; A.i_gate = 5; A.Y = P_XG; A.INV = P_INV; A.rpe = RPE1; A.nrows = NLAT;
        row_phase<true, false, true>(C, A);
        }
    if (MK_TIME_A > -2) { const Ctx C = make_ctx(lds_raw, g_wave); CArgs& pa = *opaque_args(); { XcdBarrier b_; b_.bar = (unsigned*)(pa.ws + WS_CTL) + CW_BAR; b_.x = xb_xcc_id(); b_.st = (volatile LAS unsigned*)((LAS unsigned char*)lds_raw + MISC_OFF) + 8; xcd_barrier(b_, g_wave); }
        if (blockIdx.x == 0 && C.tid == 0) { float add = ((const float*)(ws + WS_CTL))[2050]; if (MK_TIME_B == 21) { const unsigned long long t0_ = ((unsigned long long*)(ws + WS_CTL))[1024]; add = (float)(__builtin_amdgcn_s_memrealtime() - t0_) * (MK_TIME_A == -1 ? 0.0001f : 0.00125f); } pa.out[0] += add; } }
#undef IN
#undef P_x
#undef P_ctx_in
#undef P_MV
#undef P_LBT
#undef P_AFF
#undef P_INV
#undef P_SEL
#undef P_GSEL
#undef P_CTXS
#undef P_HB
#undef P_UB
#undef P_HB8
#undef P_HBUF8
#undef P_XG
#undef P_PRJ
#undef P_OLOC
#undef P_QGG
#undef P_SLOC
#undef P_PTOT
#undef P_SST
#undef P_YH
#undef P_out
#undef REP
#undef INR
#undef SEAM
}

extern "C" void kernel_launch(void* const* d_in, const int* in_sizes, int n_in, void* d_out, int out_size, void* d_ws, size_t ws_size, hipStream_t stream) {
    static int grid = 0;
    if (grid == 0) {
        if (n_in != 25 || in_sizes[0] != NLAT * D || out_size != NLAT * D || ws_size < WS_END) { fprintf(stderr, "kernel_launch: unexpected shapes (n_in %d, in0 %d, out %d, ws %zu)\n", n_in, n_in > 0 ? in_sizes[0] : -1, out_size, ws_size); grid = -1; return; }
        int dev = 0, cus = 0, per_cu = 0;
        if (hipGetDevice(&dev) != hipSuccess || hipDeviceGetAttribute(&cus, hipDeviceAttributeMultiprocessorCount, dev) != hipSuccess) { grid = -1; return; }
        if (hipFuncSetAttribute((const void*)mk_fwd, hipFuncAttributeMaxDynamicSharedMemorySize, LDS_BYTES) != hipSuccess) { fprintf(stderr, "kernel_launch: hipFuncSetAttribute failed\n"); grid = -1; return; }
        if (hipOccupancyMaxActiveBlocksPerMultiprocessor(&per_cu, (const void*)mk_fwd, NW * 64, LDS_BYTES) != hipSuccess || per_cu < 1) { fprintf(stderr, "kernel_launch: occupancy query reports %d blocks per CU\n", per_cu); (void)hipGetLastError(); grid = -1; return; }
        if (cus != GRID_C) { fprintf(stderr, "kernel_launch: built for a %d-CU device, found %d CUs\n", GRID_C, cus); grid = -1; return; }
        grid = cus;
    }
    if (grid < 0) return;
    if (hipMemsetAsync((char*)d_ws + WS_CTL, 0, CTL_ZERO_BYTES, stream) != hipSuccess) { fprintf(stderr, "kernel_launch: memset failed\n"); return; }
    Args a{};
    for (int i = 0; i < 25; ++i) a.in[i] = (const float*)d_in[i];
    a.out = (float*)d_out; a.ws = (unsigned char*)d_ws;
#if MK_SPLIT
    for (int p = 0; p < NPHASE; ++p) { a.ph_lo = p; a.ph_hi = p + 1; hipLaunchKernelGGL(mk_fwd, dim3(grid), dim3(NW * 64), LDS_BYTES, stream, a); }
#else
    a.ph_lo = 0; a.ph_hi = NPHASE;
#ifndef MK_COOP
#define MK_COOP 1
#endif
#if MK_COOP
    void* kargs[] = {&a};
    hipError_t e = hipLaunchCooperativeKernel((const void*)mk_fwd, dim3(grid), dim3(NW * 64), kargs, LDS_BYTES, stream);
    if (e != hipSuccess) fprintf(stderr, "kernel_launch: cooperative launch failed: %s (grid %d)\n", hipGetErrorString(e), grid);
#else
    hipLaunchKernelGGL(mk_fwd, dim3(grid), dim3(NW * 64), LDS_BYTES, stream, a);
#endif
#endif
}
```

```cpp
#include <hip/hip_runtime.h>
#include <hip/hip_cooperative_groups.h>
#include <cstdio>
#include <cstdint>
namespace cg = cooperative_groups;

#ifndef MK_SPLIT
#define MK_SPLIT 0
#endif

__device__ __forceinline__ int lane_id() { int l; asm volatile("v_mbcnt_lo_u32_b32 %0, -1, 0\n\tv_mbcnt_hi_u32_b32 %0, -1, %0" : "=v"(l)); return l; }
#define TID_OF(wv) ((wv) * 64 + lane_id())
namespace pg8 {
#define PG8_LAS __attribute__((address_space(3)))
typedef unsigned short bf16_t;
typedef short bf16x8 __attribute__((ext_vector_type(8)));
typedef float f32x4 __attribute__((ext_vector_type(4)));
typedef unsigned u32x4 __attribute__((ext_vector_type(4)));
constexpr int BM = 256, BK = 64, HALF = 128, HTB = HALF * BK * 2  , STAGE_BYTES = 8 * HTB, NXCD = 8, WGM = 8;

__host__ __device__ __forceinline__ int lds_byte(int r, int c) { const int st = (r >> 4) * 2 + (c >> 5), rr = r & 15, cc = c & 31, ob = rr * 64 + cc * 2; return st * 1024 + (ob ^ (((ob >> 9) & 1) << 5)); }
__host__ __device__ __forceinline__ void stage_rc(int b, int& R, int& C) { const int st = b / 1024, sb = b % 1024, swz = sb ^ (((sb >> 9) & 1) << 5); R = (st >> 1) * 16 + swz / 64; C = (st & 1) * 32 + (swz % 64) / 2; }
__host__ __device__ __forceinline__ int perm32(int rho) { const int n = rho >> 4, i = rho & 15; return 8 * (i >> 2) + 4 * n + (i & 3); }

struct Unit { int pm, pn, pb; };
struct Gemm { const bf16_t* A; const bf16_t* Bt; int M, N, K; };

struct StaticOrder {
    int nM, nN, nwg, G, c, tpe;
    __host__ __device__ void init(int M, int N, int G_, int c_, int tpe_ = 0) { nM = M / BM; nN = N / BM; nwg = nM * nN; G = G_; c = c_; tpe = tpe_; }
    __host__ __device__ bool next(int i, Unit& u) const {
        const long L = (long)i * G + c; if (L >= nwg) return false;
        int wgid = (int)L; { const int q = nwg / NXCD, r = nwg % NXCD, xcd = wgid % NXCD, off = wgid / NXCD; wgid = (xcd < r ? xcd * (q + 1) : r * (q + 1) + (xcd - r) * q) + off; }
        const int nig = WGM * nN, gid = wgid / nig, fm = gid * WGM, gsz = (nM - fm) < WGM ? (nM - fm) : WGM;
        u.pm = fm + ((wgid % nig) % gsz); u.pn = (wgid % nig) / gsz; u.pb = tpe ? (u.pm / tpe) * nN + u.pn : u.pn; return true;
    }
    __device__ __forceinline__ void a_ready(const Unit&) const {}
    __device__ __forceinline__ void done(const Unit&) const {}
};

typedef float f32x32 __attribute__((ext_vector_type(32)));
struct AccQ { f32x32 q[2][2];
    __device__ __forceinline__ f32x4 get(int ai, int bj, int m, int n) const { const int i = (m * 2 + n) * 4; const f32x32& v = q[ai][bj]; return (f32x4){v[i], v[i + 1], v[i + 2], v[i + 3]}; }
    __device__ __forceinline__ void set(int ai, int bj, int m, int n, f32x4 c) { const int i = (m * 2 + n) * 4; f32x32& v = q[ai][bj]; v[i] = c[0]; v[i + 1] = c[1]; v[i + 2] = c[2]; v[i + 3] = c[3]; }
};
__device__ __forceinline__ unsigned cvt_pk_bf16(float lo, float hi) { unsigned r; asm("v_cvt_pk_bf16_f32 %0, %1, %2" : "=v"(r) : "v"(lo), "v"(hi)); return r; }
__device__ __forceinline__ float fsigmoid(float x) { return __builtin_amdgcn_rcpf(1.0f + __expf(-x)); }

struct EpiBf16 {
    static constexpr bool PERM = true, AFTER_DRAIN = false;
    bf16_t* O; int ldc; const float* lb; int hm_rows;
    __device__ __forceinline__ void operator()(const f32x4 (&acc)[2][2][4][2], const Unit& u, int wr, int wc, int fr, int fq) const {
        const int row0 = u.pm * BM + wr * 64 + fr, col0 = u.pn * BM + wc * 32 + 8 * fq;
        const bool gate = lb != nullptr && u.pn >= 4 && u.pn < 12;
        f32x4 om[2][2];
#pragma unroll
        for (int bj = 0; bj < 2; ++bj)
#pragma unroll
            for (int n = 0; n < 2; ++n) om[bj][n] = gate ? (f32x4){1.f, 1.f, 1.f, 1.f} - *(const f32x4*)(lb + (col0 - 1024) + bj * HALF + 4 * n) : (f32x4){0.f, 0.f, 0.f, 0.f};
#pragma unroll
        for (int ai = 0; ai < 2; ++ai)
#pragma unroll
            for (int m = 0; m < 4; ++m) { const int row = row0 + ai * HALF + m * 16;
                bf16_t* rowp = hm_rows ? O + ((size_t)(2 * u.pn) * hm_rows + row) * HALF + wc * 32 + 8 * fq - 0 : O + (size_t)row * ldc + col0;
                const size_t bjstep = hm_rows ? (size_t)hm_rows * HALF : (size_t)HALF;
#pragma unroll
                for (int bj = 0; bj < 2; ++bj) { f32x4 v0 = acc[ai][bj][m][0], v1 = acc[ai][bj][m][1];
                    if (gate) {
#pragma unroll
                        for (int j = 0; j < 4; ++j) { v0[j] = om[bj][0][j] * fsigmoid(-v0[j]); v1[j] = om[bj][1][j] * fsigmoid(-v1[j]); } }
                    u32x4 w; w.x = cvt_pk_bf16(v0[0], v0[1]); w.y = cvt_pk_bf16(v0[2], v0[3]); w.z = cvt_pk_bf16(v1[0], v1[1]); w.w = cvt_pk_bf16(v1[2], v1[3]);
                    *(u32x4*)(rowp + bj * bjstep) = w; } }
    }
};
struct EpiBf16Q {
    static constexpr bool PERM = true, AFTER_DRAIN = false;
    bf16_t* O; int ldc; const float* lb; int hm_rows; float s;
    __device__ __forceinline__ void operator()(const AccQ& acc, const Unit& u, int wr, int wc, int fr, int fq) const {
        const int row0 = u.pm * BM + wr * 64 + fr, col0 = u.pn * BM + wc * 32 + 8 * fq;
        const bool gate = lb != nullptr && u.pn >= 4 && u.pn < 12;
        f32x4 om[2][2];
#pragma unroll
        for (int bj = 0; bj < 2; ++bj)
#pragma unroll
            for (int n = 0; n < 2; ++n) om[bj][n] = gate ? (f32x4){1.f, 1.f, 1.f, 1.f} - *(const f32x4*)(lb + (col0 - 1024) + bj * HALF + 4 * n) : (f32x4){0.f, 0.f, 0.f, 0.f};
#pragma unroll
        for (int ai = 0; ai < 2; ++ai)
#pragma unroll
            for (int m = 0; m < 4; ++m) { const int row = row0 + ai * HALF + m * 16;
                bf16_t* rowp = O + ((size_t)(2 * u.pn) * hm_rows + row) * HALF + wc * 32 + 8 * fq;
                const size_t bjstep = (size_t)hm_rows * HALF;
#pragma unroll
                for (int bj = 0; bj < 2; ++bj) { f32x4 v0 = acc.get(ai, bj, m, 0) * s, v1 = acc.get(ai, bj, m, 1) * s;
                    if (gate) {
#pragma unroll
                        for (int j = 0; j < 4; ++j) { v0[j] = om[bj][0][j] * fsigmoid(-v0[j]); v1[j] = om[bj][1][j] * fsigmoid(-v1[j]); } }
                    u32x4 w; w.x = cvt_pk_bf16(v0[0], v0[1]); w.y = cvt_pk_bf16(v0[2], v0[3]); w.z = cvt_pk_bf16(v1[0], v1[1]); w.w = cvt_pk_bf16(v1[2], v1[3]);
                    *(u32x4*)(rowp + bj * bjstep) = w; }
                asm volatile("" ::: "memory"); }
    }
};
template <int MODE> struct EpiGated {
    static constexpr bool PERM = true, AFTER_DRAIN = false;
    bf16_t* O; int ldc; const float* bias; int ystride;
    __device__ __forceinline__ void operator()(const f32x4 (&acc)[2][2][4][2], const Unit& u, int wr, int wc, int fr, int fq) const {
        const int row0 = u.pm * BM + wr * 64 + fr, ch0 = u.pn * HALF + wc * 32 + 8 * fq;
        f32x4 bx[2], by[2];
#pragma unroll
        for (int n = 0; n < 2; ++n) { if (MODE == 0) { bx[n] = *(const f32x4*)(bias + ch0 + 4 * n); by[n] = *(const f32x4*)(bias + ystride + ch0 + 4 * n); } else { bx[n] = (f32x4){0.f, 0.f, 0.f, 0.f}; by[n] = bx[n]; } }
#pragma unroll
        for (int ai = 0; ai < 2; ++ai)
#pragma unroll
            for (int m = 0; m < 4; ++m) { bf16_t* rowp = O + (size_t)(row0 + ai * HALF + m * 16) * ldc + ch0;
                float r[8];
#pragma unroll
                for (int n = 0; n < 2; ++n) { const f32x4 x = acc[ai][0][m][n] + bx[n], y = acc[ai][1][m][n] + by[n];
#pragma unroll
                    for (int j = 0; j < 4; ++j) r[4 * n + j] = (MODE == 0) ? x[j] * fsigmoid(y[j]) : x[j] * fsigmoid(x[j]) * y[j]; }
                u32x4 w; w.x = cvt_pk_bf16(r[0], r[1]); w.y = cvt_pk_bf16(r[2], r[3]); w.z = cvt_pk_bf16(r[4], r[5]); w.w = cvt_pk_bf16(r[6], r[7]);
                *(u32x4*)rowp = w; }
    }
};
struct EpiDelta {
    static constexpr bool PERM = true, AFTER_DRAIN = false;
    bf16_t* O; int ldc; const float* bias; const float* gate; int gstride;
    __device__ __forceinline__ void operator()(const f32x4 (&acc)[2][2][4][2], const Unit& u, int wr, int wc, int fr, int fq) const {
        const int grp = u.pm >= 128 ? 4 : (u.pm >> 5);
        const int row0 = u.pm * BM + wr * 64 + fr, col0 = u.pn * BM + wc * 32 + 8 * fq;
        const float* gp = gate + (size_t)grp * gstride + col0;
        f32x4 gv[2][2], bv[2][2];
#pragma unroll
        for (int bj = 0; bj < 2; ++bj)
#pragma unroll
            for (int n = 0; n < 2; ++n) { gv[bj][n] = *(const f32x4*)(gp + bj * HALF + 4 * n); bv[bj][n] = bias ? *(const f32x4*)(bias + col0 + bj * HALF + 4 * n) : (f32x4){0.f, 0.f, 0.f, 0.f}; }
#pragma unroll
        for (int ai = 0; ai < 2; ++ai)
#pragma unroll
            for (int m = 0; m < 4; ++m) { bf16_t* rowp = O + (size_t)(row0 + ai * HALF + m * 16) * ldc + col0;
#pragma unroll
                for (int bj = 0; bj < 2; ++bj) { const f32x4 v0 = gv[bj][0] * (acc[ai][bj][m][0] + bv[bj][0]), v1 = gv[bj][1] * (acc[ai][bj][m][1] + bv[bj][1]);
                    u32x4 w; w.x = cvt_pk_bf16(v0[0], v0[1]); w.y = cvt_pk_bf16(v0[2], v0[3]); w.z = cvt_pk_bf16(v1[0], v1[1]); w.w = cvt_pk_bf16(v1[2], v1[3]);
                    *(u32x4*)(rowp + bj * HALF) = w; } }
    }
};
struct EpiRes {
    static constexpr bool PERM = false, AFTER_DRAIN = false;
    const float* res0; float* out0; const float* res1; float* out1; const float* bias; const float* gate; int gstride;
    __device__ __forceinline__ void operator()(const f32x4 (&acc)[2][2][4][2], const Unit& u, int wr, int wc, int fr, int fq) const {
        const bool second = u.pm >= 128; const int grp = second ? 4 : (u.pm >> 5);
        const float* res = second ? res1 : res0; float* out = second ? out1 : out0;
        const int row0 = (second ? u.pm - 128 : u.pm) * BM + wr * 64 + fr, col0 = u.pn * BM + wc * 32 + 4 * fq;
        const float* gp = gate + (size_t)grp * gstride + col0;
        const unsigned off0 = ((unsigned)row0 * 1024u + (unsigned)col0) * 4u;
#pragma unroll
        for (int bj = 0; bj < 2; ++bj) {
            f32x4 gv[2], bv[2], rv[2][2][4];
#pragma unroll
            for (int n = 0; n < 2; ++n) { gv[n] = *(const f32x4*)(gp + bj * HALF + n * 16); bv[n] = bias ? *(const f32x4*)(bias + col0 + bj * HALF + n * 16) : (f32x4){0.f, 0.f, 0.f, 0.f}; }
#pragma unroll
            for (int n = 0; n < 2; ++n)
#pragma unroll
                for (int ai = 0; ai < 2; ++ai)
#pragma unroll
                    for (int m = 0; m < 4; ++m) rv[n][ai][m] = *(const f32x4*)((const char*)res + (off0 + (unsigned)(((ai * HALF + m * 16) * 1024 + bj * HALF + n * 16) * 4)));
#pragma unroll
            for (int n = 0; n < 2; ++n)
#pragma unroll
                for (int ai = 0; ai < 2; ++ai)
#pragma unroll
                    for (int m = 0; m < 4; ++m) *(f32x4*)((char*)out + (off0 + (unsigned)(((ai * HALF + m * 16) * 1024 + bj * HALF + n * 16) * 4))) = rv[n][ai][m] + gv[n] * (acc[ai][bj][m][n] + bv[n]);
            asm volatile("" ::: "memory"); }
    }
};
typedef unsigned u32x2 __attribute__((ext_vector_type(2)));
__device__ __forceinline__ unsigned pk4_fp8(float a, float b, float c, float d) { unsigned lo, hi; asm("v_cvt_pk_fp8_f32 %0, %1, %2" : "=v"(lo) : "v"(a), "v"(b)); asm("v_cvt_pk_fp8_f32 %0, %1, %2" : "=v"(hi) : "v"(c), "v"(d)); return (lo & 0xffffu) | (hi << 16); }
struct EpiScaleRow {
    static constexpr bool PERM = true, AFTER_DRAIN = false;
    unsigned char* O; int ldc; const float* rs; float mul;
    __device__ __forceinline__ void operator()(const AccQ& acc, const Unit& u, int wr, int wc, int fr, int fq) const {
        const int row0 = u.pm * BM + wr * 64 + fr, col0 = u.pn * BM + wc * 32 + 8 * fq;
        float sv[2][4];
#pragma unroll
        for (int ai = 0; ai < 2; ++ai)
#pragma unroll
            for (int m = 0; m < 4; ++m) sv[ai][m] = rs[row0 + ai * HALF + m * 16] * mul;
#pragma unroll
        for (int ai = 0; ai < 2; ++ai)
#pragma unroll
            for (int m = 0; m < 4; ++m) { const int row = row0 + ai * HALF + m * 16; const float s = sv[ai][m]; unsigned char* rowp = O + (size_t)row * ldc + col0;
#pragma unroll
                for (int bj = 0; bj < 2; ++bj) { const f32x4 v0 = acc.get(ai, bj, m, 0) * s, v1 = acc.get(ai, bj, m, 1) * s;
                    u32x2 w; w.x = pk4_fp8(v0[0], v0[1], v0[2], v0[3]); w.y = pk4_fp8(v1[0], v1[1], v1[2], v1[3]);
                    *(u32x2*)(rowp + bj * HALF) = w; }
                asm volatile("" ::: "memory"); }
    }
};

struct EpiSwiGLU8 {
    static constexpr bool PERM = true, AFTER_DRAIN = false;
    unsigned char* O; int ldc; float s;
    __device__ __forceinline__ void operator()(const AccQ& acc, const Unit& u, int wr, int wc, int fr, int fq) const {
        const int row0 = u.pm * BM + wr * 64 + fr, ch0 = u.pn * HALF + wc * 32 + 8 * fq;
#pragma unroll
        for (int ai = 0; ai < 2; ++ai)
#pragma unroll
            for (int m = 0; m < 4; ++m) { unsigned char* rowp = O + (size_t)(row0 + ai * HALF + m * 16) * ldc + ch0;
                float r[8];
#pragma unroll
                for (int n = 0; n < 2; ++n) { const f32x4 x = acc.get(ai, 0, m, n) * s, y = acc.get(ai, 1, m, n) * s;
#pragma unroll
                    for (int j = 0; j < 4; ++j) r[4 * n + j] = x[j] * fsigmoid(x[j]) * y[j]; }
                u32x2 w; w.x = pk4_fp8(r[0], r[1], r[2], r[3]); w.y = pk4_fp8(r[4], r[5], r[6], r[7]);
                *(u32x2*)rowp = w; }
    }
};


__device__ float g_probe_val;
template <class Epi, class Sched, bool ALIGN_EPI = false, bool SP2 = false, bool GATHER = false, int PRB = 0>
__device__ __forceinline__ void gemm_phase(PG8_LAS unsigned char* lds, const Gemm g, const Sched& S, const Epi& E, const int wv, const int* gsel = nullptr, PG8_LAS unsigned* gtab = nullptr) {
    const int tid = TID_OF(wv), wid = wv, lane = tid & 63, wr = wid >> 2, wc = wid & 3, fr = lane & 15, fq = lane >> 4;
    const int K = g.K, nt = K / BK;
    unsigned voffA[2], voffB[2]; int gR[2]; unsigned gC2[2];
#pragma unroll
    for (int i = 0; i < 2; ++i) { int R, C; stage_rc(tid * 16 + i * 8192, R, C); const int Rb = Epi::PERM ? ((R & ~31) + perm32(R & 31)) : R;
        voffA[i] = (unsigned)(R * K + C) * 2u; voffB[i] = (unsigned)(Rb * K + C) * 2u; gR[i] = R; gC2[i] = (unsigned)C * 2u; }
    unsigned cur0[2] = {0u, 0u}, cur1[2] = {0u, 0u}, nx0[2] = {0u, 0u}, nx1[2] = {0u, 0u};
    if constexpr (GATHER) { Unit uu; for (int i = 0; S.next(i, uu); ++i) if (tid < 256) gtab[i * 256 + tid] = (unsigned)gsel[uu.pm * 256 + tid] * (unsigned)(K * 2);
        __syncthreads(); }
#define PG8_GOFFS(ui_, o0, o1) do { _Pragma("unroll") for (int i = 0; i < 2; ++i) { o0[i] = gtab[(ui_) * 256 + gR[i]] + gC2[i]; o1[i] = gtab[(ui_) * 256 + 128 + gR[i]] + gC2[i]; } } while (0)
#define PG8_STAGE_A(bufoff, ptr_plain, ptr_gather, goffs) do { if constexpr (GATHER) { PG8_STAGE(bufoff, ptr_gather, goffs); } else { PG8_STAGE(bufoff, ptr_plain, voffA); } } while (0)
    const size_t kstep = (size_t)(BK * 2);
    const size_t hstep = (size_t)HALF * K * 2;
    const size_t tstep = 2 * hstep;
    const unsigned ldsw = (unsigned)wid * 1024u;
    const int aoff = lds_byte(wr * 64 + fr, fq * 8), boff = lds_byte(wc * 32 + fr, fq * 8);
#define PG8_SA(b, h) (((b) * 2 + (h)) * HTB)
#define PG8_SB(b, h) ((4 + (b) * 2 + (h)) * HTB)
#define PG8_STAGE(bufoff, gbase, voff) do { _Pragma("unroll") for (int _i = 0; _i < 2; ++_i) \
        __builtin_amdgcn_global_load_lds((const unsigned*)((const char*)(gbase) + (voff)[_i]), (PG8_LAS unsigned*)(lds + (bufoff) + ldsw + _i * 8192), 16, 0, 0); } while (0)
#define PG8_LDA(dst, b, h) do { _Pragma("unroll") for (int m = 0; m < 4; ++m) _Pragma("unroll") for (int k = 0; k < 2; ++k) dst[m][k] = *(const PG8_LAS bf16x8*)(lds + PG8_SA(b, h) + aoff + m * 2048 + k * 1024); } while (0)
#define PG8_LDB(dst, b, h) do { _Pragma("unroll") for (int n = 0; n < 2; ++n) _Pragma("unroll") for (int k = 0; k < 2; ++k) dst[n][k] = *(const PG8_LAS bf16x8*)(lds + PG8_SB(b, h) + boff + n * 2048 + k * 1024); } while (0)
#define PG8_MMA(ai, bj, At, Bt) do { __builtin_amdgcn_s_setprio(1); _Pragma("unroll") for (int m = 0; m < 4; ++m) _Pragma("unroll") for (int n = 0; n < 2; ++n) _Pragma("unroll") for (int k = 0; k < 2; ++k) \
        acc[ai][bj][m][n] = __builtin_amdgcn_mfma_f32_16x16x32_bf16(Bt[n][k], At[m][k], acc[ai][bj][m][n], 0, 0, 0); __builtin_amdgcn_s_setprio(0); } while (0)
#define PG8_WAIT_V(n) asm volatile("s_waitcnt vmcnt(" #n ")" ::: "memory")
#define PG8_WAIT_L(n) asm volatile("s_waitcnt lgkmcnt(" #n ")" ::: "memory")
#define PG8_BAR __builtin_amdgcn_s_barrier()
#define PG8_SCHED __builtin_amdgcn_sched_barrier(0)
    Unit cur, nxt; int ui = 0;
    if (!S.next(0, cur)) return;
    f32x4 acc[2][2][4][2];
#pragma unroll
    for (int a = 0; a < 2; ++a)
#pragma unroll
        for (int b = 0; b < 2; ++b)
#pragma unroll
            for (int m = 0; m < 4; ++m)
#pragma unroll
                for (int n = 0; n < 2; ++n) acc[a][b][m][n] = (f32x4){0.f, 0.f, 0.f, 0.f};
    bf16x8 At[4][2], B0[2][2], B1[2][2];
    const char* cA = (const char*)g.A + (size_t)cur.pm * tstep; const char* cB = (const char*)g.Bt + (size_t)cur.pb * tstep;
    const char* const gA = (const char*)g.A;
    if constexpr (GATHER) PG8_GOFFS(0, cur0, cur1);
    S.a_ready(cur);
    if constexpr (SP2) {
        PG8_STAGE(PG8_SB(0, 0), cB, voffB); PG8_STAGE(PG8_SB(0, 1), cB + hstep, voffB); PG8_STAGE_A(PG8_SA(0, 0), cA, gA, cur0); PG8_STAGE_A(PG8_SA(0, 1), cA + hstep, gA, cur1);
        if (wr == 1) PG8_BAR;
        PG8_WAIT_V(2); PG8_BAR;
        PG8_STAGE(PG8_SB(1, 0), cB + kstep, voffB); PG8_STAGE_A(PG8_SA(1, 0), cA + kstep, gA + kstep, cur0); PG8_STAGE(PG8_SB(1, 1), cB + hstep + kstep, voffB);
        PG8_WAIT_V(6); PG8_BAR;
    } else {
        PG8_STAGE(PG8_SB(0, 0), cB, voffB); PG8_STAGE_A(PG8_SA(0, 0), cA, gA, cur0); PG8_STAGE(PG8_SB(0, 1), cB + hstep, voffB); PG8_STAGE_A(PG8_SA(0, 1), cA + hstep, gA, cur1);
        if (wr == 1) PG8_BAR;
        PG8_WAIT_V(4); PG8_BAR;
        PG8_STAGE(PG8_SB(1, 0), cB + kstep, voffB); PG8_STAGE_A(PG8_SA(1, 0), cA + kstep, gA + kstep, cur0); PG8_STAGE(PG8_SB(1, 1), cB + hstep + kstep, voffB);
        PG8_WAIT_V(6); PG8_BAR;
    }
    for (;;) {
        const bool has_next = S.next(ui + 1, nxt);
        if constexpr (GATHER) { if (has_next) PG8_GOFFS(ui + 1, nx0, nx1); else { _Pragma("unroll") for (int i = 0; i < 2; ++i) { nx0[i] = cur0[i]; nx1[i] = cur1[i]; } } }
        const char* nA = has_next ? (const char*)g.A + (size_t)nxt.pm * tstep : cA; const char* nB = has_next ? (const char*)g.Bt + (size_t)nxt.pb * tstep : cB;
        unsigned long long pr_a = 0, pr_b = 0;
        if constexpr (PRB != 0) { if (ui == 1) pr_a = __builtin_amdgcn_s_memtime(); }
#pragma unroll 1
        for (int t = 0; t < nt; t += 2) {
            const bool last = (t == nt - 2);
            const char* a1 = cA + (size_t)(t + 1) * kstep;
            const char* a2 = last ? nA : cA + (size_t)(t + 2) * kstep; const char* b2 = last ? nB : cB + (size_t)(t + 2) * kstep;
            const char* a3 = a2 + kstep; const char* b3 = b2 + kstep;
            const char* ga1 = gA + (size_t)(t + 1) * kstep; const char* ga2 = last ? gA : gA + (size_t)(t + 2) * kstep; const char* ga3 = ga2 + kstep;
            unsigned o2h0[2], o2h1[2];
#pragma unroll
            for (int i = 0; i < 2; ++i) { o2h0[i] = last ? nx0[i] : cur0[i]; o2h1[i] = last ? nx1[i] : cur1[i]; }
            if (last && has_next) S.a_ready(nxt);
            if constexpr (SP2) {
            PG8_LDB(B0, 0, 0); PG8_LDB(B1, 0, 1); PG8_SCHED; PG8_LDA(At, 0, 0); PG8_STAGE_A(PG8_SA(1, 1), a1 + hstep, ga1, cur1);
            PG8_WAIT_V(8); PG8_WAIT_L(0); PG8_BAR; PG8_MMA(0, 0, At, B0); PG8_MMA(0, 1, At, B1); PG8_BAR; PG8_SCHED;
            PG8_LDA(At, 0, 1); PG8_STAGE(PG8_SB(0, 0), b2, voffB); PG8_STAGE(PG8_SB(0, 1), b2 + hstep, voffB); PG8_STAGE_A(PG8_SA(0, 0), a2, ga2, o2h0);
            PG8_WAIT_V(8); PG8_WAIT_L(0); PG8_BAR; PG8_MMA(1, 0, At, B0); PG8_MMA(1, 1, At, B1); PG8_BAR; PG8_SCHED;
            PG8_LDB(B0, 1, 0); PG8_LDB(B1, 1, 1); PG8_SCHED; PG8_LDA(At, 1, 0); PG8_STAGE_A(PG8_SA(0, 1), a2 + hstep, ga2, o2h1);
            PG8_WAIT_V(8); PG8_WAIT_L(0); PG8_BAR; PG8_MMA(0, 0, At, B0); PG8_MMA(0, 1, At, B1); PG8_BAR; PG8_SCHED;
            PG8_LDA(At, 1, 1); PG8_STAGE(PG8_SB(1, 0), b3, voffB); PG8_STAGE(PG8_SB(1, 1), b3 + hstep, voffB); PG8_STAGE_A(PG8_SA(1, 0), a3, ga3, o2h0);
            PG8_WAIT_V(8); PG8_WAIT_L(0); PG8_BAR; PG8_MMA(1, 0, At, B0); PG8_MMA(1, 1, At, B1); PG8_BAR; PG8_SCHED;
            } else {
            PG8_LDB(B0, 0, 0); PG8_SCHED; PG8_LDA(At, 0, 0); PG8_STAGE_A(PG8_SA(1, 1), a1 + hstep, ga1, cur1);
            PG8_WAIT_L(8); PG8_BAR; PG8_WAIT_L(0); PG8_MMA(0, 0, At, B0); PG8_BAR; PG8_SCHED;
            PG8_LDB(B1, 0, 1); PG8_STAGE(PG8_SB(0, 0), b2, voffB);
            PG8_BAR; PG8_WAIT_L(0); PG8_MMA(0, 1, At, B1); PG8_BAR;
            PG8_LDA(At, 0, 1); PG8_STAGE_A(PG8_SA(0, 0), a2, ga2, o2h0);
            PG8_BAR; PG8_WAIT_L(0); PG8_MMA(1, 0, At, B0); PG8_BAR; PG8_SCHED;
            PG8_STAGE(PG8_SB(0, 1), b2 + hstep, voffB);
            PG8_WAIT_V(6); PG8_BAR; PG8_MMA(1, 1, At, B1); PG8_BAR;
            PG8_LDB(B0, 1, 0); PG8_SCHED; PG8_LDA(At, 1, 0); PG8_STAGE_A(PG8_SA(0, 1), a2 + hstep, ga2, o2h1);
            PG8_WAIT_L(8); PG8_BAR; PG8_WAIT_L(0); PG8_MMA(0, 0, At, B0); PG8_BAR; PG8_SCHED;
            PG8_LDB(B1, 1, 1); PG8_STAGE(PG8_SB(1, 0), b3, voffB);
            PG8_BAR; PG8_WAIT_L(0); PG8_MMA(0, 1, At, B1); PG8_BAR;
            PG8_LDA(At, 1, 1); PG8_STAGE_A(PG8_SA(1, 0), a3, ga3, o2h0);
            PG8_BAR; PG8_WAIT_L(0); PG8_MMA(1, 0, At, B0); PG8_BAR; PG8_SCHED;
            PG8_STAGE(PG8_SB(1, 1), b3 + hstep, voffB);
            PG8_WAIT_V(6); PG8_BAR; PG8_MMA(1, 1, At, B1); PG8_BAR;
            }
        }
        if constexpr (PRB != 0) { if (ui == 1) pr_b = __builtin_amdgcn_s_memtime(); }
        if constexpr (ALIGN_EPI) { if (wr == 0) PG8_BAR; }
        if constexpr (!Epi::AFTER_DRAIN) { int tq = tid; asm volatile("" : "+v"(tq)); const int lq = tq & 63; E(acc, cur, wr, wc, lq & 15, lq >> 4); S.done(cur); }
        if constexpr (PRB != 0) { if (ui == 1 && blockIdx.x == 0 && tid == 0) { asm volatile("s_waitcnt vmcnt(0)" ::: "memory"); const unsigned long long pr_c = __builtin_amdgcn_s_memtime(); g_probe_val = PRB == 1 ? (float)(pr_b - pr_a) * (1.0f / (float)nt) * 0.001f : (float)(pr_c - pr_b) * 0.001f; } }
        if (!has_next) break;
#pragma unroll
        for (int a = 0; a < 2; ++a)
#pragma unroll
            for (int b = 0; b < 2; ++b)
#pragma unroll
                for (int m = 0; m < 4; ++m)
#pragma unroll
                    for (int n = 0; n < 2; ++n) acc[a][b][m][n] = (f32x4){0.f, 0.f, 0.f, 0.f};
        cur = nxt; cA = nA; cB = nB; ++ui;
#pragma unroll
        for (int i = 0; i < 2; ++i) { cur0[i] = nx0[i]; cur1[i] = nx1[i]; }
        if constexpr (ALIGN_EPI) { if (wr == 1) PG8_BAR; }
    }
    PG8_WAIT_V(0);
    if constexpr (!ALIGN_EPI) { if (wr == 0) PG8_BAR; }
    PG8_BAR;
    if constexpr (Epi::AFTER_DRAIN) { E.fused(acc, cur, wr, wc, fr, fq, lds, wid, lane); S.done(cur); }
#undef PG8_SA
#undef PG8_SB
#undef PG8_STAGE
#undef PG8_STAGE_A
#undef PG8_GOFFS
#undef PG8_LDA
#undef PG8_LDB
#undef PG8_MMA
#undef PG8_WAIT_V
#undef PG8_WAIT_L
#undef PG8_BAR
#undef PG8_SCHED
}
typedef int v4i_t __attribute__((ext_vector_type(4)));
typedef int v8i_t __attribute__((ext_vector_type(8)));
typedef short s16x16_ld __attribute__((ext_vector_type(16), aligned(16)));
typedef v8i_t v8i_ld __attribute__((aligned(16)));
template <class Epi, class Sched, bool ALIGN_EPI = false, bool SP2 = false, bool GATHER = false, int KC = 0, int PRB = 0>
__device__ __forceinline__ void gemm_phase_f8(PG8_LAS unsigned char* lds, const Gemm g, const Sched& S, const Epi& E, const int wv, const int* gsel = nullptr, PG8_LAS unsigned* gtab = nullptr) {
    const int tid = TID_OF(wv), wid = wv, lane = tid & 63, wr = wid >> 2, wc = wid & 3, fr = lane & 15, fq = lane >> 4;
    const int K = KC ? KC : g.K, nt = K / 128;
    unsigned voffA[2], voffB[2]; int gR[2]; unsigned gC2[2];
#pragma unroll
    for (int i = 0; i < 2; ++i) { int R, C; stage_rc(tid * 16 + i * 8192, R, C); const int Rb = Epi::PERM ? ((R & ~31) + perm32(R & 31)) : R;
        voffA[i] = (unsigned)(R * K) + (unsigned)C * 2u; voffB[i] = (unsigned)(Rb * K) + (unsigned)C * 2u; gR[i] = R; gC2[i] = (unsigned)C * 2u; }
    unsigned cur0[2] = {0u, 0u}, cur1[2] = {0u, 0u}, nx0[2] = {0u, 0u}, nx1[2] = {0u, 0u};
    if constexpr (GATHER) { Unit uu; for (int i = 0; S.next(i, uu); ++i) if (tid < 256) ((PG8_LAS float*)gtab)[i * 256 + tid] = __uint_as_float((unsigned)(gsel ? gsel[uu.pm * 256 + tid] : uu.pm * 256 + tid) * (unsigned)K);
        __syncthreads(); }
#define PG8_GOFFS(ui_, o0, o1) do { _Pragma("unroll") for (int i = 0; i < 2; ++i) { o0[i] = __float_as_uint(((const PG8_LAS float*)gtab)[(ui_) * 256 + gR[i]]) + gC2[i]; o1[i] = __float_as_uint(((const PG8_LAS float*)gtab)[(ui_) * 256 + 128 + gR[i]]) + gC2[i]; } } while (0)
#define PG8_STAGE_A(bufoff, ptr_plain, ptr_gather, goffs) do { if constexpr (GATHER) { PG8_STAGE(bufoff, ptr_gather, goffs); } else { PG8_STAGE(bufoff, ptr_plain, voffA); } } while (0)
#define PG8_STAGE_AG(bufoff, ptr_plain, ptr_gather, u_, h_) do { if constexpr (GATHER) { unsigned go_[2]; _Pragma("unroll") for (int i = 0; i < 2; ++i) go_[i] = __float_as_uint(((const PG8_LAS float*)gtab)[(u_) * 256 + (h_) * 128 + lR[i]]) + lC2[i]; PG8_STAGE(bufoff, ptr_gather, go_); } else { PG8_STAGE(bufoff, ptr_plain, lvA); } } while (0)
    const unsigned gtab_b = GATHER ? (unsigned)(size_t)gtab : 0u;
#define PG8_GO(go_, u_, h_) unsigned go_[2] = {0u, 0u}; do { if constexpr (GATHER) { const unsigned a0_ = gtab_b + (unsigned)(((u_) * 256 + (h_) * 128 + lR[0]) * 4), a1_ = gtab_b + (unsigned)(((u_) * 256 + (h_) * 128 + lR[1]) * 4); \
        asm volatile("ds_read_b32 %0, %2\n\tds_read_b32 %1, %3" : "=&v"(go_[0]), "=&v"(go_[1]) : "v"(a0_), "v"(a1_) : "memory"); } } while (0)
#define PG8_GO_WAIT(go_, n) do { if constexpr (GATHER) asm volatile("s_waitcnt lgkmcnt(" #n ")" : "+v"(go_[0]), "+v"(go_[1]) :: "memory"); } while (0)
#define PG8_STAGE_G(bufoff, ptr_plain, ptr_gather, go_) do { if constexpr (GATHER) { unsigned g2_[2]; _Pragma("unroll") for (int i = 0; i < 2; ++i) g2_[i] = go_[i] + lC2[i]; PG8_STAGE(bufoff, ptr_gather, g2_); } else { PG8_STAGE(bufoff, ptr_plain, lvA); } } while (0)
    const size_t kstep = (size_t)(BK * 2);
    const size_t hstep = (size_t)HALF * K;
    const size_t tstep = 2 * hstep;
    const unsigned ldsw = (unsigned)wid * 1024u;
    const int aoff = lds_byte(wr * 64 + fr, fq * 8), boff = lds_byte(wc * 32 + fr, fq * 8);
#define PG8_SA(b, h) (((b) * 2 + (h)) * HTB)
#define PG8_SB(b, h) ((4 + (b) * 2 + (h)) * HTB)
#define PG8_STAGE(bufoff, gbase, voff) do { _Pragma("unroll") for (int _i = 0; _i < 2; ++_i) \
        __builtin_amdgcn_global_load_lds((const unsigned*)((const char*)(gbase) + (voff)[_i]), (PG8_LAS unsigned*)(lds + (bufoff) + ldsw + _i * 8192), 16, 0, 0); } while (0)
#define PG8_LDA(dst, b, h) do { _Pragma("unroll") for (int m = 0; m < 4; ++m) { const bf16x8 lo_ = *(const PG8_LAS bf16x8*)(lds + PG8_SA(b, h) + aoffv + m * 2048), hi_ = *(const PG8_LAS bf16x8*)(lds + PG8_SA(b, h) + aoffv + m * 2048 + 1024); dst[m] = __builtin_bit_cast(v8i_t, __builtin_shufflevector(lo_, hi_, 0, 1, 2, 3, 4, 5, 6, 7, 8, 9, 10, 11, 12, 13, 14, 15)); } } while (0)
#define PG8_LDB(dst, b, h) do { _Pragma("unroll") for (int n = 0; n < 2; ++n) { const bf16x8 lo_ = *(const PG8_LAS bf16x8*)(lds + PG8_SB(b, h) + boffv + n * 2048), hi_ = *(const PG8_LAS bf16x8*)(lds + PG8_SB(b, h) + boffv + n * 2048 + 1024); dst[n] = __builtin_bit_cast(v8i_t, __builtin_shufflevector(lo_, hi_, 0, 1, 2, 3, 4, 5, 6, 7, 8, 9, 10, 11, 12, 13, 14, 15)); } } while (0)
#define aoffv laoff
#define boffv lboff
#define PG8_MMA(ai, bj, At, Bt) do { __builtin_amdgcn_s_setprio(1); _Pragma("unroll") for (int m = 0; m < 4; ++m) _Pragma("unroll") for (int n = 0; n < 2; ++n) \
        acc.set(ai, bj, m, n, __builtin_amdgcn_mfma_scale_f32_16x16x128_f8f6f4(Bt[n], At[m], acc.get(ai, bj, m, n), 0, 0, 0, 0, 0, 0)); __builtin_amdgcn_s_setprio(0); } while (0)
#define PG8_WAIT_V(n) asm volatile("s_waitcnt vmcnt(" #n ")" ::: "memory")
#define PG8_WAIT_L(n) asm volatile("s_waitcnt lgkmcnt(" #n ")" ::: "memory")
#define PG8_BAR __builtin_amdgcn_s_barrier()
#define PG8_SCHED __builtin_amdgcn_sched_barrier(0)
    Unit cur, nxt; int ui = 0;
    if (!S.next(0, cur)) return;
    AccQ acc;
#pragma unroll
    for (int a = 0; a < 2; ++a)
#pragma unroll
        for (int b = 0; b < 2; ++b)
#pragma unroll
            for (int e = 0; e < 32; ++e) acc.q[a][b][e] = 0.f;
    v8i_t At[4], B0[2], B1[2];
    const char* cA = (const char*)g.A + (size_t)cur.pm * tstep; const char* cB = (const char*)g.Bt + (size_t)cur.pb * tstep;
    const char* const gA = (const char*)g.A;
    if constexpr (GATHER) PG8_GOFFS(0, cur0, cur1);
    S.a_ready(cur);
    if constexpr (SP2) {
        PG8_STAGE(PG8_SB(0, 0), cB, voffB); PG8_STAGE(PG8_SB(0, 1), cB + hstep, voffB); PG8_STAGE_A(PG8_SA(0, 0), cA, gA, cur0); PG8_STAGE_A(PG8_SA(0, 1), cA + hstep, gA, cur1);
        if (wr == 1) PG8_BAR;
        PG8_WAIT_V(2); PG8_BAR;
        PG8_STAGE(PG8_SB(1, 0), cB + kstep, voffB); PG8_STAGE_A(PG8_SA(1, 0), cA + kstep, gA + kstep, cur0); PG8_STAGE(PG8_SB(1, 1), cB + hstep + kstep, voffB);
        PG8_WAIT_V(6); PG8_BAR;
    } else {
        PG8_STAGE(PG8_SB(0, 0), cB, voffB); PG8_STAGE_A(PG8_SA(0, 0), cA, gA, cur0); PG8_STAGE(PG8_SB(0, 1), cB + hstep, voffB); PG8_STAGE_A(PG8_SA(0, 1), cA + hstep, gA, cur1);
        if (wr == 1) PG8_BAR;
        PG8_WAIT_V(4); PG8_BAR;
        PG8_STAGE(PG8_SB(1, 0), cB + kstep, voffB); PG8_STAGE_A(PG8_SA(1, 0), cA + kstep, gA + kstep, cur0); PG8_STAGE(PG8_SB(1, 1), cB + hstep + kstep, voffB);
        PG8_WAIT_V(6); PG8_BAR;
    }
    for (;;) {
        const bool has_next = S.next(ui + 1, nxt);
        const char* nA = has_next ? (const char*)g.A + (size_t)nxt.pm * tstep : cA; const char* nB = has_next ? (const char*)g.Bt + (size_t)nxt.pb * tstep : cB;
        unsigned lvA[2], lvB[2], lC2[2]; int lR[2];
        { int tq = tid; asm volatile("" : "+v"(tq));
#pragma unroll
          for (int i = 0; i < 2; ++i) { int R, C; stage_rc(tq * 16 + i * 8192, R, C); const int Rb = Epi::PERM ? ((R & ~31) + perm32(R & 31)) : R;
              lvA[i] = (unsigned)(R * K) + (unsigned)C * 2u; lvB[i] = (unsigned)(Rb * K) + (unsigned)C * 2u; lR[i] = R; lC2[i] = (unsigned)C * 2u; } }
        int laoff, lboff; { int tq = tid; asm volatile("" : "+v"(tq)); const int lq = tq & 63, lfr = lq & 15, lfq = lq >> 4, lw = tq >> 6; laoff = lds_byte((lw >> 2) * 64 + lfr, lfq * 8); lboff = lds_byte((lw & 3) * 32 + lfr, lfq * 8); }
        unsigned long long pr_a = 0, pr_b = 0, ps0 = 0, ps1 = 0, ps2 = 0, ps3 = 0, ps4 = 0, ps5 = 0, ps6 = 0;
#define PG8_STAMP(v_) do { if constexpr (PRB >= 3) { if (ui == 1 && t == 2) { PG8_SCHED; v_ = __builtin_amdgcn_s_memtime(); PG8_SCHED; } } } while (0)
        if constexpr (PRB != 0) { if (ui == 1) pr_a = __builtin_amdgcn_s_memtime(); }
#pragma unroll 1
        for (int t = 0; t < nt; t += 2) {
            const bool last = (t == nt - 2);
            if constexpr (PRB == 9) { if (ui == 1 && t == nt / 2) ps0 = __builtin_amdgcn_s_memtime(); }
            const char* a1 = cA + (size_t)(t + 1) * kstep;
            const char* a2 = last ? nA : cA + (size_t)(t + 2) * kstep; const char* b2 = last ? nB : cB + (size_t)(t + 2) * kstep;
            const char* a3 = a2 + kstep; const char* b3 = b2 + kstep;
            const char* ga1 = gA + (size_t)(t + 1) * kstep; const char* ga2 = last ? gA : gA + (size_t)(t + 2) * kstep; const char* ga3 = ga2 + kstep;
            const int u2 = (last && has_next) ? ui + 1 : ui;
            if (last && has_next) S.a_ready(nxt);
            if constexpr (SP2) {
            PG8_LDB(B0, 0, 0); PG8_SCHED; PG8_GO(goA1, ui, 1); PG8_SCHED; PG8_LDB(B1, 0, 1); PG8_SCHED; PG8_LDA(At, 0, 0); PG8_SCHED; PG8_GO_WAIT(goA1, 12); PG8_STAGE_G(PG8_SA(1, 1), a1 + hstep, ga1, goA1);
            PG8_WAIT_V(8); PG8_WAIT_L(0); PG8_BAR; PG8_STAMP(ps0); PG8_MMA(0, 0, At, B0); PG8_MMA(0, 1, At, B1); PG8_STAMP(ps1); PG8_BAR; PG8_STAMP(ps2); PG8_SCHED;
            PG8_GO(goB1, u2, 0); PG8_SCHED; PG8_LDA(At, 0, 1); PG8_SCHED; PG8_STAGE(PG8_SB(0, 0), b2, lvB); PG8_STAGE(PG8_SB(0, 1), b2 + hstep, lvB); PG8_GO_WAIT(goB1, 8); PG8_STAGE_G(PG8_SA(0, 0), a2, ga2, goB1);
            PG8_STAMP(ps5); PG8_WAIT_V(8); PG8_STAMP(ps6); PG8_WAIT_L(0); PG8_STAMP(ps3); PG8_BAR; PG8_STAMP(ps4); PG8_MMA(1, 0, At, B0); PG8_MMA(1, 1, At, B1); PG8_BAR; PG8_SCHED;
            PG8_LDB(B0, 1, 0); PG8_SCHED; PG8_GO(goA2, u2, 1); PG8_SCHED; PG8_LDB(B1, 1, 1); PG8_SCHED; PG8_LDA(At, 1, 0); PG8_SCHED; PG8_GO_WAIT(goA2, 12); PG8_STAGE_G(PG8_SA(0, 1), a2 + hstep, ga2, goA2);
            PG8_WAIT_V(8); PG8_WAIT_L(0); PG8_BAR; PG8_MMA(0, 0, At, B0); PG8_MMA(0, 1, At, B1); PG8_BAR; PG8_SCHED;
            PG8_GO(goB2, u2, 0); PG8_SCHED; PG8_LDA(At, 1, 1); PG8_SCHED; PG8_STAGE(PG8_SB(1, 0), b3, lvB); PG8_STAGE(PG8_SB(1, 1), b3 + hstep, lvB); PG8_GO_WAIT(goB2, 8); PG8_STAGE_G(PG8_SA(1, 0), a3, ga3, goB2);
            PG8_WAIT_V(8); PG8_WAIT_L(0); PG8_BAR; PG8_MMA(1, 0, At, B0); PG8_MMA(1, 1, At, B1); PG8_BAR; PG8_SCHED;
            } else {
            PG8_LDB(B0, 0, 0); PG8_SCHED; PG8_LDA(At, 0, 0); PG8_STAGE_AG(PG8_SA(1, 1), a1 + hstep, ga1, ui, 1);
            PG8_WAIT_L(8); PG8_BAR; PG8_WAIT_L(0); PG8_MMA(0, 0, At, B0); PG8_BAR; PG8_SCHED;
            PG8_LDB(B1, 0, 1); PG8_STAGE(PG8_SB(0, 0), b2, lvB);
            PG8_BAR; PG8_WAIT_L(0); PG8_MMA(0, 1, At, B1); PG8_BAR;
            PG8_LDA(At, 0, 1); PG8_STAGE_AG(PG8_SA(0, 0), a2, ga2, u2, 0);
            PG8_BAR; PG8_WAIT_L(0); PG8_MMA(1, 0, At, B0); PG8_BAR; PG8_SCHED;
            PG8_STAGE(PG8_SB(0, 1), b2 + hstep, lvB);
            PG8_WAIT_V(6); PG8_BAR; PG8_MMA(1, 1, At, B1); PG8_BAR;
            PG8_LDB(B0, 1, 0); PG8_SCHED; PG8_LDA(At, 1, 0); PG8_STAGE_AG(PG8_SA(0, 1), a2 + hstep, ga2, u2, 1);
            PG8_WAIT_L(8); PG8_BAR; PG8_WAIT_L(0); PG8_MMA(0, 0, At, B0); PG8_BAR; PG8_SCHED;
            PG8_LDB(B1, 1, 1); PG8_STAGE(PG8_SB(1, 0), b3, lvB);
            PG8_BAR; PG8_WAIT_L(0); PG8_MMA(0, 1, At, B1); PG8_BAR;
            PG8_LDA(At, 1, 1); PG8_STAGE_AG(PG8_SA(1, 0), a3, ga3, u2, 0);
            PG8_BAR; PG8_WAIT_L(0); PG8_MMA(1, 0, At, B0); PG8_BAR; PG8_SCHED;
            PG8_STAGE(PG8_SB(1, 1), b3 + hstep, lvB);
            PG8_WAIT_V(6); PG8_BAR; PG8_MMA(1, 1, At, B1); PG8_BAR;
            }
        }
        if constexpr (PRB != 0) { if (ui == 1) pr_b = __builtin_amdgcn_s_memtime(); }
        if constexpr (ALIGN_EPI) { if (wr == 0) PG8_BAR; }
        if constexpr (!Epi::AFTER_DRAIN) { int tq = tid; asm volatile("" : "+v"(tq)); const int lq = tq & 63; E(acc, cur, wr, wc, lq & 15, lq >> 4); S.done(cur); }
        if constexpr (PRB != 0) { if (ui == 1 && blockIdx.x == 0 && tid == 0) { asm volatile("s_waitcnt vmcnt(0)" ::: "memory"); const unsigned long long pr_c = __builtin_amdgcn_s_memtime(); g_probe_val = PRB == 1 ? (float)(pr_b - pr_a) * (1.0f / (float)nt) * 0.001f : PRB == 2 ? (float)(pr_c - pr_b) * 0.001f : PRB == 3 ? (float)(ps1 - ps0) * 0.005f : PRB == 4 ? (float)(ps3 - ps2) * 0.005f : PRB == 5 ? (float)(ps2 - ps1) * 0.02f : PRB == 6 ? (float)(ps4 - ps3) * 0.02f : PRB == 7 ? (float)(ps6 - ps5) * 0.005f : PRB == 9 ? (float)(pr_b - ps0) * (2.0f / (float)nt) * 0.001f : (float)(ps5 - ps2) * 0.005f; } }
        if (!has_next) break;
#pragma unroll
        for (int a = 0; a < 2; ++a)
#pragma unroll
            for (int b = 0; b < 2; ++b)
#pragma unroll
                for (int e = 0; e < 32; ++e) acc.q[a][b][e] = 0.f;
        cur = nxt; cA = nA; cB = nB; ++ui;

        if constexpr (ALIGN_EPI) { if (wr == 1) PG8_BAR; }
    }
    PG8_WAIT_V(0);
    if constexpr (!ALIGN_EPI) { if (wr == 0) PG8_BAR; }
    PG8_BAR;
    if constexpr (Epi::AFTER_DRAIN) { E.fused(acc, cur, wr, wc, fr, fq, lds, wid, lane); S.done(cur); }
#undef PG8_SA
#undef PG8_SB
#undef PG8_STAGE
#undef PG8_STAGE_A
#undef PG8_STAGE_AG
#undef PG8_GO
#undef PG8_GO_WAIT
#undef PG8_STAGE_G
#undef PG8_GOFFS
#undef PG8_LDA
#undef PG8_LDB
#undef aoffv
#undef boffv
#undef PG8_MMA
#undef PG8_WAIT_V
#undef PG8_WAIT_L
#undef PG8_BAR
#undef PG8_SCHED
}
}

constexpr int NW = 8;
constexpr int D = 1024, NB = 4, T = 8192, TCX = 256, NLAT = NB * T, NCTX = NB * TCX, R = NLAT + NCTX;
constexpr int NE = 16, FF = 2048, CAPL = 1024, CAPC = 32;
constexpr int RPE0 = 4352, RPE1 = 4096;
constexpr int HD = 128, NH = 8, NSEQ = NB * NH * 2;
constexpr int NGRP = 17;
constexpr float EPS = 1e-6f;

constexpr size_t MiB = 1u << 20;
constexpr size_t WS_CTL = 0, CTL_ZERO_BYTES = 64 * 1024;
constexpr size_t WS_MV = 1 * MiB;
constexpr size_t WS_LB = WS_MV + 256 * 1024;
constexpr size_t WS_AFF = 2 * MiB;
constexpr size_t WS_INV = 5 * MiB;
constexpr size_t WS_SEL = 7 * MiB;
constexpr size_t WS_GSEL = 7 * MiB + 512 * 1024;
constexpr size_t WS_CTXS = 8 * MiB;
constexpr size_t WS_W1T = 12 * MiB, WS_W2T = 16 * MiB, WS_WINT = 18 * MiB, WS_WOUTT = 28 * MiB;
constexpr size_t WS_PTOT = 30 * MiB;
constexpr size_t WS_W13T = 32 * MiB;
constexpr size_t WS_WDT = 160 * MiB;
constexpr size_t WS_W13T_L1 = 96 * MiB, WS_WDT_L1 = 192 * MiB;
constexpr int MOE_ITEMS = 16 * (16 * 128 + 32 * 32);
constexpr size_t WS_HB = 224 * MiB;
constexpr size_t WS_UB = 290 * MiB;
constexpr size_t WS_XG = 356 * MiB;
constexpr size_t WS_HBUF = 492 * MiB;
constexpr size_t WS_PRJ = 356 * MiB;
constexpr size_t WS_OLOC = 764 * MiB;
constexpr size_t WS_QGG = 892 * MiB;
constexpr size_t WS_SST = 32 * MiB;
constexpr size_t WS_S2B = 686 * MiB;
constexpr size_t WS_XB = 892 * MiB;
constexpr size_t WS_END = 1020 * MiB;
static_assert(WS_PRJ + (size_t)R * 5120 * 2 <= WS_OLOC && WS_HBUF + (size_t)16 * RPE0 * 2048 * 2 <= WS_OLOC && WS_XG + (size_t)16 * RPE0 * 1024 * 2 <= WS_HBUF, "ws map");
static_assert(WS_HB + (size_t)R * 1024 * 2 <= WS_UB && WS_UB + (size_t)R * 1024 * 2 <= WS_XG && WS_QGG + (size_t)2 * NLAT * 1024 * 2 <= WS_END, "ws map 2");

constexpr int CW_BAR = 4096;
constexpr int LDS_BYTES = 155648;
constexpr int GTAB_OFF = 131072;
constexpr int MISC_OFF = 131072 + 20 * 1024 + 320;
static_assert(MISC_OFF + 192 <= LDS_BYTES, "LDS map");

#define GAS __attribute__((address_space(1)))
#define LAS __attribute__((address_space(3)))
typedef unsigned short bf16;
typedef unsigned v4u __attribute__((ext_vector_type(4)));
typedef unsigned v2u __attribute__((ext_vector_type(2)));
typedef float f32x4 __attribute__((ext_vector_type(4)));
typedef float f32x2 __attribute__((ext_vector_type(2)));
typedef short bf16x8 __attribute__((ext_vector_type(8)));
typedef short bf16x4 __attribute__((ext_vector_type(4)));
#define LDS_WAIT() asm volatile("s_waitcnt lgkmcnt(0)" ::: "memory")
__device__ __forceinline__ unsigned pk2(float lo, float hi) { return pg8::cvt_pk_bf16(lo, hi); }
__device__ __forceinline__ float bflo(unsigned w) { return __uint_as_float(w << 16); }
__device__ __forceinline__ float bfhi(unsigned w) { return __uint_as_float(w & 0xffff0000u); }
__device__ __forceinline__ float fsig(float x) { return __builtin_amdgcn_rcpf(1.0f + __expf(-x)); }
__device__ __forceinline__ float wave_sum(float v) {
#pragma unroll
    for (int o = 1; o < 64; o <<= 1) v += __shfl_xor(v, o);
    return v;
}

#define XB_TMO      128
#define XB_XCNT(j)  (256  + 64 * (j))
#define XB_XSUB(j)  (1280 + 64 * (j))
#define XB_XGEN(j)  (2304 + 64 * (j))
#define XB_TOP      3328
#define XB_TOPGEN   3392
#define XCD_BAR_WORDS 3456
#define XB_SPIN_CAP (1u << 20)
__device__ __forceinline__ unsigned xb_ld(unsigned* p)              { return __hip_atomic_load(p, __ATOMIC_RELAXED, __HIP_MEMORY_SCOPE_AGENT); }
__device__ __forceinline__ unsigned xb_add(unsigned* p, unsigned v) { return __hip_atomic_fetch_add(p, v, __ATOMIC_RELAXED, __HIP_MEMORY_SCOPE_AGENT); }
__device__ __forceinline__ unsigned xb_xcc_id() { return (unsigned)__builtin_amdgcn_s_getreg((3 << 11) | 20) & 0xFu; }
#define XB_SPIN(cond, bar) do { unsigned _sp = 0; while (cond) { __builtin_amdgcn_s_sleep(1); \
    if ((++_sp & 255u) == 0u) { if (xb_ld(&(bar)[XB_TMO])) break; if (_sp > XB_SPIN_CAP) { atomicAdd(&(bar)[XB_TMO], 1u); break; } } } } while (0)
struct XcdBarrier { unsigned* bar; unsigned x; volatile LAS unsigned* st; };
__device__ __forceinline__ XcdBarrier xcd_barrier_post(unsigned* bar, volatile LAS unsigned* st, const int wv) {
    XcdBarrier b; b.bar = bar; b.x = xb_xcc_id(); b.st = st;
    if (TID_OF(wv) == 0) (void)xb_add(&bar[XB_XCNT(b.x)], 1u);
    return b;
}
__device__ __forceinline__ void xcd_barrier_complete(unsigned* bar, unsigned x, unsigned& nloc, unsigned& nx) {
    const unsigned G = gridDim.x * gridDim.y * gridDim.z;
    unsigned sum, cnt, mine, sp = 0u;
    for (;;) {
        sum = 0u; cnt = 0u; mine = 0u;
#pragma unroll
        for (unsigned j = 0; j < 16; ++j) { const unsigned c = xb_ld(&bar[XB_XCNT(j)]); sum += c; cnt += (c > 0u) ? 1u : 0u; mine = (j == x) ? c : mine; }
        if (sum == G) break;
        __builtin_amdgcn_s_sleep(1);
        if ((++sp & 255u) == 0u) { if (xb_ld(&bar[XB_TMO])) break; if (sp > XB_SPIN_CAP) { atomicAdd(&bar[XB_TMO], 1u); break; } }
    }
    nloc = mine > 0u ? mine : 1u; nx = cnt > 0u ? cnt : 1u;
}
__device__ __forceinline__ void xcd_barrier(const XcdBarrier& b, const int wv) {
    asm volatile("s_waitcnt vmcnt(0)" ::: "memory");
    __syncthreads();
    if (TID_OF(wv) == 0) {
        unsigned* bar = b.bar;
        __builtin_amdgcn_s_waitcnt(0);
        unsigned nloc = b.st[0], nx = b.st[1];
        if (nloc == 0u) { xcd_barrier_complete(bar, b.x, nloc, nx); b.st[0] = nloc; b.st[1] = nx; }
        const unsigned old = xb_add(&bar[XB_XSUB(b.x)], 1u);
        const unsigned gen = old / nloc;
        if (old + 1u == (gen + 1u) * nloc) {
            __builtin_amdgcn_fence(__ATOMIC_RELEASE, "agent");
            asm volatile("s_waitcnt vmcnt(0)" ::: "memory");
            const unsigned og = xb_add(&bar[XB_TOP], 1u);
            const unsigned tg = og / nx;
            if (og + 1u == (tg + 1u) * nx) xb_add(&bar[XB_TOPGEN], 1u);
            else XB_SPIN(xb_ld(&bar[XB_TOPGEN]) == tg, bar);
            __builtin_amdgcn_fence(__ATOMIC_ACQUIRE, "agent");
            xb_add(&bar[XB_XGEN(b.x)], 1u);
            asm volatile("s_waitcnt vmcnt(0)" ::: "memory");
        } else {
            XB_SPIN(xb_ld(&bar[XB_XGEN(b.x)]) == gen, bar);
            __builtin_amdgcn_fence(__ATOMIC_ACQUIRE, "agent");
            asm volatile("s_waitcnt vmcnt(0)" ::: "memory");
        }
    }
    __syncthreads();
}

struct Ctx {
    LAS unsigned char* lds;
    int tid, lane, wave, vcu, G, gw, NGW;
};
__device__ __forceinline__ Ctx make_ctx(unsigned char* lds_raw, const int wv) {
    Ctx C; int l = lane_id(); asm volatile("" : "+v"(l));
    C.lds = (LAS unsigned char*)lds_raw; C.tid = wv * 64 + l; C.lane = l; C.wave = wv;
    C.G = gridDim.x; { const int bx = blockIdx.x; C.vcu = (C.G % 8 == 0) ? (bx % 8) * (C.G / 8) + bx / 8 : bx; }
    C.gw = C.vcu * NW + C.wave; C.NGW = C.G * NW;
    return C;
}

__device__ __forceinline__ void transpose_item(const float* W, int ldw, int k0, int n0, bf16* WT, int K, int drow0, LAS float* scr, int lane) {
    float tv[32];
    const float* wp = W + (size_t)(k0 + (lane >> 5)) * ldw + n0 + (lane & 31);
#pragma unroll
    for (int i = 0; i < 32; ++i) tv[i] = __builtin_nontemporal_load(wp + (size_t)(2 * i) * ldw);
#pragma unroll
    for (int i = 0; i < 32; ++i) scr[(2 * i + (lane >> 5)) * 33 + (lane & 31)] = tv[i];
    LDS_WAIT(); asm volatile("" ::: "memory");
    const int c = lane & 7;
#pragma unroll
    for (int j = 0; j < 4; ++j) { const int n = (lane >> 3) + 8 * j; const LAS float* s = scr + (8 * c) * 33 + n;
        v4u o; o.x = pk2(s[0 * 33], s[1 * 33]); o.y = pk2(s[2 * 33], s[3 * 33]); o.z = pk2(s[4 * 33], s[5 * 33]); o.w = pk2(s[6 * 33], s[7 * 33]);
        *(v4u*)(WT + (size_t)(drow0 + n) * K + k0 + 8 * c) = o; }
    LDS_WAIT(); asm volatile("" ::: "memory");
}
__device__ __forceinline__ void paired_src(int db, int& type, int& ch) { const int j0 = 32 * db, pn = j0 >> 8, jj = j0 & 255; type = jj >> 7; ch = 128 * pn + (jj & 127); }

__device__ __forceinline__ void transpose_item_f8(const float* W, int ldw, int k0, int n0, unsigned char* WT, int K, int drow0, LAS float* scr, int lane);
constexpr int CS_EARLY = 16 * 64 + 16 * 32, CS_ALL = 16 * 64 + 16 * 32 + 16 * 160 + 16 * 32;
__device__ __forceinline__ void convert_small(const Ctx& C, const float* w1, const float* w2, const float* win, const float* wout, unsigned char* ws, int it_lo = 0, int it_hi = CS_ALL, int scr_base = 0, int scr_stride = 16384) {
    LAS float* scr = (LAS float*)(C.lds + scr_base + C.wave * scr_stride);
    constexpr int I1 = 16 * 64, I2 = 16 * 32, I3 = 16 * 160, I4 = 16 * 32, NI = I1 + I2 + I3 + I4;
    for (int it = it_lo + C.gw; it < it_hi; it += C.NGW) {
        int r = it;
        if (r < I1) { const int kb = r / 64, db = r % 64; int type, ch; paired_src(db, type, ch); transpose_item(w1, 2048, 64 * kb, type * 1024 + ch, (bf16*)(ws + WS_W1T), 1024, 32 * db, scr, C.lane); continue; } r -= I1;
        if (r < I2) { const int kb = r / 32, db = r % 32; transpose_item(w2, 1024, 64 * kb, 32 * db, (bf16*)(ws + WS_W2T), 1024, 32 * db, scr, C.lane); continue; } r -= I2;
        if (r < I3) { const int kb = r / 160, db = r % 160; transpose_item_f8(win, 5120, 64 * kb, 32 * db, ws + WS_WINT, 1024, 32 * db, scr, C.lane); continue; } r -= I3;
        { const int kb = r / 32, db = r % 32; transpose_item(wout, 1024, 64 * kb, 32 * db, (bf16*)(ws + WS_WOUTT), 1024, 32 * db, scr, C.lane); }
    }
}
__device__ __forceinline__ void transpose_item_f8(const float* W, int ldw, int k0, int n0, unsigned char* WT, int K, int drow0, LAS float* scr, int lane) {
    float tv[32];
    const float* wp = W + (size_t)(k0 + (lane >> 5)) * ldw + n0 + (lane & 31);
#pragma unroll
    for (int i = 0; i < 32; ++i) tv[i] = __builtin_nontemporal_load(wp + (size_t)(2 * i) * ldw);
#pragma unroll
    for (int i = 0; i < 32; ++i) scr[(2 * i + (lane >> 5)) * 33 + (lane & 31)] = tv[i] * 32.0f;
    LDS_WAIT(); asm volatile("" ::: "memory");
    const int n = lane >> 1, kh = (lane & 1) * 32; const LAS float* sp = scr + kh * 33 + n;
    unsigned o[8];
#pragma unroll
    for (int q = 0; q < 8; ++q) o[q] = pg8::pk4_fp8(sp[(4 * q) * 33], sp[(4 * q + 1) * 33], sp[(4 * q + 2) * 33], sp[(4 * q + 3) * 33]);
    unsigned char* dp = WT + (size_t)(drow0 + n) * K + k0 + kh;
    __builtin_nontemporal_store((v4u){o[0], o[1], o[2], o[3]}, (v4u*)dp); __builtin_nontemporal_store((v4u){o[4], o[5], o[6], o[7]}, (v4u*)(dp + 16));
    LDS_WAIT(); asm volatile("" ::: "memory");
}
__device__ __forceinline__ void convert_moe(const Ctx& C, const float* wg, const float* wu, const float* wd, int layer, unsigned char* ws, int it_lo, int it_hi, int widx, int nw, int scr_base = 0, int scr_stride = 16384) {
    LAS float* scr = (LAS float*)(C.lds + scr_base + C.wave * scr_stride);
    constexpr int IGU = 16 * 128, IDN = 32 * 32, IE = IGU + IDN;
    const size_t lo = (size_t)layer * NE * 1024 * 2048;
    unsigned char* const w13 = ws + (layer ? WS_W13T_L1 : WS_W13T); unsigned char* const wdt = ws + (layer ? WS_WDT_L1 : WS_WDT);
    for (int it = it_lo + widx; it < it_hi; it += nw) {
        const int e = it / IE; int r = it % IE;
        if (r < IGU) { const int kb = r / 128, db = r % 128; int type, ch; paired_src(db, type, ch);
            transpose_item_f8((type ? wu : wg) + lo + (size_t)e * 1024 * 2048, 2048, 64 * kb, ch, w13 + (size_t)e * 4096 * 1024, 1024, 32 * db, scr, C.lane); }
        else { r -= IGU; const int kb = r / 32, db = r % 32;
            transpose_item_f8(wd + lo + (size_t)e * 2048 * 1024, 1024, 64 * kb, 32 * db, wdt + (size_t)e * 1024 * 2048, 2048, 32 * db, scr, C.lane); }
    }
}
__device__ __forceinline__ void mod_gemv(const Ctx& C, const float* c, const float* cctx, const float* mod_w, const float* mod_b, float* MV) {
    LAS float* cond = (LAS float*)C.lds;
    LAS float* red = cond + 5 * 1024;
    bool have = false;
    for (int item = blockIdx.x; item < 192; item += C.G) {
        if (!have) { for (int i = C.tid; i < 5 * 1024; i += NW * 64) { const int g = i >> 10, k = i & 1023; const float v = g < 4 ? c[g * 1024 + k] : cctx[k]; cond[i] = v * fsig(v); } have = true; }
        __syncthreads();
        const int l = item / 96, n = (item % 96) * 64 + C.lane;
        const float* W = mod_w + (size_t)l * 1024 * 6144 + n;
        float a[5] = {0.f, 0.f, 0.f, 0.f, 0.f};
        for (int kk = 0; kk < 128; kk += 32) { float w[32];
#pragma unroll
            for (int u = 0; u < 32; ++u) w[u] = __builtin_nontemporal_load(W + (size_t)(C.wave * 128 + kk + u) * 6144);
#pragma unroll
            for (int u = 0; u < 32; ++u)
#pragma unroll
                for (int g = 0; g < 5; ++g) a[g] += cond[g * 1024 + C.wave * 128 + kk + u] * w[u]; }
#pragma unroll
        for (int g = 0; g < 5; ++g) red[(C.wave * 5 + g) * 64 + C.lane] = a[g];
        __syncthreads();
        if (C.wave < 5) { float s = 0.f;
#pragma unroll
            for (int w = 0; w < 8; ++w) s += red[(w * 5 + C.wave) * 64 + C.lane];
            MV[(size_t)(l * 5 + C.wave) * 6144 + n] = s + mod_b[l * 6144 + n]; }
    }
}

struct RowArgs {
    const float* src_lat; const float* src_ctx;
    const bf16* delta;
    const bf16* src16; bf16* dst16; bf16* xb;
    float* dst_lat; float* dst_ctx;
    const float* gamma;
    const float* mv;
    const float* mvg;
    int i_shift, i_scale, i_gate;
    bf16* HB; unsigned char* HB8; float* AFF; const float* router_w;
    const unsigned char* Y; const short* INV; int rpe;
    int nrows;
    const float* cv_wg; const float* cv_wu; const float* cv_wd; unsigned char* cv_ws; int cv_layer, cv_lo, cv_hi; const float* cs_w1; const float* cs_w2; const float* cs_win; const float* cs_wout; int cs_lo, cs_hi;
};
template <bool COMBINE, bool ROUTER, bool FINAL, bool F8OUT = ROUTER>
__device__ __forceinline__ void row_phase(const Ctx& C, const RowArgs& A) {
    LAS float* rwT = (LAS float*)C.lds;
    if (ROUTER) { for (int i = C.tid; i < 16384; i += NW * 64) rwT[(i & 15) * 1024 + (i >> 4)] = A.router_w[i]; __syncthreads();
        if (A.cv_hi > A.cv_lo && (C.wave & 1)) { convert_moe(C, A.cv_wg, A.cv_wu, A.cv_wd, A.cv_layer, A.cv_ws, A.cv_lo, A.cv_hi, C.gw, C.NGW, 65536, 8448); if (A.cs_hi > A.cs_lo) convert_small(C, A.cs_w1, A.cs_w2, A.cs_win, A.cs_wout, A.cv_ws, A.cs_lo, A.cs_hi, 65536, 8448); } }
    const int rpw = (A.nrows + C.NGW - 1) / C.NGW;
    const int r_lo = C.gw * rpw, r_hi = min(A.nrows, r_lo + rpw);
    const int l4 = 4 * C.lane;
    int cur_grp = -1;
    f32x4 ga[4], sh[4], m5[4];
#pragma unroll
    for (int j = 0; j < 4; ++j) { ga[j] = (f32x4){0.f, 0.f, 0.f, 0.f}; sh[j] = ga[j]; m5[j] = ga[j]; }
    constexpr bool DELTA = ROUTER || COMBINE, SRC16 = DELTA;
    f32x4 vn[4]; v2u dn[4], sn[4];
#pragma unroll
    for (int j = 0; j < 4; ++j) { vn[j] = (f32x4){0.f, 0.f, 0.f, 0.f}; dn[j] = (v2u){0u, 0u}; sn[j] = (v2u){0u, 0u}; }
    if (r_lo < r_hi) {
        if (SRC16) {
#pragma unroll
            for (int j = 0; j < 4; ++j) { sn[j] = __builtin_nontemporal_load((const v2u*)(A.src16 + (size_t)r_lo * 1024 + l4 + 256 * j)); dn[j] = __builtin_nontemporal_load((const v2u*)(A.delta + (size_t)r_lo * 1024 + l4 + 256 * j)); } }
        else { const bool ic = r_lo >= NLAT; const float* s0 = (ic ? A.src_ctx + (size_t)(r_lo - NLAT) * 1024 : A.src_lat + (size_t)r_lo * 1024);
#pragma unroll
            for (int j = 0; j < 4; ++j) vn[j] = __builtin_nontemporal_load((const f32x4*)(s0 + l4 + 256 * j)); } }
    int svn = -1;
    if (COMBINE && r_lo < r_hi) svn = (C.lane < 16) ? (int)A.INV[(size_t)C.lane * R + r_lo] : -1;
    for (int r = r_lo; r < r_hi; ++r) {
        const bool isctx = r >= NLAT; const int grp = isctx ? 4 : (r >> 13);
        if (grp != cur_grp) { cur_grp = grp; const float* mvn = A.mv + (size_t)grp * 6144;
#pragma unroll
            for (int j = 0; j < 4; ++j) { const int c0 = l4 + 256 * j; const f32x4 g = *(const f32x4*)(A.gamma + c0);
                if (FINAL) { ga[j] = g; }
                else { const f32x4 sc = *(const f32x4*)(mvn + A.i_scale * 1024 + c0); ga[j] = g * (sc + 1.0f); sh[j] = *(const f32x4*)(mvn + A.i_shift * 1024 + c0); }
                if (COMBINE) m5[j] = *(const f32x4*)(A.mvg + (size_t)grp * 6144 + A.i_gate * 1024 + c0); } }
        const size_t roff = isctx ? (size_t)(r - NLAT) * 1024 : (size_t)r * 1024;
        f32x4 v[4];
#pragma unroll
        for (int j = 0; j < 4; ++j) { v[j] = SRC16 ? (f32x4){bflo(sn[j].x), bfhi(sn[j].x), bflo(sn[j].y), bfhi(sn[j].y)} : vn[j]; if (DELTA) v[j] += (f32x4){bflo(dn[j].x), bfhi(dn[j].x), bflo(dn[j].y), bfhi(dn[j].y)}; }
        if (r + 1 < r_hi) { const int rn = r + 1;
            if (SRC16) {
#pragma unroll
                for (int j = 0; j < 4; ++j) { sn[j] = __builtin_nontemporal_load((const v2u*)(A.src16 + (size_t)rn * 1024 + l4 + 256 * j)); dn[j] = __builtin_nontemporal_load((const v2u*)(A.delta + (size_t)rn * 1024 + l4 + 256 * j)); } }
            else { const bool ic = rn >= NLAT; const float* s1 = (ic ? A.src_ctx + (size_t)(rn - NLAT) * 1024 : A.src_lat + (size_t)rn * 1024);
#pragma unroll
                for (int j = 0; j < 4; ++j) vn[j] = __builtin_nontemporal_load((const f32x4*)(s1 + l4 + 256 * j)); } }
        if (!DELTA) {
#pragma unroll
            for (int j = 0; j < 4; ++j) { v2u w; w.x = pk2(v[j].x, v[j].y); w.y = pk2(v[j].z, v[j].w); *(v2u*)(A.xb + (size_t)r * 1024 + l4 + 256 * j) = w; } }
        if (COMBINE) {
            f32x4 acc[4];
#pragma unroll
            for (int j = 0; j < 4; ++j) acc[j] = (f32x4){0.f, 0.f, 0.f, 0.f};
            const int sv = svn;
            if (r + 1 < r_hi) svn = (C.lane < 16) ? (int)A.INV[(size_t)C.lane * R + (r + 1)] : -1;
            unsigned long long m = __ballot(sv >= 0);
            while (m) {
                const int e0 = __ffsll((long long)m) - 1; m &= m - 1;
                const bool two = m != 0ull; const int e1 = two ? __ffsll((long long)m) - 1 : e0; if (two) m &= m - 1;
                const unsigned char* y0 = A.Y + ((size_t)e0 * A.rpe + __shfl(sv, e0)) * 1024 + l4;
                const unsigned char* y1 = A.Y + ((size_t)e1 * A.rpe + __shfl(sv, e1)) * 1024 + l4;
                unsigned w0[4], w1[4];
#pragma unroll
                for (int j = 0; j < 4; ++j) { w0[j] = __builtin_nontemporal_load((const unsigned*)(y0 + 256 * j)); w1[j] = __builtin_nontemporal_load((const unsigned*)(y1 + 256 * j)); }
#pragma unroll
                for (int j = 0; j < 4; ++j) { const f32x2 a0 = __builtin_amdgcn_cvt_pk_f32_fp8((int)w0[j], false), b0 = __builtin_amdgcn_cvt_pk_f32_fp8((int)w0[j], true); acc[j] += (f32x4){a0.x, a0.y, b0.x, b0.y};
                    if (two) { const f32x2 a1 = __builtin_amdgcn_cvt_pk_f32_fp8((int)w1[j], false), b1 = __builtin_amdgcn_cvt_pk_f32_fp8((int)w1[j], true); acc[j] += (f32x4){a1.x, a1.y, b1.x, b1.y}; } } }
#pragma unroll
            for (int j = 0; j < 4; ++j) v[j] += (m5[j] * (1.0f / 64.0f)) * acc[j];
            if (!FINAL) {
#pragma unroll
                for (int j = 0; j < 4; ++j) { v2u w; w.x = pk2(v[j].x, v[j].y); w.y = pk2(v[j].z, v[j].w); __builtin_nontemporal_store(w, (v2u*)(A.dst16 + (size_t)r * 1024 + l4 + 256 * j)); } }
        }
        float ss = 0.f;
#pragma unroll
        for (int j = 0; j < 4; ++j) ss += (v[j].x * v[j].x + v[j].y * v[j].y) + (v[j].z * v[j].z + v[j].w * v[j].w);
        const float rstd = rsqrtf(wave_sum(ss) * (1.0f / 1024.0f) + EPS);
        if (FINAL) { float* dst = A.dst_lat + roff;
#pragma unroll
            for (int j = 0; j < 4; ++j) __builtin_nontemporal_store(v[j] * rstd * ga[j], (f32x4*)(dst + l4 + 256 * j));
            continue; }
        f32x4 hv[4];
#pragma unroll
        for (int j = 0; j < 4; ++j) { hv[j] = v[j] * rstd * ga[j] + sh[j];
            if (F8OUT) { *(unsigned*)(A.HB8 + (size_t)r * 1024 + l4 + 256 * j) = pg8::pk4_fp8(hv[j].x, hv[j].y, hv[j].z, hv[j].w); }
            else { v2u w; w.x = pk2(hv[j].x, hv[j].y); w.y = pk2(hv[j].z, hv[j].w); *(v2u*)(A.HB + (size_t)r * 1024 + l4 + 256 * j) = w; } }
        if (ROUTER) {
            float lg[16];
#pragma unroll
            for (int e = 0; e < 16; ++e) { float s = 0.f;
#pragma unroll
                for (int j = 0; j < 4; ++j) { const f32x4 w = *(const LAS f32x4*)(rwT + e * 1024 + l4 + 256 * j); s += (hv[j].x * w.x + hv[j].y * w.y) + (hv[j].z * w.z + hv[j].w * w.w); }
                lg[e] = s; }
            float t8[8], t4[4], t2[2], t1;
#pragma unroll
            for (int i = 0; i < 8; ++i) { const bool up = (C.lane & 32) != 0; const float send = up ? lg[i] : lg[i + 8], keep = up ? lg[i + 8] : lg[i]; t8[i] = keep + __shfl_xor(send, 32); }
#pragma unroll
            for (int i = 0; i < 4; ++i) { const bool up = (C.lane & 16) != 0; const float send = up ? t8[i] : t8[i + 4], keep = up ? t8[i + 4] : t8[i]; t4[i] = keep + __shfl_xor(send, 16); }
#pragma unroll
            for (int i = 0; i < 2; ++i) { const bool up = (C.lane & 8) != 0; const float send = up ? t4[i] : t4[i + 2], keep = up ? t4[i + 2] : t4[i]; t2[i] = keep + __shfl_xor(send, 8); }
            { const bool up = (C.lane & 4) != 0; const float send = up ? t2[0] : t2[1], keep = up ? t2[1] : t2[0]; t1 = keep + __shfl_xor(send, 4); }
            t1 += __shfl_xor(t1, 2); t1 += __shfl_xor(t1, 1);
            const int e = ((C.lane >> 5) & 1) * 8 + ((C.lane >> 4) & 1) * 4 + ((C.lane >> 3) & 1) * 2 + ((C.lane >> 2) & 1);
            float mx = t1;
#pragma unroll
            for (int o = 4; o < 64; o <<= 1) mx = fmaxf(mx, __shfl_xor(mx, o));
            const float p = __expf(t1 - mx); float sum = p;
#pragma unroll
            for (int o = 4; o < 64; o <<= 1) sum += __shfl_xor(sum, o);
            if ((C.lane & 3) == 0) A.AFF[(size_t)r * 16 + e] = p / sum;
        }
    }
    if (ROUTER) { if (A.cv_hi > A.cv_lo && !(C.wave & 1)) { convert_moe(C, A.cv_wg, A.cv_wu, A.cv_wd, A.cv_layer, A.cv_ws, A.cv_lo, A.cv_hi, C.gw, C.NGW, 65536, 8448); if (A.cs_hi > A.cs_lo) convert_small(C, A.cs_w1, A.cs_w2, A.cs_win, A.cs_wout, A.cv_ws, A.cs_lo, A.cs_hi, 65536, 8448); } __syncthreads(); }
}

__device__ __forceinline__ void conv_phase(const Ctx& C, const bf16* U, bf16* V, const float* dw, const float* dwb, const float* lng, const float* lnb) {
    LAS unsigned* ut = (LAS unsigned*)C.lds;
    LAS float* part = (LAS float*)(C.lds + 126976);
    LAS float* stat = part + 512;
    const int cp = C.tid;
    f32x2 wt[31];
#pragma unroll
    for (int j = 0; j < 31; ++j) wt[j] = *(const f32x2*)(dw + j * 1024 + 2 * cp);
    const f32x2 bb = *(const f32x2*)(dwb + 2 * cp), gg = *(const f32x2*)(lng + 2 * cp), be = *(const f32x2*)(lnb + 2 * cp);
    for (int tile = C.vcu; tile < 1056; tile += C.G) {
        int rowbase, t0, tseq;
        if (tile < 1024) { rowbase = (tile >> 8) * T; t0 = (tile & 255) * 32; tseq = T; } else { const int tt = tile - 1024; rowbase = NLAT + (tt >> 3) * TCX; t0 = (tt & 7) * 32; tseq = TCX; }
        { v4u tv[16];
#pragma unroll
            for (int k = 0; k < 16; ++k) { const int i = 4 * k + (C.tid >> 7), t = t0 - 15 + i; tv[k] = (v4u){0u, 0u, 0u, 0u};
                if (i < 62 && t >= 0 && t < tseq) tv[k] = __builtin_nontemporal_load((const v4u*)(U + (size_t)(rowbase + t) * 1024 + (C.tid & 127) * 8)); }
#pragma unroll
            for (int k = 0; k < 16; ++k) { const int i = 4 * k + (C.tid >> 7); if (i < 62) *(LAS v4u*)(C.lds + i * 2048 + (C.tid & 127) * 16) = tv[k]; } }
        __syncthreads();
        f32x2 ov[32];
#pragma unroll
        for (int g = 0; g < 8; ++g) {
            f32x2 a[4];
#pragma unroll
            for (int oo = 0; oo < 4; ++oo) a[oo] = bb;
#pragma unroll
            for (int jj = 0; jj < 34; ++jj) { const unsigned uw = ut[(4 * g + jj) * 512 + cp]; const f32x2 uu = (f32x2){bflo(uw), bfhi(uw)};
#pragma unroll
                for (int oo = 0; oo < 4; ++oo) { const int tap = jj - oo; if (tap >= 0 && tap <= 30) a[oo] = __builtin_elementwise_fma(wt[tap], uu, a[oo]); } }
            float r8[8];
#pragma unroll
            for (int oo = 0; oo < 4; ++oo) { ov[4 * g + oo] = a[oo]; r8[2 * oo] = a[oo].x + a[oo].y; r8[2 * oo + 1] = a[oo].x * a[oo].x + a[oo].y * a[oo].y; }
            float r4[4], r2[2], r1;
#pragma unroll
            for (int i = 0; i < 4; ++i) { const bool up = (C.lane & 32) != 0; const float send = up ? r8[i] : r8[i + 4], keep = up ? r8[i + 4] : r8[i]; r4[i] = keep + __shfl_xor(send, 32); }
#pragma unroll
            for (int i = 0; i < 2; ++i) { const bool up = (C.lane & 16) != 0; const float send = up ? r4[i] : r4[i + 2], keep = up ? r4[i + 2] : r4[i]; r2[i] = keep + __shfl_xor(send, 16); }
            { const bool up = (C.lane & 8) != 0; const float send = up ? r2[0] : r2[1], keep = up ? r2[1] : r2[0]; r1 = keep + __shfl_xor(send, 8); }
            r1 += __shfl_xor(r1, 4); r1 += __shfl_xor(r1, 2); r1 += __shfl_xor(r1, 1);
            if ((C.lane & 7) == 0) { const int vi = ((C.lane >> 5) & 1) * 4 + ((C.lane >> 4) & 1) * 2 + ((C.lane >> 3) & 1); part[((4 * g + (vi >> 1)) * 8 + C.wave) * 2 + (vi & 1)] = r1; }
            asm volatile("" ::: "memory");
        }
        __syncthreads();
        if (C.tid < 32) { float s1 = 0.f, s2 = 0.f;
#pragma unroll
            for (int w = 0; w < 8; ++w) { s1 += part[(C.tid * 8 + w) * 2]; s2 += part[(C.tid * 8 + w) * 2 + 1]; }
            const float mean = s1 * (1.0f / 1024.0f), var = fmaxf(s2 * (1.0f / 1024.0f) - mean * mean, 0.f);
            stat[C.tid * 2] = mean; stat[C.tid * 2 + 1] = rsqrtf(var + EPS); }
        __syncthreads();
#pragma unroll
        for (int tk = 0; tk < 32; ++tk) { const float mean = stat[tk * 2], rstd = stat[tk * 2 + 1];
            const float y0 = (ov[tk].x - mean) * rstd * gg.x + be.x, y1 = (ov[tk].y - mean) * rstd * gg.y + be.y;
            *(unsigned*)(V + (size_t)(rowbase + t0 + tk) * 1024 + 2 * cp) = pk2(y0 * fsig(y0), y1 * fsig(y1)); }
    }
}

__device__ __forceinline__ unsigned block_excl_scan(const Ctx& C, unsigned v, LAS unsigned* wsum, unsigned& total) {
    unsigned inc = v;
#pragma unroll
    for (int o = 1; o < 64; o <<= 1) { const unsigned t = __shfl_up(inc, o); if (C.lane >= o) inc += t; }
    if (C.lane == 63) wsum[C.wave] = inc;
    __syncthreads();
    unsigned base = 0, tot = 0;
#pragma unroll
    for (int w = 0; w < NW; ++w) { const unsigned s = wsum[w]; if (w < C.wave) base += s; tot += s; }
    __syncthreads();
    total = tot;
    return base + inc - v;
}
__device__ __forceinline__ void topk_phase(const Ctx& C, int nprob, int rpe, const float* AFF, int* SEL, float* GSEL, short* INV) {
    LAS unsigned* hist = (LAS unsigned*)C.lds;
    LAS unsigned* misc = hist + 256;
    LAS unsigned* wsum = misc + 16;
    for (int prob = blockIdx.x; prob < nprob; prob += C.G) {
        const int set = prob >> 4, e = prob & 15; const bool lat = set < 4;
        const int kk = lat ? CAPL : CAPC, rowbase = lat ? set * T : NLAT + (set - 4) * TCX, slotbase = lat ? set * CAPL : 4 * CAPL + (set - 4) * CAPC;
        const int cnt = lat ? 16 : (C.tid < 256 ? 1 : 0), base = lat ? C.tid * 16 : C.tid;
        unsigned key[16];
#pragma unroll
        for (int i = 0; i < 16; ++i) key[i] = (i < cnt) ? __float_as_uint(AFF[(size_t)(rowbase + base + i) * 16 + e]) : 0u;
        unsigned prefix = 0u, mask = 0u, need = (unsigned)kk;
#pragma unroll 1
        for (int pass = 0; pass < 4; ++pass) { const int shift = 24 - 8 * pass;
            if (C.tid < 256) hist[C.tid] = 0u;
            __syncthreads();
#pragma unroll
            for (int i = 0; i < 16; ++i) if (i < cnt && (key[i] & mask) == prefix) __hip_atomic_fetch_add(&hist[(key[i] >> shift) & 255u], 1u, __ATOMIC_RELAXED, __HIP_MEMORY_SCOPE_WORKGROUP);
            __syncthreads();
            if (C.wave == 0) { unsigned h[4], tot = 0u;
#pragma unroll
                for (int b = 0; b < 4; ++b) { h[b] = hist[4 * C.lane + b]; tot += h[b]; }
                unsigned inc = tot;
#pragma unroll
                for (int o = 1; o < 64; o <<= 1) { const unsigned t = __shfl_down(inc, o); if (C.lane + o < 64) inc += t; }
                unsigned cgt = inc - tot;
#pragma unroll
                for (int b = 3; b >= 0; --b) { if (cgt < need && need <= cgt + h[b]) { misc[0] = (unsigned)(4 * C.lane + b); misc[1] = need - cgt; } cgt += h[b]; } }
            __syncthreads();
            prefix |= misc[0] << shift; mask |= 255u << shift; need = misc[1];
        }
        unsigned neq = 0u, ngt = 0u;
#pragma unroll
        for (int i = 0; i < 16; ++i) if (i < cnt) { neq += (key[i] == prefix) ? 1u : 0u; ngt += (key[i] > prefix) ? 1u : 0u; }
        unsigned tot;
        const unsigned eq_before = block_excl_scan(C, neq, wsum, tot);
        const unsigned take_eq = (need > eq_before) ? min(neq, need - eq_before) : 0u;
        unsigned slot = block_excl_scan(C, ngt + take_eq, wsum, tot);
        unsigned eqr = eq_before;
        unsigned iv[8];
#pragma unroll
        for (int i = 0; i < 8; ++i) iv[i] = 0xffffffffu;
#pragma unroll
        for (int i = 0; i < 16; ++i) if (i < cnt) {
            bool sel = key[i] > prefix;
            if (key[i] == prefix) { sel = eqr < need; ++eqr; }
            const int row = rowbase + base + i;
            if (sel) { const int s = slotbase + (int)slot; ++slot; SEL[e * rpe + s] = row; GSEL[e * rpe + s] = __uint_as_float(key[i]);
                iv[i >> 1] = (i & 1) ? ((iv[i >> 1] & 0x0000ffffu) | ((unsigned)s << 16)) : ((iv[i >> 1] & 0xffff0000u) | ((unsigned)s & 0xffffu)); } }
        if (lat) { v4u* ip = (v4u*)(INV + (size_t)e * R + rowbase + base); ip[0] = (v4u){iv[0], iv[1], iv[2], iv[3]}; ip[1] = (v4u){iv[4], iv[5], iv[6], iv[7]}; }
        else if (cnt) INV[(size_t)e * R + rowbase + base] = (short)(iv[0] & 0xffffu);
        if (rpe == RPE0 && set == 4 && C.tid < RPE0 - (4 * CAPL + 4 * CAPC)) { const int s = 4 * CAPL + 4 * CAPC + C.tid; SEL[e * rpe + s] = 0; GSEL[e * rpe + s] = 0.f; }
        __syncthreads();
    }
}
__device__ __forceinline__ void gather_phase(const Ctx& C, int nrows, const int* SEL, const bf16* HB, bf16* XG) {
    for (int r = C.gw; r < nrows; r += C.NGW) { const int src = SEL[r];
        const v4u a = *(const v4u*)(HB + (size_t)src * 1024 + 8 * C.lane), b = *(const v4u*)(HB + (size_t)src * 1024 + 512 + 8 * C.lane);
        *(v4u*)(XG + (size_t)r * 1024 + 8 * C.lane) = a; *(v4u*)(XG + (size_t)r * 1024 + 512 + 8 * C.lane) = b; }
}

__device__ __forceinline__ f32x4 mfma16(bf16x8 a, bf16x8 b, f32x4 c) { return __builtin_amdgcn_mfma_f32_16x16x32_bf16(a, b, c, 0, 0, 0); }
#define PRJ_AT(qn, h_, row_) (PRJ + (((size_t)((qn) * NH + (h_)) * R + (size_t)(row_)) * HD))
#define DH_AT(buf, dir_, h_, row_) ((buf) + (((size_t)((dir_) * NH + (h_)) * NLAT + (size_t)(row_)) * HD))
constexpr int QROW = 272, TROW = 144;
constexpr int SC_QG = 0, SC_KT = 17408, SC_KGT = 34816  , SC_VT = 71680  , SC_SC = 108544, SC_SEG = 117760, SC_PCH = 121856  , SC_PG = 122880;
static_assert(SC_PG + 512 <= 131072, "scan LDS map");

__device__ __forceinline__ void scanA_phase(const Ctx& C, const bf16* PRJ, const float* LB, bf16* OLOC, bf16* QGG, float* SLOC, float* PTOT) {
    LAS unsigned char* L = C.lds;
    LAS float* SEG = (LAS float*)(L + SC_SEG); LAS float* PG = (LAS float*)(L + SC_PG);
    const int lane = C.lane, w = C.wave, g = lane >> 4, lr = lane & 15, k0 = 2 * lane, seg = w;
    for (int ui = C.vcu; ui < NSEQ * NGRP; ui += C.G) {
        int seq, grp; if (ui < NSEQ * 16) { seq = ui >> 4; grp = 1 + (ui & 15); } else { seq = ui - NSEQ * 16; grp = 0; }
        const int b = seq >> 4, h = (seq >> 1) & 7, dir = seq & 1, nch = grp ? 8 : 4, sgn = dir ? -1 : 1;
        const int hc = h * HD;
        f32x4 S[8];
#pragma unroll
        for (int i = 0; i < 8; ++i) S[i] = (f32x4){0.f, 0.f, 0.f, 0.f};
        if (C.tid < 128) PG[C.tid] = 1.0f;
        const int Pb = grp ? (grp - 1) * 512 : 0, rbase = grp ? b * T : NLAT + b * TCX, tlen = grp ? T : TCX;
#define ROWC(c) (rbase + (dir ? tlen - 1 - (Pb + 64 * (c)) : Pb + 64 * (c)))
        unsigned fq[8], qq[8]; v4u vv[2];
        float pl0[8], pl1[8], kk0[8], kk1[8], pg0 = 1.f, pg1 = 1.f, pt0 = 1.f, pt1 = 1.f;
#define SC_LOAD(c) do { const int rn_ = ROWC(c); \
            _Pragma("unroll") for (int i = 0; i < 8; ++i) { const int rw_ = rn_ + sgn * (8 * seg + i); fq[i] = __builtin_nontemporal_load((const unsigned*)(PRJ_AT(1 + dir, h, rw_) + k0)); qq[i] = *(const unsigned*)(PRJ_AT(0, h, rw_) + k0); } \
            _Pragma("unroll") for (int ii = 0; ii < 2; ++ii) { const int cq = C.tid + 512 * ii; vv[ii] = *(const v4u*)(PRJ_AT(3, h, rn_ + sgn * ((cq >> 1) & 63)) + (((cq >> 7) << 1) | (cq & 1)) * 8); } } while (0)
#define SC_PREP1(c) do { float run0 = 1.f, run1 = 1.f; \
            _Pragma("unroll") for (int i = 0; i < 8; ++i) { kk0[i] = bflo(fq[i]); kk1[i] = bfhi(fq[i]);          \
                run0 *= 1.f - kk0[i]; run1 *= 1.f - kk1[i]; pl0[i] = run0; pl1[i] = run1; } \
            *(LAS f32x2*)(SEG + seg * 128 + k0) = (f32x2){run0, run1}; \
            _Pragma("unroll") for (int ii = 0; ii < 2; ++ii) { const int cq = C.tid + 512 * ii, p_ = (cq >> 1) & 63, v0 = (((cq >> 7) << 1) | (cq & 1)) * 8; LAS bf16* vt = (LAS bf16*)(L + SC_VT + ((c) & 1) * 18432) + p_; \
                const unsigned wds[4] = {vv[ii].x, vv[ii].y, vv[ii].z, vv[ii].w}; \
                _Pragma("unroll") for (int j = 0; j < 4; ++j) { vt[(v0 + 2 * j) * (TROW / 2)] = (bf16)(wds[j] & 0xffffu); vt[(v0 + 2 * j + 1) * (TROW / 2)] = (bf16)(wds[j] >> 16); } } \
            pg0 = PG[k0]; pg1 = PG[k0 + 1]; } while (0)
#define SC_PREP2(c) do { const int rc_ = ROWC(c); float pb0 = 1.f, pb1 = 1.f; pt0 = 1.f; pt1 = 1.f; \
            _Pragma("unroll") for (int s = 0; s < 8; ++s) { const f32x2 t = *(const LAS f32x2*)(SEG + s * 128 + k0); if (s < seg) { pb0 *= t.x; pb1 *= t.y; } pt0 *= t.x; pt1 *= t.y; } \
            unsigned kg0[4], kg1[4]; float kprev0 = 0.f, kprev1 = 0.f; \
            _Pragma("unroll") for (int i = 0; i < 8; ++i) { const int p_ = 8 * seg + i; \
                const float P0 = pb0 * pl0[i], P1 = pb1 * pl1[i]; \
                const float qg0 = bflo(qq[i]) * P0, qg1 = bfhi(qq[i]) * P1; \
                const float kt0 = kk0[i] * __builtin_amdgcn_rcpf(fmaxf(P0, 1e-30f)), kt1 = kk1[i] * __builtin_amdgcn_rcpf(fmaxf(P1, 1e-30f)); \
                *(LAS unsigned*)(L + SC_QG + p_ * QROW + k0 * 2) = pk2(qg0, qg1); \
                *(LAS unsigned*)(L + SC_KT + p_ * QROW + k0 * 2) = pk2(kt0, kt1); \
                const float a0 = kt0 * pt0, a1 = kt1 * pt1; \
                if (i & 1) { kg0[i >> 1] = pk2(kprev0, a0); kg1[i >> 1] = pk2(kprev1, a1); } else { kprev0 = a0; kprev1 = a1; } \
                if (grp) *(unsigned*)(DH_AT(QGG, dir, h, rc_ + sgn * p_) + k0) = pk2(qg0 * pg0, qg1 * pg1); } \
            *(LAS v4u*)(L + SC_KGT + ((c) & 1) * 18432 + k0 * TROW + seg * 16) = (v4u){kg0[0], kg0[1], kg0[2], kg0[3]}; \
            *(LAS v4u*)(L + SC_KGT + ((c) & 1) * 18432 + (k0 + 1) * TROW + seg * 16) = (v4u){kg1[0], kg1[1], kg1[2], kg1[3]}; \
            if (seg == 0) *(LAS f32x2*)(L + SC_PCH + ((c) & 1) * 512 + k0 * 4) = (f32x2){pt0, pt1}; \
            if ((c) + 1 < nch) SC_LOAD((c) + 1); } while (0)
#define SC_SCORES() do { if (seg == 0) *(LAS f32x2*)(PG + k0) = (f32x2){pg0 * pt0, pg1 * pt1}; \
            const int pi = w >> 1; \
            _Pragma("unroll") for (int tt = 0; tt < 2; ++tt) { const int si = 2 * (w & 1) + tt; f32x4 acc = (f32x4){0.f, 0.f, 0.f, 0.f}; \
                _Pragma("unroll") for (int ks = 0; ks < 4; ++ks) { const bf16x8 a = *(const LAS bf16x8*)(L + SC_QG + (16 * pi + lr) * QROW + (32 * ks + 8 * g) * 2); \
                    const bf16x8 bb = *(const LAS bf16x8*)(L + SC_KT + (16 * si + lr) * QROW + (32 * ks + 8 * g) * 2); acc = mfma16(a, bb, acc); } \
                _Pragma("unroll") for (int r = 0; r < 4; ++r) { const int p_ = 16 * pi + 4 * g + r, s_ = 16 * si + lr; const float val = (s_ <= p_) ? acc[r] : 0.f; \
                    *(LAS bf16*)(L + SC_SC + p_ * TROW + s_ * 2) = (bf16)(pk2(val, 0.f) & 0xffffu); } } } while (0)
#define SC_OUTPUTS(c) do { const int rc_ = ROWC(c); const LAS unsigned char* VTc = L + SC_VT + ((c) & 1) * 18432; f32x4 O[4]; \
            _Pragma("unroll") for (int pt = 0; pt < 4; ++pt) O[pt] = (f32x4){0.f, 0.f, 0.f, 0.f}; \
            _Pragma("unroll") for (int ks = 0; ks < 4; ++ks) { \
                v4u sw; sw.x = pk2(S[2 * ks][0], S[2 * ks][1]); sw.y = pk2(S[2 * ks][2], S[2 * ks][3]); sw.z = pk2(S[2 * ks + 1][0], S[2 * ks + 1][1]); sw.w = pk2(S[2 * ks + 1][2], S[2 * ks + 1][3]); \
                const bf16x8 sb = __builtin_bit_cast(bf16x8, sw); \
                _Pragma("unroll") for (int pt = 0; pt < 4; ++pt) { const LAS unsigned char* qp = L + SC_QG + (16 * pt + lr) * QROW + (32 * ks + 4 * g) * 2; \
                    const v2u lo = *(const LAS v2u*)qp, hi = *(const LAS v2u*)(qp + 32); \
                    const bf16x8 a = __builtin_bit_cast(bf16x8, (v4u){lo.x, lo.y, hi.x, hi.y}); O[pt] = mfma16(sb, a, O[pt]); } } \
            _Pragma("unroll") for (int ks = 0; ks < 2; ++ks) { const bf16x8 bvk = *(const LAS bf16x8*)(VTc + (16 * w + lr) * TROW + (32 * ks + 8 * g) * 2); \
                _Pragma("unroll") for (int pt = 0; pt < 4; ++pt) { const bf16x8 a = *(const LAS bf16x8*)(L + SC_SC + (16 * pt + lr) * TROW + (32 * ks + 8 * g) * 2); O[pt] = mfma16(bvk, a, O[pt]); } } \
            if (grp) { _Pragma("unroll") for (int pt = 0; pt < 4; ++pt) { const int p_ = 16 * pt + lr; \
                *(v2u*)(DH_AT(OLOC, dir, h, rc_ + sgn * p_) + 16 * w + 4 * g) = (v2u){pk2(O[pt][0], O[pt][1]), pk2(O[pt][2], O[pt][3])}; } } } while (0)
#define SC_UPDATE(c) do { const LAS unsigned char* VTc = L + SC_VT + ((c) & 1) * 18432; const LAS unsigned char* KGc = L + SC_KGT + ((c) & 1) * 18432; const LAS float* PCc = (const LAS float*)(L + SC_PCH + ((c) & 1) * 512); \
            bf16x8 bv[2]; \
            _Pragma("unroll") for (int ks = 0; ks < 2; ++ks) bv[ks] = *(const LAS bf16x8*)(VTc + (16 * w + lr) * TROW + (32 * ks + 8 * g) * 2); \
            _Pragma("unroll") for (int kt = 0; kt < 8; ++kt) { const f32x4 pc = *(const LAS f32x4*)(PCc + 16 * kt + 4 * g); S[kt] = S[kt] * pc; \
                _Pragma("unroll") for (int ks = 0; ks < 2; ++ks) { const bf16x8 a = *(const LAS bf16x8*)(KGc + (16 * kt + lr) * TROW + (32 * ks + 8 * g) * 2); S[kt] = mfma16(a, bv[ks], S[kt]); } } } while (0)
        SC_LOAD(0);
        __syncthreads();
        SC_PREP1(0);
        __syncthreads();
        SC_PREP2(0);
        __syncthreads();
        SC_SCORES();
        __syncthreads();
#pragma unroll 1
        for (int c = 0; c < nch; ++c) {
            const bool more = c + 1 < nch;
            if (more) SC_PREP1(c + 1);
            SC_OUTPUTS(c);
            __syncthreads();
            if (more) SC_PREP2(c + 1);
            SC_UPDATE(c);
            __syncthreads();
            if (more) SC_SCORES();
            __syncthreads();
        }
        if (grp < 16) {
#pragma unroll
            for (int kt = 0; kt < 8; ++kt) *(f32x4*)(SLOC + ((((size_t)seq * 16 + grp) * 128 + 16 * w + lr) * 128 + 16 * kt + 4 * g)) = S[kt]; }
        if (C.tid < 128) PTOT[((size_t)seq * NGRP + grp) * 128 + C.tid] = PG[C.tid];
        __syncthreads();
#undef ROWC
#undef SC_LOAD
#undef SC_PREP1
#undef SC_PREP2
#undef SC_SCORES
#undef SC_OUTPUTS
#undef SC_UPDATE
    }
}
__device__ __forceinline__ void scanB_phase(const Ctx& C, const float* SLOC, const float* PTOT, bf16* SST) {
    for (int id = C.vcu * (NW * 64) + C.tid; id < NSEQ * 2048; id += C.G * NW * 64) {
        const int seq = id >> 11, v = (id >> 4) & 127, k = (id & 15) * 8;
        float s[8];
#pragma unroll
        for (int i = 0; i < 8; ++i) s[i] = 0.f;
#pragma unroll 4
        for (int gi = 0; gi < 16; ++gi) { const float* pt = PTOT + ((size_t)seq * NGRP + gi) * 128 + k; const float* sl = SLOC + ((((size_t)seq * 16 + gi) * 128 + v) * 128 + k);
            const f32x4 p0 = *(const f32x4*)pt, p1 = *(const f32x4*)(pt + 4), l0 = *(const f32x4*)sl, l1 = *(const f32x4*)(sl + 4);
#pragma unroll
            for (int i = 0; i < 4; ++i) { s[i] = p0[i] * s[i] + l0[i]; s[4 + i] = p1[i] * s[4 + i] + l1[i]; }
            v4u o; o.x = pk2(s[0], s[1]); o.y = pk2(s[2], s[3]); o.z = pk2(s[4], s[5]); o.w = pk2(s[6], s[7]);
            *(v4u*)(SST + (((size_t)seq * 16 + gi) * 128 + v) * 128 + k) = o; }
    }
}
__device__ __forceinline__ void readout_phase(const Ctx& C, const bf16* PRJ, const bf16* OLOC, const bf16* QGG, const bf16* SST, const float* norm_g, bf16* YH) {
    LAS unsigned char* L = C.lds;
    constexpr int ABUF = 64 * QROW;
    LAS float* OT = (LAS float*)(L + 4 * ABUF);
    const int lane = C.lane, w = C.wave, g = lane >> 4, lr = lane & 15;
    const int p = C.tid >> 3, sg = C.tid & 7;
    f32x4 ng[4];
#pragma unroll
    for (int i = 0; i < 4; ++i) ng[i] = *(const f32x4*)(norm_g + 8 * sg + 64 * (i >> 1) + 4 * (i & 1));
    for (int ui = C.vcu; ui < NB * NH * 16; ui += C.G) {
        const int j = ui & 15, h = (ui >> 4) & 7, b = ui >> 7, hc = h * HD, row00 = b * T + 512 * j;
        bf16x8 bfr[2][4];
#pragma unroll
        for (int dir = 0; dir < 2; ++dir) { const int seq = (b * 8 + h) * 2 + dir, gs = dir ? 15 - j : j;
            const bf16* Bb = SST + (((size_t)seq * 16 + gs) * 128 + 16 * w + lr) * 128;
#pragma unroll
            for (int ks = 0; ks < 4; ++ks) bfr[dir][ks] = *(const bf16x8*)(Bb + 32 * ks + 8 * g); }
        v4u ar[2][2];
#define RO_LOADA(tile) do { _Pragma("unroll") for (int dir = 0; dir < 2; ++dir) _Pragma("unroll") for (int ii = 0; ii < 2; ++ii) { const int cq = C.tid + 512 * ii; \
            ar[dir][ii] = __builtin_nontemporal_load((const v4u*)(DH_AT(QGG, dir, h, row00 + 64 * (tile) + (cq >> 4)) + (cq & 15) * 8)); } } while (0)
#define RO_WRITEA(buf) do { _Pragma("unroll") for (int dir = 0; dir < 2; ++dir) _Pragma("unroll") for (int ii = 0; ii < 2; ++ii) { const int cq = C.tid + 512 * ii; \
            *(LAS v4u*)(L + ((buf) * 2 + dir) * ABUF + (cq >> 4) * QROW + (cq & 15) * 16) = ar[dir][ii]; } } while (0)
        RO_LOADA(0); RO_WRITEA(0);
        __syncthreads();
#pragma unroll 1
        for (int t = 0; t < 8; ++t) {
            const int buf = t & 1; const size_t row = (size_t)row00 + 64 * t + p; const int c0 = hc + 8 * sg;
            if (t < 7) RO_LOADA(t + 1);
            v4u eo[2][2]; v4u eg[2];
#pragma unroll
            for (int dir = 0; dir < 2; ++dir) { const bf16* op = DH_AT(OLOC, dir, h, row) + 8 * sg; eo[dir][0] = __builtin_nontemporal_load((const v4u*)op); eo[dir][1] = __builtin_nontemporal_load((const v4u*)(op + 64)); }
            { const bf16* gp = PRJ_AT(4, h, row) + 8 * sg; eg[0] = __builtin_nontemporal_load((const v4u*)gp); eg[1] = __builtin_nontemporal_load((const v4u*)(gp + 64)); }
            f32x4 O[4];
#pragma unroll
            for (int pt = 0; pt < 4; ++pt) O[pt] = (f32x4){0.f, 0.f, 0.f, 0.f};
#pragma unroll
            for (int dir = 0; dir < 2; ++dir)
#pragma unroll
                for (int ks = 0; ks < 4; ++ks)
#pragma unroll
                    for (int pt = 0; pt < 4; ++pt) { const bf16x8 a = *(const LAS bf16x8*)(L + (buf * 2 + dir) * ABUF + (16 * pt + lr) * QROW + (32 * ks + 8 * g) * 2); O[pt] = mfma16(a, bfr[dir][ks], O[pt]); }
#pragma unroll
            for (int pt = 0; pt < 4; ++pt)
#pragma unroll
                for (int r = 0; r < 4; ++r) OT[(16 * pt + 4 * g + r) * 132 + 16 * w + lr] = O[pt][r];
            if (t < 7) RO_WRITEA(buf ^ 1);
            __syncthreads();
            f32x4 o[4];
#pragma unroll
            for (int i = 0; i < 4; ++i) o[i] = *(const LAS f32x4*)(OT + p * 132 + 8 * sg + 64 * (i >> 1) + 4 * (i & 1));
#pragma unroll
            for (int dir = 0; dir < 2; ++dir) { const v4u a = eo[dir][0], bq = eo[dir][1];
                o[0] += (f32x4){bflo(a.x), bfhi(a.x), bflo(a.y), bfhi(a.y)}; o[1] += (f32x4){bflo(a.z), bfhi(a.z), bflo(a.w), bfhi(a.w)};
                o[2] += (f32x4){bflo(bq.x), bfhi(bq.x), bflo(bq.y), bfhi(bq.y)}; o[3] += (f32x4){bflo(bq.z), bfhi(bq.z), bflo(bq.w), bfhi(bq.w)}; }
            float ss = 0.f;
#pragma unroll
            for (int i = 0; i < 4; ++i) ss += (o[i].x * o[i].x + o[i].y * o[i].y) + (o[i].z * o[i].z + o[i].w * o[i].w);
            ss += __shfl_xor(ss, 1); ss += __shfl_xor(ss, 2); ss += __shfl_xor(ss, 4);
            const float rstd = rsqrtf(ss * (1.0f / 128.0f) + EPS);
            const unsigned gw[8] = {eg[0].x, eg[0].y, eg[0].z, eg[0].w, eg[1].x, eg[1].y, eg[1].z, eg[1].w};
            unsigned ow[8];
#pragma unroll
            for (int i = 0; i < 8; ++i) { const float g0 = bflo(gw[i]), g1 = bfhi(gw[i]);
                const float y0 = o[i >> 1][(2 * i) & 3] * rstd * ng[i >> 1][(2 * i) & 3] * (g0 * fsig(g0));
                const float y1 = o[i >> 1][(2 * i + 1) & 3] * rstd * ng[i >> 1][(2 * i + 1) & 3] * (g1 * fsig(g1));
                ow[i] = pk2(y0, y1); }
            bf16* yp = YH + row * 1024 + c0;
            *(v4u*)yp = (v4u){ow[0], ow[1], ow[2], ow[3]}; *(v4u*)(yp + 64) = (v4u){ow[4], ow[5], ow[6], ow[7]};
            __syncthreads();
        }
#undef RO_LOADA
#undef RO_WRITEA
    }
}

constexpr int NPHASE = 22;
struct Args { const float* in[25]; float* out; unsigned char* ws; int ph_lo, ph_hi; };
constexpr int GRID_C = 256;
constexpr int CVQ_P5 = 8;
constexpr int TAILQ_P2 = 5, TAILQ_P4 = 9, TAILQ_P9 = 6, TAILQ_P11 = 3, TAILQ_P6 = 4, TAILQ_P17 = 3, TAILQ_P3 = 4, TAILQ_P12 = 5;
__device__ __forceinline__ int tail_waves(int nwg, int G) { const int extra = nwg % G; return extra ? (G - extra) * NW : 0; }
#define IDLE_CONVERT(first_, layer_, lo_, q_) do { const int G_ = GRID_C; if ((first_) < G_ && (int)blockIdx.x >= (first_)) { const Ctx Ct = make_ctx(lds_raw, g_wave); CArgs& pt = *opaque_args(); const int nw_ = (G_ - (first_)) * NW; \
        convert_moe(Ct, pt.in[21], pt.in[22], pt.in[23], (layer_), pt.ws, (lo_), min(MOE_ITEMS, (lo_) + (q_) * nw_), ((int)blockIdx.x - (first_)) * NW + Ct.wave, nw_); } } while (0)
__device__ __forceinline__ int idle_waves(int first, int G) { return first < G ? (G - first) * NW : 0; }
#define RANK_CONVERT(rank_, first_, layer_, lo_, q_) do { const int G_ = GRID_C; if ((first_) < G_ && (rank_) >= (first_)) { const Ctx Ct = make_ctx(lds_raw, g_wave); CArgs& pt = *opaque_args(); const int nw_ = (G_ - (first_)) * NW; \
        convert_moe(Ct, pt.in[21], pt.in[22], pt.in[23], (layer_), pt.ws, (lo_), min(MOE_ITEMS, (lo_) + (q_) * nw_), ((rank_) - (first_)) * NW + Ct.wave, nw_); } } while (0)
#define L0_R2 (TAILQ_P2 * tail_waves(NWG_P2, GRID_C))
#define L0_R4 (TAILQ_P4 * tail_waves(NWG_P4, GRID_C))
#define L0_R3 (TAILQ_P3 * tail_waves(1056, GRID_C))
#define L0_A (max(0, MOE_ITEMS - L0_R2 - L0_R3 - L0_R4))
#define L0_P0 (max(0, L0_A - CVQ_P5 * GRID_C * NW))
#define L1_R6 (TAILQ_P6 * idle_waves(128, GRID_C))
#define L1_R9 (TAILQ_P9 * tail_waves(NWG_P9, GRID_C))
#define L1_R11 (TAILQ_P11 * tail_waves(NWG_P11, GRID_C))
#define L1_R12 (TAILQ_P12 * tail_waves(NSEQ * NGRP, GRID_C))
#define L1_R17 (TAILQ_P17 * idle_waves(64, GRID_C))
#define L1_B (min(MOE_ITEMS, L1_R6 + L1_R9 + L1_R11 + L1_R12))
#define NWG_P2 ((R / 256) * 8)
#define NWG_P4 ((R / 256) * 4)
#define NWG_P9 ((NE * RPE0 / 256) * 4)
#define NWG_P11 ((R / 256) * 20)
#define TAIL_CONVERT(nwg_, layer_, lo_, q_) do { const int G_ = GRID_C, extra_ = (nwg_) % G_; if (extra_ && (int)blockIdx.x >= extra_) { const Ctx Ct = make_ctx(lds_raw, g_wave); CArgs& pt = *opaque_args(); const int nw_ = (G_ - extra_) * NW; \
        convert_moe(Ct, pt.in[21], pt.in[22], pt.in[23], (layer_), pt.ws, (lo_), min(MOE_ITEMS, (lo_) + (q_) * nw_), ((int)blockIdx.x - extra_) * NW + Ct.wave, nw_); } } while (0)
typedef const __attribute__((address_space(4))) Args CArgs;
__device__ __forceinline__ CArgs* opaque_args() { unsigned long long p = (unsigned long long)__builtin_amdgcn_kernarg_segment_ptr(); asm volatile("" : "+s"(p)); return (CArgs*)p; }
__global__ void __launch_bounds__(NW * 64, 2) mk_fwd(Args args) {
    extern __shared__ __attribute__((aligned(16))) unsigned char lds_raw[];
    const int g_wave = __builtin_amdgcn_readfirstlane((int)threadIdx.x >> 6);
    const Ctx C0 = make_ctx(lds_raw, g_wave);
    unsigned char* const ws = opaque_args()->ws;
#if MK_SPLIT
    const int lo = args.ph_lo, hi = args.ph_hi;
#else
    constexpr int lo = 0, hi = NPHASE;
#endif
    volatile LAS unsigned* MISC = (volatile LAS unsigned*)(C0.lds + MISC_OFF);
    for (int u = C0.tid; u < 128; u += NW * 64) ((LAS unsigned*)(C0.lds + MISC_OFF - 320))[u] = 0u;
    __syncthreads();
    if (hi - lo > 1) (void)xcd_barrier_post((unsigned*)(ws + WS_CTL) + CW_BAR, MISC + 8, g_wave);
#ifndef MK_PHMASK
#define MK_PHMASK 0x3fffff
#endif
#define INR(k) (lo <= (k) && (k) < hi)
#define IN(k) ((((MK_PHMASK) >> (k)) & 1) && INR(k))
#ifndef MK_TIME_A
#define MK_TIME_A -2
#define MK_TIME_B -2
#endif
#define MK_TIME_PHASE (MK_TIME_A > -2 ? 1 : -1)
#ifndef MK_PRB
#define MK_PRB 0
#endif
#ifndef MK_PRB20
#define MK_PRB20 0
#endif
#ifndef MK_PRB11
#define MK_PRB11 0
#endif
#ifndef MK_MB
#define MK_MB 0
#endif
#ifndef MK_CLOCK
#define MK_CLOCK 0
#endif
#define SEAM(k) do { if (INR(k) && INR((k) + 1)) { XcdBarrier b_; b_.bar = (unsigned*)(opaque_args()->ws + WS_CTL) + CW_BAR; b_.x = xb_xcc_id(); b_.st = (volatile LAS unsigned*)((LAS unsigned char*)lds_raw + MISC_OFF) + 8; xcd_barrier(b_, g_wave); } \
    if (MK_TIME_A > -2 && blockIdx.x == 0 && TID_OF(g_wave) == 0) { const unsigned long long t_ = __builtin_amdgcn_s_memrealtime(); \
        const unsigned long long c_ = __builtin_amdgcn_s_memtime(); \
        if ((k) == MK_TIME_A) { ((unsigned long long*)(ws + WS_CTL))[1024] = t_; ((unsigned long long*)(ws + WS_CTL))[1026] = c_; } \
        if ((k) == MK_TIME_B) { const unsigned long long t0_ = ((unsigned long long*)(ws + WS_CTL))[1024]; const unsigned long long c0_ = ((unsigned long long*)(ws + WS_CTL))[1026]; \
            ((float*)(ws + WS_CTL))[2050] = MK_CLOCK ? ((float)(c_ - c0_) / (float)(t_ - t0_)) * 0.125f : (float)(t_ - t0_) * 0.00125f; } } } while (0)
#ifndef MK_REP_PHASE
#define MK_REP_PHASE -1
#endif
#define REP(k) for (int _rep = 0; _rep < ((k) == MK_REP_PHASE ? 3 : 1); ++_rep, __syncthreads())

#define P_x ((const float*)pa.in[0])
#define P_ctx_in ((const float*)pa.in[2])
#define P_MV ((float*)(ws + WS_MV))
#define P_LBT ((float*)(ws + WS_LB))
#define P_AFF ((float*)(ws + WS_AFF))
#define P_INV ((short*)(ws + WS_INV))
#define P_SEL ((int*)(ws + WS_SEL))
#define P_GSEL ((float*)(ws + WS_GSEL))
#define P_CTXS ((float*)(ws + WS_CTXS))
#define P_HB ((bf16*)(ws + WS_HB))
#define P_UB ((bf16*)(ws + WS_UB))
#define P_HB8 (ws + WS_UB)
#define P_HBUF8 (ws + WS_HBUF)
#define P_XG ((bf16*)(ws + WS_XG))
#define P_PRJ ((bf16*)(ws + WS_PRJ))
#define P_OLOC ((bf16*)(ws + WS_OLOC))
#define P_QGG ((bf16*)(ws + WS_QGG))
#define P_SLOC ((float*)(ws + WS_UB))
#define P_PTOT ((float*)(ws + WS_PTOT))
#define P_SST ((bf16*)(ws + WS_SST))
#define P_YH ((bf16*)(ws + WS_UB))
#define P_out (pa.out)

#if MK_MB >= 3
    if (blockIdx.x == 0) {
        const int ln = lane_id();
        if (g_wave == 4 && MK_MB != 5) {
            pg8::v8i_t a8, b8;
#pragma unroll
            for (int i = 0; i < 8; ++i) { a8[i] = 0x38383838 + ln * (i + 1); b8[i] = 0x3a3a3a3a + ln * (2 * i + 1); }
            pg8::bf16x8 a16 = __builtin_bit_cast(pg8::bf16x8, (v4u){0x3f803f80u + ln, 0x3f803f80u, 0x3f003f00u + ln, 0x3f803f80u}), b16 = __builtin_bit_cast(pg8::bf16x8, (v4u){0x3f803f80u, 0x3f003f00u + ln, 0x3f803f80u, 0x3f803f80u});
            f32x4 ac[16];
#pragma unroll
            for (int j = 0; j < 16; ++j) ac[j] = (f32x4){0.f, 0.f, 0.f, 0.f};
            __builtin_amdgcn_s_setprio(1);
#pragma unroll 1
            for (int it = 0; it < 64; ++it) {
#pragma unroll
                for (int j = 0; j < 16; ++j) { if (MK_MB == 3) ac[j] = __builtin_amdgcn_mfma_scale_f32_16x16x128_f8f6f4(a8, b8, ac[j], 0, 0, 0, 0, 0, 0); else { ac[j] = __builtin_amdgcn_mfma_f32_16x16x32_bf16(a16, b16, ac[j], 0, 0, 0); ac[j] = __builtin_amdgcn_mfma_f32_16x16x32_bf16(b16, a16, ac[j], 0, 0, 0); } }
                asm volatile("" ::: "memory"); }
            __builtin_amdgcn_s_setprio(0);
            f32x4 sm = ac[0];
#pragma unroll
            for (int j = 1; j < 16; ++j) sm += ac[j];
            ((float*)(ws + WS_CTL))[3000 + ln] = sm[0] + sm[1] + sm[2] + sm[3];
        }
        if (g_wave == 0) {
            __builtin_amdgcn_s_sleep(40);
            const LAS unsigned char* base = (const LAS unsigned char*)lds_raw + ln * 16;
            v4u acc4 = (v4u){0u, 0u, 0u, 0u};
            const unsigned long long t0 = __builtin_amdgcn_s_memtime();
#pragma unroll 1
            for (int it = 0; it < 16; ++it) { v4u r[16];
#pragma unroll
                for (int j = 0; j < 16; ++j) r[j] = *(const LAS v4u*)(base + j * 1024 + (it & 3) * 16384);
#pragma unroll
                for (int j = 0; j < 16; ++j) acc4 ^= r[j];
                asm volatile("" ::: "memory"); }
            const unsigned long long t1 = __builtin_amdgcn_s_memtime();
            ((unsigned*)(ws + WS_CTL))[3100 + ln] = acc4.x ^ acc4.y ^ acc4.z ^ acc4.w;
            if (ln == 0) pg8::g_probe_val = (float)(t1 - t0) * (1.0f / 16.0f) * 0.01f;
        }
        __syncthreads();
    }
#elif MK_MB
    if (blockIdx.x == 0 && g_wave == 0) {
        const int ln = lane_id();
        pg8::v8i_t a8, b8;
#pragma unroll
        for (int i = 0; i < 8; ++i) { a8[i] = 0x38383838 + ln * (i + 1); b8[i] = 0x3a3a3a3a + ln * (2 * i + 1); }
        pg8::bf16x8 a16 = __builtin_bit_cast(pg8::bf16x8, (v4u){0x3f803f80u + ln, 0x3f803f80u, 0x3f003f00u + ln, 0x3f803f80u}), b16 = __builtin_bit_cast(pg8::bf16x8, (v4u){0x3f803f80u, 0x3f003f00u + ln, 0x3f803f80u, 0x3f803f80u});
        f32x4 ac[16];
#pragma unroll
        for (int j = 0; j < 16; ++j) ac[j] = (f32x4){0.f, 0.f, 0.f, 0.f};
        const unsigned long long t0 = __builtin_amdgcn_s_memtime();
#pragma unroll 1
        for (int it = 0; it < 64; ++it) {
#pragma unroll
            for (int j = 0; j < 16; ++j) { if (MK_MB == 1) ac[j] = __builtin_amdgcn_mfma_scale_f32_16x16x128_f8f6f4(a8, b8, ac[j], 0, 0, 0, 0, 0, 0); else ac[j] = __builtin_amdgcn_mfma_f32_16x16x32_bf16(a16, b16, ac[j], 0, 0, 0); }
            asm volatile("" ::: "memory"); }
        f32x4 sm = ac[0];
#pragma unroll
        for (int j = 1; j < 16; ++j) sm += ac[j];
        const unsigned long long t1 = __builtin_amdgcn_s_memtime();
        ((float*)(ws + WS_CTL))[3000 + ln] = sm[0] + sm[1] + sm[2] + sm[3];
        if (ln == 0) pg8::g_probe_val = (float)(t1 - t0) * (1.0f / 1024.0f) * 0.1f;
    }
#endif
    if (MK_TIME_A == -1 && blockIdx.x == 0 && TID_OF(g_wave) == 0) ((unsigned long long*)(ws + WS_CTL))[1024] = __builtin_amdgcn_s_memrealtime();
    if (IN(0)) REP(0) { const Ctx C = make_ctx(lds_raw, g_wave); CArgs& pa = *opaque_args(); unsigned char* const ws = pa.ws;
        mod_gemv(C, pa.in[1], pa.in[3], pa.in[4], pa.in[5], P_MV);
        for (int i = C.vcu * NW * 64 + C.tid; i < 2048; i += C.G * NW * 64) { const float* lg = pa.in[17]; P_LBT[i] = fsig(lg[2048 + i] - lg[i]); }
        __syncthreads();
        convert_small(C, pa.in[8], pa.in[14], pa.in[16], pa.in[19], ws, 0, CS_EARLY);
        convert_moe(C, pa.in[21], pa.in[22], pa.in[23], 0, ws, 0, L0_P0, C.gw, C.NGW);
    }
    SEAM(0);
    if (IN(1)) REP(1) { const Ctx C = make_ctx(lds_raw, g_wave); CArgs& pa = *opaque_args(); unsigned char* const ws = pa.ws; RowArgs A{}; A.src_lat = P_x; A.src_ctx = P_ctx_in; A.gamma = pa.in[6]; A.mv = P_MV; A.i_shift = 0; A.i_scale = 1; A.i_gate = 2; A.HB = P_HB; A.xb = (bf16*)(ws + WS_XB); A.nrows = R;
        row_phase<false, false, false>(C, A); }
    SEAM(1);
    if (IN(2)) REP(2) { const Ctx C = make_ctx(lds_raw, g_wave); CArgs& pa = *opaque_args(); unsigned char* const ws = pa.ws; pg8::Gemm g{P_HB, (const bf16*)(ws + WS_W1T), R, 2048, 1024}; pg8::StaticOrder S; S.init(R, 2048, C.G, (int)blockIdx.x);
        pg8::EpiGated<0> E{P_UB, 1024, pa.in[9], 1024};
        pg8::gemm_phase<pg8::EpiGated<0>, pg8::StaticOrder, true, true>(C.lds, g, S, E, C.wave);
        TAIL_CONVERT(NWG_P2, 0, min(MOE_ITEMS, L0_A + L0_R3), TAILQ_P2); }
    SEAM(2);
    if (IN(3)) REP(3) { const Ctx C = make_ctx(lds_raw, g_wave); CArgs& pa = *opaque_args(); unsigned char* const ws = pa.ws; conv_phase(C, P_UB, P_HB, pa.in[10], pa.in[11], pa.in[12], pa.in[13]); RANK_CONVERT(C.vcu, 1056 % GRID_C, 0, L0_A, TAILQ_P3); }
    SEAM(3);
    if (IN(4)) REP(4) { const Ctx C = make_ctx(lds_raw, g_wave); CArgs& pa = *opaque_args(); unsigned char* const ws = pa.ws; pg8::Gemm g{P_HB, (const bf16*)(ws + WS_W2T), R, 1024, 1024}; pg8::StaticOrder S; S.init(R, 1024, C.G, (int)blockIdx.x);
        pg8::EpiDelta E{(bf16*)(ws + WS_OLOC), 1024, pa.in[15], P_MV + 2 * 1024, 6144};
        pg8::gemm_phase<pg8::EpiDelta, pg8::StaticOrder, true, true>(C.lds, g, S, E, C.wave);
        TAIL_CONVERT(NWG_P4, 0, min(MOE_ITEMS, L0_A + L0_R3 + L0_R2), TAILQ_P4); }
    SEAM(4);
    if (IN(5)) REP(5) { const Ctx C = make_ctx(lds_raw, g_wave); CArgs& pa = *opaque_args(); unsigned char* const ws = pa.ws; RowArgs A{}; A.src16 = (const bf16*)(ws + WS_XB); A.delta = (const bf16*)(ws + WS_OLOC); A.gamma = pa.in[7]; A.mv = P_MV; A.i_shift = 3; A.i_scale = 4; A.i_gate = 5; A.HB = P_HB; A.HB8 = P_HB8; A.AFF = P_AFF; A.router_w = pa.in[20]; A.nrows = R;
        A.cv_wg = pa.in[21]; A.cv_wu = pa.in[22]; A.cv_wd = pa.in[23]; A.cv_ws = ws; A.cv_layer = 0; A.cv_lo = L0_P0; A.cv_hi = L0_A; A.cs_w1 = pa.in[8]; A.cs_w2 = pa.in[14]; A.cs_win = pa.in[16]; A.cs_wout = pa.in[19]; A.cs_lo = CS_EARLY; A.cs_hi = CS_ALL;
        row_phase<false, true, false>(C, A); }
    SEAM(5);
    if (IN(6)) REP(6) { const Ctx C = make_ctx(lds_raw, g_wave); CArgs& pa = *opaque_args(); unsigned char* const ws = pa.ws; topk_phase(C, 128, RPE0, P_AFF, P_SEL, P_GSEL, P_INV); IDLE_CONVERT(128, 1, 0, TAILQ_P6); }
    SEAM(6);
    if (IN(8)) REP(8) { const Ctx C = make_ctx(lds_raw, g_wave); CArgs& pa = *opaque_args(); unsigned char* const ws = pa.ws; pg8::Gemm g{(const bf16*)P_HB8, (const bf16*)(ws + WS_W13T), NE * RPE0, 4096, 1024}; pg8::StaticOrder S; S.init(NE * RPE0, 4096, C.G, (int)blockIdx.x, RPE0 / 256);
        pg8::EpiSwiGLU8 E{P_HBUF8, 2048, 1.0f / 32.0f};
        pg8::gemm_phase_f8<pg8::EpiSwiGLU8, pg8::StaticOrder, true, true, true, 1024>(C.lds, g, S, E, C.wave, P_SEL, (LAS unsigned*)(C.lds + GTAB_OFF)); }
    SEAM(8);
    if (IN(9)) REP(9) { const Ctx C = make_ctx(lds_raw, g_wave); CArgs& pa = *opaque_args(); unsigned char* const ws = pa.ws; pg8::Gemm g{(const bf16*)P_HBUF8, (const bf16*)(ws + WS_WDT), NE * RPE0, 1024, 2048}; pg8::StaticOrder S; S.init(NE * RPE0, 1024, C.G, (int)blockIdx.x, RPE0 / 256);
        pg8::EpiScaleRow E{(unsigned char*)P_XG, 1024, P_GSEL, 2.0f};
        pg8::gemm_phase_f8<pg8::EpiScaleRow, pg8::StaticOrder, true, true, false, 2048>(C.lds, g, S, E, C.wave);
        TAIL_CONVERT(NWG_P9, 1, L1_R6, TAILQ_P9); }
    SEAM(9);
    if (IN(10)) REP(10) { const Ctx C = make_ctx(lds_raw, g_wave); CArgs& pa = *opaque_args(); unsigned char* const ws = pa.ws; RowArgs A{}; A.src16 = (const bf16*)(ws + WS_XB); A.delta = (const bf16*)(ws + WS_OLOC); A.dst16 = (bf16*)(ws + WS_S2B); A.gamma = pa.in[6] + 1024; A.mv = P_MV; A.i_shift = 0; A.i_scale = 1; A.i_gate = 5; A.HB = P_HB;
        A.Y = (const unsigned char*)P_XG; A.INV = P_INV; A.rpe = RPE0; A.nrows = R;
        A.HB8 = P_HB8; A.mv = P_MV + 5 * 6144; A.mvg = P_MV; row_phase<true, false, false, true>(C, A); }
    SEAM(10);
    if (IN(11)) REP(11) { const Ctx C = make_ctx(lds_raw, g_wave); CArgs& pa = *opaque_args(); unsigned char* const ws = pa.ws; pg8::Gemm g{(const bf16*)P_HB8, (const bf16*)(ws + WS_WINT), R, 5120, 1024}; pg8::StaticOrder S; S.init(R, 5120, C.G, (int)blockIdx.x);
        pg8::EpiBf16Q E{P_PRJ, 5120, P_LBT, R, 1.0f / 32.0f};
        pg8::gemm_phase_f8<pg8::EpiBf16Q, pg8::StaticOrder, true, true, false, 1024>(C.lds, g, S, E, C.wave);
        TAIL_CONVERT(NWG_P11, 1, L1_R6 + L1_R9, TAILQ_P11); }
    SEAM(11);
    if (IN(12)) REP(12) { const Ctx C = make_ctx(lds_raw, g_wave); CArgs& pa = *opaque_args(); unsigned char* const ws = pa.ws; scanA_phase(C, P_PRJ, P_LBT, P_OLOC, P_QGG, P_SLOC, P_PTOT); RANK_CONVERT(C.vcu, (NSEQ * NGRP) % GRID_C, 1, L1_R6 + L1_R9 + L1_R11, TAILQ_P12); }
    SEAM(12);
    if (IN(13)) REP(13) { const Ctx C = make_ctx(lds_raw, g_wave); CArgs& pa = *opaque_args(); unsigned char* const ws = pa.ws; scanB_phase(C, P_SLOC, P_PTOT, P_SST); }
    SEAM(13);
    if (IN(14)) REP(14) { const Ctx C = make_ctx(lds_raw, g_wave); CArgs& pa = *opaque_args(); unsigned char* const ws = pa.ws; readout_phase(C, P_PRJ, P_OLOC, P_QGG, P_SST, pa.in[18], P_YH); }
    SEAM(14);
    if (IN(15)) REP(15) { const Ctx C = make_ctx(lds_raw, g_wave); CArgs& pa = *opaque_args(); unsigned char* const ws = pa.ws; pg8::Gemm g{P_YH, (const bf16*)(ws + WS_WOUTT), NLAT, 1024, 1024}; pg8::StaticOrder S; S.init(NLAT, 1024, C.G, (int)blockIdx.x);
        pg8::EpiDelta E{(bf16*)(ws + WS_OLOC), 1024, nullptr, P_MV + 5 * 6144 + 2 * 1024, 6144};
        pg8::gemm_phase<pg8::EpiDelta, pg8::StaticOrder, true, true>(C.lds, g, S, E, C.wave); }
    SEAM(15);
    if (IN(16)) REP(16) { const Ctx C = make_ctx(lds_raw, g_wave); CArgs& pa = *opaque_args(); unsigned char* const ws = pa.ws; RowArgs A{}; A.src16 = (const bf16*)(ws + WS_S2B); A.delta = (const bf16*)(ws + WS_OLOC); A.gamma = pa.in[7] + 1024; A.mv = P_MV + 5 * 6144; A.i_shift = 3; A.i_scale = 4; A.i_gate = 5; A.HB = P_HB; A.HB8 = P_HB8; A.AFF = P_AFF; A.router_w = pa.in[20] + 16384; A.nrows = NLAT;
        A.cv_wg = pa.in[21]; A.cv_wu = pa.in[22]; A.cv_wd = pa.in[23]; A.cv_ws = ws; A.cv_layer = 1; A.cv_lo = L1_B; A.cv_hi = max(L1_B, MOE_ITEMS - L1_R17);
        row_phase<false, true, false>(C, A); }
    SEAM(16);
    if (IN(17)) REP(17) { const Ctx C = make_ctx(lds_raw, g_wave); CArgs& pa = *opaque_args(); unsigned char* const ws = pa.ws; topk_phase(C, 64, RPE1, P_AFF, P_SEL, P_GSEL, P_INV);
        IDLE_CONVERT(64, 1, max(L1_B, MOE_ITEMS - L1_R17), TAILQ_P17); }
    SEAM(17);
    if (IN(19)) REP(19) { const Ctx C = make_ctx(lds_raw, g_wave); CArgs& pa = *opaque_args(); unsigned char* const ws = pa.ws; pg8::Gemm g{(const bf16*)P_HB8, (const bf16*)(ws + WS_W13T_L1), NE * RPE1, 4096, 1024}; pg8::StaticOrder S; S.init(NE * RPE1, 4096, C.G, (int)blockIdx.x, RPE1 / 256);
        pg8::EpiSwiGLU8 E{P_HBUF8, 2048, 1.0f / 32.0f};
        pg8::gemm_phase_f8<pg8::EpiSwiGLU8, pg8::StaticOrder, true, true, true, 1024, MK_PRB>(C.lds, g, S, E, C.wave, P_SEL, (LAS unsigned*)(C.lds + GTAB_OFF)); }
    SEAM(19);
    if (IN(20)) REP(20) { const Ctx C = make_ctx(lds_raw, g_wave); CArgs& pa = *opaque_args(); unsigned char* const ws = pa.ws; pg8::Gemm g{(const bf16*)P_HBUF8, (const bf16*)(ws + WS_WDT_L1), NE * RPE1, 1024, 2048}; pg8::StaticOrder S; S.init(NE * RPE1, 1024, C.G, (int)blockIdx.x, RPE1 / 256);
        pg8::EpiScaleRow E{(unsigned char*)P_XG, 1024, P_GSEL, 2.0f};
        pg8::gemm_phase_f8<pg8::EpiScaleRow, pg8::StaticOrder, true, true, false, 2048, MK_PRB20>(C.lds, g, S, E, C.wave); }
    SEAM(20);
    if (IN(21)) REP(21) { const Ctx C = make_ctx(lds_raw, g_wave); CArgs& pa = *opaque_args(); unsigned char* const ws = pa.ws; RowArgs A{}; A.src16 = (const bf16*)(ws + WS_S2B); A.delta = (const bf16*)(ws + WS_OLOC); A.dst_lat = P_out; A.gamma = pa.in[24]; A.mv = P_MV + 5 * 6144; A.mvg = P_MV + 5 * 6144; A.i_gate = 5; A.Y = (const unsigned char*)P_XG; A.INV = P_INV; A.rpe = RPE1; A.nrows = NLAT;
        row_phase<true, false, true>(C, A);
        }
    if (MK_PRB || MK_PRB20 || MK_PRB11 || MK_MB) { const Ctx C = make_ctx(lds_raw, g_wave); CArgs& pa = *opaque_args(); { XcdBarrier b_; b_.bar = (unsigned*)(pa.ws + WS_CTL) + CW_BAR; b_.x = xb_xcc_id(); b_.st = (volatile LAS unsigned*)((LAS unsigned char*)lds_raw + MISC_OFF) + 8; xcd_barrier(b_, g_wave); }
        if (blockIdx.x == 0 && C.tid == 0) pa.out[0] += pg8::g_probe_val; }
    if (MK_TIME_A > -2) { const Ctx C = make_ctx(lds_raw, g_wave); CArgs& pa = *opaque_args(); { XcdBarrier b_; b_.bar = (unsigned*)(pa.ws + WS_CTL) + CW_BAR; b_.x = xb_xcc_id(); b_.st = (volatile LAS unsigned*)((LAS unsigned char*)lds_raw + MISC_OFF) + 8; xcd_barrier(b_, g_wave); }
        if (blockIdx.x == 0 && C.tid == 0) { float add = ((const float*)(ws + WS_CTL))[2050]; if (MK_TIME_B == 21) { const unsigned long long t0_ = ((unsigned long long*)(ws + WS_CTL))[1024]; add = (float)(__builtin_amdgcn_s_memrealtime() - t0_) * (MK_TIME_A == -1 ? 0.0001f : 0.00125f); } pa.out[0] += add; } }
#undef IN
#undef P_x
#undef P_ctx_in
#undef P_MV
#undef P_LBT
#undef P_AFF
#undef P_INV
#undef P_SEL
#undef P_GSEL
#undef P_CTXS
#undef P_HB
#undef P_UB
#undef P_HB8
#undef P_HBUF8
#undef P_XG
#undef P_PRJ
#undef P_OLOC
#undef P_QGG
#undef P_SLOC
#undef P_PTOT
#undef P_SST
#undef P_YH
#undef P_out
#undef REP
#undef INR
#undef SEAM
}

extern "C" void kernel_launch(void* const* d_in, const int* in_sizes, int n_in, void* d_out, int out_size, void* d_ws, size_t ws_size, hipStream_t stream) {
    static int grid = 0;
    if (grid == 0) {
        if (n_in != 25 || in_sizes[0] != NLAT * D || out_size != NLAT * D || ws_size < WS_END) { fprintf(stderr, "kernel_launch: unexpected shapes (n_in %d, in0 %d, out %d, ws %zu)\n", n_in, n_in > 0 ? in_sizes[0] : -1, out_size, ws_size); grid = -1; return; }
        int dev = 0, cus = 0, per_cu = 0;
        if (hipGetDevice(&dev) != hipSuccess || hipDeviceGetAttribute(&cus, hipDeviceAttributeMultiprocessorCount, dev) != hipSuccess) { grid = -1; return; }
        if (hipFuncSetAttribute((const void*)mk_fwd, hipFuncAttributeMaxDynamicSharedMemorySize, LDS_BYTES) != hipSuccess) { fprintf(stderr, "kernel_launch: hipFuncSetAttribute failed\n"); grid = -1; return; }
        if (hipOccupancyMaxActiveBlocksPerMultiprocessor(&per_cu, (const void*)mk_fwd, NW * 64, LDS_BYTES) != hipSuccess || per_cu < 1) { fprintf(stderr, "kernel_launch: occupancy query reports %d blocks per CU\n", per_cu); (void)hipGetLastError(); grid = -1; return; }
        if (cus != GRID_C) { fprintf(stderr, "kernel_launch: built for a %d-CU device, found %d CUs\n", GRID_C, cus); grid = -1; return; }
        grid = cus;
    }
    if (grid < 0) return;
    if (hipMemsetAsync((char*)d_ws + WS_CTL, 0, CTL_ZERO_BYTES, stream) != hipSuccess) { fprintf(stderr, "kernel_launch: memset failed\n"); return; }
    Args a{};
    for (int i = 0; i < 25; ++i) a.in[i] = (const float*)d_in[i];
    a.out = (float*)d_out; a.ws = (unsigned char*)d_ws;
#if MK_SPLIT
    for (int p = 0; p < NPHASE; ++p) { a.ph_lo = p; a.ph_hi = p + 1; hipLaunchKernelGGL(mk_fwd, dim3(grid), dim3(NW * 64), LDS_BYTES, stream, a); }
#else
    a.ph_lo = 0; a.ph_hi = NPHASE;
#ifndef MK_COOP
#define MK_COOP 1
#endif
#if MK_COOP
    void* kargs[] = {&a};
    hipError_t e = hipLaunchCooperativeKernel((const void*)mk_fwd, dim3(grid), dim3(NW * 64), kargs, LDS_BYTES, stream);
    if (e != hipSuccess) fprintf(stderr, "kernel_launch: cooperative launch failed: %s (grid %d)\n", hipGetErrorString(e), grid);
#else
    hipLaunchKernelGGL(mk_fwd, dim3(grid), dim3(NW * 64), LDS_BYTES, stream, a);
#endif
#endif
}
```
